# Optimizing an MI355X kernel written in HIP

```python
import jax, jax.numpy as jnp
from jax import lax
import numpy as np

D_MODEL = 1024
BATCH = 16
SEQ = 256
DEPTH = 2
DEC_BATCH = 2
DEC_SEQ = 4096
PAST_LEN = 512

GRID_W = 64
HEAD_DIM = 64
N_HEADS_A = 16
N_KV_A = 4
WINDOW = 128
BLOCK = 128
N_HEADS_B = 16
WIN_R = 8
WIN_C = 16
D_FF = 2816
CONV_W = 3
ROPE_BASE = 10000.0
EPS = 1e-6
SCALE = HEAD_DIM ** -0.5
N_A = (DEPTH + 1) // 2
N_B = DEPTH // 2

kernel_name = 'hybrid_prefix_diffusion_step'


def rmsnorm(x, w):
    xf = x.astype(jnp.float32)
    y = xf * lax.rsqrt(jnp.mean(xf * xf, axis=-1, keepdims=True) + EPS)
    return (y * w.astype(jnp.float32)).astype(x.dtype)


def adaln(cond, w_ada, b_ada):
    m = jax.nn.silu(cond) @ w_ada + b_ada
    return [t[:, None, :] for t in jnp.split(m, 6, axis=-1)]


def modulate(h, shift, scale):
    return h * (1 + scale) + shift


def project_qkv(h, w_qkv, qn, kn, n_heads, n_kv):
    b, l, _ = h.shape
    qkv = h @ w_qkv
    q, k, v = jnp.split(qkv, [n_heads * HEAD_DIM, (n_heads + n_kv) * HEAD_DIM], axis=-1)
    q = rmsnorm(q.reshape(b, l, n_heads, HEAD_DIM), qn)
    k = rmsnorm(k.reshape(b, l, n_kv, HEAD_DIM), kn)
    v = v.reshape(b, l, n_kv, HEAD_DIM)
    return q, k, v


def rope_1d(x, pos):
    half = x.shape[-1] // 2
    freqs = ROPE_BASE ** (-jnp.arange(half, dtype=jnp.float32) / half)
    ang = pos.astype(jnp.float32)[:, None] * freqs[None, :]
    cos = jnp.cos(ang)[:, None, :]
    sin = jnp.sin(ang)[:, None, :]
    xf = x.astype(jnp.float32)
    x1, x2 = xf[..., :half], xf[..., half:]
    return jnp.concatenate([x1 * cos - x2 * sin, x2 * cos + x1 * sin], axis=-1).astype(x.dtype)


def rope_2d(x):
    t = jnp.arange(x.shape[1])
    half = HEAD_DIM // 2
    return jnp.concatenate([rope_1d(x[..., :half], t // GRID_W), rope_1d(x[..., half:], t % GRID_W)], axis=-1)


def context_attention(q, k, v, sink):
    b, lc, h, _ = q.shape
    n_kv = k.shape[2]
    g = h // n_kv
    qg = q.reshape(b, lc, n_kv, g, HEAD_DIM)
    s = jnp.einsum('bqkgd,bckd->bkgqc', qg, k).astype(jnp.float32) * SCALE
    if sink is not None:
        sk = jnp.broadcast_to(sink.astype(jnp.float32).reshape(n_kv, g)[None, :, :, None, None], s.shape[:-1] + (1,))
        s = jnp.concatenate([s, sk], axis=-1)
    p = jax.nn.softmax(s, axis=-1)[..., :lc].astype(v.dtype)
    o = jnp.einsum('bkgqc,bckd->bqkgd', p, v)
    return o.reshape(b, lc, h * HEAD_DIM)


def window_attention_latent(q, k, v, kc, vc, sink):
    b, l, h, _ = q.shape
    n_kv = k.shape[2]
    g = h // n_kv
    lc = kc.shape[1]
    nb = l // BLOCK
    qb = q.reshape(b, nb, BLOCK, n_kv, g, HEAD_DIM)
    pad = ((0, 0), (BLOCK, BLOCK), (0, 0), (0, 0))
    kp = jnp.pad(k, pad).reshape(b, nb + 2, BLOCK, n_kv, HEAD_DIM)
    vp = jnp.pad(v, pad).reshape(b, nb + 2, BLOCK, n_kv, HEAD_DIM)
    kb = jnp.concatenate([kp[:, :-2], kp[:, 1:-1], kp[:, 2:]], axis=2)
    vb = jnp.concatenate([vp[:, :-2], vp[:, 1:-1], vp[:, 2:]], axis=2)
    qpos = jnp.arange(nb)[:, None] * BLOCK + jnp.arange(BLOCK)[None, :]
    kpos = jnp.arange(nb)[:, None] * BLOCK - BLOCK + jnp.arange(3 * BLOCK)[None, :]
    valid = (jnp.abs(qpos[:, :, None] - kpos[:, None, :]) <= WINDOW) & (kpos[:, None, :] >= 0) & (kpos[:, None, :] < l)
    s_loc = jnp.einsum('bnqkgd,bnjkd->bkgnqj', qb, kb).astype(jnp.float32) * SCALE
    s_loc = jnp.where(valid[None, None, None], s_loc, -jnp.inf)
    s_ctx = jnp.einsum('bnqkgd,bckd->bkgnqc', qb, kc).astype(jnp.float32) * SCALE
    s_sink = jnp.broadcast_to(sink.astype(jnp.float32).reshape(n_kv, g)[None, :, :, None, None, None], s_loc.shape[:-1] + (1,))
    p = jax.nn.softmax(jnp.concatenate([s_loc, s_ctx, s_sink], axis=-1), axis=-1)
    p_loc = p[..., :3 * BLOCK].astype(v.dtype)
    p_ctx = p[..., 3 * BLOCK:3 * BLOCK + lc].astype(v.dtype)
    o = jnp.einsum('bkgnqj,bnjkd->bnqkgd', p_loc, vb) + jnp.einsum('bkgnqc,bckd->bnqkgd', p_ctx, vc)
    return o.reshape(b, l, h * HEAD_DIM)


def neighborhood_attention_latent(q, k, v, kc, vc, rpb):
    b, l, h, _ = q.shape
    rows = l // GRID_W
    wr = min(WIN_R, rows)
    r = jnp.arange(rows)
    rs = jnp.clip(r - wr // 2, 0, rows - wr)
    key_rows = rs[:, None] + jnp.arange(wr)[None, :]
    qg = q.reshape(b, rows, GRID_W, h, HEAD_DIM)
    kg = k.reshape(b, rows, GRID_W, h, HEAD_DIM)[:, key_rows]
    vg = v.reshape(b, rows, GRID_W, h, HEAD_DIM)[:, key_rows]
    col = jnp.arange(GRID_W)
    cs = jnp.clip(col - WIN_C // 2, 0, GRID_W - WIN_C)
    col_ok = (col[None, :] >= cs[:, None]) & (col[None, :] < cs[:, None] + WIN_C)
    dr = key_rows - r[:, None]
    dc = jnp.clip(col[None, :] - col[:, None], -(WIN_C - 1), WIN_C - 1)
    bias = rpb.astype(jnp.float32)[:, dr[:, None, :, None] + WIN_R - 1, dc[None, :, None, :] + WIN_C - 1]
    s_loc = jnp.einsum('brqhd,brikhd->bhrqik', qg, kg).astype(jnp.float32) * SCALE + bias[None]
    s_loc = jnp.where(col_ok[None, None, None, :, None, :], s_loc, -jnp.inf)
    s_loc = s_loc.reshape(b, h, rows, GRID_W, wr * GRID_W)
    s_ctx = jnp.einsum('brqhd,bchd->bhrqc', qg, kc).astype(jnp.float32) * SCALE
    p = jax.nn.softmax(jnp.concatenate([s_loc, s_ctx], axis=-1), axis=-1)
    p_loc = p[..., :wr * GRID_W].astype(v.dtype)
    p_ctx = p[..., wr * GRID_W:].astype(v.dtype)
    o = jnp.einsum('bhrqj,brjhd->brqhd', p_loc, vg.reshape(b, rows, wr * GRID_W, h, HEAD_DIM))
    o = o + jnp.einsum('bhrqc,bchd->brqhd', p_ctx, vc)
    return o.reshape(b, l, h * HEAD_DIM)


def conv_ffn(h, w_up, conv_w, conv_b, w_down):
    l = h.shape[1]
    u = h @ w_up
    half = CONV_W // 2
    up = jnp.pad(u, ((0, 0), (half, half), (0, 0)))
    u = sum(up[:, o:o + l] * conv_w[o] for o in range(CONV_W)) + conv_b
    gate, val = jnp.split(u, 2, axis=-1)
    return (jax.nn.silu(gate) * val) @ w_down


def setup_inputs(seed: int = 0) -> dict:
    key = jax.random.key(seed)
    ks = jax.random.split(key, 26)
    f32 = jnp.float32

    def nrm(k, shape, scale):
        return jax.random.normal(k, shape, f32) * scale

    qkv_a = (N_HEADS_A + 2 * N_KV_A) * HEAD_DIM
    qkv_b = 3 * N_HEADS_B * HEAD_DIM
    return {
        'x_prompt': nrm(ks[0], (BATCH, SEQ, D_MODEL), 1.0),
        'x_sample': nrm(ks[1], (DEC_BATCH, DEC_SEQ, D_MODEL), 1.0),
        'cache_k_a': nrm(ks[2], (DEC_BATCH, N_A, PAST_LEN, N_KV_A, HEAD_DIM), 1.0),
        'cache_v_a': nrm(ks[3], (DEC_BATCH, N_A, PAST_LEN, N_KV_A, HEAD_DIM), 1.0),
        'cache_k_b': nrm(ks[4], (DEC_BATCH, N_B, PAST_LEN, N_HEADS_B, HEAD_DIM), 1.0),
        'cache_v_b': nrm(ks[5], (DEC_BATCH, N_B, PAST_LEN, N_HEADS_B, HEAD_DIM), 1.0),
        'c': nrm(ks[6], (DEC_BATCH, D_MODEL), 1.0),
        'c_ctx': nrm(ks[7], (D_MODEL,), 1.0),
        'norm_attn_w': 1.0 + nrm(ks[8], (DEPTH, D_MODEL), 0.05),
        'norm_ffn_w': 1.0 + nrm(ks[9], (DEPTH, D_MODEL), 0.05),
        'w_ada': nrm(ks[10], (DEPTH, D_MODEL, 6 * D_MODEL), D_MODEL ** -0.5),
        'b_ada': nrm(ks[11], (DEPTH, 6 * D_MODEL), 0.02),
        'w_qkv_a': nrm(ks[12], (N_A, D_MODEL, qkv_a), D_MODEL ** -0.5),
        'q_norm_a': 1.0 + nrm(ks[13], (N_A, HEAD_DIM), 0.05),
        'k_norm_a': 1.0 + nrm(ks[14], (N_A, HEAD_DIM), 0.05),
        'sink_a': nrm(ks[15], (N_A, N_HEADS_A), 0.5),
        'w_o_a': nrm(ks[16], (N_A, N_HEADS_A * HEAD_DIM, D_MODEL), (N_HEADS_A * HEAD_DIM) ** -0.5),
        'w_qkv_b': nrm(ks[17], (N_B, D_MODEL, qkv_b), D_MODEL ** -0.5),
        'q_norm_b': 1.0 + nrm(ks[18], (N_B, HEAD_DIM), 0.05),
        'k_norm_b': 1.0 + nrm(ks[19], (N_B, HEAD_DIM), 0.05),
        'rpb_b': nrm(ks[20], (N_B, N_HEADS_B, 2 * WIN_R - 1, 2 * WIN_C - 1), 0.5),
        'w_o_b': nrm(ks[21], (N_B, N_HEADS_B * HEAD_DIM, D_MODEL), (N_HEADS_B * HEAD_DIM) ** -0.5),
        'w_up': nrm(ks[22], (DEPTH, D_MODEL, 2 * D_FF), D_MODEL ** -0.5),
        'conv_w': nrm(ks[23], (DEPTH, CONV_W, 2 * D_FF), 0.5),
        'conv_b': nrm(ks[24], (DEPTH, 2 * D_FF), 0.02),
        'w_down': nrm(ks[25], (DEPTH, D_FF, D_MODEL), D_FF ** -0.5),
    }


def reference(x_prompt, x_sample, cache_k_a, cache_v_a, cache_k_b, cache_v_b, c, c_ctx,
              norm_attn_w, norm_ffn_w, w_ada, b_ada,
              w_qkv_a, q_norm_a, k_norm_a, sink_a, w_o_a,
              w_qkv_b, q_norm_b, k_norm_b, rpb_b, w_o_b,
              w_up, conv_w, conv_b, w_down):
    xp = x_prompt
    xs = x_sample
    new_k_a, new_v_a, new_k_b, new_v_b = [], [], [], []
    for i in range(DEPTH):
        j = i // 2
        mp = adaln(c_ctx[None, :], w_ada[i], b_ada[i])
        ms = adaln(c, w_ada[i], b_ada[i])
        hp = modulate(rmsnorm(xp, norm_attn_w[i]), mp[0], mp[1])
        hs = modulate(rmsnorm(xs, norm_attn_w[i]), ms[0], ms[1])
        if i % 2 == 0:
            q, k, v = project_qkv(hp, w_qkv_a[j], q_norm_a[j], k_norm_a[j], N_HEADS_A, N_KV_A)
            op = context_attention(q, k, v, sink_a[j]) @ w_o_a[j]
            new_k_a.append(k)
            new_v_a.append(v)
            q, k, v = project_qkv(hs, w_qkv_a[j], q_norm_a[j], k_norm_a[j], N_HEADS_A, N_KV_A)
            o_s = window_attention_latent(rope_2d(q), rope_2d(k), v, cache_k_a[:, j], cache_v_a[:, j], sink_a[j]) @ w_o_a[j]
        else:
            q, k, v = project_qkv(hp, w_qkv_b[j], q_norm_b[j], k_norm_b[j], N_HEADS_B, N_HEADS_B)
            op = context_attention(q, k, v, None) @ w_o_b[j]
            new_k_b.append(k)
            new_v_b.append(v)
            q, k, v = project_qkv(hs, w_qkv_b[j], q_norm_b[j], k_norm_b[j], N_HEADS_B, N_HEADS_B)
            o_s = neighborhood_attention_latent(q, k, v, cache_k_b[:, j], cache_v_b[:, j], rpb_b[j]) @ w_o_b[j]
        xp = xp + mp[2] * op
        xs = xs + ms[2] * o_s
        hp = modulate(rmsnorm(xp, norm_ffn_w[i]), mp[3], mp[4])
        hs = modulate(rmsnorm(xs, norm_ffn_w[i]), ms[3], ms[4])
        xp = xp + mp[5] * conv_ffn(hp, w_up[i], conv_w[i], conv_b[i], w_down[i])
        xs = xs + ms[5] * conv_ffn(hs, w_up[i], conv_w[i], conv_b[i], w_down[i])
    return (xp, xs, jnp.stack(new_k_a, axis=1), jnp.stack(new_v_a, axis=1), jnp.stack(new_k_b, axis=1), jnp.stack(new_v_b, axis=1))
```

```cpp
#include <hip/hip_runtime.h>
#include <hip/hip_cooperative_groups.h>
#include <cstdio>
#include <cstdint>
namespace cg = cooperative_groups;
namespace pg8 {
#define PG8_LAS __attribute__((address_space(3)))
typedef unsigned short bf16_t;
typedef short bf16x8 __attribute__((ext_vector_type(8)));
typedef float f32x4 __attribute__((ext_vector_type(4)));
typedef unsigned u32x4 __attribute__((ext_vector_type(4)));
constexpr int BM = 256, BK = 64, HALF = 128, HTB = HALF * BK * 2  , STAGE_BYTES = 8 * HTB, NXCD = 8, WGM = 8;

__host__ __device__ __forceinline__ int lds_byte(int r, int c) { const int st = (r >> 4) * 2 + (c >> 5), rr = r & 15, cc = c & 31, ob = rr * 64 + cc * 2; return st * 1024 + (ob ^ (((ob >> 9) & 1) << 5)); }
__host__ __device__ __forceinline__ void stage_rc(int b, int& R, int& C) { const int st = b / 1024, sb = b % 1024, swz = sb ^ (((sb >> 9) & 1) << 5); R = (st >> 1) * 16 + swz / 64; C = (st & 1) * 32 + (swz % 64) / 2; }
__host__ __device__ __forceinline__ int perm32(int rho) { const int n = rho >> 4, i = rho & 15; return 8 * (i >> 2) + 4 * n + (i & 3); }

struct Unit { int pm, pn; };
struct Gemm { const bf16_t* A; const bf16_t* Bt; int M, N, K; };

struct StaticOrder {
    int nM, nN, nwg, G, c;
    __host__ __device__ void init(int M, int N, int G_, int c_) { nM = M / BM; nN = N / BM; nwg = nM * nN; G = G_; c = c_; }
    __host__ __device__ bool next(int i, Unit& u) const {
        const long L = (long)i * G + c; if (L >= nwg) return false;
        int wgid = (int)L; { const int q = nwg / NXCD, r = nwg % NXCD, xcd = wgid % NXCD, off = wgid / NXCD; wgid = (xcd < r ? xcd * (q + 1) : r * (q + 1) + (xcd - r) * q) + off; }
        const int nig = WGM * nN, gid = wgid / nig, fm = gid * WGM, gsz = (nM - fm) < WGM ? (nM - fm) : WGM;
        u.pm = fm + ((wgid % nig) % gsz); u.pn = (wgid % nig) / gsz; return true;
    }
    __device__ __forceinline__ void a_ready(const Unit&) const {}
    __device__ __forceinline__ void done(const Unit&) const {}
};

__device__ __forceinline__ unsigned cvt_pk_bf16(float lo, float hi) { unsigned r; asm volatile("v_cvt_pk_bf16_f32 %0, %1, %2" : "=v"(r) : "v"(lo), "v"(hi)); return r; }
template <class Epi, class Sched, bool ALIGN_EPI = false, bool SP2 = false>
__device__ __forceinline__ void gemm_phase(PG8_LAS unsigned char* lds, const Gemm g, const Sched& S, const Epi& E, const int tid_in) {
    const int tid = tid_in, wid = __builtin_amdgcn_readfirstlane(tid >> 6), lane = tid & 63, wr = wid >> 2, wc = wid & 3, fr = lane & 15, fq = lane >> 4;
    const int K = g.K, nt = K / BK;
    unsigned voffA[2], voffB[2];
#pragma unroll
    for (int i = 0; i < 2; ++i) { int R, C; stage_rc(tid * 16 + i * 8192, R, C); const int Rb = Epi::PERM ? ((R & ~31) + perm32(R & 31)) : R;
        voffA[i] = (unsigned)(R * K + C) * 2u; voffB[i] = (unsigned)(Rb * K + C) * 2u; }
    const size_t kstep = (size_t)(BK * 2);
    const size_t hstep = (size_t)HALF * K * 2;
    const size_t tstep = 2 * hstep;
    const unsigned ldsw = (unsigned)wid * 1024u;
    const int aoff = lds_byte(wr * 64 + fr, fq * 8), boff = lds_byte(wc * 32 + fr, fq * 8);
#define PG8_SA(b, h) (((b) * 2 + (h)) * HTB)
#define PG8_SB(b, h) ((4 + (b) * 2 + (h)) * HTB)
#define PG8_STAGE(bufoff, gbase, voff) do { _Pragma("unroll") for (int _i = 0; _i < 2; ++_i) \
        __builtin_amdgcn_global_load_lds((const unsigned*)((const char*)(gbase) + (voff)[_i]), (PG8_LAS unsigned*)(lds + (bufoff) + ldsw + _i * 8192), 16, 0, 0); } while (0)
#define PG8_LDA(dst, b, h) do { _Pragma("unroll") for (int m = 0; m < 4; ++m) _Pragma("unroll") for (int k = 0; k < 2; ++k) dst[m][k] = *(const PG8_LAS bf16x8*)(lds + PG8_SA(b, h) + aoff + m * 2048 + k * 1024); } while (0)
#define PG8_LDB(dst, b, h) do { _Pragma("unroll") for (int n = 0; n < 2; ++n) _Pragma("unroll") for (int k = 0; k < 2; ++k) dst[n][k] = *(const PG8_LAS bf16x8*)(lds + PG8_SB(b, h) + boff + n * 2048 + k * 1024); } while (0)
#define PG8_MMA(ai, bj, At, Bt) do { __builtin_amdgcn_s_setprio(1); _Pragma("unroll") for (int m = 0; m < 4; ++m) _Pragma("unroll") for (int n = 0; n < 2; ++n) _Pragma("unroll") for (int k = 0; k < 2; ++k) \
        acc[ai][bj][m][n] = __builtin_amdgcn_mfma_f32_16x16x32_bf16(Bt[n][k], At[m][k], acc[ai][bj][m][n], 0, 0, 0); __builtin_amdgcn_s_setprio(0); } while (0)
#define PG8_WAIT_V(n) asm volatile("s_waitcnt vmcnt(" #n ")" ::: "memory")
#define PG8_WAIT_L(n) asm volatile("s_waitcnt lgkmcnt(" #n ")" ::: "memory")
#define PG8_BAR __builtin_amdgcn_s_barrier()
#define PG8_SCHED __builtin_amdgcn_sched_barrier(0)
    Unit cur, nxt; int ui = 0;
    if (!S.next(0, cur)) return;
    f32x4 acc[2][2][4][2];
#pragma unroll
    for (int a = 0; a < 2; ++a)
#pragma unroll
        for (int b = 0; b < 2; ++b)
#pragma unroll
            for (int m = 0; m < 4; ++m)
#pragma unroll
                for (int n = 0; n < 2; ++n) acc[a][b][m][n] = (f32x4){0.f, 0.f, 0.f, 0.f};
    bf16x8 At[4][2], B0[2][2], B1[2][2];
    const char* cA = (const char*)g.A + (size_t)cur.pm * tstep; const char* cB = (const char*)g.Bt + (size_t)cur.pn * tstep;
    S.a_ready(cur);
    if constexpr (SP2) {
        PG8_STAGE(PG8_SB(0, 0), cB, voffB); PG8_STAGE(PG8_SB(0, 1), cB + hstep, voffB); PG8_STAGE(PG8_SA(0, 0), cA, voffA); PG8_STAGE(PG8_SA(0, 1), cA + hstep, voffA);
        if (wr == 1) PG8_BAR;
        PG8_WAIT_V(2); PG8_BAR;
        PG8_STAGE(PG8_SB(1, 0), cB + kstep, voffB); PG8_STAGE(PG8_SA(1, 0), cA + kstep, voffA); PG8_STAGE(PG8_SB(1, 1), cB + hstep + kstep, voffB);
        PG8_WAIT_V(6); PG8_BAR;
    } else {
        PG8_STAGE(PG8_SB(0, 0), cB, voffB); PG8_STAGE(PG8_SA(0, 0), cA, voffA); PG8_STAGE(PG8_SB(0, 1), cB + hstep, voffB); PG8_STAGE(PG8_SA(0, 1), cA + hstep, voffA);
        if (wr == 1) PG8_BAR;
        PG8_WAIT_V(4); PG8_BAR;
        PG8_STAGE(PG8_SB(1, 0), cB + kstep, voffB); PG8_STAGE(PG8_SA(1, 0), cA + kstep, voffA); PG8_STAGE(PG8_SB(1, 1), cB + hstep + kstep, voffB);
        PG8_WAIT_V(6); PG8_BAR;
    }
    for (;;) {
        const bool has_next = S.next(ui + 1, nxt);
        const char* nA = has_next ? (const char*)g.A + (size_t)nxt.pm * tstep : cA; const char* nB = has_next ? (const char*)g.Bt + (size_t)nxt.pn * tstep : cB;
        for (int t = 0; t < nt; t += 2) {
            const bool last = (t == nt - 2);
            const char* a1 = cA + (size_t)(t + 1) * kstep;
            const char* a2 = last ? nA : cA + (size_t)(t + 2) * kstep; const char* b2 = last ? nB : cB + (size_t)(t + 2) * kstep;
            const char* a3 = a2 + kstep; const char* b3 = b2 + kstep;
            if (last && has_next) S.a_ready(nxt);
            if constexpr (SP2) {
            PG8_LDB(B0, 0, 0); PG8_LDB(B1, 0, 1); PG8_SCHED; PG8_LDA(At, 0, 0); PG8_STAGE(PG8_SA(1, 1), a1 + hstep, voffA);
            PG8_WAIT_V(8); PG8_WAIT_L(0); PG8_BAR; PG8_MMA(0, 0, At, B0); PG8_MMA(0, 1, At, B1); PG8_BAR; PG8_SCHED;
            PG8_LDA(At, 0, 1); PG8_STAGE(PG8_SB(0, 0), b2, voffB); PG8_STAGE(PG8_SB(0, 1), b2 + hstep, voffB); PG8_STAGE(PG8_SA(0, 0), a2, voffA);
            PG8_WAIT_V(8); PG8_WAIT_L(0); PG8_BAR; PG8_MMA(1, 0, At, B0); PG8_MMA(1, 1, At, B1); PG8_BAR; PG8_SCHED;
            PG8_LDB(B0, 1, 0); PG8_LDB(B1, 1, 1); PG8_SCHED; PG8_LDA(At, 1, 0); PG8_STAGE(PG8_SA(0, 1), a2 + hstep, voffA);
            PG8_WAIT_V(8); PG8_WAIT_L(0); PG8_BAR; PG8_MMA(0, 0, At, B0); PG8_MMA(0, 1, At, B1); PG8_BAR; PG8_SCHED;
            PG8_LDA(At, 1, 1); PG8_STAGE(PG8_SB(1, 0), b3, voffB); PG8_STAGE(PG8_SB(1, 1), b3 + hstep, voffB); PG8_STAGE(PG8_SA(1, 0), a3, voffA);
            PG8_WAIT_V(8); PG8_WAIT_L(0); PG8_BAR; PG8_MMA(1, 0, At, B0); PG8_MMA(1, 1, At, B1); PG8_BAR; PG8_SCHED;
            } else {
            PG8_LDB(B0, 0, 0); PG8_SCHED; PG8_LDA(At, 0, 0); PG8_STAGE(PG8_SA(1, 1), a1 + hstep, voffA);
            PG8_WAIT_L(8); PG8_BAR; PG8_WAIT_L(0); PG8_MMA(0, 0, At, B0); PG8_BAR; PG8_SCHED;
            PG8_LDB(B1, 0, 1); PG8_STAGE(PG8_SB(0, 0), b2, voffB);
            PG8_BAR; PG8_WAIT_L(0); PG8_MMA(0, 1, At, B1); PG8_BAR;
            PG8_LDA(At, 0, 1); PG8_STAGE(PG8_SA(0, 0), a2, voffA);
            PG8_BAR; PG8_WAIT_L(0); PG8_MMA(1, 0, At, B0); PG8_BAR; PG8_SCHED;
            PG8_STAGE(PG8_SB(0, 1), b2 + hstep, voffB);
            PG8_WAIT_V(6); PG8_BAR; PG8_MMA(1, 1, At, B1); PG8_BAR;
            PG8_LDB(B0, 1, 0); PG8_SCHED; PG8_LDA(At, 1, 0); PG8_STAGE(PG8_SA(0, 1), a2 + hstep, voffA);
            PG8_WAIT_L(8); PG8_BAR; PG8_WAIT_L(0); PG8_MMA(0, 0, At, B0); PG8_BAR; PG8_SCHED;
            PG8_LDB(B1, 1, 1); PG8_STAGE(PG8_SB(1, 0), b3, voffB);
            PG8_BAR; PG8_WAIT_L(0); PG8_MMA(0, 1, At, B1); PG8_BAR;
            PG8_LDA(At, 1, 1); PG8_STAGE(PG8_SA(1, 0), a3, voffA);
            PG8_BAR; PG8_WAIT_L(0); PG8_MMA(1, 0, At, B0); PG8_BAR; PG8_SCHED;
            PG8_STAGE(PG8_SB(1, 1), b3 + hstep, voffB);
            PG8_WAIT_V(6); PG8_BAR; PG8_MMA(1, 1, At, B1); PG8_BAR;
            }
        }
        if constexpr (ALIGN_EPI) { if (wr == 0) PG8_BAR; }
        if constexpr (!Epi::AFTER_DRAIN) { E(acc, cur, wr, wc, fr, fq); S.done(cur); }
        if (!has_next) break;
#pragma unroll
        for (int a = 0; a < 2; ++a)
#pragma unroll
            for (int b = 0; b < 2; ++b)
#pragma unroll
                for (int m = 0; m < 4; ++m)
#pragma unroll
                    for (int n = 0; n < 2; ++n) acc[a][b][m][n] = (f32x4){0.f, 0.f, 0.f, 0.f};
        cur = nxt; cA = nA; cB = nB; ++ui;
        if constexpr (ALIGN_EPI) { if (wr == 1) PG8_BAR; }
    }
    PG8_WAIT_V(0);
    if constexpr (!ALIGN_EPI) { if (wr == 0) PG8_BAR; }
    PG8_BAR;
    if constexpr (Epi::AFTER_DRAIN) { E.fused(acc, cur, wr, wc, fr, fq, lds, wid, lane); S.done(cur); }
#undef PG8_SA
#undef PG8_SB
#undef PG8_STAGE
#undef PG8_LDA
#undef PG8_LDB
#undef PG8_MMA
#undef PG8_WAIT_V
#undef PG8_WAIT_L
#undef PG8_BAR
#undef PG8_SCHED
}
}

#define LAS __attribute__((address_space(3)))
typedef unsigned short bf16_t;
typedef short bf16x8 __attribute__((ext_vector_type(8)));
typedef float f32x4 __attribute__((ext_vector_type(4)));
typedef float f32x2 __attribute__((ext_vector_type(2)));
typedef unsigned u32x4 __attribute__((ext_vector_type(4)));
typedef unsigned u32x2 __attribute__((ext_vector_type(2)));
using pg8::cvt_pk_bf16;

constexpr int NWAVES = 8, NTHR = 512;
constexpr int LDS_BYTES = 147456;
constexpr int MTOK = 12288, NCTXROWS = 4096, DM = 1024, DFF = 2816, DUP = 5632;
constexpr float EPSN = 1e-6f;
constexpr float LOG2E = 1.4426950408889634f;
constexpr float SCL2 = 0.125f * 1.4426950408889634f;

constexpr size_t MiB = 1u << 20;
constexpr size_t WS_MOD = 0;
constexpr size_t WS_ROPE = 256 * 1024;
constexpr size_t WS_KCA = 1 * MiB;
constexpr size_t WS_VTCA = 1 * MiB + 512 * 1024;
constexpr size_t WS_KCB = 2 * MiB;
constexpr size_t WS_VTCB = 4 * MiB;
constexpr size_t WS_WQKVA = 6 * MiB, WS_WQKVB = 9 * MiB, WS_WOA = 15 * MiB, WS_WOB = 17 * MiB;
constexpr size_t WS_WUP0 = 19 * MiB, WS_WUP1 = 30 * MiB, WS_WDN0 = 41 * MiB, WS_WDN1 = 46 * MiB + 512 * 1024;
constexpr size_t WS_H = 52 * MiB;
constexpr size_t WS_ACT = 52 * MiB;
constexpr size_t WS_U = 118 * MiB;
constexpr size_t WS_Q = 118 * MiB, WS_K = 142 * MiB, WS_VT = 166 * MiB, WS_O = 190 * MiB;
constexpr size_t WS_END = 250 * MiB;
constexpr size_t OUT_Y = 0, OUT_KA = 12582912, OUT_VA = 13631488, OUT_KB = 14680064, OUT_VB = 18874368;

__device__ __forceinline__ unsigned f2bf(float f) { unsigned u = __builtin_bit_cast(unsigned, f); return (u + 0x7fffu + ((u >> 16) & 1u)) >> 16; }
__device__ __forceinline__ float bflo(unsigned w) { return __builtin_bit_cast(float, w << 16); }
__device__ __forceinline__ float bfhi(unsigned w) { return __builtin_bit_cast(float, w & 0xffff0000u); }
__device__ __forceinline__ float wave_sum(float v) {
#pragma unroll
    for (int o = 1; o < 64; o <<= 1) v += __shfl_xor(v, o);
    return v;
}
__device__ __forceinline__ float fast_exp2(float x) { return __builtin_amdgcn_exp2f(x); }
__device__ __forceinline__ float silu_f(float x) { return x * __builtin_amdgcn_rcpf(1.0f + __expf(-x)); }

struct Args { const float* in[26]; float* out; unsigned char* ws; };

using pg8::Unit;
struct EpiUp {
    static constexpr bool PERM = true, AFTER_DRAIN = false;
    bf16_t* O; int ldc;
    __device__ __forceinline__ void operator()(const f32x4 (&acc)[2][2][4][2], const Unit& u, int wr, int wc, int fr, int fq) const {
        const int row0 = u.pm * 256 + wr * 64 + fr, col0 = u.pn * 256 + wc * 32 + 8 * fq;
#pragma unroll
        for (int ai = 0; ai < 2; ++ai)
#pragma unroll
            for (int m = 0; m < 4; ++m) { bf16_t* rowp = O + (size_t)(row0 + ai * 128 + m * 16) * ldc + col0;
#pragma unroll
                for (int bj = 0; bj < 2; ++bj) { const f32x4 v0 = acc[ai][bj][m][0], v1 = acc[ai][bj][m][1];
                    u32x4 w; w.x = cvt_pk_bf16(v0[0], v0[1]); w.y = cvt_pk_bf16(v0[2], v0[3]); w.z = cvt_pk_bf16(v1[0], v1[1]); w.w = cvt_pk_bf16(v1[2], v1[3]);
                    *(u32x4*)(rowp + bj * 128) = w; } }
    }
};
struct EpiResid {
    static constexpr bool PERM = false, AFTER_DRAIN = false;
    const float* xa; const float* xb; float* out; const float* gate;
    __device__ __forceinline__ void operator()(const f32x4 (&acc)[2][2][4][2], const Unit& u, int wr, int wc, int fr, int fq) const {
        const int rbase = u.pm * 256;
        const float* xin = rbase < NCTXROWS ? xa + (size_t)rbase * DM : xb + (size_t)(rbase - NCTXROWS) * DM;
        const int cond = rbase < NCTXROWS ? 0 : 1 + ((rbase - NCTXROWS) >> 12);
        const int col0 = u.pn * 256 + wc * 32 + 4 * fq;
        const float* g = gate + cond * 6144 + col0;
        float* o = out + (size_t)rbase * DM;
        f32x4 gv[2][2];
#pragma unroll
        for (int bj = 0; bj < 2; ++bj)
#pragma unroll
            for (int n = 0; n < 2; ++n) gv[bj][n] = *(const f32x4*)(g + bj * 128 + n * 16);
#pragma unroll
        for (int ai = 0; ai < 2; ++ai)
#pragma unroll
            for (int m = 0; m < 4; ++m) { const size_t off = (size_t)(ai * 128 + wr * 64 + m * 16 + fr) * DM + col0;
#pragma unroll
                for (int bj = 0; bj < 2; ++bj)
#pragma unroll
                    for (int n = 0; n < 2; ++n) { const f32x4 x = *(const f32x4*)(xin + off + bj * 128 + n * 16);
                        *(f32x4*)(o + off + bj * 128 + n * 16) = x + gv[bj][n] * acc[ai][bj][m][n]; }
                if (m & 1) asm volatile("" ::: "memory"); }
    }
};
template <int NKV>
struct EpiQKV {
    static constexpr bool PERM = false, AFTER_DRAIN = false;
    bf16_t* Q; bf16_t* K; bf16_t* VT; float* newk; float* newv; const float* qn; const float* kn; const float* rope;
    __device__ __forceinline__ void operator()(const f32x4 (&acc)[2][2][4][2], const Unit& u, int wr, int wc, int fr, int fq) const {
        constexpr int KLD = NKV * 64;
        const int hs = 4 * u.pn + wc;
        const int rbase = u.pm * 256 + wr * 64 + fr;
        const bool latent = u.pm >= 16;
        if (hs < 16 + NKV) {
            const bool isq = hs < 16;
            const float* nw = isq ? qn : kn;
            f32x4 wn[2][2];
#pragma unroll
            for (int bj = 0; bj < 2; ++bj)
#pragma unroll
                for (int n = 0; n < 2; ++n) wn[bj][n] = *(const f32x4*)(nw + 32 * bj + 16 * n + 4 * fq);
#pragma unroll
            for (int ai = 0; ai < 2; ++ai)
#pragma unroll
                for (int m = 0; m < 4; ++m) {
                    const int row = rbase + ai * 128 + m * 16;
                    f32x4 v[2][2]; float ss = 0.f;
#pragma unroll
                    for (int bj = 0; bj < 2; ++bj)
#pragma unroll
                        for (int n = 0; n < 2; ++n) { v[bj][n] = acc[ai][bj][m][n]; const f32x4 t = v[bj][n] * v[bj][n]; ss += (t[0] + t[1]) + (t[2] + t[3]); }
                    ss += __shfl_xor(ss, 16); ss += __shfl_xor(ss, 32);
                    const float rinv = rsqrtf(ss * (1.0f / 64.0f) + EPSN);
#pragma unroll
                    for (int bj = 0; bj < 2; ++bj)
#pragma unroll
                        for (int n = 0; n < 2; ++n) v[bj][n] = v[bj][n] * rinv * wn[bj][n];
                    if (latent && NKV == 4) {
                        const int pr = ((row - NCTXROWS) & 4095) >> 6, pc = row & 63;
#pragma unroll
                        for (int bj = 0; bj < 2; ++bj) {
                            const int pos = bj ? pc : pr;
                            const f32x4* t = (const f32x4*)(rope + (pos * 16 + 4 * fq) * 2);
                            const f32x4 t0 = t[0], t1 = t[1];
                            const f32x4 cs = (f32x4){t0[0], t0[2], t1[0], t1[2]}, sn = (f32x4){t0[1], t0[3], t1[1], t1[3]};
                            const f32x4 x1 = v[bj][0], x2 = v[bj][1];
                            v[bj][0] = x1 * cs - x2 * sn; v[bj][1] = x2 * cs + x1 * sn;
                        }
                    }
                    if (isq) {
                        bf16_t* p = Q + (size_t)row * DM + hs * 64 + 4 * fq;
#pragma unroll
                        for (int bj = 0; bj < 2; ++bj)
#pragma unroll
                            for (int n = 0; n < 2; ++n) { u32x2 w; w.x = cvt_pk_bf16(v[bj][n][0], v[bj][n][1]); w.y = cvt_pk_bf16(v[bj][n][2], v[bj][n][3]); *(u32x2*)(p + 32 * bj + 16 * n) = w; }
                    } else {
                        const int kvh = hs - 16;
                        bf16_t* p = K + (size_t)row * KLD + kvh * 64 + 4 * fq;
#pragma unroll
                        for (int bj = 0; bj < 2; ++bj)
#pragma unroll
                            for (int n = 0; n < 2; ++n) { u32x2 w; w.x = cvt_pk_bf16(v[bj][n][0], v[bj][n][1]); w.y = cvt_pk_bf16(v[bj][n][2], v[bj][n][3]); *(u32x2*)(p + 32 * bj + 16 * n) = w; }
                        if (!latent) {
                            float* o = newk + (size_t)row * KLD + kvh * 64 + 4 * fq;
#pragma unroll
                            for (int bj = 0; bj < 2; ++bj)
#pragma unroll
                                for (int n = 0; n < 2; ++n) *(f32x4*)(o + 32 * bj + 16 * n) = v[bj][n];
                        }
                    }
                    asm volatile("" ::: "memory");
                }
        } else {
            const int kvh = hs - 16 - NKV;
#pragma unroll
            for (int ai = 0; ai < 2; ++ai)
#pragma unroll
                for (int m = 0; m < 4; ++m) {
                    const int row = rbase + ai * 128 + m * 16;
                    bf16_t* p = VT + ((size_t)(row >> 5) * NKV + kvh) * 2048 + (row & 31) + (4 * fq) * 32;
#pragma unroll
                    for (int bj = 0; bj < 2; ++bj)
#pragma unroll
                        for (int n = 0; n < 2; ++n)
#pragma unroll
                            for (int i = 0; i < 4; ++i) p[(32 * bj + 16 * n + i) * 32] = (bf16_t)f2bf(acc[ai][bj][m][n][i]);
                    if (!latent) {
                        float* o = newv + (size_t)row * KLD + kvh * 64 + 4 * fq;
#pragma unroll
                        for (int bj = 0; bj < 2; ++bj)
#pragma unroll
                            for (int n = 0; n < 2; ++n) *(f32x4*)(o + 32 * bj + 16 * n) = acc[ai][bj][m][n];
                    }
                    asm volatile("" ::: "memory");
                }
        }
    }
};

struct AttnState { f32x4 o[2][4]; float m[2]; float l[2]; };
#define MFMA16(a, b, c) __builtin_amdgcn_mfma_f32_16x16x32_bf16((a), (b), (c), 0, 0, 0)
template <int MASK>
__device__ __forceinline__ void attn_chunk(AttnState& st, const bf16x8 (&qf)[2][2], const bf16_t* kp, int kld, const bf16_t* vp, int fr, int fq, int mk0, int mk1, const float* bias) {
    bf16x8 kf[2][2], vf[4];
#pragma unroll
    for (int t = 0; t < 2; ++t)
#pragma unroll
        for (int h2 = 0; h2 < 2; ++h2) kf[t][h2] = *(const bf16x8*)(kp + (size_t)(16 * t + fr) * kld + 32 * h2 + 8 * fq);
#pragma unroll
    for (int dt = 0; dt < 4; ++dt) { const bf16_t* v = vp + (16 * dt + fr) * 32 + 4 * fq; const u32x2 lo = *(const u32x2*)v, hi = *(const u32x2*)(v + 16);
        vf[dt] = __builtin_bit_cast(bf16x8, ((u32x4){lo.x, lo.y, hi.x, hi.y})); }
#pragma unroll
    for (int qb = 0; qb < 2; ++qb) {
        f32x4 s0 = (f32x4){0.f, 0.f, 0.f, 0.f}, s1 = (f32x4){0.f, 0.f, 0.f, 0.f};
        s0 = MFMA16(kf[0][0], qf[qb][0], s0); s0 = MFMA16(kf[0][1], qf[qb][1], s0);
        s1 = MFMA16(kf[1][0], qf[qb][0], s1); s1 = MFMA16(kf[1][1], qf[qb][1], s1);
        float sv[8];
#pragma unroll
        for (int j = 0; j < 4; ++j) { sv[j] = s0[j] * SCL2; sv[4 + j] = s1[j] * SCL2; }
        if (MASK == 1) {
            const int d0 = mk0 + 4 * fq - 16 * qb - fr;
#pragma unroll
            for (int t = 0; t < 2; ++t)
#pragma unroll
                for (int j = 0; j < 4; ++j) { const int df = d0 + 16 * t + j; if (df > 128 || df < -128) sv[4 * t + j] = -INFINITY; }
        }
        if (MASK == 2) {
            const int qc = mk1 + 16 * qb + fr; int cs = qc - 8; cs = cs < 0 ? 0 : (cs > 48 ? 48 : cs);
#pragma unroll
            for (int t = 0; t < 2; ++t)
#pragma unroll
                for (int j = 0; j < 4; ++j) { const int kc = mk0 + 16 * t + 4 * fq + j; const bool ok = (kc >= cs) && (kc < cs + 16);
                    float bv = 0.f; if (ok) bv = bias[kc - qc + 15];
                    sv[4 * t + j] = ok ? sv[4 * t + j] + bv * LOG2E : -INFINITY; }
        }
        float cmax = fmaxf(fmaxf(fmaxf(sv[0], sv[1]), fmaxf(sv[2], sv[3])), fmaxf(fmaxf(sv[4], sv[5]), fmaxf(sv[6], sv[7])));
        cmax = fmaxf(cmax, __shfl_xor(cmax, 16)); cmax = fmaxf(cmax, __shfl_xor(cmax, 32));
        const float mnew = fmaxf(st.m[qb], cmax);
        const float msafe = (mnew == -INFINITY) ? 0.f : mnew;
        const float alpha = fast_exp2(st.m[qb] - msafe);
        st.m[qb] = mnew;
        float p[8]; float ps = 0.f;
#pragma unroll
        for (int j = 0; j < 8; ++j) { p[j] = fast_exp2(sv[j] - msafe); ps += p[j]; }
        st.l[qb] = st.l[qb] * alpha + ps;
        u32x4 pw; pw.x = cvt_pk_bf16(p[0], p[1]); pw.y = cvt_pk_bf16(p[2], p[3]); pw.z = cvt_pk_bf16(p[4], p[5]); pw.w = cvt_pk_bf16(p[6], p[7]);
        const bf16x8 pf = __builtin_bit_cast(bf16x8, pw);
#pragma unroll
        for (int dt = 0; dt < 4; ++dt) { st.o[qb][dt] = st.o[qb][dt] * alpha; st.o[qb][dt] = MFMA16(vf[dt], pf, st.o[qb][dt]); }
    }
}
__device__ __forceinline__ void attn_init(AttnState& st, bf16x8 (&qf)[2][2], const bf16_t* Q, int qrow0, int head, int fr, int fq) {
#pragma unroll
    for (int qb = 0; qb < 2; ++qb) { st.m[qb] = -INFINITY; st.l[qb] = 0.f;
#pragma unroll
        for (int dt = 0; dt < 4; ++dt) st.o[qb][dt] = (f32x4){0.f, 0.f, 0.f, 0.f};
#pragma unroll
        for (int h2 = 0; h2 < 2; ++h2) qf[qb][h2] = *(const bf16x8*)(Q + (size_t)(qrow0 + 16 * qb + fr) * DM + head * 64 + 32 * h2 + 8 * fq); }
}
__device__ __forceinline__ void attn_finish(AttnState& st, bf16_t* O, int qrow0, int head, int fr, int fq, bool has_sink, float sink) {
#pragma unroll
    for (int qb = 0; qb < 2; ++qb) {
        float l = st.l[qb]; l += __shfl_xor(l, 16); l += __shfl_xor(l, 32);
        if (has_sink) l += fast_exp2(sink * LOG2E - st.m[qb]);
        const float inv = 1.0f / l;
        bf16_t* o = O + (size_t)(qrow0 + 16 * qb + fr) * DM + head * 64 + 4 * fq;
#pragma unroll
        for (int dt = 0; dt < 4; ++dt) { const f32x4 v = st.o[qb][dt] * inv; u32x2 w; w.x = cvt_pk_bf16(v[0], v[1]); w.y = cvt_pk_bf16(v[2], v[3]); *(u32x2*)(o + 16 * dt) = w; }
    }
}
__device__ __forceinline__ void attn_phase_a(const bf16_t* Q, const bf16_t* K, const bf16_t* VT, const bf16_t* Kc, const bf16_t* VTc, const float* sinkp, bf16_t* O, int gw, int ngw, int lane) {
    const int fr = lane & 15, fq = lane >> 4;
    for (int t = gw; t < 4096; t += ngw) {
        const int b = t >> 11, rem = t & 2047, kvh = rem >> 9, rem2 = rem & 511, qblk = ((rem2 >> 3) << 1) | (rem2 & 1), g = (rem2 & 7) >> 1;
        const int head = kvh * 4 + g, qpos0 = qblk * 32, seq0 = NCTXROWS + b * 4096, qrow0 = seq0 + qpos0;
        AttnState st; bf16x8 qf[2][2];
        attn_init(st, qf, Q, qrow0, head, fr, fq);
        for (int c = 0; c < 16; ++c)
            attn_chunk<0>(st, qf, Kc + (size_t)(b * 512 + 32 * c) * 256 + kvh * 64, 256, VTc + (size_t)((b * 16 + c) * 4 + kvh) * 2048, fr, fq, 0, 0, nullptr);
        const int c0 = qblk - 4 < 0 ? 0 : qblk - 4, c1 = qblk + 4 > 127 ? 127 : qblk + 4;
        for (int c = c0; c <= c1; ++c) { const int krow = seq0 + 32 * c;
            attn_chunk<1>(st, qf, K + (size_t)krow * 256 + kvh * 64, 256, VT + (size_t)((krow >> 5) * 4 + kvh) * 2048, fr, fq, 32 * c - qpos0, 0, nullptr); }
        attn_finish(st, O, qrow0, head, fr, fq, true, sinkp[head]);
    }
    for (int t = gw; t < 2048; t += ngw) {
        const int b = t >> 7, rem = t & 127, kvh = rem >> 5, rem2 = rem & 31, qblk = ((rem2 >> 3) << 1) | (rem2 & 1), g = (rem2 & 7) >> 1;
        const int head = kvh * 4 + g, qrow0 = b * 256 + qblk * 32;
        AttnState st; bf16x8 qf[2][2];
        attn_init(st, qf, Q, qrow0, head, fr, fq);
        for (int c = 0; c < 8; ++c) { const int krow = b * 256 + 32 * c;
            attn_chunk<0>(st, qf, K + (size_t)krow * 256 + kvh * 64, 256, VT + (size_t)((krow >> 5) * 4 + kvh) * 2048, fr, fq, 0, 0, nullptr); }
        attn_finish(st, O, qrow0, head, fr, fq, true, sinkp[head]);
    }
}
__device__ __forceinline__ void attn_phase_b(const bf16_t* Q, const bf16_t* K, const bf16_t* VT, const bf16_t* Kc, const bf16_t* VTc, const float* rpb, bf16_t* O, int gw, int ngw, int lane) {
    const int fr = lane & 15, fq = lane >> 4;
    for (int t = gw; t < 4096; t += ngw) {
        const int b = t >> 11, rem = t & 2047, head = rem >> 7, qblk = rem & 127, r = qblk >> 1, half = qblk & 1;
        const int seq0 = NCTXROWS + b * 4096, qrow0 = seq0 + qblk * 32;
        AttnState st; bf16x8 qf[2][2];
        attn_init(st, qf, Q, qrow0, head, fr, fq);
        for (int c = 0; c < 16; ++c)
            attn_chunk<0>(st, qf, Kc + (size_t)(b * 512 + 32 * c) * 1024 + head * 64, 1024, VTc + (size_t)((b * 16 + c) * 16 + head) * 2048, fr, fq, 0, 0, nullptr);
        int rs = r - 4; rs = rs < 0 ? 0 : (rs > 56 ? 56 : rs);
        for (int i = 0; i < 8; ++i) { const int kr = rs + i; const float* brow = rpb + (size_t)(head * 15 + (kr - r + 7)) * 31;
            for (int ch = 0; ch < 2; ++ch) { const int krow = seq0 + kr * 64 + 32 * ch;
                attn_chunk<2>(st, qf, K + (size_t)krow * 1024 + head * 64, 1024, VT + (size_t)((krow >> 5) * 16 + head) * 2048, fr, fq, 32 * ch, 32 * half, brow); } }
        attn_finish(st, O, qrow0, head, fr, fq, false, 0.f);
    }
    for (int t = gw; t < 2048; t += ngw) {
        const int b = t >> 7, rem = t & 127, head = rem >> 3, qblk = rem & 7;
        const int qrow0 = b * 256 + qblk * 32;
        AttnState st; bf16x8 qf[2][2];
        attn_init(st, qf, Q, qrow0, head, fr, fq);
        for (int c = 0; c < 8; ++c) { const int krow = b * 256 + 32 * c;
            attn_chunk<0>(st, qf, K + (size_t)krow * 1024 + head * 64, 1024, VT + (size_t)((krow >> 5) * 16 + head) * 2048, fr, fq, 0, 0, nullptr); }
        attn_finish(st, O, qrow0, head, fr, fq, false, 0.f);
    }
}

__device__ __forceinline__ void transpose_item(const float* W, int K, int N, bf16_t* WT, int kb, int nb, int dst_n0, LAS float* scr, int lane) {
    const int k0 = 64 * kb, n0 = 32 * nb;
#pragma unroll 8
    for (int i = 0; i < 32; ++i) { const int kk = 2 * i + (lane >> 5); scr[kk * 33 + (lane & 31)] = W[(size_t)(k0 + kk) * N + n0 + (lane & 31)]; }
    asm volatile("s_waitcnt lgkmcnt(0)" ::: "memory");
    const int c = lane & 7;
#pragma unroll
    for (int j = 0; j < 4; ++j) { const int n = (lane >> 3) + 8 * j; const LAS float* s = scr + (8 * c) * 33 + n;
        u32x4 o; o.x = cvt_pk_bf16(s[0 * 33], s[1 * 33]); o.y = cvt_pk_bf16(s[2 * 33], s[3 * 33]); o.z = cvt_pk_bf16(s[4 * 33], s[5 * 33]); o.w = cvt_pk_bf16(s[6 * 33], s[7 * 33]);
        *(u32x4*)(WT + (size_t)(dst_n0 + n) * K + k0 + 8 * c) = o; }
    asm volatile("s_waitcnt lgkmcnt(0)" ::: "memory");
}
__device__ __forceinline__ int qkv_perm(int o) { return (o & ~255) + 128 * ((o >> 5) & 1) + 32 * ((o >> 6) & 3); }

__device__ __forceinline__ void prologue(const Args& a, LAS unsigned char* lds, int tid, int lane, int wave) {
    unsigned char* ws = a.ws;
    const int G = gridDim.x, bx = blockIdx.x;
    {
        LAS float* sc = (LAS float*)lds;
        LAS float* red = (LAS float*)(lds + 16384);
        bool have = false;
        for (int it = bx; it < 192; it += G) {
            if (!have) { for (int k = tid; k < 3072; k += NTHR) { const int cnd = k >> 10, kk = k & 1023; const float x = cnd == 0 ? a.in[7][kk] : a.in[6][(cnd - 1) * 1024 + kk]; sc[k] = silu_f(x); } have = true; }
            __syncthreads();
            const int l = it / 96, n0 = (it % 96) * 64;
            const float* W = a.in[10] + (size_t)l * 1024 * 6144 + n0;
            const int c4 = tid & 15, ks = tid >> 4;
            f32x4 a0 = (f32x4){0.f, 0.f, 0.f, 0.f}, a1 = a0, a2 = a0;
#pragma unroll 8
            for (int kk = 0; kk < 32; ++kk) { const int k = ks * 32 + kk; const f32x4 w = *(const f32x4*)(W + (size_t)k * 6144 + 4 * c4);
                a0 += w * sc[k]; a1 += w * sc[1024 + k]; a2 += w * sc[2048 + k]; }
#pragma unroll
            for (int j = 0; j < 4; ++j) { red[(ks * 3 + 0) * 64 + 4 * c4 + j] = a0[j]; red[(ks * 3 + 1) * 64 + 4 * c4 + j] = a1[j]; red[(ks * 3 + 2) * 64 + 4 * c4 + j] = a2[j]; }
            __syncthreads();
            if (tid < 192) { const int cnd = tid >> 6, col = tid & 63; float s = 0.f;
#pragma unroll 8
                for (int q = 0; q < 32; ++q) s += red[(q * 3 + cnd) * 64 + col];
                ((float*)(ws + WS_MOD))[(l * 3 + cnd) * 6144 + n0 + col] = s + a.in[11][l * 6144 + n0 + col]; }
        }
        __syncthreads();
    }
    const int gw = bx * NWAVES + wave, NGW = G * NWAVES;
    const size_t gt = (size_t)bx * NTHR + tid, NT = (size_t)G * NTHR;
    if (gt < 1024) { const int pos = (int)gt >> 4, f = (int)gt & 15; const float freq = exp2f(-(float)f * (13.287712379549449f / 16.0f)); const float ang = (float)pos * freq;
        float* rp = (float*)(ws + WS_ROPE); rp[2 * gt] = cosf(ang); rp[2 * gt + 1] = sinf(ang); }
    {
        LAS float* scr = (LAS float*)(lds + wave * 16384);
        constexpr int I_QA = 16 * 48, I_QB = 16 * 96, I_O = 16 * 32, I_UP = 16 * 176, I_DN = 44 * 32;
        constexpr int NITEMS = I_QA + I_QB + 2 * I_O + 2 * I_UP + 2 * I_DN;
        for (int it = gw; it < NITEMS; it += NGW) {
            int r = it;
            if (r < I_QA) { const int kb = r / 48, nb = r % 48; transpose_item(a.in[12], 1024, 1536, (bf16_t*)(ws + WS_WQKVA), kb, nb, qkv_perm(32 * nb), scr, lane); continue; } r -= I_QA;
            if (r < I_QB) { const int kb = r / 96, nb = r % 96; transpose_item(a.in[17], 1024, 3072, (bf16_t*)(ws + WS_WQKVB), kb, nb, qkv_perm(32 * nb), scr, lane); continue; } r -= I_QB;
            if (r < I_O) { const int kb = r / 32, nb = r % 32; transpose_item(a.in[16], 1024, 1024, (bf16_t*)(ws + WS_WOA), kb, nb, 32 * nb, scr, lane); continue; } r -= I_O;
            if (r < I_O) { const int kb = r / 32, nb = r % 32; transpose_item(a.in[21], 1024, 1024, (bf16_t*)(ws + WS_WOB), kb, nb, 32 * nb, scr, lane); continue; } r -= I_O;
            if (r < 2 * I_UP) { const int l = r / I_UP; r -= l * I_UP; const int kb = r / 176, nb = r % 176;
                transpose_item(a.in[22] + (size_t)l * 1024 * 5632, 1024, 5632, (bf16_t*)(ws + (l ? WS_WUP1 : WS_WUP0)), kb, nb, 32 * nb, scr, lane); continue; } r -= 2 * I_UP;
            { const int l = r / I_DN; r -= l * I_DN; const int kb = r / 32, nb = r % 32;
                transpose_item(a.in[25] + (size_t)l * 2816 * 1024, 2816, 1024, (bf16_t*)(ws + (l ? WS_WDN1 : WS_WDN0)), kb, nb, 32 * nb, scr, lane); }
        }
    }
    {
        bf16_t* kca = (bf16_t*)(ws + WS_KCA); bf16_t* kcb = (bf16_t*)(ws + WS_KCB); bf16_t* vca = (bf16_t*)(ws + WS_VTCA); bf16_t* vcb = (bf16_t*)(ws + WS_VTCB);
        for (size_t i = gt; i < 262144; i += NT) kca[i] = (bf16_t)f2bf(a.in[2][i]);
        for (size_t i = gt; i < 1048576; i += NT) kcb[i] = (bf16_t)f2bf(a.in[4][i]);
        for (size_t i = gt; i < 262144; i += NT) { const int tt = (int)i & 31, d = ((int)i >> 5) & 63, kvh = ((int)i >> 11) & 3, c = ((int)i >> 13) & 15, b = (int)i >> 17;
            vca[i] = (bf16_t)f2bf(a.in[3][((size_t)(b * 512 + c * 32 + tt) * 4 + kvh) * 64 + d]); }
        for (size_t i = gt; i < 1048576; i += NT) { const int tt = (int)i & 31, d = ((int)i >> 5) & 63, kvh = ((int)i >> 11) & 15, c = ((int)i >> 15) & 15, b = (int)i >> 19;
            vcb[i] = (bf16_t)f2bf(a.in[5][((size_t)(b * 512 + c * 32 + tt) * 16 + kvh) * 64 + d]); }
    }
}
__device__ __forceinline__ void norm_mod_phase(const float* xa, const float* xb, const float* nw, const float* shift, const float* scale, bf16_t* H, int gw, int ngw, int lane) {
    for (int row = gw; row < MTOK; row += ngw) {
        const float* xr = row < NCTXROWS ? xa + (size_t)row * DM : xb + (size_t)(row - NCTXROWS) * DM;
        const int cond = row < NCTXROWS ? 0 : 1 + ((row - NCTXROWS) >> 12);
        f32x4 v[4]; float s = 0.f;
#pragma unroll
        for (int j = 0; j < 4; ++j) { v[j] = *(const f32x4*)(xr + 4 * (lane + 64 * j)); const f32x4 t = v[j] * v[j]; s += (t[0] + t[1]) + (t[2] + t[3]); }
        const float rinv = rsqrtf(wave_sum(s) * (1.0f / DM) + EPSN);
#pragma unroll
        for (int j = 0; j < 4; ++j) { const int col = 4 * (lane + 64 * j);
            const f32x4 w = *(const f32x4*)(nw + col), sc = *(const f32x4*)(scale + cond * 6144 + col), sh = *(const f32x4*)(shift + cond * 6144 + col);
            const f32x4 y = (v[j] * rinv * w) * (sc + 1.0f) + sh;
            u32x2 o; o.x = cvt_pk_bf16(y[0], y[1]); o.y = cvt_pk_bf16(y[2], y[3]);
            *(u32x2*)(H + (size_t)row * DM + col) = o; }
    }
}
__device__ __forceinline__ void conv_act_phase(const bf16_t* U, const float* cw, const float* cb, bf16_t* ACT, size_t gt, size_t nt) {
    for (size_t item = gt; item < (size_t)384 * 352; item += nt) {
        const int rb = (int)(item / 352), fg = (int)(item % 352), r0 = rb * 32, f0 = fg * 8;
        const int pos0 = r0 < NCTXROWS ? (r0 & 255) : (r0 & 4095), L = r0 < NCTXROWS ? 256 : 4096;
        const bool has_prev = pos0 > 0, has_next = pos0 + 32 < L;
        float wg[3][8], wv[3][8], bg[8], bv[8];
#pragma unroll
        for (int o = 0; o < 3; ++o)
#pragma unroll
            for (int j = 0; j < 8; ++j) { wg[o][j] = cw[o * DUP + f0 + j]; wv[o][j] = cw[o * DUP + DFF + f0 + j]; }
#pragma unroll
        for (int j = 0; j < 8; ++j) { bg[j] = cb[f0 + j]; bv[j] = cb[DFF + f0 + j]; }
        const u32x4 z4 = (u32x4){0u, 0u, 0u, 0u};
        const bf16_t* up = U + (size_t)r0 * DUP + f0;
        u32x4 gp = z4, vp = z4, gc, vc, gn, vn;
        if (has_prev) { gp = *(const u32x4*)(up - DUP); vp = *(const u32x4*)(up - DUP + DFF); }
        gc = *(const u32x4*)up; vc = *(const u32x4*)(up + DFF);
        for (int r = 0; r < 32; ++r) {
            gn = z4; vn = z4;
            if (r < 31 || has_next) { gn = *(const u32x4*)(up + (size_t)(r + 1) * DUP); vn = *(const u32x4*)(up + (size_t)(r + 1) * DUP + DFF); }
            float res[8];
#pragma unroll
            for (int q = 0; q < 4; ++q) {
                const float g0 = wg[0][2 * q] * bflo(gp[q]) + wg[1][2 * q] * bflo(gc[q]) + wg[2][2 * q] * bflo(gn[q]) + bg[2 * q];
                const float g1 = wg[0][2 * q + 1] * bfhi(gp[q]) + wg[1][2 * q + 1] * bfhi(gc[q]) + wg[2][2 * q + 1] * bfhi(gn[q]) + bg[2 * q + 1];
                const float v0 = wv[0][2 * q] * bflo(vp[q]) + wv[1][2 * q] * bflo(vc[q]) + wv[2][2 * q] * bflo(vn[q]) + bv[2 * q];
                const float v1 = wv[0][2 * q + 1] * bfhi(vp[q]) + wv[1][2 * q + 1] * bfhi(vc[q]) + wv[2][2 * q + 1] * bfhi(vn[q]) + bv[2 * q + 1];
                res[2 * q] = silu_f(g0) * v0; res[2 * q + 1] = silu_f(g1) * v1;
            }
            u32x4 o; o.x = cvt_pk_bf16(res[0], res[1]); o.y = cvt_pk_bf16(res[2], res[3]); o.z = cvt_pk_bf16(res[4], res[5]); o.w = cvt_pk_bf16(res[6], res[7]);
            *(u32x4*)(ACT + (size_t)(r0 + r) * DFF + f0) = o;
            gp = gc; vp = vc; gc = gn; vc = vn;
        }
    }
}

__global__ void __launch_bounds__(NTHR, 2) mk_fwd(Args a) {
    extern __shared__ __attribute__((aligned(16))) unsigned char lds_raw[];
    cg::grid_group grid = cg::this_grid();
    LAS unsigned char* lds = (LAS unsigned char*)lds_raw;
    const int tid = threadIdx.x, lane = tid & 63, wave = __builtin_amdgcn_readfirstlane(tid >> 6);
    const int G = gridDim.x, bx = blockIdx.x;
    const int gw = bx * NWAVES + wave, NGW = G * NWAVES;
    const size_t gt = (size_t)bx * NTHR + tid, NT = (size_t)G * NTHR;
    unsigned char* ws = a.ws;
    float* out = a.out;
    bf16_t* H = (bf16_t*)(ws + WS_H); bf16_t* ACT = (bf16_t*)(ws + WS_ACT); bf16_t* U = (bf16_t*)(ws + WS_U);
    bf16_t* Qb = (bf16_t*)(ws + WS_Q); bf16_t* Kb = (bf16_t*)(ws + WS_K); bf16_t* VTb = (bf16_t*)(ws + WS_VT); bf16_t* Ob = (bf16_t*)(ws + WS_O);
    const float* rope = (const float*)(ws + WS_ROPE);

#ifndef NO_PRO
    prologue(a, lds, tid, lane, wave);
#endif
    grid.sync();

#pragma unroll 1
    for (int layer = 0; layer < 2; ++layer) {
        const float* mod = (const float*)(ws + WS_MOD) + layer * 3 * 6144;
        const float* xa = layer == 0 ? a.in[0] : out;
        const float* xb = layer == 0 ? a.in[1] : out + (size_t)NCTXROWS * DM;
#ifndef NO_NORM
        { int tl = tid; asm volatile("" : "+v"(tl)); const int wv = __builtin_amdgcn_readfirstlane(tl >> 6);
          norm_mod_phase(xa, xb, a.in[8] + layer * DM, mod + 0 * 1024, mod + 1 * 1024, H, bx * NWAVES + wv, NGW, tl & 63); }
#endif
        grid.sync();
#ifndef NO_QKV
        if (layer == 0) {
            pg8::Gemm g{H, (const bf16_t*)(ws + WS_WQKVA), MTOK, 1536, 1024}; pg8::StaticOrder S; int bxl = bx; asm volatile("" : "+s"(bxl)); int tl = tid; asm volatile("" : "+v"(tl)); S.init(MTOK, 1536, G, bxl);
            EpiQKV<4> E{Qb, Kb, VTb, out + OUT_KA, out + OUT_VA, a.in[13], a.in[14], rope};
            pg8::gemm_phase<EpiQKV<4>, pg8::StaticOrder, true, true>(lds, g, S, E, tl);
        } else {
            pg8::Gemm g{H, (const bf16_t*)(ws + WS_WQKVB), MTOK, 3072, 1024}; pg8::StaticOrder S; int bxl = bx; asm volatile("" : "+s"(bxl)); int tl = tid; asm volatile("" : "+v"(tl)); S.init(MTOK, 3072, G, bxl);
            EpiQKV<16> E{Qb, Kb, VTb, out + OUT_KB, out + OUT_VB, a.in[18], a.in[19], rope};
            pg8::gemm_phase<EpiQKV<16>, pg8::StaticOrder, true, true>(lds, g, S, E, tl);
        }
#endif
        grid.sync();
#ifndef NO_ATTN
        { int tl = tid; asm volatile("" : "+v"(tl)); const int wv = __builtin_amdgcn_readfirstlane(tl >> 6); const int gwl = bx * NWAVES + wv;
        if (layer == 0) attn_phase_a(Qb, Kb, VTb, (const bf16_t*)(ws + WS_KCA), (const bf16_t*)(ws + WS_VTCA), a.in[15], Ob, gwl, NGW, tl & 63);
        else attn_phase_b(Qb, Kb, VTb, (const bf16_t*)(ws + WS_KCB), (const bf16_t*)(ws + WS_VTCB), a.in[20], Ob, gwl, NGW, tl & 63); }
#endif
        grid.sync();
#ifndef NO_OPROJ
        {
            pg8::Gemm g{Ob, (const bf16_t*)(ws + (layer ? WS_WOB : WS_WOA)), MTOK, 1024, 1024}; pg8::StaticOrder S; int bxl = bx; asm volatile("" : "+s"(bxl)); int tl = tid; asm volatile("" : "+v"(tl)); S.init(MTOK, 1024, G, bxl);
            EpiResid E{xa, xb, out, mod + 2 * 1024};
            pg8::gemm_phase<EpiResid, pg8::StaticOrder, true, true>(lds, g, S, E, tl);
        }
#endif
        grid.sync();
#ifndef NO_NORM
        { int tl = tid; asm volatile("" : "+v"(tl)); const int wv = __builtin_amdgcn_readfirstlane(tl >> 6);
          norm_mod_phase(out, out + (size_t)NCTXROWS * DM, a.in[9] + layer * DM, mod + 3 * 1024, mod + 4 * 1024, H, bx * NWAVES + wv, NGW, tl & 63); }
#endif
        grid.sync();
#ifndef NO_UP
        {
            pg8::Gemm g{H, (const bf16_t*)(ws + (layer ? WS_WUP1 : WS_WUP0)), MTOK, DUP, 1024}; pg8::StaticOrder S; int bxl = bx; asm volatile("" : "+s"(bxl)); int tl = tid; asm volatile("" : "+v"(tl)); S.init(MTOK, DUP, G, bxl);
            EpiUp E{U, DUP};
            pg8::gemm_phase<EpiUp, pg8::StaticOrder, true, true>(lds, g, S, E, tl);
        }
#endif
        grid.sync();
#ifndef NO_CONV
        { int tl = tid; asm volatile("" : "+v"(tl));
          conv_act_phase(U, a.in[23] + (size_t)layer * 3 * DUP, a.in[24] + (size_t)layer * DUP, ACT, (size_t)bx * NTHR + tl, NT); }
#endif
        grid.sync();
#ifndef NO_DOWN
        {
            pg8::Gemm g{ACT, (const bf16_t*)(ws + (layer ? WS_WDN1 : WS_WDN0)), MTOK, 1024, DFF}; pg8::StaticOrder S; int bxl = bx; asm volatile("" : "+s"(bxl)); int tl = tid; asm volatile("" : "+v"(tl)); S.init(MTOK, 1024, G, bxl);
            EpiResid E{out, out + (size_t)NCTXROWS * DM, out, mod + 5 * 1024};
            pg8::gemm_phase<EpiResid, pg8::StaticOrder, true, true>(lds, g, S, E, tl);
        }
#endif
        if (layer == 0) grid.sync();
    }
}

extern "C" void kernel_launch(void* const* d_in, const int* in_sizes, int n_in, void* d_out, int out_size, void* d_ws, size_t ws_size, hipStream_t stream) {
    static int grid = 0;
    if (grid == 0) {
        if (n_in != 26 || out_size != 23068672 || ws_size < WS_END) { fprintf(stderr, "kernel_launch: unexpected shapes n_in %d out %d ws %zu\n", n_in, out_size, ws_size); grid = -1; return; }
        int dev = 0, cus = 0, per_cu = 0;
        hipGetDevice(&dev);
        hipDeviceGetAttribute(&cus, hipDeviceAttributeMultiprocessorCount, dev);
        hipFuncSetAttribute((const void*)mk_fwd, hipFuncAttributeMaxDynamicSharedMemorySize, LDS_BYTES);
        hipOccupancyMaxActiveBlocksPerMultiprocessor(&per_cu, (const void*)mk_fwd, NTHR, LDS_BYTES);
        if (per_cu < 1) per_cu = 1;
        grid = cus * per_cu;
    }
    if (grid < 0) return;
    Args a{};
    for (int i = 0; i < 26; ++i) a.in[i] = (const float*)d_in[i];
    a.out = (float*)d_out; a.ws = (unsigned char*)d_ws;
    void* args[] = {&a};
    hipError_t e = hipLaunchCooperativeKernel((const void*)mk_fwd, dim3(grid), dim3(NTHR), args, LDS_BYTES, stream);
    if (e != hipSuccess) fprintf(stderr, "cooperative launch failed: %s (grid %d)\n", hipGetErrorString(e), grid);
}
```

```cpp
#include <hip/hip_runtime.h>
#include <hip/hip_cooperative_groups.h>
#include <cstdio>
#include <cstdint>
namespace cg = cooperative_groups;
namespace pg8 {
#define PG8_LAS __attribute__((address_space(3)))
typedef unsigned short bf16_t;
typedef short bf16x8 __attribute__((ext_vector_type(8)));
typedef float f32x4 __attribute__((ext_vector_type(4)));
typedef unsigned u32x4 __attribute__((ext_vector_type(4)));
constexpr int BM = 256, BK = 64, HALF = 128, HTB = HALF * BK * 2  , STAGE_BYTES = 8 * HTB, NXCD = 8, WGM = 8;

__host__ __device__ __forceinline__ int lds_byte(int r, int c) { const int st = (r >> 4) * 2 + (c >> 5), rr = r & 15, cc = c & 31, ob = rr * 64 + cc * 2; return st * 1024 + (ob ^ (((ob >> 9) & 1) << 5)); }
__host__ __device__ __forceinline__ void stage_rc(int b, int& R, int& C) { const int st = b / 1024, sb = b % 1024, swz = sb ^ (((sb >> 9) & 1) << 5); R = (st >> 1) * 16 + swz / 64; C = (st & 1) * 32 + (swz % 64) / 2; }
__host__ __device__ __forceinline__ int perm32(int rho) { const int n = rho >> 4, i = rho & 15; return 8 * (i >> 2) + 4 * n + (i & 3); }

struct Unit { int pm, pn; };
struct Gemm { const bf16_t* A; const bf16_t* Bt; int M, N, K; };

struct StaticOrder {
    int nM, nN, nwg, G, c;
    __host__ __device__ void init(int M, int N, int G_, int c_) { nM = M / BM; nN = N / BM; nwg = nM * nN; G = G_; c = c_; }
    __host__ __device__ bool next(int i, Unit& u) const {
        const long L = (long)i * G + c; if (L >= nwg) return false;
        int wgid = (int)L; { const int q = nwg / NXCD, r = nwg % NXCD, xcd = wgid % NXCD, off = wgid / NXCD; wgid = (xcd < r ? xcd * (q + 1) : r * (q + 1) + (xcd - r) * q) + off; }
        const int nig = WGM * nN, gid = wgid / nig, fm = gid * WGM, gsz = (nM - fm) < WGM ? (nM - fm) : WGM;
        u.pm = fm + ((wgid % nig) % gsz); u.pn = (wgid % nig) / gsz; return true;
    }
    __device__ __forceinline__ void a_ready(const Unit&) const {}
    __device__ __forceinline__ void done(const Unit&) const {}
};

__device__ __forceinline__ unsigned cvt_pk_bf16(float lo, float hi) { unsigned r; asm volatile("v_cvt_pk_bf16_f32 %0, %1, %2" : "=v"(r) : "v"(lo), "v"(hi)); return r; }
template <class Epi, class Sched, bool ALIGN_EPI = false, bool SP2 = false>
__device__ __forceinline__ void gemm_phase(PG8_LAS unsigned char* lds, const Gemm g, const Sched& S, const Epi& E, const int tid_in) {
    const int tid = tid_in, wid = __builtin_amdgcn_readfirstlane(tid >> 6), lane = tid & 63, wr = wid >> 2, wc = wid & 3, fr = lane & 15, fq = lane >> 4;
    const int K = g.K, nt = K / BK;
    unsigned voffA[2], voffB[2];
#pragma unroll
    for (int i = 0; i < 2; ++i) { int R, C; stage_rc(tid * 16 + i * 8192, R, C); const int Rb = Epi::PERM ? ((R & ~31) + perm32(R & 31)) : R;
        voffA[i] = (unsigned)(R * K + C) * 2u; voffB[i] = (unsigned)(Rb * K + C) * 2u; }
    const size_t kstep = (size_t)(BK * 2);
    const size_t hstep = (size_t)HALF * K * 2;
    const size_t tstep = 2 * hstep;
    const unsigned ldsw = (unsigned)wid * 1024u;
    const int aoff = lds_byte(wr * 64 + fr, fq * 8), boff = lds_byte(wc * 32 + fr, fq * 8);
#define PG8_SA(b, h) (((b) * 2 + (h)) * HTB)
#define PG8_SB(b, h) ((4 + (b) * 2 + (h)) * HTB)
#define PG8_STAGE(bufoff, gbase, voff) do { _Pragma("unroll") for (int _i = 0; _i < 2; ++_i) \
        __builtin_amdgcn_global_load_lds((const unsigned*)((const char*)(gbase) + (voff)[_i]), (PG8_LAS unsigned*)(lds + (bufoff) + ldsw + _i * 8192), 16, 0, 0); } while (0)
#define PG8_LDA(dst, b, h) do { _Pragma("unroll") for (int m = 0; m < 4; ++m) _Pragma("unroll") for (int k = 0; k < 2; ++k) dst[m][k] = *(const PG8_LAS bf16x8*)(lds + PG8_SA(b, h) + aoff + m * 2048 + k * 1024); } while (0)
#define PG8_LDB(dst, b, h) do { _Pragma("unroll") for (int n = 0; n < 2; ++n) _Pragma("unroll") for (int k = 0; k < 2; ++k) dst[n][k] = *(const PG8_LAS bf16x8*)(lds + PG8_SB(b, h) + boff + n * 2048 + k * 1024); } while (0)
#define PG8_MMA(ai, bj, At, Bt) do { __builtin_amdgcn_s_setprio(1); _Pragma("unroll") for (int m = 0; m < 4; ++m) _Pragma("unroll") for (int n = 0; n < 2; ++n) _Pragma("unroll") for (int k = 0; k < 2; ++k) \
        acc[ai][bj][m][n] = __builtin_amdgcn_mfma_f32_16x16x32_bf16(Bt[n][k], At[m][k], acc[ai][bj][m][n], 0, 0, 0); __builtin_amdgcn_s_setprio(0); } while (0)
#define PG8_WAIT_V(n) asm volatile("s_waitcnt vmcnt(" #n ")" ::: "memory")
#define PG8_WAIT_L(n) asm volatile("s_waitcnt lgkmcnt(" #n ")" ::: "memory")
#define PG8_BAR __builtin_amdgcn_s_barrier()
#define PG8_SCHED __builtin_amdgcn_sched_barrier(0)
    Unit cur, nxt; int ui = 0;
    if (!S.next(0, cur)) return;
    f32x4 acc[2][2][4][2];
#pragma unroll
    for (int a = 0; a < 2; ++a)
#pragma unroll
        for (int b = 0; b < 2; ++b)
#pragma unroll
            for (int m = 0; m < 4; ++m)
#pragma unroll
                for (int n = 0; n < 2; ++n) acc[a][b][m][n] = (f32x4){0.f, 0.f, 0.f, 0.f};
    bf16x8 At[4][2], B0[2][2], B1[2][2];
    const char* cA = (const char*)g.A + (size_t)cur.pm * tstep; const char* cB = (const char*)g.Bt + (size_t)cur.pn * tstep;
    S.a_ready(cur);
    if constexpr (SP2) {
        PG8_STAGE(PG8_SB(0, 0), cB, voffB); PG8_STAGE(PG8_SB(0, 1), cB + hstep, voffB); PG8_STAGE(PG8_SA(0, 0), cA, voffA); PG8_STAGE(PG8_SA(0, 1), cA + hstep, voffA);
        if (wr == 1) PG8_BAR;
        PG8_WAIT_V(2); PG8_BAR;
        PG8_STAGE(PG8_SB(1, 0), cB + kstep, voffB); PG8_STAGE(PG8_SA(1, 0), cA + kstep, voffA); PG8_STAGE(PG8_SB(1, 1), cB + hstep + kstep, voffB);
        PG8_WAIT_V(6); PG8_BAR;
    } else {
        PG8_STAGE(PG8_SB(0, 0), cB, voffB); PG8_STAGE(PG8_SA(0, 0), cA, voffA); PG8_STAGE(PG8_SB(0, 1), cB + hstep, voffB); PG8_STAGE(PG8_SA(0, 1), cA + hstep, voffA);
        if (wr == 1) PG8_BAR;
        PG8_WAIT_V(4); PG8_BAR;
        PG8_STAGE(PG8_SB(1, 0), cB + kstep, voffB); PG8_STAGE(PG8_SA(1, 0), cA + kstep, voffA); PG8_STAGE(PG8_SB(1, 1), cB + hstep + kstep, voffB);
        PG8_WAIT_V(6); PG8_BAR;
    }
    for (;;) {
        const bool has_next = S.next(ui + 1, nxt);
        const char* nA = has_next ? (const char*)g.A + (size_t)nxt.pm * tstep : cA; const char* nB = has_next ? (const char*)g.Bt + (size_t)nxt.pn * tstep : cB;
        for (int t = 0; t < nt; t += 2) {
            const bool last = (t == nt - 2);
            const char* a1 = cA + (size_t)(t + 1) * kstep;
            const char* a2 = last ? nA : cA + (size_t)(t + 2) * kstep; const char* b2 = last ? nB : cB + (size_t)(t + 2) * kstep;
            const char* a3 = a2 + kstep; const char* b3 = b2 + kstep;
            if (last && has_next) S.a_ready(nxt);
            if constexpr (SP2) {
            PG8_LDB(B0, 0, 0); PG8_LDB(B1, 0, 1); PG8_SCHED; PG8_LDA(At, 0, 0); PG8_STAGE(PG8_SA(1, 1), a1 + hstep, voffA);
            PG8_WAIT_V(8); PG8_WAIT_L(0); PG8_BAR; PG8_MMA(0, 0, At, B0); PG8_MMA(0, 1, At, B1); PG8_BAR; PG8_SCHED;
            PG8_LDA(At, 0, 1); PG8_STAGE(PG8_SB(0, 0), b2, voffB); PG8_STAGE(PG8_SB(0, 1), b2 + hstep, voffB); PG8_STAGE(PG8_SA(0, 0), a2, voffA);
            PG8_WAIT_V(8); PG8_WAIT_L(0); PG8_BAR; PG8_MMA(1, 0, At, B0); PG8_MMA(1, 1, At, B1); PG8_BAR; PG8_SCHED;
            PG8_LDB(B0, 1, 0); PG8_LDB(B1, 1, 1); PG8_SCHED; PG8_LDA(At, 1, 0); PG8_STAGE(PG8_SA(0, 1), a2 + hstep, voffA);
            PG8_WAIT_V(8); PG8_WAIT_L(0); PG8_BAR; PG8_MMA(0, 0, At, B0); PG8_MMA(0, 1, At, B1); PG8_BAR; PG8_SCHED;
            PG8_LDA(At, 1, 1); PG8_STAGE(PG8_SB(1, 0), b3, voffB); PG8_STAGE(PG8_SB(1, 1), b3 + hstep, voffB); PG8_STAGE(PG8_SA(1, 0), a3, voffA);
            PG8_WAIT_V(8); PG8_WAIT_L(0); PG8_BAR; PG8_MMA(1, 0, At, B0); PG8_MMA(1, 1, At, B1); PG8_BAR; PG8_SCHED;
            } else {
            PG8_LDB(B0, 0, 0); PG8_SCHED; PG8_LDA(At, 0, 0); PG8_STAGE(PG8_SA(1, 1), a1 + hstep, voffA);
            PG8_WAIT_L(8); PG8_BAR; PG8_WAIT_L(0); PG8_MMA(0, 0, At, B0); PG8_BAR; PG8_SCHED;
            PG8_LDB(B1, 0, 1); PG8_STAGE(PG8_SB(0, 0), b2, voffB);
            PG8_BAR; PG8_WAIT_L(0); PG8_MMA(0, 1, At, B1); PG8_BAR;
            PG8_LDA(At, 0, 1); PG8_STAGE(PG8_SA(0, 0), a2, voffA);
            PG8_BAR; PG8_WAIT_L(0); PG8_MMA(1, 0, At, B0); PG8_BAR; PG8_SCHED;
            PG8_STAGE(PG8_SB(0, 1), b2 + hstep, voffB);
            PG8_WAIT_V(6); PG8_BAR; PG8_MMA(1, 1, At, B1); PG8_BAR;
            PG8_LDB(B0, 1, 0); PG8_SCHED; PG8_LDA(At, 1, 0); PG8_STAGE(PG8_SA(0, 1), a2 + hstep, voffA);
            PG8_WAIT_L(8); PG8_BAR; PG8_WAIT_L(0); PG8_MMA(0, 0, At, B0); PG8_BAR; PG8_SCHED;
            PG8_LDB(B1, 1, 1); PG8_STAGE(PG8_SB(1, 0), b3, voffB);
            PG8_BAR; PG8_WAIT_L(0); PG8_MMA(0, 1, At, B1); PG8_BAR;
            PG8_LDA(At, 1, 1); PG8_STAGE(PG8_SA(1, 0), a3, voffA);
            PG8_BAR; PG8_WAIT_L(0); PG8_MMA(1, 0, At, B0); PG8_BAR; PG8_SCHED;
            PG8_STAGE(PG8_SB(1, 1), b3 + hstep, voffB);
            PG8_WAIT_V(6); PG8_BAR; PG8_MMA(1, 1, At, B1); PG8_BAR;
            }
        }
        if constexpr (ALIGN_EPI) { if (wr == 0) PG8_BAR; }
        if constexpr (!Epi::AFTER_DRAIN) { E(acc, cur, wr, wc, fr, fq); S.done(cur); }
        if (!has_next) break;
#pragma unroll
        for (int a = 0; a < 2; ++a)
#pragma unroll
            for (int b = 0; b < 2; ++b)
#pragma unroll
                for (int m = 0; m < 4; ++m)
#pragma unroll
                    for (int n = 0; n < 2; ++n) acc[a][b][m][n] = (f32x4){0.f, 0.f, 0.f, 0.f};
        cur = nxt; cA = nA; cB = nB; ++ui;
        if constexpr (ALIGN_EPI) { if (wr == 1) PG8_BAR; }
    }
    PG8_WAIT_V(0);
    if constexpr (!ALIGN_EPI) { if (wr == 0) PG8_BAR; }
    PG8_BAR;
    if constexpr (Epi::AFTER_DRAIN) { E.fused(acc, cur, wr, wc, fr, fq, lds, wid, lane); S.done(cur); }
#undef PG8_SA
#undef PG8_SB
#undef PG8_STAGE
#undef PG8_LDA
#undef PG8_LDB
#undef PG8_MMA
#undef PG8_WAIT_V
#undef PG8_WAIT_L
#undef PG8_BAR
#undef PG8_SCHED
}
}

#define LAS __attribute__((address_space(3)))
typedef unsigned short bf16_t;
typedef short bf16x8 __attribute__((ext_vector_type(8)));
typedef float f32x4 __attribute__((ext_vector_type(4)));
typedef float f32x2 __attribute__((ext_vector_type(2)));
typedef unsigned u32x4 __attribute__((ext_vector_type(4)));
typedef unsigned u32x2 __attribute__((ext_vector_type(2)));
using pg8::cvt_pk_bf16;

#ifndef REP_ATTN
#define REP_ATTN 1
#endif
#ifndef REP_THIN
#define REP_THIN 1
#endif
constexpr int NWAVES = 8, NTHR = 512;
constexpr int LDS_BYTES = 147456;
constexpr int MTOK = 12288, NCTXROWS = 4096, DM = 1024, DFF = 2816, DUP = 5632;
constexpr float EPSN = 1e-6f;
constexpr float LOG2E = 1.4426950408889634f;
constexpr float SCL2 = 0.125f * 1.4426950408889634f;

constexpr size_t MiB = 1u << 20;
constexpr size_t WS_MOD = 0;
constexpr size_t WS_ROPE = 256 * 1024;
constexpr size_t WS_BAR = 512 * 1024;
constexpr size_t WS_KCA = 1 * MiB;
constexpr size_t WS_VTCA = 1 * MiB + 512 * 1024;
constexpr size_t WS_KCB = 2 * MiB;
constexpr size_t WS_VTCB = 4 * MiB;
constexpr size_t WS_WQKVA = 6 * MiB, WS_WQKVB = 9 * MiB, WS_WOA = 15 * MiB, WS_WOB = 17 * MiB;
constexpr size_t WS_WUP0 = 19 * MiB, WS_WUP1 = 30 * MiB, WS_WDN0 = 41 * MiB, WS_WDN1 = 46 * MiB + 512 * 1024;
constexpr size_t WS_H = 52 * MiB;
constexpr size_t WS_ACT = 52 * MiB;
constexpr size_t WS_U = 118 * MiB;
constexpr size_t WS_Q = 118 * MiB, WS_K = 142 * MiB, WS_VT = 166 * MiB, WS_O = 190 * MiB;
constexpr size_t WS_END = 250 * MiB;
constexpr size_t OUT_Y = 0, OUT_KA = 12582912, OUT_VA = 13631488, OUT_KB = 14680064, OUT_VB = 18874368;

__device__ __forceinline__ unsigned f2bf(float f) { unsigned u = __builtin_bit_cast(unsigned, f); return (u + 0x7fffu + ((u >> 16) & 1u)) >> 16; }
__device__ __forceinline__ float bflo(unsigned w) { return __builtin_bit_cast(float, w << 16); }
__device__ __forceinline__ float bfhi(unsigned w) { return __builtin_bit_cast(float, w & 0xffff0000u); }
__device__ __forceinline__ float wave_sum(float v) {
#pragma unroll
    for (int o = 1; o < 64; o <<= 1) v += __shfl_xor(v, o);
    return v;
}
__device__ __forceinline__ float fast_exp2(float x) { return __builtin_amdgcn_exp2f(x); }
__device__ __forceinline__ float silu_f(float x) { return x * __builtin_amdgcn_rcpf(1.0f + __expf(-x)); }

struct Args { const float* in[26]; float* out; unsigned char* ws; };

#define XB_TMO      128
#define XB_XCNT(j)  (256  + 64 * (j))
#define XB_XSUB(j)  (1280 + 64 * (j))
#define XB_XGEN(j)  (2304 + 64 * (j))
#define XB_TOP      3328
#define XB_TOPGEN   3392
#define XCD_BAR_WORDS 3456
#define XB_SPIN_CAP (1u << 18)

__device__ __forceinline__ unsigned xb_ld(unsigned* p)              { return __hip_atomic_load(p, __ATOMIC_RELAXED, __HIP_MEMORY_SCOPE_AGENT); }
__device__ __forceinline__ unsigned xb_add(unsigned* p, unsigned v) { return __hip_atomic_fetch_add(p, v, __ATOMIC_RELAXED, __HIP_MEMORY_SCOPE_AGENT); }
__device__ __forceinline__ unsigned xb_xcc_id() { return (unsigned)__builtin_amdgcn_s_getreg((3 << 11) | 20) & 0xFu; }
#define XB_SPIN(cond, bar) do { unsigned _sp = 0; while (cond) { __builtin_amdgcn_s_sleep(1); \
    if ((++_sp & 255u) == 0u) { if (xb_ld(&(bar)[XB_TMO])) break; if (_sp > XB_SPIN_CAP) { atomicAdd(&(bar)[XB_TMO], 1u); break; } } } } while (0)

struct XcdBarrier {
    unsigned* bar; unsigned x;
    volatile LAS unsigned* st;
};

__device__ __forceinline__ XcdBarrier xcd_barrier_post(unsigned* bar, volatile LAS unsigned* st) {
    XcdBarrier b; b.bar = bar; b.x = xb_xcc_id(); b.st = st;
    if (threadIdx.x == 0) (void)xb_add(&bar[XB_XCNT(b.x)], 1u);
    return b;
}
__device__ __forceinline__ void xcd_barrier_complete(unsigned* bar, unsigned x, unsigned& nloc, unsigned& nx) {
    const unsigned G = gridDim.x * gridDim.y * gridDim.z;
    unsigned sum, cnt, mine, sp = 0u;
    for (;;) {
        sum = 0u; cnt = 0u; mine = 0u;
#pragma unroll
        for (unsigned j = 0; j < 16; ++j) { const unsigned c = xb_ld(&bar[XB_XCNT(j)]); sum += c; cnt += (c > 0u) ? 1u : 0u; mine = (j == x) ? c : mine; }
        if (sum == G) break;
        __builtin_amdgcn_s_sleep(1);
        if ((++sp & 255u) == 0u) { if (xb_ld(&bar[XB_TMO])) break; if (sp > XB_SPIN_CAP) { atomicAdd(&bar[XB_TMO], 1u); break; } }
    }
    nloc = mine > 0u ? mine : 1u; nx = cnt > 0u ? cnt : 1u;
}

__device__ __forceinline__ void xcd_barrier(const XcdBarrier& b) {
    asm volatile("s_waitcnt vmcnt(0)" ::: "memory");
    __syncthreads();
    if (threadIdx.x == 0) {
        unsigned* bar = b.bar;
        __builtin_amdgcn_s_waitcnt(0);
        unsigned nloc = b.st[0], nx = b.st[1];
        if (nloc == 0u) { xcd_barrier_complete(bar, b.x, nloc, nx); b.st[0] = nloc; b.st[1] = nx; }
        const unsigned old = xb_add(&bar[XB_XSUB(b.x)], 1u);
        const unsigned gen = old / nloc;
        if (old + 1u == (gen + 1u) * nloc) {
            __builtin_amdgcn_fence(__ATOMIC_RELEASE, "agent");
            asm volatile("s_waitcnt vmcnt(0)" ::: "memory");
            const unsigned og = xb_add(&bar[XB_TOP], 1u);
            const unsigned tg = og / nx;
            if (og + 1u == (tg + 1u) * nx) xb_add(&bar[XB_TOPGEN], 1u);
            else XB_SPIN(xb_ld(&bar[XB_TOPGEN]) == tg, bar);
            __builtin_amdgcn_fence(__ATOMIC_ACQUIRE, "agent");
            xb_add(&bar[XB_XGEN(b.x)], 1u);
            asm volatile("s_waitcnt vmcnt(0)" ::: "memory");
        } else {
            XB_SPIN(xb_ld(&bar[XB_XGEN(b.x)]) == gen, bar);
            __builtin_amdgcn_fence(__ATOMIC_ACQUIRE, "agent");
            asm volatile("s_waitcnt vmcnt(0)" ::: "memory");
        }
    }
    __syncthreads();
}


using pg8::Unit;
struct EpiUp {
    static constexpr bool PERM = true, AFTER_DRAIN = false;
    bf16_t* O; int ldc;
    __device__ __forceinline__ void operator()(const f32x4 (&acc)[2][2][4][2], const Unit& u, int wr, int wc, int fr, int fq) const {
        const int row0 = u.pm * 256 + wr * 64 + fr, col0 = u.pn * 256 + wc * 32 + 8 * fq;
#pragma unroll
        for (int ai = 0; ai < 2; ++ai)
#pragma unroll
            for (int m = 0; m < 4; ++m) { bf16_t* rowp = O + (size_t)(row0 + ai * 128 + m * 16) * ldc + col0;
#pragma unroll
                for (int bj = 0; bj < 2; ++bj) { const f32x4 v0 = acc[ai][bj][m][0], v1 = acc[ai][bj][m][1];
                    u32x4 w; w.x = cvt_pk_bf16(v0[0], v0[1]); w.y = cvt_pk_bf16(v0[2], v0[3]); w.z = cvt_pk_bf16(v1[0], v1[1]); w.w = cvt_pk_bf16(v1[2], v1[3]);
                    *(u32x4*)(rowp + bj * 128) = w; } }
    }
};
struct EpiResid {
    static constexpr bool PERM = false, AFTER_DRAIN = false;
    const float* xa; const float* xb; float* out; const float* gate;
    __device__ __forceinline__ void operator()(const f32x4 (&acc)[2][2][4][2], const Unit& u, int wr, int wc, int fr, int fq) const {
        const int rbase = u.pm * 256;
        const float* xin = rbase < NCTXROWS ? xa + (size_t)rbase * DM : xb + (size_t)(rbase - NCTXROWS) * DM;
        const int cond = rbase < NCTXROWS ? 0 : 1 + ((rbase - NCTXROWS) >> 12);
        const int col0 = u.pn * 256 + wc * 32 + 4 * fq;
        const float* g = gate + cond * 6144 + col0;
        float* o = out + (size_t)rbase * DM;
        f32x4 gv[2][2];
#pragma unroll
        for (int bj = 0; bj < 2; ++bj)
#pragma unroll
            for (int n = 0; n < 2; ++n) gv[bj][n] = *(const f32x4*)(g + bj * 128 + n * 16);
#pragma unroll
        for (int ai = 0; ai < 2; ++ai)
#pragma unroll
            for (int m = 0; m < 4; ++m) { const size_t off = (size_t)(ai * 128 + wr * 64 + m * 16 + fr) * DM + col0;
#pragma unroll
                for (int bj = 0; bj < 2; ++bj)
#pragma unroll
                    for (int n = 0; n < 2; ++n) { const f32x4 x = *(const f32x4*)(xin + off + bj * 128 + n * 16);
                        *(f32x4*)(o + off + bj * 128 + n * 16) = x + gv[bj][n] * acc[ai][bj][m][n]; }
                if (m & 1) asm volatile("" ::: "memory"); }
    }
};
template <int NKV>
struct EpiQKV {
    static constexpr bool PERM = false, AFTER_DRAIN = false;
    bf16_t* Q; bf16_t* K; bf16_t* VT; float* newk; float* newv; const float* qn; const float* kn; const float* rope;
    __device__ __forceinline__ void operator()(const f32x4 (&acc)[2][2][4][2], const Unit& u, int wr, int wc, int fr, int fq) const {
        constexpr int KLD = NKV * 64;
        const int hs = 4 * u.pn + wc;
        const int rbase = u.pm * 256 + wr * 64 + fr;
        const bool latent = u.pm >= 16;
        if (hs < 16 + NKV) {
            const bool isq = hs < 16;
            const float* nw = isq ? qn : kn;
            f32x4 wn[2][2];
#pragma unroll
            for (int bj = 0; bj < 2; ++bj)
#pragma unroll
                for (int n = 0; n < 2; ++n) wn[bj][n] = *(const f32x4*)(nw + 32 * bj + 16 * n + 4 * fq);
#pragma unroll
            for (int ai = 0; ai < 2; ++ai)
#pragma unroll
                for (int m = 0; m < 4; ++m) {
                    const int row = rbase + ai * 128 + m * 16;
                    f32x4 v[2][2]; float ss = 0.f;
#pragma unroll
                    for (int bj = 0; bj < 2; ++bj)
#pragma unroll
                        for (int n = 0; n < 2; ++n) { v[bj][n] = acc[ai][bj][m][n]; const f32x4 t = v[bj][n] * v[bj][n]; ss += (t[0] + t[1]) + (t[2] + t[3]); }
                    ss += __shfl_xor(ss, 16); ss += __shfl_xor(ss, 32);
                    const float rinv = rsqrtf(ss * (1.0f / 64.0f) + EPSN);
#pragma unroll
                    for (int bj = 0; bj < 2; ++bj)
#pragma unroll
                        for (int n = 0; n < 2; ++n) v[bj][n] = v[bj][n] * rinv * wn[bj][n];
                    if (latent && NKV == 4) {
                        const int pr = ((row - NCTXROWS) & 4095) >> 6, pc = row & 63;
#pragma unroll
                        for (int bj = 0; bj < 2; ++bj) {
                            const int pos = bj ? pc : pr;
                            const f32x4* t = (const f32x4*)(rope + (pos * 16 + 4 * fq) * 2);
                            const f32x4 t0 = t[0], t1 = t[1];
                            const f32x4 cs = (f32x4){t0[0], t0[2], t1[0], t1[2]}, sn = (f32x4){t0[1], t0[3], t1[1], t1[3]};
                            const f32x4 x1 = v[bj][0], x2 = v[bj][1];
                            v[bj][0] = x1 * cs - x2 * sn; v[bj][1] = x2 * cs + x1 * sn;
                        }
                    }
                    if (isq) {
                        bf16_t* p = Q + (size_t)row * DM + hs * 64 + 4 * fq;
#pragma unroll
                        for (int bj = 0; bj < 2; ++bj)
#pragma unroll
                            for (int n = 0; n < 2; ++n) { u32x2 w; w.x = cvt_pk_bf16(v[bj][n][0], v[bj][n][1]); w.y = cvt_pk_bf16(v[bj][n][2], v[bj][n][3]); *(u32x2*)(p + 32 * bj + 16 * n) = w; }
                    } else {
                        const int kvh = hs - 16;
                        bf16_t* p = K + (size_t)row * KLD + kvh * 64 + 4 * fq;
#pragma unroll
                        for (int bj = 0; bj < 2; ++bj)
#pragma unroll
                            for (int n = 0; n < 2; ++n) { u32x2 w; w.x = cvt_pk_bf16(v[bj][n][0], v[bj][n][1]); w.y = cvt_pk_bf16(v[bj][n][2], v[bj][n][3]); *(u32x2*)(p + 32 * bj + 16 * n) = w; }
                        if (!latent) {
                            float* o = newk + (size_t)row * KLD + kvh * 64 + 4 * fq;
#pragma unroll
                            for (int bj = 0; bj < 2; ++bj)
#pragma unroll
                                for (int n = 0; n < 2; ++n) *(f32x4*)(o + 32 * bj + 16 * n) = v[bj][n];
                        }
                    }
                    asm volatile("" ::: "memory");
                }
        } else {
            const int kvh = hs - 16 - NKV;
#pragma unroll
            for (int ai = 0; ai < 2; ++ai)
#pragma unroll
                for (int m = 0; m < 4; ++m) {
                    const int row = rbase + ai * 128 + m * 16;
                    bf16_t* p = VT + ((size_t)(row >> 5) * NKV + kvh) * 2048 + (row & 31) + (4 * fq) * 32;
#pragma unroll
                    for (int bj = 0; bj < 2; ++bj)
#pragma unroll
                        for (int n = 0; n < 2; ++n)
#pragma unroll
                            for (int i = 0; i < 4; ++i) p[(32 * bj + 16 * n + i) * 32] = (bf16_t)f2bf(acc[ai][bj][m][n][i]);
                    if (!latent) {
                        float* o = newv + (size_t)row * KLD + kvh * 64 + 4 * fq;
#pragma unroll
                        for (int bj = 0; bj < 2; ++bj)
#pragma unroll
                            for (int n = 0; n < 2; ++n) *(f32x4*)(o + 32 * bj + 16 * n) = acc[ai][bj][m][n];
                    }
                    asm volatile("" ::: "memory");
                }
        }
    }
};

struct AttnState { f32x4 o[2][4]; float m[2]; float l[2]; };
#define MFMA16(a, b, c) __builtin_amdgcn_mfma_f32_16x16x32_bf16((a), (b), (c), 0, 0, 0)
template <int MASK>
__device__ __forceinline__ void attn_chunk(AttnState& st, const bf16x8 (&qf)[2][2], const bf16_t* kp, int kld, const bf16_t* vp, int fr, int fq, int mk0, int mk1, const float* bias) {
    bf16x8 kf[2][2], vf[4];
#pragma unroll
    for (int t = 0; t < 2; ++t)
#pragma unroll
        for (int h2 = 0; h2 < 2; ++h2) kf[t][h2] = *(const bf16x8*)(kp + (size_t)(16 * t + fr) * kld + 32 * h2 + 8 * fq);
#pragma unroll
    for (int dt = 0; dt < 4; ++dt) { const bf16_t* v = vp + (16 * dt + fr) * 32 + 4 * fq; const u32x2 lo = *(const u32x2*)v, hi = *(const u32x2*)(v + 16);
        vf[dt] = __builtin_bit_cast(bf16x8, ((u32x4){lo.x, lo.y, hi.x, hi.y})); }
#pragma unroll
    for (int qb = 0; qb < 2; ++qb) {
        f32x4 s0 = (f32x4){0.f, 0.f, 0.f, 0.f}, s1 = (f32x4){0.f, 0.f, 0.f, 0.f};
        s0 = MFMA16(kf[0][0], qf[qb][0], s0); s0 = MFMA16(kf[0][1], qf[qb][1], s0);
        s1 = MFMA16(kf[1][0], qf[qb][0], s1); s1 = MFMA16(kf[1][1], qf[qb][1], s1);
        float sv[8];
#pragma unroll
        for (int j = 0; j < 4; ++j) { sv[j] = s0[j] * SCL2; sv[4 + j] = s1[j] * SCL2; }
        if (MASK == 1) {
            const int d0 = mk0 + 4 * fq - 16 * qb - fr;
#pragma unroll
            for (int t = 0; t < 2; ++t)
#pragma unroll
                for (int j = 0; j < 4; ++j) { const int df = d0 + 16 * t + j; if (df > 128 || df < -128) sv[4 * t + j] = -INFINITY; }
        }
        if (MASK == 2) {
            const int qc = mk1 + 16 * qb + fr; int cs = qc - 8; cs = cs < 0 ? 0 : (cs > 48 ? 48 : cs);
#pragma unroll
            for (int t = 0; t < 2; ++t)
#pragma unroll
                for (int j = 0; j < 4; ++j) { const int kc = mk0 + 16 * t + 4 * fq + j; const bool ok = (kc >= cs) && (kc < cs + 16);
                    float bv = 0.f; if (ok) bv = bias[kc - qc + 15];
                    sv[4 * t + j] = ok ? sv[4 * t + j] + bv * LOG2E : -INFINITY; }
        }
        float cmax = fmaxf(fmaxf(fmaxf(sv[0], sv[1]), fmaxf(sv[2], sv[3])), fmaxf(fmaxf(sv[4], sv[5]), fmaxf(sv[6], sv[7])));
        cmax = fmaxf(cmax, __shfl_xor(cmax, 16)); cmax = fmaxf(cmax, __shfl_xor(cmax, 32));
        const float mnew = fmaxf(st.m[qb], cmax);
        const float msafe = (mnew == -INFINITY) ? 0.f : mnew;
        const float alpha = fast_exp2(st.m[qb] - msafe);
        st.m[qb] = mnew;
        float p[8]; float ps = 0.f;
#pragma unroll
        for (int j = 0; j < 8; ++j) { p[j] = fast_exp2(sv[j] - msafe); ps += p[j]; }
        st.l[qb] = st.l[qb] * alpha + ps;
        u32x4 pw; pw.x = cvt_pk_bf16(p[0], p[1]); pw.y = cvt_pk_bf16(p[2], p[3]); pw.z = cvt_pk_bf16(p[4], p[5]); pw.w = cvt_pk_bf16(p[6], p[7]);
        const bf16x8 pf = __builtin_bit_cast(bf16x8, pw);
#pragma unroll
        for (int dt = 0; dt < 4; ++dt) { st.o[qb][dt] = st.o[qb][dt] * alpha; st.o[qb][dt] = MFMA16(vf[dt], pf, st.o[qb][dt]); }
    }
}
__device__ __forceinline__ void attn_init(AttnState& st, bf16x8 (&qf)[2][2], const bf16_t* Q, int qrow0, int head, int fr, int fq) {
#pragma unroll
    for (int qb = 0; qb < 2; ++qb) { st.m[qb] = -INFINITY; st.l[qb] = 0.f;
#pragma unroll
        for (int dt = 0; dt < 4; ++dt) st.o[qb][dt] = (f32x4){0.f, 0.f, 0.f, 0.f};
#pragma unroll
        for (int h2 = 0; h2 < 2; ++h2) qf[qb][h2] = *(const bf16x8*)(Q + (size_t)(qrow0 + 16 * qb + fr) * DM + head * 64 + 32 * h2 + 8 * fq); }
}
__device__ __forceinline__ void attn_finish(AttnState& st, bf16_t* O, int qrow0, int head, int fr, int fq, bool has_sink, float sink) {
#pragma unroll
    for (int qb = 0; qb < 2; ++qb) {
        float l = st.l[qb]; l += __shfl_xor(l, 16); l += __shfl_xor(l, 32);
        if (has_sink) l += fast_exp2(sink * LOG2E - st.m[qb]);
        const float inv = 1.0f / l;
        bf16_t* o = O + (size_t)(qrow0 + 16 * qb + fr) * DM + head * 64 + 4 * fq;
#pragma unroll
        for (int dt = 0; dt < 4; ++dt) { const f32x4 v = st.o[qb][dt] * inv; u32x2 w; w.x = cvt_pk_bf16(v[0], v[1]); w.y = cvt_pk_bf16(v[2], v[3]); *(u32x2*)(o + 16 * dt) = w; }
    }
}
__device__ __forceinline__ void attn_phase_a(const bf16_t* Q, const bf16_t* K, const bf16_t* VT, const bf16_t* Kc, const bf16_t* VTc, const float* sinkp, bf16_t* O, int gw, int ngw, int lane) {
    const int fr = lane & 15, fq = lane >> 4;
    for (int t = gw; t < 4096; t += ngw) {
        const int b = t >> 11, rem = t & 2047, kvh = rem >> 9, rem2 = rem & 511, qblk = ((rem2 >> 3) << 1) | (rem2 & 1), g = (rem2 & 7) >> 1;
        const int head = kvh * 4 + g, qpos0 = qblk * 32, seq0 = NCTXROWS + b * 4096, qrow0 = seq0 + qpos0;
        AttnState st; bf16x8 qf[2][2];
        attn_init(st, qf, Q, qrow0, head, fr, fq);
        for (int c = 0; c < 16; ++c)
            attn_chunk<0>(st, qf, Kc + (size_t)(b * 512 + 32 * c) * 256 + kvh * 64, 256, VTc + (size_t)((b * 16 + c) * 4 + kvh) * 2048, fr, fq, 0, 0, nullptr);
        const int c0 = qblk - 4 < 0 ? 0 : qblk - 4, c1 = qblk + 4 > 127 ? 127 : qblk + 4;
        for (int c = c0; c <= c1; ++c) { const int krow = seq0 + 32 * c;
            attn_chunk<1>(st, qf, K + (size_t)krow * 256 + kvh * 64, 256, VT + (size_t)((krow >> 5) * 4 + kvh) * 2048, fr, fq, 32 * c - qpos0, 0, nullptr); }
        attn_finish(st, O, qrow0, head, fr, fq, true, sinkp[head]);
    }
    for (int t = gw; t < 2048; t += ngw) {
        const int b = t >> 7, rem = t & 127, kvh = rem >> 5, rem2 = rem & 31, qblk = ((rem2 >> 3) << 1) | (rem2 & 1), g = (rem2 & 7) >> 1;
        const int head = kvh * 4 + g, qrow0 = b * 256 + qblk * 32;
        AttnState st; bf16x8 qf[2][2];
        attn_init(st, qf, Q, qrow0, head, fr, fq);
        for (int c = 0; c < 8; ++c) { const int krow = b * 256 + 32 * c;
            attn_chunk<0>(st, qf, K + (size_t)krow * 256 + kvh * 64, 256, VT + (size_t)((krow >> 5) * 4 + kvh) * 2048, fr, fq, 0, 0, nullptr); }
        attn_finish(st, O, qrow0, head, fr, fq, true, sinkp[head]);
    }
}
__device__ __forceinline__ void attn_phase_b(const bf16_t* Q, const bf16_t* K, const bf16_t* VT, const bf16_t* Kc, const bf16_t* VTc, const float* rpb, bf16_t* O, int gw, int ngw, int lane) {
    const int fr = lane & 15, fq = lane >> 4;
    for (int t = gw; t < 4096; t += ngw) {
        const int b = t >> 11, rem = t & 2047, head = rem >> 7, qblk = rem & 127, r = qblk >> 1, half = qblk & 1;
        const int seq0 = NCTXROWS + b * 4096, qrow0 = seq0 + qblk * 32;
        AttnState st; bf16x8 qf[2][2];
        attn_init(st, qf, Q, qrow0, head, fr, fq);
        for (int c = 0; c < 16; ++c)
            attn_chunk<0>(st, qf, Kc + (size_t)(b * 512 + 32 * c) * 1024 + head * 64, 1024, VTc + (size_t)((b * 16 + c) * 16 + head) * 2048, fr, fq, 0, 0, nullptr);
        int rs = r - 4; rs = rs < 0 ? 0 : (rs > 56 ? 56 : rs);
        for (int i = 0; i < 8; ++i) { const int kr = rs + i; const float* brow = rpb + (size_t)(head * 15 + (kr - r + 7)) * 31;
            for (int ch = 0; ch < 2; ++ch) { const int krow = seq0 + kr * 64 + 32 * ch;
                attn_chunk<2>(st, qf, K + (size_t)krow * 1024 + head * 64, 1024, VT + (size_t)((krow >> 5) * 16 + head) * 2048, fr, fq, 32 * ch, 32 * half, brow); } }
        attn_finish(st, O, qrow0, head, fr, fq, false, 0.f);
    }
    for (int t = gw; t < 2048; t += ngw) {
        const int b = t >> 7, rem = t & 127, head = rem >> 3, qblk = rem & 7;
        const int qrow0 = b * 256 + qblk * 32;
        AttnState st; bf16x8 qf[2][2];
        attn_init(st, qf, Q, qrow0, head, fr, fq);
        for (int c = 0; c < 8; ++c) { const int krow = b * 256 + 32 * c;
            attn_chunk<0>(st, qf, K + (size_t)krow * 1024 + head * 64, 1024, VT + (size_t)((krow >> 5) * 16 + head) * 2048, fr, fq, 0, 0, nullptr); }
        attn_finish(st, O, qrow0, head, fr, fq, false, 0.f);
    }
}

__device__ __forceinline__ void transpose_item(const float* W, int K, int N, bf16_t* WT, int kb, int nb, int dst_n0, LAS float* scr, int lane) {
    const int k0 = 64 * kb, n0 = 32 * nb;
#pragma unroll 8
    for (int i = 0; i < 32; ++i) { const int kk = 2 * i + (lane >> 5); scr[kk * 33 + (lane & 31)] = W[(size_t)(k0 + kk) * N + n0 + (lane & 31)]; }
    asm volatile("s_waitcnt lgkmcnt(0)" ::: "memory");
    const int c = lane & 7;
#pragma unroll
    for (int j = 0; j < 4; ++j) { const int n = (lane >> 3) + 8 * j; const LAS float* s = scr + (8 * c) * 33 + n;
        u32x4 o; o.x = cvt_pk_bf16(s[0 * 33], s[1 * 33]); o.y = cvt_pk_bf16(s[2 * 33], s[3 * 33]); o.z = cvt_pk_bf16(s[4 * 33], s[5 * 33]); o.w = cvt_pk_bf16(s[6 * 33], s[7 * 33]);
        *(u32x4*)(WT + (size_t)(dst_n0 + n) * K + k0 + 8 * c) = o; }
    asm volatile("s_waitcnt lgkmcnt(0)" ::: "memory");
}
__device__ __forceinline__ int qkv_perm(int o) { return (o & ~255) + 128 * ((o >> 5) & 1) + 32 * ((o >> 6) & 3); }

__device__ __forceinline__ void prologue(const Args& a, LAS unsigned char* lds, int tid, int lane, int wave) {
    unsigned char* ws = a.ws;
    const int G = gridDim.x, bx = blockIdx.x;
    {
        LAS float* sc = (LAS float*)lds;
        LAS float* red = (LAS float*)(lds + 16384);
        bool have = false;
        for (int it = bx; it < 192; it += G) {
            if (!have) { for (int k = tid; k < 3072; k += NTHR) { const int cnd = k >> 10, kk = k & 1023; const float x = cnd == 0 ? a.in[7][kk] : a.in[6][(cnd - 1) * 1024 + kk]; sc[k] = silu_f(x); } have = true; }
            __syncthreads();
            const int l = it / 96, n0 = (it % 96) * 64;
            const float* W = a.in[10] + (size_t)l * 1024 * 6144 + n0;
            const int c4 = tid & 15, ks = tid >> 4;
            f32x4 a0 = (f32x4){0.f, 0.f, 0.f, 0.f}, a1 = a0, a2 = a0;
#pragma unroll 8
            for (int kk = 0; kk < 32; ++kk) { const int k = ks * 32 + kk; const f32x4 w = *(const f32x4*)(W + (size_t)k * 6144 + 4 * c4);
                a0 += w * sc[k]; a1 += w * sc[1024 + k]; a2 += w * sc[2048 + k]; }
#pragma unroll
            for (int j = 0; j < 4; ++j) { red[(ks * 3 + 0) * 64 + 4 * c4 + j] = a0[j]; red[(ks * 3 + 1) * 64 + 4 * c4 + j] = a1[j]; red[(ks * 3 + 2) * 64 + 4 * c4 + j] = a2[j]; }
            __syncthreads();
            if (tid < 192) { const int cnd = tid >> 6, col = tid & 63; float s = 0.f;
#pragma unroll 8
                for (int q = 0; q < 32; ++q) s += red[(q * 3 + cnd) * 64 + col];
                ((float*)(ws + WS_MOD))[(l * 3 + cnd) * 6144 + n0 + col] = s + a.in[11][l * 6144 + n0 + col]; }
        }
        __syncthreads();
    }
    const int gw = bx * NWAVES + wave, NGW = G * NWAVES;
    const size_t gt = (size_t)bx * NTHR + tid, NT = (size_t)G * NTHR;
    if (gt < 1024) { const int pos = (int)gt >> 4, f = (int)gt & 15; const float freq = exp2f(-(float)f * (13.287712379549449f / 16.0f)); const float ang = (float)pos * freq;
        float* rp = (float*)(ws + WS_ROPE); rp[2 * gt] = cosf(ang); rp[2 * gt + 1] = sinf(ang); }
    {
        LAS float* scr = (LAS float*)(lds + wave * 16384);
        constexpr int I_QA = 16 * 48, I_QB = 16 * 96, I_O = 16 * 32, I_UP = 16 * 176, I_DN = 44 * 32;
        constexpr int NITEMS = I_QA + I_QB + 2 * I_O + 2 * I_UP + 2 * I_DN;
        for (int it = gw; it < NITEMS; it += NGW) {
            int r = it;
            if (r < I_QA) { const int kb = r / 48, nb = r % 48; transpose_item(a.in[12], 1024, 1536, (bf16_t*)(ws + WS_WQKVA), kb, nb, qkv_perm(32 * nb), scr, lane); continue; } r -= I_QA;
            if (r < I_QB) { const int kb = r / 96, nb = r % 96; transpose_item(a.in[17], 1024, 3072, (bf16_t*)(ws + WS_WQKVB), kb, nb, qkv_perm(32 * nb), scr, lane); continue; } r -= I_QB;
            if (r < I_O) { const int kb = r / 32, nb = r % 32; transpose_item(a.in[16], 1024, 1024, (bf16_t*)(ws + WS_WOA), kb, nb, 32 * nb, scr, lane); continue; } r -= I_O;
            if (r < I_O) { const int kb = r / 32, nb = r % 32; transpose_item(a.in[21], 1024, 1024, (bf16_t*)(ws + WS_WOB), kb, nb, 32 * nb, scr, lane); continue; } r -= I_O;
            if (r < 2 * I_UP) { const int l = r / I_UP; r -= l * I_UP; const int kb = r / 176, nb = r % 176;
                transpose_item(a.in[22] + (size_t)l * 1024 * 5632, 1024, 5632, (bf16_t*)(ws + (l ? WS_WUP1 : WS_WUP0)), kb, nb, 32 * nb, scr, lane); continue; } r -= 2 * I_UP;
            { const int l = r / I_DN; r -= l * I_DN; const int kb = r / 32, nb = r % 32;
                transpose_item(a.in[25] + (size_t)l * 2816 * 1024, 2816, 1024, (bf16_t*)(ws + (l ? WS_WDN1 : WS_WDN0)), kb, nb, 32 * nb, scr, lane); }
        }
    }
    {
        bf16_t* kca = (bf16_t*)(ws + WS_KCA); bf16_t* kcb = (bf16_t*)(ws + WS_KCB); bf16_t* vca = (bf16_t*)(ws + WS_VTCA); bf16_t* vcb = (bf16_t*)(ws + WS_VTCB);
        for (size_t i = gt; i < 262144; i += NT) kca[i] = (bf16_t)f2bf(a.in[2][i]);
        for (size_t i = gt; i < 1048576; i += NT) kcb[i] = (bf16_t)f2bf(a.in[4][i]);
        for (size_t i = gt; i < 262144; i += NT) { const int tt = (int)i & 31, d = ((int)i >> 5) & 63, kvh = ((int)i >> 11) & 3, c = ((int)i >> 13) & 15, b = (int)i >> 17;
            vca[i] = (bf16_t)f2bf(a.in[3][((size_t)(b * 512 + c * 32 + tt) * 4 + kvh) * 64 + d]); }
        for (size_t i = gt; i < 1048576; i += NT) { const int tt = (int)i & 31, d = ((int)i >> 5) & 63, kvh = ((int)i >> 11) & 15, c = ((int)i >> 15) & 15, b = (int)i >> 19;
            vcb[i] = (bf16_t)f2bf(a.in[5][((size_t)(b * 512 + c * 32 + tt) * 16 + kvh) * 64 + d]); }
    }
}
__device__ __forceinline__ void norm_mod_phase(const float* xa, const float* xb, const float* nw, const float* shift, const float* scale, bf16_t* H, int gw, int ngw, int lane) {
    for (int row = gw; row < MTOK; row += ngw) {
        const float* xr = row < NCTXROWS ? xa + (size_t)row * DM : xb + (size_t)(row - NCTXROWS) * DM;
        const int cond = row < NCTXROWS ? 0 : 1 + ((row - NCTXROWS) >> 12);
        f32x4 v[4]; float s = 0.f;
#pragma unroll
        for (int j = 0; j < 4; ++j) { v[j] = *(const f32x4*)(xr + 4 * (lane + 64 * j)); const f32x4 t = v[j] * v[j]; s += (t[0] + t[1]) + (t[2] + t[3]); }
        const float rinv = rsqrtf(wave_sum(s) * (1.0f / DM) + EPSN);
#pragma unroll
        for (int j = 0; j < 4; ++j) { const int col = 4 * (lane + 64 * j);
            const f32x4 w = *(const f32x4*)(nw + col), sc = *(const f32x4*)(scale + cond * 6144 + col), sh = *(const f32x4*)(shift + cond * 6144 + col);
            const f32x4 y = (v[j] * rinv * w) * (sc + 1.0f) + sh;
            u32x2 o; o.x = cvt_pk_bf16(y[0], y[1]); o.y = cvt_pk_bf16(y[2], y[3]);
            *(u32x2*)(H + (size_t)row * DM + col) = o; }
    }
}
__device__ __forceinline__ void conv_act_phase(const bf16_t* U, const float* cw, const float* cb, bf16_t* ACT, size_t gt, size_t nt) {
    for (size_t item = gt; item < (size_t)384 * 352; item += nt) {
        const int rb = (int)(item / 352), fg = (int)(item % 352), r0 = rb * 32, f0 = fg * 8;
        const int pos0 = r0 < NCTXROWS ? (r0 & 255) : (r0 & 4095), L = r0 < NCTXROWS ? 256 : 4096;
        const bool has_prev = pos0 > 0, has_next = pos0 + 32 < L;
        float wg[3][8], wv[3][8], bg[8], bv[8];
#pragma unroll
        for (int o = 0; o < 3; ++o)
#pragma unroll
            for (int j = 0; j < 8; ++j) { wg[o][j] = cw[o * DUP + f0 + j]; wv[o][j] = cw[o * DUP + DFF + f0 + j]; }
#pragma unroll
        for (int j = 0; j < 8; ++j) { bg[j] = cb[f0 + j]; bv[j] = cb[DFF + f0 + j]; }
        const u32x4 z4 = (u32x4){0u, 0u, 0u, 0u};
        const bf16_t* up = U + (size_t)r0 * DUP + f0;
        u32x4 gp = z4, vp = z4, gc, vc, gn, vn;
        if (has_prev) { gp = *(const u32x4*)(up - DUP); vp = *(const u32x4*)(up - DUP + DFF); }
        gc = *(const u32x4*)up; vc = *(const u32x4*)(up + DFF);
        for (int r = 0; r < 32; ++r) {
            gn = z4; vn = z4;
            if (r < 31 || has_next) { gn = *(const u32x4*)(up + (size_t)(r + 1) * DUP); vn = *(const u32x4*)(up + (size_t)(r + 1) * DUP + DFF); }
            float res[8];
#pragma unroll
            for (int q = 0; q < 4; ++q) {
                const float g0 = wg[0][2 * q] * bflo(gp[q]) + wg[1][2 * q] * bflo(gc[q]) + wg[2][2 * q] * bflo(gn[q]) + bg[2 * q];
                const float g1 = wg[0][2 * q + 1] * bfhi(gp[q]) + wg[1][2 * q + 1] * bfhi(gc[q]) + wg[2][2 * q + 1] * bfhi(gn[q]) + bg[2 * q + 1];
                const float v0 = wv[0][2 * q] * bflo(vp[q]) + wv[1][2 * q] * bflo(vc[q]) + wv[2][2 * q] * bflo(vn[q]) + bv[2 * q];
                const float v1 = wv[0][2 * q + 1] * bfhi(vp[q]) + wv[1][2 * q + 1] * bfhi(vc[q]) + wv[2][2 * q + 1] * bfhi(vn[q]) + bv[2 * q + 1];
                res[2 * q] = silu_f(g0) * v0; res[2 * q + 1] = silu_f(g1) * v1;
            }
            u32x4 o; o.x = cvt_pk_bf16(res[0], res[1]); o.y = cvt_pk_bf16(res[2], res[3]); o.z = cvt_pk_bf16(res[4], res[5]); o.w = cvt_pk_bf16(res[6], res[7]);
            *(u32x4*)(ACT + (size_t)(r0 + r) * DFF + f0) = o;
            gp = gc; vp = vc; gc = gn; vc = vn;
        }
    }
}

__global__ void __launch_bounds__(NTHR, 2) mk_fwd(Args a) {
    extern __shared__ __attribute__((aligned(16))) unsigned char lds_raw[];
    cg::grid_group grid = cg::this_grid();
    LAS unsigned char* lds = (LAS unsigned char*)lds_raw;
    const int tid = threadIdx.x, lane = tid & 63, wave = __builtin_amdgcn_readfirstlane(tid >> 6);
    const int G = gridDim.x, bx = blockIdx.x;
    const int gw = bx * NWAVES + wave, NGW = G * NWAVES;
    const size_t gt = (size_t)bx * NTHR + tid, NT = (size_t)G * NTHR;
    unsigned char* ws = a.ws;
    float* out = a.out;
    bf16_t* H = (bf16_t*)(ws + WS_H); bf16_t* ACT = (bf16_t*)(ws + WS_ACT); bf16_t* U = (bf16_t*)(ws + WS_U);
    bf16_t* Qb = (bf16_t*)(ws + WS_Q); bf16_t* Kb = (bf16_t*)(ws + WS_K); bf16_t* VTb = (bf16_t*)(ws + WS_VT); bf16_t* Ob = (bf16_t*)(ws + WS_O);
    const float* rope = (const float*)(ws + WS_ROPE);

#ifndef NO_PRO
    for (int rep = 0; rep < REP_THIN; ++rep) { prologue(a, lds, tid, lane, wave); __syncthreads(); }
#endif
    volatile LAS unsigned* bst = (volatile LAS unsigned*)(lds + 131072 + 64);
    if (tid < 2) bst[tid] = 0u;
    unsigned* barw = (unsigned*)(ws + WS_BAR);
    if (bx == 0) for (int i = tid; i < XCD_BAR_WORDS; i += NTHR) barw[i] = 0u;
    grid.sync();
    const XcdBarrier xbar = xcd_barrier_post(barw, bst);
#define GSYNC() xcd_barrier(xbar)

#pragma unroll 1
    for (int layer = 0; layer < 2; ++layer) {
        const float* mod = (const float*)(ws + WS_MOD) + layer * 3 * 6144;
        const float* xa = layer == 0 ? a.in[0] : out;
        const float* xb = layer == 0 ? a.in[1] : out + (size_t)NCTXROWS * DM;
#ifndef NO_NORM
        for (int rep = 0; rep < REP_THIN; ++rep)
        { int tl = tid; asm volatile("" : "+v"(tl)); const int wv = __builtin_amdgcn_readfirstlane(tl >> 6);
          norm_mod_phase(xa, xb, a.in[8] + layer * DM, mod + 0 * 1024, mod + 1 * 1024, H, bx * NWAVES + wv, NGW, tl & 63); }
#endif
        GSYNC();
#ifndef NO_QKV
        if (layer == 0) {
            pg8::Gemm g{H, (const bf16_t*)(ws + WS_WQKVA), MTOK, 1536, 1024}; pg8::StaticOrder S; int bxl = bx; asm volatile("" : "+s"(bxl)); int tl = tid; asm volatile("" : "+v"(tl)); S.init(MTOK, 1536, G, bxl);
            EpiQKV<4> E{Qb, Kb, VTb, out + OUT_KA, out + OUT_VA, a.in[13], a.in[14], rope};
            pg8::gemm_phase<EpiQKV<4>, pg8::StaticOrder, true, true>(lds, g, S, E, tl);
        } else {
            pg8::Gemm g{H, (const bf16_t*)(ws + WS_WQKVB), MTOK, 3072, 1024}; pg8::StaticOrder S; int bxl = bx; asm volatile("" : "+s"(bxl)); int tl = tid; asm volatile("" : "+v"(tl)); S.init(MTOK, 3072, G, bxl);
            EpiQKV<16> E{Qb, Kb, VTb, out + OUT_KB, out + OUT_VB, a.in[18], a.in[19], rope};
            pg8::gemm_phase<EpiQKV<16>, pg8::StaticOrder, true, true>(lds, g, S, E, tl);
        }
#endif
        GSYNC();
#ifndef NO_ATTN
        for (int rep = 0; rep < REP_ATTN; ++rep)
        { int tl = tid; asm volatile("" : "+v"(tl)); const int wv = __builtin_amdgcn_readfirstlane(tl >> 6); const int gwl = bx * NWAVES + wv;
        if (layer == 0) attn_phase_a(Qb, Kb, VTb, (const bf16_t*)(ws + WS_KCA), (const bf16_t*)(ws + WS_VTCA), a.in[15], Ob, gwl, NGW, tl & 63);
        else attn_phase_b(Qb, Kb, VTb, (const bf16_t*)(ws + WS_KCB), (const bf16_t*)(ws + WS_VTCB), a.in[20], Ob, gwl, NGW, tl & 63); }
#endif
        GSYNC();
#ifndef NO_OPROJ
        {
            pg8::Gemm g{Ob, (const bf16_t*)(ws + (layer ? WS_WOB : WS_WOA)), MTOK, 1024, 1024}; pg8::StaticOrder S; int bxl = bx; asm volatile("" : "+s"(bxl)); int tl = tid; asm volatile("" : "+v"(tl)); S.init(MTOK, 1024, G, bxl);
            EpiResid E{xa, xb, out, mod + 2 * 1024};
            pg8::gemm_phase<EpiResid, pg8::StaticOrder, true, true>(lds, g, S, E, tl);
        }
#endif
        GSYNC();
#ifndef NO_NORM
        for (int rep = 0; rep < REP_THIN; ++rep)
        { int tl = tid; asm volatile("" : "+v"(tl)); const int wv = __builtin_amdgcn_readfirstlane(tl >> 6);
          norm_mod_phase(out, out + (size_t)NCTXROWS * DM, a.in[9] + layer * DM, mod + 3 * 1024, mod + 4 * 1024, H, bx * NWAVES + wv, NGW, tl & 63); }
#endif
        GSYNC();
#ifndef NO_UP
        {
            pg8::Gemm g{H, (const bf16_t*)(ws + (layer ? WS_WUP1 : WS_WUP0)), MTOK, DUP, 1024}; pg8::StaticOrder S; int bxl = bx; asm volatile("" : "+s"(bxl)); int tl = tid; asm volatile("" : "+v"(tl)); S.init(MTOK, DUP, G, bxl);
            EpiUp E{U, DUP};
            pg8::gemm_phase<EpiUp, pg8::StaticOrder, true, true>(lds, g, S, E, tl);
        }
#endif
        GSYNC();
#ifndef NO_CONV
        for (int rep = 0; rep < REP_THIN; ++rep)
        { int tl = tid; asm volatile("" : "+v"(tl));
          conv_act_phase(U, a.in[23] + (size_t)layer * 3 * DUP, a.in[24] + (size_t)layer * DUP, ACT, (size_t)bx * NTHR + tl, NT); }
#endif
        GSYNC();
#ifndef NO_DOWN
        {
            pg8::Gemm g{ACT, (const bf16_t*)(ws + (layer ? WS_WDN1 : WS_WDN0)), MTOK, 1024, DFF}; pg8::StaticOrder S; int bxl = bx; asm volatile("" : "+s"(bxl)); int tl = tid; asm volatile("" : "+v"(tl)); S.init(MTOK, 1024, G, bxl);
            EpiResid E{out, out + (size_t)NCTXROWS * DM, out, mod + 5 * 1024};
            pg8::gemm_phase<EpiResid, pg8::StaticOrder, true, true>(lds, g, S, E, tl);
        }
#endif
        if (layer == 0) GSYNC();
    }
}

extern "C" void kernel_launch(void* const* d_in, const int* in_sizes, int n_in, void* d_out, int out_size, void* d_ws, size_t ws_size, hipStream_t stream) {
    static int grid = 0;
    if (grid == 0) {
        if (n_in != 26 || out_size != 23068672 || ws_size < WS_END) { fprintf(stderr, "kernel_launch: unexpected shapes n_in %d out %d ws %zu\n", n_in, out_size, ws_size); grid = -1; return; }
        int dev = 0, cus = 0, per_cu = 0;
        hipGetDevice(&dev);
        hipDeviceGetAttribute(&cus, hipDeviceAttributeMultiprocessorCount, dev);
        hipFuncSetAttribute((const void*)mk_fwd, hipFuncAttributeMaxDynamicSharedMemorySize, LDS_BYTES);
        hipOccupancyMaxActiveBlocksPerMultiprocessor(&per_cu, (const void*)mk_fwd, NTHR, LDS_BYTES);
        if (per_cu < 1) per_cu = 1;
        grid = cus * per_cu;
    }
    if (grid < 0) return;
    Args a{};
    for (int i = 0; i < 26; ++i) a.in[i] = (const float*)d_in[i];
    a.out = (float*)d_out; a.ws = (unsigned char*)d_ws;
    void* args[] = {&a};
    hipError_t e = hipLaunchCooperativeKernel((const void*)mk_fwd, dim3(grid), dim3(NTHR), args, LDS_BYTES, stream);
    if (e != hipSuccess) fprintf(stderr, "cooperative launch failed: %s (grid %d)\n", hipGetErrorString(e), grid);
}
```

```cpp
#include <hip/hip_runtime.h>
#include <hip/hip_cooperative_groups.h>
#include <cstdio>
#include <cstdint>
namespace cg = cooperative_groups;
namespace pg8 {
#define PG8_LAS __attribute__((address_space(3)))
typedef unsigned short bf16_t;
typedef short bf16x8 __attribute__((ext_vector_type(8)));
typedef float f32x4 __attribute__((ext_vector_type(4)));
typedef unsigned u32x4 __attribute__((ext_vector_type(4)));
constexpr int BM = 256, BK = 64, HALF = 128, HTB = HALF * BK * 2  , STAGE_BYTES = 8 * HTB, NXCD = 8, WGM = 8;

__host__ __device__ __forceinline__ int lds_byte(int r, int c) { const int st = (r >> 4) * 2 + (c >> 5), rr = r & 15, cc = c & 31, ob = rr * 64 + cc * 2; return st * 1024 + (ob ^ (((ob >> 9) & 1) << 5)); }
__host__ __device__ __forceinline__ void stage_rc(int b, int& R, int& C) { const int st = b / 1024, sb = b % 1024, swz = sb ^ (((sb >> 9) & 1) << 5); R = (st >> 1) * 16 + swz / 64; C = (st & 1) * 32 + (swz % 64) / 2; }
__host__ __device__ __forceinline__ int perm32(int rho) { const int n = rho >> 4, i = rho & 15; return 8 * (i >> 2) + 4 * n + (i & 3); }

struct Unit { int pm, pn; };
struct Gemm { const bf16_t* A; const bf16_t* Bt; int M, N, K; };

struct StaticOrder {
    int nM, nN, nwg, G, c;
    __host__ __device__ void init(int M, int N, int G_, int c_) { nM = M / BM; nN = N / BM; nwg = nM * nN; G = G_; c = c_; }
    __host__ __device__ bool next(int i, Unit& u) const {
        const long L = (long)i * G + c; if (L >= nwg) return false;
        int wgid = (int)L; { const int q = nwg / NXCD, r = nwg % NXCD, xcd = wgid % NXCD, off = wgid / NXCD; wgid = (xcd < r ? xcd * (q + 1) : r * (q + 1) + (xcd - r) * q) + off; }
        const int nig = WGM * nN, gid = wgid / nig, fm = gid * WGM, gsz = (nM - fm) < WGM ? (nM - fm) : WGM;
        u.pm = fm + ((wgid % nig) % gsz); u.pn = (wgid % nig) / gsz; return true;
    }
    __device__ __forceinline__ void a_ready(const Unit&) const {}
    __device__ __forceinline__ void done(const Unit&) const {}
};

__device__ __forceinline__ unsigned cvt_pk_bf16(float lo, float hi) { unsigned r; asm volatile("v_cvt_pk_bf16_f32 %0, %1, %2" : "=v"(r) : "v"(lo), "v"(hi)); return r; }
template <class Epi, class Sched, bool ALIGN_EPI = false, bool SP2 = false>
__device__ __forceinline__ void gemm_phase(PG8_LAS unsigned char* lds, const Gemm g, const Sched& S, const Epi& E, const int tid_in) {
    const int tid = tid_in, wid = __builtin_amdgcn_readfirstlane(tid >> 6), lane = tid & 63, wr = wid >> 2, wc = wid & 3, fr = lane & 15, fq = lane >> 4;
    const int K = g.K, nt = K / BK;
    unsigned voffA[2], voffB[2];
#pragma unroll
    for (int i = 0; i < 2; ++i) { int R, C; stage_rc(tid * 16 + i * 8192, R, C); const int Rb = Epi::PERM ? ((R & ~31) + perm32(R & 31)) : R;
        voffA[i] = (unsigned)(R * K + C) * 2u; voffB[i] = (unsigned)(Rb * K + C) * 2u; }
    const size_t kstep = (size_t)(BK * 2);
    const size_t hstep = (size_t)HALF * K * 2;
    const size_t tstep = 2 * hstep;
    const unsigned ldsw = (unsigned)wid * 1024u;
    const int aoff = lds_byte(wr * 64 + fr, fq * 8), boff = lds_byte(wc * 32 + fr, fq * 8);
#define PG8_SA(b, h) (((b) * 2 + (h)) * HTB)
#define PG8_SB(b, h) ((4 + (b) * 2 + (h)) * HTB)
#define PG8_STAGE(bufoff, gbase, voff) do { _Pragma("unroll") for (int _i = 0; _i < 2; ++_i) \
        __builtin_amdgcn_global_load_lds((const unsigned*)((const char*)(gbase) + (voff)[_i]), (PG8_LAS unsigned*)(lds + (bufoff) + ldsw + _i * 8192), 16, 0, 0); } while (0)
#define PG8_LDA(dst, b, h) do { _Pragma("unroll") for (int m = 0; m < 4; ++m) _Pragma("unroll") for (int k = 0; k < 2; ++k) dst[m][k] = *(const PG8_LAS bf16x8*)(lds + PG8_SA(b, h) + aoff + m * 2048 + k * 1024); } while (0)
#define PG8_LDB(dst, b, h) do { _Pragma("unroll") for (int n = 0; n < 2; ++n) _Pragma("unroll") for (int k = 0; k < 2; ++k) dst[n][k] = *(const PG8_LAS bf16x8*)(lds + PG8_SB(b, h) + boff + n * 2048 + k * 1024); } while (0)
#define PG8_MMA(ai, bj, At, Bt) do { __builtin_amdgcn_s_setprio(1); _Pragma("unroll") for (int m = 0; m < 4; ++m) _Pragma("unroll") for (int n = 0; n < 2; ++n) _Pragma("unroll") for (int k = 0; k < 2; ++k) \
        acc[ai][bj][m][n] = __builtin_amdgcn_mfma_f32_16x16x32_bf16(Bt[n][k], At[m][k], acc[ai][bj][m][n], 0, 0, 0); __builtin_amdgcn_s_setprio(0); } while (0)
#define PG8_WAIT_V(n) asm volatile("s_waitcnt vmcnt(" #n ")" ::: "memory")
#define PG8_WAIT_L(n) asm volatile("s_waitcnt lgkmcnt(" #n ")" ::: "memory")
#define PG8_BAR __builtin_amdgcn_s_barrier()
#define PG8_SCHED __builtin_amdgcn_sched_barrier(0)
    Unit cur, nxt; int ui = 0;
    if (!S.next(0, cur)) return;
    f32x4 acc[2][2][4][2];
#pragma unroll
    for (int a = 0; a < 2; ++a)
#pragma unroll
        for (int b = 0; b < 2; ++b)
#pragma unroll
            for (int m = 0; m < 4; ++m)
#pragma unroll
                for (int n = 0; n < 2; ++n) acc[a][b][m][n] = (f32x4){0.f, 0.f, 0.f, 0.f};
    bf16x8 At[4][2], B0[2][2], B1[2][2];
    const char* cA = (const char*)g.A + (size_t)Epi::a_row0(cur.pm) * ((size_t)K * 2); const char* cB = (const char*)g.Bt + (size_t)cur.pn * tstep;
    S.a_ready(cur);
    if constexpr (SP2) {
        PG8_STAGE(PG8_SB(0, 0), cB, voffB); PG8_STAGE(PG8_SB(0, 1), cB + hstep, voffB); PG8_STAGE(PG8_SA(0, 0), cA, voffA); PG8_STAGE(PG8_SA(0, 1), cA + hstep, voffA);
        if (wr == 1) PG8_BAR;
        PG8_WAIT_V(2); PG8_BAR;
        PG8_STAGE(PG8_SB(1, 0), cB + kstep, voffB); PG8_STAGE(PG8_SA(1, 0), cA + kstep, voffA); PG8_STAGE(PG8_SB(1, 1), cB + hstep + kstep, voffB);
        PG8_WAIT_V(6); PG8_BAR;
    } else {
        PG8_STAGE(PG8_SB(0, 0), cB, voffB); PG8_STAGE(PG8_SA(0, 0), cA, voffA); PG8_STAGE(PG8_SB(0, 1), cB + hstep, voffB); PG8_STAGE(PG8_SA(0, 1), cA + hstep, voffA);
        if (wr == 1) PG8_BAR;
        PG8_WAIT_V(4); PG8_BAR;
        PG8_STAGE(PG8_SB(1, 0), cB + kstep, voffB); PG8_STAGE(PG8_SA(1, 0), cA + kstep, voffA); PG8_STAGE(PG8_SB(1, 1), cB + hstep + kstep, voffB);
        PG8_WAIT_V(6); PG8_BAR;
    }
    for (;;) {
        const bool has_next = S.next(ui + 1, nxt);
        const char* nA = has_next ? (const char*)g.A + (size_t)Epi::a_row0(nxt.pm) * ((size_t)K * 2) : cA; const char* nB = has_next ? (const char*)g.Bt + (size_t)nxt.pn * tstep : cB;
        for (int t = 0; t < nt; t += 2) {
            const bool last = (t == nt - 2);
            const char* a1 = cA + (size_t)(t + 1) * kstep;
            const char* a2 = last ? nA : cA + (size_t)(t + 2) * kstep; const char* b2 = last ? nB : cB + (size_t)(t + 2) * kstep;
            const char* a3 = a2 + kstep; const char* b3 = b2 + kstep;
            if (last && has_next) S.a_ready(nxt);
            if constexpr (SP2) {
            PG8_LDB(B0, 0, 0); PG8_LDB(B1, 0, 1); PG8_SCHED; PG8_LDA(At, 0, 0); PG8_STAGE(PG8_SA(1, 1), a1 + hstep, voffA);
            PG8_WAIT_V(8); PG8_WAIT_L(0); PG8_BAR; PG8_MMA(0, 0, At, B0); PG8_MMA(0, 1, At, B1); PG8_BAR; PG8_SCHED;
            PG8_LDA(At, 0, 1); PG8_STAGE(PG8_SB(0, 0), b2, voffB); PG8_STAGE(PG8_SB(0, 1), b2 + hstep, voffB); PG8_STAGE(PG8_SA(0, 0), a2, voffA);
            PG8_WAIT_V(8); PG8_WAIT_L(0); PG8_BAR; PG8_MMA(1, 0, At, B0); PG8_MMA(1, 1, At, B1); PG8_BAR; PG8_SCHED;
            PG8_LDB(B0, 1, 0); PG8_LDB(B1, 1, 1); PG8_SCHED; PG8_LDA(At, 1, 0); PG8_STAGE(PG8_SA(0, 1), a2 + hstep, voffA);
            PG8_WAIT_V(8); PG8_WAIT_L(0); PG8_BAR; PG8_MMA(0, 0, At, B0); PG8_MMA(0, 1, At, B1); PG8_BAR; PG8_SCHED;
            PG8_LDA(At, 1, 1); PG8_STAGE(PG8_SB(1, 0), b3, voffB); PG8_STAGE(PG8_SB(1, 1), b3 + hstep, voffB); PG8_STAGE(PG8_SA(1, 0), a3, voffA);
            PG8_WAIT_V(8); PG8_WAIT_L(0); PG8_BAR; PG8_MMA(1, 0, At, B0); PG8_MMA(1, 1, At, B1); PG8_BAR; PG8_SCHED;
            } else {
            PG8_LDB(B0, 0, 0); PG8_SCHED; PG8_LDA(At, 0, 0); PG8_STAGE(PG8_SA(1, 1), a1 + hstep, voffA);
            PG8_WAIT_L(8); PG8_BAR; PG8_WAIT_L(0); PG8_MMA(0, 0, At, B0); PG8_BAR; PG8_SCHED;
            PG8_LDB(B1, 0, 1); PG8_STAGE(PG8_SB(0, 0), b2, voffB);
            PG8_BAR; PG8_WAIT_L(0); PG8_MMA(0, 1, At, B1); PG8_BAR;
            PG8_LDA(At, 0, 1); PG8_STAGE(PG8_SA(0, 0), a2, voffA);
            PG8_BAR; PG8_WAIT_L(0); PG8_MMA(1, 0, At, B0); PG8_BAR; PG8_SCHED;
            PG8_STAGE(PG8_SB(0, 1), b2 + hstep, voffB);
            PG8_WAIT_V(6); PG8_BAR; PG8_MMA(1, 1, At, B1); PG8_BAR;
            PG8_LDB(B0, 1, 0); PG8_SCHED; PG8_LDA(At, 1, 0); PG8_STAGE(PG8_SA(0, 1), a2 + hstep, voffA);
            PG8_WAIT_L(8); PG8_BAR; PG8_WAIT_L(0); PG8_MMA(0, 0, At, B0); PG8_BAR; PG8_SCHED;
            PG8_LDB(B1, 1, 1); PG8_STAGE(PG8_SB(1, 0), b3, voffB);
            PG8_BAR; PG8_WAIT_L(0); PG8_MMA(0, 1, At, B1); PG8_BAR;
            PG8_LDA(At, 1, 1); PG8_STAGE(PG8_SA(1, 0), a3, voffA);
            PG8_BAR; PG8_WAIT_L(0); PG8_MMA(1, 0, At, B0); PG8_BAR; PG8_SCHED;
            PG8_STAGE(PG8_SB(1, 1), b3 + hstep, voffB);
            PG8_WAIT_V(6); PG8_BAR; PG8_MMA(1, 1, At, B1); PG8_BAR;
            }
        }
        if constexpr (ALIGN_EPI) { if (wr == 0) PG8_BAR; }
        if constexpr (!Epi::AFTER_DRAIN) { E(acc, cur, wr, wc, fr, fq); S.done(cur); }
        if (!has_next) break;
#pragma unroll
        for (int a = 0; a < 2; ++a)
#pragma unroll
            for (int b = 0; b < 2; ++b)
#pragma unroll
                for (int m = 0; m < 4; ++m)
#pragma unroll
                    for (int n = 0; n < 2; ++n) acc[a][b][m][n] = (f32x4){0.f, 0.f, 0.f, 0.f};
        cur = nxt; cA = nA; cB = nB; ++ui;
        if constexpr (ALIGN_EPI) { if (wr == 1) PG8_BAR; }
    }
    PG8_WAIT_V(0);
    if constexpr (!ALIGN_EPI) { if (wr == 0) PG8_BAR; }
    PG8_BAR;
    if constexpr (Epi::AFTER_DRAIN) { E.fused(acc, cur, wr, wc, fr, fq, lds, wid, lane); S.done(cur); }
#undef PG8_SA
#undef PG8_SB
#undef PG8_STAGE
#undef PG8_LDA
#undef PG8_LDB
#undef PG8_MMA
#undef PG8_WAIT_V
#undef PG8_WAIT_L
#undef PG8_BAR
#undef PG8_SCHED
}
}

#define LAS __attribute__((address_space(3)))
typedef unsigned short bf16_t;
typedef short bf16x8 __attribute__((ext_vector_type(8)));
typedef float f32x4 __attribute__((ext_vector_type(4)));
typedef float f32x2 __attribute__((ext_vector_type(2)));
typedef unsigned u32x4 __attribute__((ext_vector_type(4)));
typedef unsigned u32x2 __attribute__((ext_vector_type(2)));
using pg8::cvt_pk_bf16;

#ifndef REP_ATTN
#define REP_ATTN 1
#endif
#ifndef REP_THIN
#define REP_THIN 1
#endif
constexpr int NWAVES = 8, NTHR = 512;
constexpr int LDS_BYTES = 147456;
constexpr int MTOK = 12288, NCTXROWS = 4096, DM = 1024, DFF = 2816, DUP = 5632;
constexpr float EPSN = 1e-6f;
constexpr float LOG2E = 1.4426950408889634f;
constexpr float SCL2 = 0.125f * 1.4426950408889634f;

constexpr size_t MiB = 1u << 20;
constexpr size_t WS_MOD = 0;
constexpr size_t WS_ROPE = 256 * 1024;
constexpr size_t WS_BAR = 512 * 1024;
constexpr size_t WS_KCA = 1 * MiB;
constexpr size_t WS_VTCA = 1 * MiB + 512 * 1024;
constexpr size_t WS_KCB = 2 * MiB;
constexpr size_t WS_VTCB = 4 * MiB;
constexpr size_t WS_WQKVA = 6 * MiB, WS_WQKVB = 9 * MiB, WS_WOA = 15 * MiB, WS_WOB = 17 * MiB;
constexpr size_t WS_WUP0 = 19 * MiB, WS_WUP1 = 30 * MiB, WS_WDN0 = 41 * MiB, WS_WDN1 = 46 * MiB + 512 * 1024;
constexpr size_t WS_H = 52 * MiB;
constexpr size_t WS_ACT = 118 * MiB;
constexpr size_t WS_U = 118 * MiB;
constexpr size_t WS_Q = 118 * MiB, WS_K = 142 * MiB, WS_VT = 166 * MiB, WS_O = 190 * MiB;
constexpr size_t WS_END = 250 * MiB;
constexpr size_t OUT_Y = 0, OUT_KA = 12582912, OUT_VA = 13631488, OUT_KB = 14680064, OUT_VB = 18874368;

__device__ __forceinline__ unsigned f2bf(float f) { unsigned u = __builtin_bit_cast(unsigned, f); return (u + 0x7fffu + ((u >> 16) & 1u)) >> 16; }
__device__ __forceinline__ float bflo(unsigned w) { return __builtin_bit_cast(float, w << 16); }
__device__ __forceinline__ float bfhi(unsigned w) { return __builtin_bit_cast(float, w & 0xffff0000u); }
__device__ __forceinline__ float wave_sum(float v) {
#pragma unroll
    for (int o = 1; o < 64; o <<= 1) v += __shfl_xor(v, o);
    return v;
}
__device__ __forceinline__ float fast_exp2(float x) { return __builtin_amdgcn_exp2f(x); }
__device__ __forceinline__ float silu_f(float x) { return x * __builtin_amdgcn_rcpf(1.0f + __expf(-x)); }

struct Args { const float* in[26]; float* out; unsigned char* ws; };

#define XB_TMO      128
#define XB_XCNT(j)  (256  + 64 * (j))
#define XB_XSUB(j)  (1280 + 64 * (j))
#define XB_XGEN(j)  (2304 + 64 * (j))
#define XB_TOP      3328
#define XB_TOPGEN   3392
#define XCD_BAR_WORDS 3456
#define XB_SPIN_CAP (1u << 18)

__device__ __forceinline__ unsigned xb_ld(unsigned* p)              { return __hip_atomic_load(p, __ATOMIC_RELAXED, __HIP_MEMORY_SCOPE_AGENT); }
__device__ __forceinline__ unsigned xb_add(unsigned* p, unsigned v) { return __hip_atomic_fetch_add(p, v, __ATOMIC_RELAXED, __HIP_MEMORY_SCOPE_AGENT); }
__device__ __forceinline__ unsigned xb_xcc_id() { return (unsigned)__builtin_amdgcn_s_getreg((3 << 11) | 20) & 0xFu; }
#define XB_SPIN(cond, bar) do { unsigned _sp = 0; while (cond) { __builtin_amdgcn_s_sleep(1); \
    if ((++_sp & 255u) == 0u) { if (xb_ld(&(bar)[XB_TMO])) break; if (_sp > XB_SPIN_CAP) { atomicAdd(&(bar)[XB_TMO], 1u); break; } } } } while (0)

struct XcdBarrier {
    unsigned* bar; unsigned x;
    volatile LAS unsigned* st;
};

__device__ __forceinline__ XcdBarrier xcd_barrier_post(unsigned* bar, volatile LAS unsigned* st) {
    XcdBarrier b; b.bar = bar; b.x = xb_xcc_id(); b.st = st;
    if (threadIdx.x == 0) (void)xb_add(&bar[XB_XCNT(b.x)], 1u);
    return b;
}
__device__ __forceinline__ void xcd_barrier_complete(unsigned* bar, unsigned x, unsigned& nloc, unsigned& nx) {
    const unsigned G = gridDim.x * gridDim.y * gridDim.z;
    unsigned sum, cnt, mine, sp = 0u;
    for (;;) {
        sum = 0u; cnt = 0u; mine = 0u;
#pragma unroll
        for (unsigned j = 0; j < 16; ++j) { const unsigned c = xb_ld(&bar[XB_XCNT(j)]); sum += c; cnt += (c > 0u) ? 1u : 0u; mine = (j == x) ? c : mine; }
        if (sum == G) break;
        __builtin_amdgcn_s_sleep(1);
        if ((++sp & 255u) == 0u) { if (xb_ld(&bar[XB_TMO])) break; if (sp > XB_SPIN_CAP) { atomicAdd(&bar[XB_TMO], 1u); break; } }
    }
    nloc = mine > 0u ? mine : 1u; nx = cnt > 0u ? cnt : 1u;
}

__device__ __forceinline__ void xcd_barrier(const XcdBarrier& b) {
    asm volatile("s_waitcnt vmcnt(0)" ::: "memory");
    __syncthreads();
    if (threadIdx.x == 0) {
        unsigned* bar = b.bar;
        __builtin_amdgcn_s_waitcnt(0);
        unsigned nloc = b.st[0], nx = b.st[1];
        if (nloc == 0u) { xcd_barrier_complete(bar, b.x, nloc, nx); b.st[0] = nloc; b.st[1] = nx; }
        const unsigned old = xb_add(&bar[XB_XSUB(b.x)], 1u);
        const unsigned gen = old / nloc;
        if (old + 1u == (gen + 1u) * nloc) {
            __builtin_amdgcn_fence(__ATOMIC_RELEASE, "agent");
            asm volatile("s_waitcnt vmcnt(0)" ::: "memory");
            const unsigned og = xb_add(&bar[XB_TOP], 1u);
            const unsigned tg = og / nx;
            if (og + 1u == (tg + 1u) * nx) xb_add(&bar[XB_TOPGEN], 1u);
            else XB_SPIN(xb_ld(&bar[XB_TOPGEN]) == tg, bar);
            __builtin_amdgcn_fence(__ATOMIC_ACQUIRE, "agent");
            xb_add(&bar[XB_XGEN(b.x)], 1u);
            asm volatile("s_waitcnt vmcnt(0)" ::: "memory");
        } else {
            XB_SPIN(xb_ld(&bar[XB_XGEN(b.x)]) == gen, bar);
            __builtin_amdgcn_fence(__ATOMIC_ACQUIRE, "agent");
            asm volatile("s_waitcnt vmcnt(0)" ::: "memory");
        }
    }
    __syncthreads();
}


using pg8::Unit;
struct EpiUp {
    static constexpr bool PERM = true, AFTER_DRAIN = false;
    static __device__ __forceinline__ int a_row0(int pm) { return pm * 256; }
    bf16_t* O; int ldc;
    __device__ __forceinline__ void operator()(const f32x4 (&acc)[2][2][4][2], const Unit& u, int wr, int wc, int fr, int fq) const {
        const int row0 = u.pm * 256 + wr * 64 + fr, col0 = u.pn * 256 + wc * 32 + 8 * fq;
#pragma unroll
        for (int ai = 0; ai < 2; ++ai)
#pragma unroll
            for (int m = 0; m < 4; ++m) { bf16_t* rowp = O + (size_t)(row0 + ai * 128 + m * 16) * ldc + col0;
#pragma unroll
                for (int bj = 0; bj < 2; ++bj) { const f32x4 v0 = acc[ai][bj][m][0], v1 = acc[ai][bj][m][1];
                    u32x4 w; w.x = cvt_pk_bf16(v0[0], v0[1]); w.y = cvt_pk_bf16(v0[2], v0[3]); w.z = cvt_pk_bf16(v1[0], v1[1]); w.w = cvt_pk_bf16(v1[2], v1[3]);
                    *(u32x4*)(rowp + bj * 128) = w; } }
    }
};
struct EpiResid {
    static constexpr bool PERM = false, AFTER_DRAIN = false;
    static __device__ __forceinline__ int a_row0(int pm) { return pm * 256; }
    const float* xa; const float* xb; float* out; const float* gate;
    __device__ __forceinline__ void operator()(const f32x4 (&acc)[2][2][4][2], const Unit& u, int wr, int wc, int fr, int fq) const {
        const int rbase = u.pm * 256;
        const float* xin = rbase < NCTXROWS ? xa + (size_t)rbase * DM : xb + (size_t)(rbase - NCTXROWS) * DM;
        const int cond = rbase < NCTXROWS ? 0 : 1 + ((rbase - NCTXROWS) >> 12);
        const int col0 = u.pn * 256 + wc * 32 + 4 * fq;
        const float* g = gate + cond * 6144 + col0;
        float* o = out + (size_t)rbase * DM;
        f32x4 gv[2][2];
#pragma unroll
        for (int bj = 0; bj < 2; ++bj)
#pragma unroll
            for (int n = 0; n < 2; ++n) gv[bj][n] = *(const f32x4*)(g + bj * 128 + n * 16);
#pragma unroll
        for (int ai = 0; ai < 2; ++ai)
#pragma unroll
            for (int m = 0; m < 4; ++m) { const size_t off = (size_t)(ai * 128 + wr * 64 + m * 16 + fr) * DM + col0;
#pragma unroll
                for (int bj = 0; bj < 2; ++bj)
#pragma unroll
                    for (int n = 0; n < 2; ++n) { const f32x4 x = *(const f32x4*)(xin + off + bj * 128 + n * 16);
                        *(f32x4*)(o + off + bj * 128 + n * 16) = x + gv[bj][n] * acc[ai][bj][m][n]; }
                if (m & 1) asm volatile("" ::: "memory"); }
    }
};

struct EpiUpConv {
    static constexpr bool PERM = false, AFTER_DRAIN = false;
    static __device__ __forceinline__ int a_row0(int pm) {
        if (pm < 16) return pm * 256;
        const int s = (pm - 16) / 17, j = (pm - 16) % 17; int st = 254 * j - 1; st = st > 3841 ? 3841 : st;
        return NCTXROWS + 4096 * s + st;
    }
    bf16_t* ACT; const float* cw; const float* cb; LAS float* xch;
    __device__ __forceinline__ void operator()(const f32x4 (&acc)[2][2][4][2], const Unit& u, int wr, int wc, int fr, int fq) const {
        const bool latent = u.pm >= 16;
        const int j17 = latent ? (u.pm - 16) % 17 : -1;
        const bool zr0 = (j17 == 0) && (wr == 0) && (fr == 0), zr255 = (j17 == 16) && (wr == 1) && (fr == 15);
        const int grow0 = a_row0(u.pm);
        const int lane = fq * 16 + fr;
        const int src_prev = (lane & 48) | ((fr + 15) & 15), src_next = (lane & 48) | ((fr + 1) & 15);
        const f32x4 z4 = (f32x4){0.f, 0.f, 0.f, 0.f};
#pragma unroll
        for (int ai = 0; ai < 2; ++ai) { const int g = ai * 2 + wr;
#pragma unroll
            for (int bj = 0; bj < 2; ++bj)
#pragma unroll
                for (int n = 0; n < 2; ++n) { const int col = bj * 128 + 32 * wc + 16 * n + 4 * fq;
                    if (fr == 0) *(LAS f32x4*)(xch + (g * 2 + 0) * 256 + col) = (ai == 0 && zr0) ? z4 : acc[ai][bj][0][n];
                    if (fr == 15) *(LAS f32x4*)(xch + (g * 2 + 1) * 256 + col) = (ai == 1 && zr255) ? z4 : acc[ai][bj][3][n]; } }
        asm volatile("s_waitcnt lgkmcnt(0)" ::: "memory"); __builtin_amdgcn_s_barrier(); asm volatile("" ::: "memory");
        const int fbase = u.pn * 128 + 32 * wc + 4 * fq;
#pragma unroll
        for (int n = 0; n < 2; ++n) {
            const int f0 = fbase + 16 * n;
            f32x4 wg[3], wv[3];
#pragma unroll
            for (int o = 0; o < 3; ++o) { wg[o] = *(const f32x4*)(cw + o * DUP + f0); wv[o] = *(const f32x4*)(cw + o * DUP + DFF + f0); }
            const f32x4 bg = *(const f32x4*)(cb + f0), bv = *(const f32x4*)(cb + DFF + f0);
#pragma unroll
            for (int ai = 0; ai < 2; ++ai) {
                const int g = ai * 2 + wr;
                f32x4 bp[2], bn[2];
#pragma unroll
                for (int bj = 0; bj < 2; ++bj) { const int col = bj * 128 + 32 * wc + 16 * n + 4 * fq;
                    bp[bj] = g > 0 ? *(const LAS f32x4*)(xch + ((g - 1) * 2 + 1) * 256 + col) : z4;
                    bn[bj] = g < 3 ? *(const LAS f32x4*)(xch + ((g + 1) * 2 + 0) * 256 + col) : z4; }
#pragma unroll
                for (int m = 0; m < 4; ++m) {
                    f32x4 cv[2];
#pragma unroll
                    for (int bj = 0; bj < 2; ++bj) {
                        f32x4 cur = acc[ai][bj][m][n];
                        if (ai == 0 && m == 0) cur = zr0 ? z4 : cur;
                        if (ai == 1 && m == 3) cur = zr255 ? z4 : cur;
                        f32x4 ps = m > 0 ? acc[ai][bj][m - 1][n] : bp[bj];
                        f32x4 ns = m < 3 ? acc[ai][bj][m + 1][n] : bn[bj];
                        f32x4 tp, tn, pv, nv;
#pragma unroll
                        for (int i = 0; i < 4; ++i) { tp[i] = fr == 15 ? ps[i] : cur[i]; tn[i] = fr == 0 ? ns[i] : cur[i]; }
#pragma unroll
                        for (int i = 0; i < 4; ++i) { pv[i] = __shfl(tp[i], src_prev); nv[i] = __shfl(tn[i], src_next); }
                        const f32x4 w0 = bj ? wv[0] : wg[0], w1 = bj ? wv[1] : wg[1], w2 = bj ? wv[2] : wg[2], bb = bj ? bv : bg;
                        cv[bj] = w0 * pv + w1 * cur + w2 * nv + bb;
                    }
                    f32x4 r;
#pragma unroll
                    for (int i = 0; i < 4; ++i) r[i] = silu_f(cv[0][i]) * cv[1][i];
                    const int R = ai * 128 + wr * 64 + m * 16 + fr;
                    const bool halo = latent && ((ai == 0 && m == 0 && wr == 0 && fr == 0) || (ai == 1 && m == 3 && wr == 1 && fr == 15));
                    if (!halo) { u32x2 w; w.x = cvt_pk_bf16(r[0], r[1]); w.y = cvt_pk_bf16(r[2], r[3]); *(u32x2*)(ACT + (size_t)(grow0 + R) * DFF + f0) = w; }
                }
            }
            asm volatile("" ::: "memory");
        }
    }
};
template <int NKV>
struct EpiQKV {
    static constexpr bool PERM = false, AFTER_DRAIN = false;
    static __device__ __forceinline__ int a_row0(int pm) { return pm * 256; }
    bf16_t* Q; bf16_t* K; bf16_t* VT; float* newk; float* newv; const float* qn; const float* kn; const float* rope;
    __device__ __forceinline__ void operator()(const f32x4 (&acc)[2][2][4][2], const Unit& u, int wr, int wc, int fr, int fq) const {
        constexpr int KLD = NKV * 64;
        const int hs = 4 * u.pn + wc;
        const int rbase = u.pm * 256 + wr * 64 + fr;
        const bool latent = u.pm >= 16;
        if (hs < 16 + NKV) {
            const bool isq = hs < 16;
            const float* nw = isq ? qn : kn;
            f32x4 wn[2][2];
#pragma unroll
            for (int bj = 0; bj < 2; ++bj)
#pragma unroll
                for (int n = 0; n < 2; ++n) wn[bj][n] = *(const f32x4*)(nw + 32 * bj + 16 * n + 4 * fq);
#pragma unroll
            for (int ai = 0; ai < 2; ++ai)
#pragma unroll
                for (int m = 0; m < 4; ++m) {
                    const int row = rbase + ai * 128 + m * 16;
                    f32x4 v[2][2]; float ss = 0.f;
#pragma unroll
                    for (int bj = 0; bj < 2; ++bj)
#pragma unroll
                        for (int n = 0; n < 2; ++n) { v[bj][n] = acc[ai][bj][m][n]; const f32x4 t = v[bj][n] * v[bj][n]; ss += (t[0] + t[1]) + (t[2] + t[3]); }
                    ss += __shfl_xor(ss, 16); ss += __shfl_xor(ss, 32);
                    const float rinv = rsqrtf(ss * (1.0f / 64.0f) + EPSN);
#pragma unroll
                    for (int bj = 0; bj < 2; ++bj)
#pragma unroll
                        for (int n = 0; n < 2; ++n) v[bj][n] = v[bj][n] * rinv * wn[bj][n];
                    if (latent && NKV == 4) {
                        const int pr = ((row - NCTXROWS) & 4095) >> 6, pc = row & 63;
#pragma unroll
                        for (int bj = 0; bj < 2; ++bj) {
                            const int pos = bj ? pc : pr;
                            const f32x4* t = (const f32x4*)(rope + (pos * 16 + 4 * fq) * 2);
                            const f32x4 t0 = t[0], t1 = t[1];
                            const f32x4 cs = (f32x4){t0[0], t0[2], t1[0], t1[2]}, sn = (f32x4){t0[1], t0[3], t1[1], t1[3]};
                            const f32x4 x1 = v[bj][0], x2 = v[bj][1];
                            v[bj][0] = x1 * cs - x2 * sn; v[bj][1] = x2 * cs + x1 * sn;
                        }
                    }
                    if (isq) {
                        bf16_t* p = Q + (size_t)row * DM + hs * 64 + 4 * fq;
#pragma unroll
                        for (int bj = 0; bj < 2; ++bj)
#pragma unroll
                            for (int n = 0; n < 2; ++n) { u32x2 w; w.x = cvt_pk_bf16(v[bj][n][0], v[bj][n][1]); w.y = cvt_pk_bf16(v[bj][n][2], v[bj][n][3]); *(u32x2*)(p + 32 * bj + 16 * n) = w; }
                    } else {
                        const int kvh = hs - 16;
                        bf16_t* p = K + (size_t)row * KLD + kvh * 64 + 4 * fq;
#pragma unroll
                        for (int bj = 0; bj < 2; ++bj)
#pragma unroll
                            for (int n = 0; n < 2; ++n) { u32x2 w; w.x = cvt_pk_bf16(v[bj][n][0], v[bj][n][1]); w.y = cvt_pk_bf16(v[bj][n][2], v[bj][n][3]); *(u32x2*)(p + 32 * bj + 16 * n) = w; }
                        if (!latent) {
                            float* o = newk + (size_t)row * KLD + kvh * 64 + 4 * fq;
#pragma unroll
                            for (int bj = 0; bj < 2; ++bj)
#pragma unroll
                                for (int n = 0; n < 2; ++n) *(f32x4*)(o + 32 * bj + 16 * n) = v[bj][n];
                        }
                    }
                    asm volatile("" ::: "memory");
                }
        } else {
            const int kvh = hs - 16 - NKV;
#pragma unroll
            for (int ai = 0; ai < 2; ++ai)
#pragma unroll
                for (int m = 0; m < 4; ++m) {
                    const int row = rbase + ai * 128 + m * 16;
                    bf16_t* p = VT + ((size_t)(row >> 5) * NKV + kvh) * 2048 + (row & 31) + (4 * fq) * 32;
#pragma unroll
                    for (int bj = 0; bj < 2; ++bj)
#pragma unroll
                        for (int n = 0; n < 2; ++n)
#pragma unroll
                            for (int i = 0; i < 4; ++i) p[(32 * bj + 16 * n + i) * 32] = (bf16_t)f2bf(acc[ai][bj][m][n][i]);
                    if (!latent) {
                        float* o = newv + (size_t)row * KLD + kvh * 64 + 4 * fq;
#pragma unroll
                        for (int bj = 0; bj < 2; ++bj)
#pragma unroll
                            for (int n = 0; n < 2; ++n) *(f32x4*)(o + 32 * bj + 16 * n) = acc[ai][bj][m][n];
                    }
                    asm volatile("" ::: "memory");
                }
        }
    }
};

struct AttnState { f32x4 o[2][4]; float m[2]; float l[2]; };
#define MFMA16(a, b, c) __builtin_amdgcn_mfma_f32_16x16x32_bf16((a), (b), (c), 0, 0, 0)
struct KVFrag { bf16x8 kf[2][2]; bf16x8 vf[4]; };
__device__ __forceinline__ void attn_load(KVFrag& f, const bf16_t* kp, int kld, const bf16_t* vp, int fr, int fq) {
#pragma unroll
    for (int t = 0; t < 2; ++t)
#pragma unroll
        for (int h2 = 0; h2 < 2; ++h2) f.kf[t][h2] = *(const bf16x8*)(kp + (size_t)(16 * t + fr) * kld + 32 * h2 + 8 * fq);
#pragma unroll
    for (int dt = 0; dt < 4; ++dt) { const bf16_t* v = vp + (16 * dt + fr) * 32 + 4 * fq; const u32x2 lo = *(const u32x2*)v, hi = *(const u32x2*)(v + 16);
        f.vf[dt] = __builtin_bit_cast(bf16x8, ((u32x4){lo.x, lo.y, hi.x, hi.y})); }
}
template <int MASK>
__device__ __forceinline__ void attn_compute(AttnState& st, const bf16x8 (&qf)[2][2], const KVFrag& f, int fr, int fq, int mk0, int mk1, const LAS float* bias) {
#pragma unroll
    for (int qb = 0; qb < 2; ++qb) {
        f32x4 s0 = (f32x4){0.f, 0.f, 0.f, 0.f}, s1 = (f32x4){0.f, 0.f, 0.f, 0.f};
        s0 = MFMA16(f.kf[0][0], qf[qb][0], s0); s0 = MFMA16(f.kf[0][1], qf[qb][1], s0);
        s1 = MFMA16(f.kf[1][0], qf[qb][0], s1); s1 = MFMA16(f.kf[1][1], qf[qb][1], s1);
        float sv[8];
#pragma unroll
        for (int j = 0; j < 4; ++j) { sv[j] = s0[j] * SCL2; sv[4 + j] = s1[j] * SCL2; }
        if (MASK == 1) {
            const int d0 = mk0 + 4 * fq - 16 * qb - fr;
#pragma unroll
            for (int t = 0; t < 2; ++t)
#pragma unroll
                for (int j = 0; j < 4; ++j) { const int df = d0 + 16 * t + j; if (df > 128 || df < -128) sv[4 * t + j] = -INFINITY; }
        }
        if (MASK == 2) {
            const int qc = mk1 + 16 * qb + fr; int cs = qc - 8; cs = cs < 0 ? 0 : (cs > 48 ? 48 : cs);
#pragma unroll
            for (int t = 0; t < 2; ++t)
#pragma unroll
                for (int j = 0; j < 4; ++j) { const int kc = mk0 + 16 * t + 4 * fq + j; const bool ok = (kc >= cs) && (kc < cs + 16);
                    int bi = kc - qc + 15; bi = bi < 0 ? 0 : (bi > 30 ? 30 : bi);
                    const float bv = bias[bi];
                    sv[4 * t + j] = ok ? sv[4 * t + j] + bv : -INFINITY; }
        }
        float cmax = fmaxf(fmaxf(fmaxf(sv[0], sv[1]), fmaxf(sv[2], sv[3])), fmaxf(fmaxf(sv[4], sv[5]), fmaxf(sv[6], sv[7])));
        cmax = fmaxf(cmax, __shfl_xor(cmax, 16)); cmax = fmaxf(cmax, __shfl_xor(cmax, 32));
        const float mnew = fmaxf(st.m[qb], cmax);
        const float msafe = (mnew == -INFINITY) ? 0.f : mnew;
        const float alpha = fast_exp2(st.m[qb] - msafe);
        st.m[qb] = mnew;
        float p[8]; float ps = 0.f;
#pragma unroll
        for (int j = 0; j < 8; ++j) { p[j] = fast_exp2(sv[j] - msafe); ps += p[j]; }
        st.l[qb] = st.l[qb] * alpha + ps;
        u32x4 pw; pw.x = cvt_pk_bf16(p[0], p[1]); pw.y = cvt_pk_bf16(p[2], p[3]); pw.z = cvt_pk_bf16(p[4], p[5]); pw.w = cvt_pk_bf16(p[6], p[7]);
        const bf16x8 pf = __builtin_bit_cast(bf16x8, pw);
#pragma unroll
        for (int dt = 0; dt < 4; ++dt) { st.o[qb][dt] = st.o[qb][dt] * alpha; st.o[qb][dt] = MFMA16(f.vf[dt], pf, st.o[qb][dt]); }
    }
}
__device__ __forceinline__ void attn_init(AttnState& st, bf16x8 (&qf)[2][2], const bf16_t* Q, int qrow0, int head, int fr, int fq) {
#pragma unroll
    for (int qb = 0; qb < 2; ++qb) { st.m[qb] = -INFINITY; st.l[qb] = 0.f;
#pragma unroll
        for (int dt = 0; dt < 4; ++dt) st.o[qb][dt] = (f32x4){0.f, 0.f, 0.f, 0.f};
#pragma unroll
        for (int h2 = 0; h2 < 2; ++h2) qf[qb][h2] = *(const bf16x8*)(Q + (size_t)(qrow0 + 16 * qb + fr) * DM + head * 64 + 32 * h2 + 8 * fq); }
}
__device__ __forceinline__ void attn_finish(AttnState& st, bf16_t* O, int qrow0, int head, int fr, int fq, bool has_sink, float sink) {
#pragma unroll
    for (int qb = 0; qb < 2; ++qb) {
        float l = st.l[qb]; l += __shfl_xor(l, 16); l += __shfl_xor(l, 32);
        if (has_sink) l += fast_exp2(sink * LOG2E - st.m[qb]);
        const float inv = 1.0f / l;
        bf16_t* o = O + (size_t)(qrow0 + 16 * qb + fr) * DM + head * 64 + 4 * fq;
#pragma unroll
        for (int dt = 0; dt < 4; ++dt) { const f32x4 v = st.o[qb][dt] * inv; u32x2 w; w.x = cvt_pk_bf16(v[0], v[1]); w.y = cvt_pk_bf16(v[2], v[3]); *(u32x2*)(o + 16 * dt) = w; }
    }
}
__device__ __forceinline__ void attn_phase_a(const bf16_t* Q, const bf16_t* K, const bf16_t* VT, const bf16_t* Kc, const bf16_t* VTc, const float* sinkp, bf16_t* O, int gw, int ngw, int lane) {
    const int fr = lane & 15, fq = lane >> 4;
    for (int t = gw; t < 4096; t += ngw) {
        const int b = t >> 11, rem = t & 2047, kvh = rem >> 9, rem2 = rem & 511, qblk = ((rem2 >> 3) << 1) | (rem2 & 1), g = (rem2 & 7) >> 1;
        const int head = kvh * 4 + g, qpos0 = qblk * 32, seq0 = NCTXROWS + b * 4096, qrow0 = seq0 + qpos0;
        AttnState st; bf16x8 qf[2][2]; KVFrag cur, nxt;
        attn_init(st, qf, Q, qrow0, head, fr, fq);
        const int c0 = qblk - 4 < 0 ? 0 : qblk - 4, c1 = qblk + 4 > 127 ? 127 : qblk + 4;
        const bf16_t* kcp = Kc + (size_t)(b * 512) * 256 + kvh * 64; const bf16_t* vcp = VTc + (size_t)(b * 16 * 4 + kvh) * 2048;
        const bf16_t* klp = K + (size_t)seq0 * 256 + kvh * 64; const bf16_t* vlp = VT + (size_t)((seq0 >> 5) * 4 + kvh) * 2048;
        attn_load(cur, kcp, 256, vcp, fr, fq);
        for (int c = 0; c < 16; ++c) {
            if (c < 15) attn_load(nxt, kcp + (size_t)(32 * (c + 1)) * 256, 256, vcp + (size_t)(c + 1) * 4 * 2048, fr, fq);
            else attn_load(nxt, klp + (size_t)(32 * c0) * 256, 256, vlp + (size_t)c0 * 4 * 2048, fr, fq);
            attn_compute<0>(st, qf, cur, fr, fq, 0, 0, nullptr);
            cur = nxt;
        }
        for (int c = c0; c <= c1; ++c) {
            if (c < c1) attn_load(nxt, klp + (size_t)(32 * (c + 1)) * 256, 256, vlp + (size_t)(c + 1) * 4 * 2048, fr, fq);
            attn_compute<1>(st, qf, cur, fr, fq, 32 * c - qpos0, 0, nullptr);
            cur = nxt;
        }
        attn_finish(st, O, qrow0, head, fr, fq, true, sinkp[head]);
    }
    for (int t = gw; t < 2048; t += ngw) {
        const int b = t >> 7, rem = t & 127, kvh = rem >> 5, rem2 = rem & 31, qblk = ((rem2 >> 3) << 1) | (rem2 & 1), g = (rem2 & 7) >> 1;
        const int head = kvh * 4 + g, qrow0 = b * 256 + qblk * 32;
        AttnState st; bf16x8 qf[2][2]; KVFrag cur, nxt;
        attn_init(st, qf, Q, qrow0, head, fr, fq);
        const bf16_t* kp = K + (size_t)(b * 256) * 256 + kvh * 64; const bf16_t* vp = VT + (size_t)((b * 8) * 4 + kvh) * 2048;
        attn_load(cur, kp, 256, vp, fr, fq);
        for (int c = 0; c < 8; ++c) {
            if (c < 7) attn_load(nxt, kp + (size_t)(32 * (c + 1)) * 256, 256, vp + (size_t)(c + 1) * 4 * 2048, fr, fq);
            attn_compute<0>(st, qf, cur, fr, fq, 0, 0, nullptr);
            cur = nxt;
        }
        attn_finish(st, O, qrow0, head, fr, fq, true, sinkp[head]);
    }
}
__device__ __forceinline__ void attn_phase_b(const bf16_t* Q, const bf16_t* K, const bf16_t* VT, const bf16_t* Kc, const bf16_t* VTc, const float* rpb, bf16_t* O, int gw, int ngw, int lane, LAS float* btab) {
    const int fr = lane & 15, fq = lane >> 4;
    int cur_head = -1;
    for (int t = gw; t < 4096; t += ngw) {
        const int b = t >> 11, rem = t & 2047, head = rem >> 7, qblk = rem & 127, r = qblk >> 1, half = qblk & 1;
        const int seq0 = NCTXROWS + b * 4096, qrow0 = seq0 + qblk * 32;
        if (head != cur_head) { for (int i = lane; i < 465; i += 64) btab[i] = rpb[head * 465 + i] * LOG2E; cur_head = head; asm volatile("s_waitcnt lgkmcnt(0)" ::: "memory"); }
        AttnState st; bf16x8 qf[2][2]; KVFrag cur, nxt;
        attn_init(st, qf, Q, qrow0, head, fr, fq);
        int rs = r - 4; rs = rs < 0 ? 0 : (rs > 56 ? 56 : rs);
        const bf16_t* kcp = Kc + (size_t)(b * 512) * 1024 + head * 64; const bf16_t* vcp = VTc + (size_t)(b * 16 * 16 + head) * 2048;
        const bf16_t* klp = K + (size_t)(seq0 + rs * 64) * 1024 + head * 64; const bf16_t* vlp = VT + (size_t)(((seq0 + rs * 64) >> 5) * 16 + head) * 2048;
        attn_load(cur, kcp, 1024, vcp, fr, fq);
        for (int c = 0; c < 16; ++c) {
            if (c < 15) attn_load(nxt, kcp + (size_t)(32 * (c + 1)) * 1024, 1024, vcp + (size_t)(c + 1) * 16 * 2048, fr, fq);
            else attn_load(nxt, klp, 1024, vlp, fr, fq);
            attn_compute<0>(st, qf, cur, fr, fq, 0, 0, nullptr);
            cur = nxt;
        }
        for (int c = 0; c < 16; ++c) {
            if (c < 15) attn_load(nxt, klp + (size_t)(32 * (c + 1)) * 1024, 1024, vlp + (size_t)(c + 1) * 16 * 2048, fr, fq);
            attn_compute<2>(st, qf, cur, fr, fq, 32 * (c & 1), 32 * half, btab + (rs + (c >> 1) - r + 7) * 31);
            cur = nxt;
        }
        attn_finish(st, O, qrow0, head, fr, fq, false, 0.f);
    }
    for (int t = gw; t < 2048; t += ngw) {
        const int b = t >> 7, rem = t & 127, head = rem >> 3, qblk = rem & 7;
        const int qrow0 = b * 256 + qblk * 32;
        AttnState st; bf16x8 qf[2][2]; KVFrag cur, nxt;
        attn_init(st, qf, Q, qrow0, head, fr, fq);
        const bf16_t* kp = K + (size_t)(b * 256) * 1024 + head * 64; const bf16_t* vp = VT + (size_t)((b * 8) * 16 + head) * 2048;
        attn_load(cur, kp, 1024, vp, fr, fq);
        for (int c = 0; c < 8; ++c) {
            if (c < 7) attn_load(nxt, kp + (size_t)(32 * (c + 1)) * 1024, 1024, vp + (size_t)(c + 1) * 16 * 2048, fr, fq);
            attn_compute<0>(st, qf, cur, fr, fq, 0, 0, nullptr);
            cur = nxt;
        }
        attn_finish(st, O, qrow0, head, fr, fq, false, 0.f);
    }
}

__device__ __forceinline__ void transpose_item(const float* W, int K, int N, bf16_t* WT, int kb, int nb, int dst_n0, LAS float* scr, int lane) {
    const int k0 = 64 * kb, n0 = 32 * nb;
#pragma unroll 8
    for (int i = 0; i < 32; ++i) { const int kk = 2 * i + (lane >> 5); scr[kk * 33 + (lane & 31)] = W[(size_t)(k0 + kk) * N + n0 + (lane & 31)]; }
    asm volatile("s_waitcnt lgkmcnt(0)" ::: "memory");
    const int c = lane & 7;
#pragma unroll
    for (int j = 0; j < 4; ++j) { const int n = (lane >> 3) + 8 * j; const LAS float* s = scr + (8 * c) * 33 + n;
        u32x4 o; o.x = cvt_pk_bf16(s[0 * 33], s[1 * 33]); o.y = cvt_pk_bf16(s[2 * 33], s[3 * 33]); o.z = cvt_pk_bf16(s[4 * 33], s[5 * 33]); o.w = cvt_pk_bf16(s[6 * 33], s[7 * 33]);
        *(u32x4*)(WT + (size_t)(dst_n0 + n) * K + k0 + 8 * c) = o; }
    asm volatile("s_waitcnt lgkmcnt(0)" ::: "memory");
}
__device__ __forceinline__ int up_perm(int o) { return o < DFF ? 256 * (o / 128) + (o % 128) : 256 * ((o - DFF) / 128) + 128 + ((o - DFF) % 128); }
__device__ __forceinline__ int qkv_perm(int o) { return (o & ~255) + 128 * ((o >> 5) & 1) + 32 * ((o >> 6) & 3); }

__device__ __forceinline__ void prologue(const Args& a, LAS unsigned char* lds, int tid, int lane, int wave) {
    unsigned char* ws = a.ws;
    const int G = gridDim.x, bx = blockIdx.x;
    {
        LAS float* sc = (LAS float*)lds;
        LAS float* red = (LAS float*)(lds + 16384);
        bool have = false;
        for (int it = bx; it < 192; it += G) {
            if (!have) { for (int k = tid; k < 3072; k += NTHR) { const int cnd = k >> 10, kk = k & 1023; const float x = cnd == 0 ? a.in[7][kk] : a.in[6][(cnd - 1) * 1024 + kk]; sc[k] = silu_f(x); } have = true; }
            __syncthreads();
            const int l = it / 96, n0 = (it % 96) * 64;
            const float* W = a.in[10] + (size_t)l * 1024 * 6144 + n0;
            const int c4 = tid & 15, ks = tid >> 4;
            f32x4 a0 = (f32x4){0.f, 0.f, 0.f, 0.f}, a1 = a0, a2 = a0;
#pragma unroll 8
            for (int kk = 0; kk < 32; ++kk) { const int k = ks * 32 + kk; const f32x4 w = *(const f32x4*)(W + (size_t)k * 6144 + 4 * c4);
                a0 += w * sc[k]; a1 += w * sc[1024 + k]; a2 += w * sc[2048 + k]; }
#pragma unroll
            for (int j = 0; j < 4; ++j) { red[(ks * 3 + 0) * 64 + 4 * c4 + j] = a0[j]; red[(ks * 3 + 1) * 64 + 4 * c4 + j] = a1[j]; red[(ks * 3 + 2) * 64 + 4 * c4 + j] = a2[j]; }
            __syncthreads();
            if (tid < 192) { const int cnd = tid >> 6, col = tid & 63; float s = 0.f;
#pragma unroll 8
                for (int q = 0; q < 32; ++q) s += red[(q * 3 + cnd) * 64 + col];
                ((float*)(ws + WS_MOD))[(l * 3 + cnd) * 6144 + n0 + col] = s + a.in[11][l * 6144 + n0 + col]; }
        }
        __syncthreads();
    }
    const int gw = bx * NWAVES + wave, NGW = G * NWAVES;
    const size_t gt = (size_t)bx * NTHR + tid, NT = (size_t)G * NTHR;
    if (gt < 1024) { const int pos = (int)gt >> 4, f = (int)gt & 15; const float freq = exp2f(-(float)f * (13.287712379549449f / 16.0f)); const float ang = (float)pos * freq;
        float* rp = (float*)(ws + WS_ROPE); rp[2 * gt] = cosf(ang); rp[2 * gt + 1] = sinf(ang); }
    {
        LAS float* scr = (LAS float*)(lds + wave * 16384);
        constexpr int I_QA = 16 * 48, I_QB = 16 * 96, I_O = 16 * 32, I_UP = 16 * 176, I_DN = 44 * 32;
        constexpr int NITEMS = I_QA + I_QB + 2 * I_O + 2 * I_UP + 2 * I_DN;
        for (int it = gw; it < NITEMS; it += NGW) {
            int r = it;
            if (r < I_QA) { const int kb = r / 48, nb = r % 48; transpose_item(a.in[12], 1024, 1536, (bf16_t*)(ws + WS_WQKVA), kb, nb, qkv_perm(32 * nb), scr, lane); continue; } r -= I_QA;
            if (r < I_QB) { const int kb = r / 96, nb = r % 96; transpose_item(a.in[17], 1024, 3072, (bf16_t*)(ws + WS_WQKVB), kb, nb, qkv_perm(32 * nb), scr, lane); continue; } r -= I_QB;
            if (r < I_O) { const int kb = r / 32, nb = r % 32; transpose_item(a.in[16], 1024, 1024, (bf16_t*)(ws + WS_WOA), kb, nb, 32 * nb, scr, lane); continue; } r -= I_O;
            if (r < I_O) { const int kb = r / 32, nb = r % 32; transpose_item(a.in[21], 1024, 1024, (bf16_t*)(ws + WS_WOB), kb, nb, 32 * nb, scr, lane); continue; } r -= I_O;
            if (r < 2 * I_UP) { const int l = r / I_UP; r -= l * I_UP; const int kb = r / 176, nb = r % 176;
                transpose_item(a.in[22] + (size_t)l * 1024 * 5632, 1024, 5632, (bf16_t*)(ws + (l ? WS_WUP1 : WS_WUP0)), kb, nb, up_perm(32 * nb), scr, lane); continue; } r -= 2 * I_UP;
            { const int l = r / I_DN; r -= l * I_DN; const int kb = r / 32, nb = r % 32;
                transpose_item(a.in[25] + (size_t)l * 2816 * 1024, 2816, 1024, (bf16_t*)(ws + (l ? WS_WDN1 : WS_WDN0)), kb, nb, 32 * nb, scr, lane); }
        }
    }
    {
        bf16_t* kca = (bf16_t*)(ws + WS_KCA); bf16_t* kcb = (bf16_t*)(ws + WS_KCB); bf16_t* vca = (bf16_t*)(ws + WS_VTCA); bf16_t* vcb = (bf16_t*)(ws + WS_VTCB);
        for (size_t i = gt; i < 262144; i += NT) kca[i] = (bf16_t)f2bf(a.in[2][i]);
        for (size_t i = gt; i < 1048576; i += NT) kcb[i] = (bf16_t)f2bf(a.in[4][i]);
        for (size_t i = gt; i < 262144; i += NT) { const int tt = (int)i & 31, d = ((int)i >> 5) & 63, kvh = ((int)i >> 11) & 3, c = ((int)i >> 13) & 15, b = (int)i >> 17;
            vca[i] = (bf16_t)f2bf(a.in[3][((size_t)(b * 512 + c * 32 + tt) * 4 + kvh) * 64 + d]); }
        for (size_t i = gt; i < 1048576; i += NT) { const int tt = (int)i & 31, d = ((int)i >> 5) & 63, kvh = ((int)i >> 11) & 15, c = ((int)i >> 15) & 15, b = (int)i >> 19;
            vcb[i] = (bf16_t)f2bf(a.in[5][((size_t)(b * 512 + c * 32 + tt) * 16 + kvh) * 64 + d]); }
    }
}
__device__ __forceinline__ void norm_mod_phase(const float* xa, const float* xb, const float* nw, const float* shift, const float* scale, bf16_t* H, int gw, int ngw, int lane) {
    for (int row = gw; row < MTOK; row += ngw) {
        const float* xr = row < NCTXROWS ? xa + (size_t)row * DM : xb + (size_t)(row - NCTXROWS) * DM;
        const int cond = row < NCTXROWS ? 0 : 1 + ((row - NCTXROWS) >> 12);
        f32x4 v[4]; float s = 0.f;
#pragma unroll
        for (int j = 0; j < 4; ++j) { v[j] = *(const f32x4*)(xr + 4 * (lane + 64 * j)); const f32x4 t = v[j] * v[j]; s += (t[0] + t[1]) + (t[2] + t[3]); }
        const float rinv = rsqrtf(wave_sum(s) * (1.0f / DM) + EPSN);
#pragma unroll
        for (int j = 0; j < 4; ++j) { const int col = 4 * (lane + 64 * j);
            const f32x4 w = *(const f32x4*)(nw + col), sc = *(const f32x4*)(scale + cond * 6144 + col), sh = *(const f32x4*)(shift + cond * 6144 + col);
            const f32x4 y = (v[j] * rinv * w) * (sc + 1.0f) + sh;
            u32x2 o; o.x = cvt_pk_bf16(y[0], y[1]); o.y = cvt_pk_bf16(y[2], y[3]);
            *(u32x2*)(H + (size_t)row * DM + col) = o; }
    }
}
__device__ __forceinline__ void conv_act_phase(const bf16_t* U, const float* cw, const float* cb, bf16_t* ACT, size_t gt, size_t nt) {
    for (size_t item = gt; item < (size_t)384 * 352; item += nt) {
        const int rb = (int)(item / 352), fg = (int)(item % 352), r0 = rb * 32, f0 = fg * 8;
        const int pos0 = r0 < NCTXROWS ? (r0 & 255) : (r0 & 4095), L = r0 < NCTXROWS ? 256 : 4096;
        const bool has_prev = pos0 > 0, has_next = pos0 + 32 < L;
        float wg[3][8], wv[3][8], bg[8], bv[8];
#pragma unroll
        for (int o = 0; o < 3; ++o)
#pragma unroll
            for (int j = 0; j < 8; ++j) { wg[o][j] = cw[o * DUP + f0 + j]; wv[o][j] = cw[o * DUP + DFF + f0 + j]; }
#pragma unroll
        for (int j = 0; j < 8; ++j) { bg[j] = cb[f0 + j]; bv[j] = cb[DFF + f0 + j]; }
        const u32x4 z4 = (u32x4){0u, 0u, 0u, 0u};
        const bf16_t* up = U + (size_t)r0 * DUP + f0;
        u32x4 gp = z4, vp = z4, gc, vc, gn, vn;
        if (has_prev) { gp = *(const u32x4*)(up - DUP); vp = *(const u32x4*)(up - DUP + DFF); }
        gc = *(const u32x4*)up; vc = *(const u32x4*)(up + DFF);
        for (int r = 0; r < 32; ++r) {
            gn = z4; vn = z4;
            if (r < 31 || has_next) { gn = *(const u32x4*)(up + (size_t)(r + 1) * DUP); vn = *(const u32x4*)(up + (size_t)(r + 1) * DUP + DFF); }
            float res[8];
#pragma unroll
            for (int q = 0; q < 4; ++q) {
                const float g0 = wg[0][2 * q] * bflo(gp[q]) + wg[1][2 * q] * bflo(gc[q]) + wg[2][2 * q] * bflo(gn[q]) + bg[2 * q];
                const float g1 = wg[0][2 * q + 1] * bfhi(gp[q]) + wg[1][2 * q + 1] * bfhi(gc[q]) + wg[2][2 * q + 1] * bfhi(gn[q]) + bg[2 * q + 1];
                const float v0 = wv[0][2 * q] * bflo(vp[q]) + wv[1][2 * q] * bflo(vc[q]) + wv[2][2 * q] * bflo(vn[q]) + bv[2 * q];
                const float v1 = wv[0][2 * q + 1] * bfhi(vp[q]) + wv[1][2 * q + 1] * bfhi(vc[q]) + wv[2][2 * q + 1] * bfhi(vn[q]) + bv[2 * q + 1];
                res[2 * q] = silu_f(g0) * v0; res[2 * q + 1] = silu_f(g1) * v1;
            }
            u32x4 o; o.x = cvt_pk_bf16(res[0], res[1]); o.y = cvt_pk_bf16(res[2], res[3]); o.z = cvt_pk_bf16(res[4], res[5]); o.w = cvt_pk_bf16(res[6], res[7]);
            *(u32x4*)(ACT + (size_t)(r0 + r) * DFF + f0) = o;
            gp = gc; vp = vc; gc = gn; vc = vn;
        }
    }
}

__global__ void __launch_bounds__(NTHR, 2) mk_fwd(Args a) {
    extern __shared__ __attribute__((aligned(16))) unsigned char lds_raw[];
    cg::grid_group grid = cg::this_grid();
    LAS unsigned char* lds = (LAS unsigned char*)lds_raw;
    const int tid = threadIdx.x, lane = tid & 63, wave = __builtin_amdgcn_readfirstlane(tid >> 6);
    const int G = gridDim.x, bx = blockIdx.x;
    const int gw = bx * NWAVES + wave, NGW = G * NWAVES;
    const size_t gt = (size_t)bx * NTHR + tid, NT = (size_t)G * NTHR;
    unsigned char* ws = a.ws;
    float* out = a.out;
    bf16_t* H = (bf16_t*)(ws + WS_H); bf16_t* ACT = (bf16_t*)(ws + WS_ACT); bf16_t* U = (bf16_t*)(ws + WS_U);
    bf16_t* Qb = (bf16_t*)(ws + WS_Q); bf16_t* Kb = (bf16_t*)(ws + WS_K); bf16_t* VTb = (bf16_t*)(ws + WS_VT); bf16_t* Ob = (bf16_t*)(ws + WS_O);
    const float* rope = (const float*)(ws + WS_ROPE);

#ifndef NO_PRO
    for (int rep = 0; rep < REP_THIN; ++rep) { prologue(a, lds, tid, lane, wave); __syncthreads(); }
#endif
    volatile LAS unsigned* bst = (volatile LAS unsigned*)(lds + 131072 + 64);
    if (tid < 2) bst[tid] = 0u;
    unsigned* barw = (unsigned*)(ws + WS_BAR);
    if (bx == 0) for (int i = tid; i < XCD_BAR_WORDS; i += NTHR) barw[i] = 0u;
    grid.sync();
    const XcdBarrier xbar = xcd_barrier_post(barw, bst);
#define GSYNC() xcd_barrier(xbar)

#pragma unroll 1
    for (int layer = 0; layer < 2; ++layer) {
        const float* mod = (const float*)(ws + WS_MOD) + layer * 3 * 6144;
        const float* xa = layer == 0 ? a.in[0] : out;
        const float* xb = layer == 0 ? a.in[1] : out + (size_t)NCTXROWS * DM;
#ifndef NO_NORM
        for (int rep = 0; rep < REP_THIN; ++rep)
        { int tl = tid; asm volatile("" : "+v"(tl)); const int wv = __builtin_amdgcn_readfirstlane(tl >> 6);
          norm_mod_phase(xa, xb, a.in[8] + layer * DM, mod + 0 * 1024, mod + 1 * 1024, H, bx * NWAVES + wv, NGW, tl & 63); }
#endif
        GSYNC();
#ifndef NO_QKV
        if (layer == 0) {
            pg8::Gemm g{H, (const bf16_t*)(ws + WS_WQKVA), MTOK, 1536, 1024}; pg8::StaticOrder S; int bxl = bx; asm volatile("" : "+s"(bxl)); int tl = tid; asm volatile("" : "+v"(tl)); S.init(MTOK, 1536, G, bxl);
            EpiQKV<4> E{Qb, Kb, VTb, out + OUT_KA, out + OUT_VA, a.in[13], a.in[14], rope};
            pg8::gemm_phase<EpiQKV<4>, pg8::StaticOrder, true, true>(lds, g, S, E, tl);
        } else {
            pg8::Gemm g{H, (const bf16_t*)(ws + WS_WQKVB), MTOK, 3072, 1024}; pg8::StaticOrder S; int bxl = bx; asm volatile("" : "+s"(bxl)); int tl = tid; asm volatile("" : "+v"(tl)); S.init(MTOK, 3072, G, bxl);
            EpiQKV<16> E{Qb, Kb, VTb, out + OUT_KB, out + OUT_VB, a.in[18], a.in[19], rope};
            pg8::gemm_phase<EpiQKV<16>, pg8::StaticOrder, true, true>(lds, g, S, E, tl);
        }
#endif
        GSYNC();
#ifndef NO_ATTN
        for (int rep = 0; rep < REP_ATTN; ++rep)
        { int tl = tid; asm volatile("" : "+v"(tl)); const int wv = __builtin_amdgcn_readfirstlane(tl >> 6); const int gwl = bx * NWAVES + wv;
        if (layer == 0) attn_phase_a(Qb, Kb, VTb, (const bf16_t*)(ws + WS_KCA), (const bf16_t*)(ws + WS_VTCA), a.in[15], Ob, gwl, NGW, tl & 63);
        else attn_phase_b(Qb, Kb, VTb, (const bf16_t*)(ws + WS_KCB), (const bf16_t*)(ws + WS_VTCB), a.in[20], Ob, gwl, NGW, tl & 63, (LAS float*)(lds + wv * 2048)); }
#endif
        GSYNC();
#ifndef NO_OPROJ
        {
            pg8::Gemm g{Ob, (const bf16_t*)(ws + (layer ? WS_WOB : WS_WOA)), MTOK, 1024, 1024}; pg8::StaticOrder S; int bxl = bx; asm volatile("" : "+s"(bxl)); int tl = tid; asm volatile("" : "+v"(tl)); S.init(MTOK, 1024, G, bxl);
            EpiResid E{xa, xb, out, mod + 2 * 1024};
            pg8::gemm_phase<EpiResid, pg8::StaticOrder, true, true>(lds, g, S, E, tl);
        }
#endif
        GSYNC();
#ifndef NO_NORM
        for (int rep = 0; rep < REP_THIN; ++rep)
        { int tl = tid; asm volatile("" : "+v"(tl)); const int wv = __builtin_amdgcn_readfirstlane(tl >> 6);
          norm_mod_phase(out, out + (size_t)NCTXROWS * DM, a.in[9] + layer * DM, mod + 3 * 1024, mod + 4 * 1024, H, bx * NWAVES + wv, NGW, tl & 63); }
#endif
        GSYNC();
#ifndef NO_UP
        {
            pg8::Gemm g{H, (const bf16_t*)(ws + (layer ? WS_WUP1 : WS_WUP0)), 50 * 256, DUP, 1024}; pg8::StaticOrder S; int bxl = bx; asm volatile("" : "+s"(bxl)); int tl = tid; asm volatile("" : "+v"(tl)); S.init(50 * 256, DUP, G, bxl);
            EpiUpConv E{ACT, a.in[23] + (size_t)layer * 3 * DUP, a.in[24] + (size_t)layer * DUP, (LAS float*)(lds + 131072 + 1024)};
            pg8::gemm_phase<EpiUpConv, pg8::StaticOrder, true, true>(lds, g, S, E, tl);
        }
#endif
        GSYNC();
#ifndef NO_DOWN
        {
            pg8::Gemm g{ACT, (const bf16_t*)(ws + (layer ? WS_WDN1 : WS_WDN0)), MTOK, 1024, DFF}; pg8::StaticOrder S; int bxl = bx; asm volatile("" : "+s"(bxl)); int tl = tid; asm volatile("" : "+v"(tl)); S.init(MTOK, 1024, G, bxl);
            EpiResid E{out, out + (size_t)NCTXROWS * DM, out, mod + 5 * 1024};
            pg8::gemm_phase<EpiResid, pg8::StaticOrder, true, true>(lds, g, S, E, tl);
        }
#endif
        if (layer == 0) GSYNC();
    }
}

extern "C" void kernel_launch(void* const* d_in, const int* in_sizes, int n_in, void* d_out, int out_size, void* d_ws, size_t ws_size, hipStream_t stream) {
    static int grid = 0;
    if (grid == 0) {
        if (n_in != 26 || out_size != 23068672 || ws_size < WS_END) { fprintf(stderr, "kernel_launch: unexpected shapes n_in %d out %d ws %zu\n", n_in, out_size, ws_size); grid = -1; return; }
        int dev = 0, cus = 0, per_cu = 0;
        hipGetDevice(&dev);
        hipDeviceGetAttribute(&cus, hipDeviceAttributeMultiprocessorCount, dev);
        hipFuncSetAttribute((const void*)mk_fwd, hipFuncAttributeMaxDynamicSharedMemorySize, LDS_BYTES);
        hipOccupancyMaxActiveBlocksPerMultiprocessor(&per_cu, (const void*)mk_fwd, NTHR, LDS_BYTES);
        if (per_cu < 1) per_cu = 1;
        grid = cus * per_cu;
    }
    if (grid < 0) return;
    Args a{};
    for (int i = 0; i < 26; ++i) a.in[i] = (const float*)d_in[i];
    a.out = (float*)d_out; a.ws = (unsigned char*)d_ws;
    void* args[] = {&a};
    hipError_t e = hipLaunchCooperativeKernel((const void*)mk_fwd, dim3(grid), dim3(NTHR), args, LDS_BYTES, stream);
    if (e != hipSuccess) fprintf(stderr, "cooperative launch failed: %s (grid %d)\n", hipGetErrorString(e), grid);
}
```

```cpp
#include <hip/hip_runtime.h>
#include <hip/hip_cooperative_groups.h>
#include <cstdio>
#include <cstdint>
namespace cg = cooperative_groups;
namespace pg8 {
#define PG8_LAS __attribute__((address_space(3)))
typedef unsigned short bf16_t;
typedef short bf16x8 __attribute__((ext_vector_type(8)));
typedef float f32x4 __attribute__((ext_vector_type(4)));
typedef unsigned u32x4 __attribute__((ext_vector_type(4)));
constexpr int BM = 256, BK = 64, HALF = 128, HTB = HALF * BK * 2  , STAGE_BYTES = 8 * HTB, NXCD = 8, WGM = 8;

__host__ __device__ __forceinline__ int lds_byte(int r, int c) { const int st = (r >> 4) * 2 + (c >> 5), rr = r & 15, cc = c & 31, ob = rr * 64 + cc * 2; return st * 1024 + (ob ^ (((ob >> 9) & 1) << 5)); }
__host__ __device__ __forceinline__ void stage_rc(int b, int& R, int& C) { const int st = b / 1024, sb = b % 1024, swz = sb ^ (((sb >> 9) & 1) << 5); R = (st >> 1) * 16 + swz / 64; C = (st & 1) * 32 + (swz % 64) / 2; }
__host__ __device__ __forceinline__ int perm32(int rho) { const int n = rho >> 4, i = rho & 15; return 8 * (i >> 2) + 4 * n + (i & 3); }

struct Unit { int pm, pn; };
struct Gemm { const bf16_t* A; const bf16_t* Bt; int M, N, K; };

struct StaticOrder {
    int nM, nN, nwg, G, c;
    __host__ __device__ void init(int M, int N, int G_, int c_) { nM = M / BM; nN = N / BM; nwg = nM * nN; G = G_; c = c_; }
    __host__ __device__ bool next(int i, Unit& u) const {
        const long L = (long)i * G + c; if (L >= nwg) return false;
        int wgid = (int)L; { const int q = nwg / NXCD, r = nwg % NXCD, xcd = wgid % NXCD, off = wgid / NXCD; wgid = (xcd < r ? xcd * (q + 1) : r * (q + 1) + (xcd - r) * q) + off; }
        const int nig = WGM * nN, gid = wgid / nig, fm = gid * WGM, gsz = (nM - fm) < WGM ? (nM - fm) : WGM;
        u.pm = fm + ((wgid % nig) % gsz); u.pn = (wgid % nig) / gsz; return true;
    }
    __device__ __forceinline__ void a_ready(const Unit&) const {}
    __device__ __forceinline__ void done(const Unit&) const {}
};

__device__ __forceinline__ unsigned cvt_pk_bf16(float lo, float hi) { unsigned r; asm volatile("v_cvt_pk_bf16_f32 %0, %1, %2" : "=v"(r) : "v"(lo), "v"(hi)); return r; }
template <class Epi, class Sched, bool ALIGN_EPI = false, bool SP2 = false>
__device__ __forceinline__ void gemm_phase(PG8_LAS unsigned char* lds, const Gemm g, const Sched& S, const Epi& E, const int tid_in) {
    const int tid = tid_in, wid = __builtin_amdgcn_readfirstlane(tid >> 6), lane = tid & 63, wr = wid >> 2, wc = wid & 3, fr = lane & 15, fq = lane >> 4;
    const int K = g.K, nt = K / BK;
    unsigned voffA[2], voffB[2];
#pragma unroll
    for (int i = 0; i < 2; ++i) { int R, C; stage_rc(tid * 16 + i * 8192, R, C); const int Rb = Epi::PERM ? ((R & ~31) + perm32(R & 31)) : R;
        voffA[i] = (unsigned)(R * K + C) * 2u; voffB[i] = (unsigned)(Rb * K + C) * 2u; }
    const size_t kstep = (size_t)(BK * 2);
    const size_t hstep = (size_t)HALF * K * 2;
    const size_t tstep = 2 * hstep;
    const unsigned ldsw = (unsigned)wid * 1024u;
    const int aoff = lds_byte(wr * 64 + fr, fq * 8), boff = lds_byte(wc * 32 + fr, fq * 8);
#define PG8_SA(b, h) (((b) * 2 + (h)) * HTB)
#define PG8_SB(b, h) ((4 + (b) * 2 + (h)) * HTB)
#define PG8_STAGE(bufoff, gbase, voff) do { _Pragma("unroll") for (int _i = 0; _i < 2; ++_i) \
        __builtin_amdgcn_global_load_lds((const unsigned*)((const char*)(gbase) + (voff)[_i]), (PG8_LAS unsigned*)(lds + (bufoff) + ldsw + _i * 8192), 16, 0, 0); } while (0)
#define PG8_LDA(dst, b, h) do { _Pragma("unroll") for (int m = 0; m < 4; ++m) _Pragma("unroll") for (int k = 0; k < 2; ++k) dst[m][k] = *(const PG8_LAS bf16x8*)(lds + PG8_SA(b, h) + aoff + m * 2048 + k * 1024); } while (0)
#define PG8_LDB(dst, b, h) do { _Pragma("unroll") for (int n = 0; n < 2; ++n) _Pragma("unroll") for (int k = 0; k < 2; ++k) dst[n][k] = *(const PG8_LAS bf16x8*)(lds + PG8_SB(b, h) + boff + n * 2048 + k * 1024); } while (0)
#define PG8_MMA(ai, bj, At, Bt) do { __builtin_amdgcn_s_setprio(1); _Pragma("unroll") for (int m = 0; m < 4; ++m) _Pragma("unroll") for (int n = 0; n < 2; ++n) _Pragma("unroll") for (int k = 0; k < 2; ++k) \
        acc[ai][bj][m][n] = __builtin_amdgcn_mfma_f32_16x16x32_bf16(Bt[n][k], At[m][k], acc[ai][bj][m][n], 0, 0, 0); __builtin_amdgcn_s_setprio(0); } while (0)
#define PG8_WAIT_V(n) asm volatile("s_waitcnt vmcnt(" #n ")" ::: "memory")
#define PG8_WAIT_L(n) asm volatile("s_waitcnt lgkmcnt(" #n ")" ::: "memory")
#define PG8_BAR __builtin_amdgcn_s_barrier()
#define PG8_SCHED __builtin_amdgcn_sched_barrier(0)
    Unit cur, nxt; int ui = 0;
    if (!S.next(0, cur)) return;
    f32x4 acc[2][2][4][2];
#pragma unroll
    for (int a = 0; a < 2; ++a)
#pragma unroll
        for (int b = 0; b < 2; ++b)
#pragma unroll
            for (int m = 0; m < 4; ++m)
#pragma unroll
                for (int n = 0; n < 2; ++n) acc[a][b][m][n] = (f32x4){0.f, 0.f, 0.f, 0.f};
    bf16x8 At[4][2], B0[2][2], B1[2][2];
    const char* cA = (const char*)g.A + (size_t)Epi::a_row0(cur.pm) * ((size_t)K * 2); const char* cB = (const char*)g.Bt + (size_t)cur.pn * tstep;
    S.a_ready(cur);
    if constexpr (SP2) {
        PG8_STAGE(PG8_SB(0, 0), cB, voffB); PG8_STAGE(PG8_SB(0, 1), cB + hstep, voffB); PG8_STAGE(PG8_SA(0, 0), cA, voffA); PG8_STAGE(PG8_SA(0, 1), cA + hstep, voffA);
        if (wr == 1) PG8_BAR;
        PG8_WAIT_V(2); PG8_BAR;
        PG8_STAGE(PG8_SB(1, 0), cB + kstep, voffB); PG8_STAGE(PG8_SA(1, 0), cA + kstep, voffA); PG8_STAGE(PG8_SB(1, 1), cB + hstep + kstep, voffB);
        PG8_WAIT_V(6); PG8_BAR;
    } else {
        PG8_STAGE(PG8_SB(0, 0), cB, voffB); PG8_STAGE(PG8_SA(0, 0), cA, voffA); PG8_STAGE(PG8_SB(0, 1), cB + hstep, voffB); PG8_STAGE(PG8_SA(0, 1), cA + hstep, voffA);
        if (wr == 1) PG8_BAR;
        PG8_WAIT_V(4); PG8_BAR;
        PG8_STAGE(PG8_SB(1, 0), cB + kstep, voffB); PG8_STAGE(PG8_SA(1, 0), cA + kstep, voffA); PG8_STAGE(PG8_SB(1, 1), cB + hstep + kstep, voffB);
        PG8_WAIT_V(6); PG8_BAR;
    }
    for (;;) {
        const bool has_next = S.next(ui + 1, nxt);
        const char* nA = has_next ? (const char*)g.A + (size_t)Epi::a_row0(nxt.pm) * ((size_t)K * 2) : cA; const char* nB = has_next ? (const char*)g.Bt + (size_t)nxt.pn * tstep : cB;
        for (int t = 0; t < nt; t += 2) {
            const bool last = (t == nt - 2);
            const char* a1 = cA + (size_t)(t + 1) * kstep;
            const char* a2 = last ? nA : cA + (size_t)(t + 2) * kstep; const char* b2 = last ? nB : cB + (size_t)(t + 2) * kstep;
            const char* a3 = a2 + kstep; const char* b3 = b2 + kstep;
            if (last && has_next) S.a_ready(nxt);
            if constexpr (SP2) {
            PG8_LDB(B0, 0, 0); PG8_LDB(B1, 0, 1); PG8_SCHED; PG8_LDA(At, 0, 0); PG8_STAGE(PG8_SA(1, 1), a1 + hstep, voffA);
            PG8_WAIT_V(8); PG8_WAIT_L(0); PG8_BAR; PG8_MMA(0, 0, At, B0); PG8_MMA(0, 1, At, B1); PG8_BAR; PG8_SCHED;
            PG8_LDA(At, 0, 1); PG8_STAGE(PG8_SB(0, 0), b2, voffB); PG8_STAGE(PG8_SB(0, 1), b2 + hstep, voffB); PG8_STAGE(PG8_SA(0, 0), a2, voffA);
            PG8_WAIT_V(8); PG8_WAIT_L(0); PG8_BAR; PG8_MMA(1, 0, At, B0); PG8_MMA(1, 1, At, B1); PG8_BAR; PG8_SCHED;
            PG8_LDB(B0, 1, 0); PG8_LDB(B1, 1, 1); PG8_SCHED; PG8_LDA(At, 1, 0); PG8_STAGE(PG8_SA(0, 1), a2 + hstep, voffA);
            PG8_WAIT_V(8); PG8_WAIT_L(0); PG8_BAR; PG8_MMA(0, 0, At, B0); PG8_MMA(0, 1, At, B1); PG8_BAR; PG8_SCHED;
            PG8_LDA(At, 1, 1); PG8_STAGE(PG8_SB(1, 0), b3, voffB); PG8_STAGE(PG8_SB(1, 1), b3 + hstep, voffB); PG8_STAGE(PG8_SA(1, 0), a3, voffA);
            PG8_WAIT_V(8); PG8_WAIT_L(0); PG8_BAR; PG8_MMA(1, 0, At, B0); PG8_MMA(1, 1, At, B1); PG8_BAR; PG8_SCHED;
            } else {
            PG8_LDB(B0, 0, 0); PG8_SCHED; PG8_LDA(At, 0, 0); PG8_STAGE(PG8_SA(1, 1), a1 + hstep, voffA);
            PG8_WAIT_L(8); PG8_BAR; PG8_WAIT_L(0); PG8_MMA(0, 0, At, B0); PG8_BAR; PG8_SCHED;
            PG8_LDB(B1, 0, 1); PG8_STAGE(PG8_SB(0, 0), b2, voffB);
            PG8_BAR; PG8_WAIT_L(0); PG8_MMA(0, 1, At, B1); PG8_BAR;
            PG8_LDA(At, 0, 1); PG8_STAGE(PG8_SA(0, 0), a2, voffA);
            PG8_BAR; PG8_WAIT_L(0); PG8_MMA(1, 0, At, B0); PG8_BAR; PG8_SCHED;
            PG8_STAGE(PG8_SB(0, 1), b2 + hstep, voffB);
            PG8_WAIT_V(6); PG8_BAR; PG8_MMA(1, 1, At, B1); PG8_BAR;
            PG8_LDB(B0, 1, 0); PG8_SCHED; PG8_LDA(At, 1, 0); PG8_STAGE(PG8_SA(0, 1), a2 + hstep, voffA);
            PG8_WAIT_L(8); PG8_BAR; PG8_WAIT_L(0); PG8_MMA(0, 0, At, B0); PG8_BAR; PG8_SCHED;
            PG8_LDB(B1, 1, 1); PG8_STAGE(PG8_SB(1, 0), b3, voffB);
            PG8_BAR; PG8_WAIT_L(0); PG8_MMA(0, 1, At, B1); PG8_BAR;
            PG8_LDA(At, 1, 1); PG8_STAGE(PG8_SA(1, 0), a3, voffA);
            PG8_BAR; PG8_WAIT_L(0); PG8_MMA(1, 0, At, B0); PG8_BAR; PG8_SCHED;
            PG8_STAGE(PG8_SB(1, 1), b3 + hstep, voffB);
            PG8_WAIT_V(6); PG8_BAR; PG8_MMA(1, 1, At, B1); PG8_BAR;
            }
        }
        if constexpr (ALIGN_EPI) { if (wr == 0) PG8_BAR; }
        if constexpr (!Epi::AFTER_DRAIN) { E(acc, cur, wr, wc, fr, fq); S.done(cur); }
        if (!has_next) break;
#pragma unroll
        for (int a = 0; a < 2; ++a)
#pragma unroll
            for (int b = 0; b < 2; ++b)
#pragma unroll
                for (int m = 0; m < 4; ++m)
#pragma unroll
                    for (int n = 0; n < 2; ++n) acc[a][b][m][n] = (f32x4){0.f, 0.f, 0.f, 0.f};
        cur = nxt; cA = nA; cB = nB; ++ui;
        if constexpr (ALIGN_EPI) { if (wr == 1) PG8_BAR; }
    }
    PG8_WAIT_V(0);
    if constexpr (!ALIGN_EPI) { if (wr == 0) PG8_BAR; }
    PG8_BAR;
    if constexpr (Epi::AFTER_DRAIN) { E.fused(acc, cur, wr, wc, fr, fq, lds, wid, lane); S.done(cur); }
#undef PG8_SA
#undef PG8_SB
#undef PG8_STAGE
#undef PG8_LDA
#undef PG8_LDB
#undef PG8_MMA
#undef PG8_WAIT_V
#undef PG8_WAIT_L
#undef PG8_BAR
#undef PG8_SCHED
}
}

#define LAS __attribute__((address_space(3)))
typedef unsigned short bf16_t;
typedef short bf16x8 __attribute__((ext_vector_type(8)));
typedef float f32x4 __attribute__((ext_vector_type(4)));
typedef float f32x2 __attribute__((ext_vector_type(2)));
typedef unsigned u32x4 __attribute__((ext_vector_type(4)));
typedef unsigned u32x2 __attribute__((ext_vector_type(2)));
using pg8::cvt_pk_bf16;

#ifndef REP_ATTN
#define REP_ATTN 1
#endif
#ifndef REP_THIN
#define REP_THIN 1
#endif
constexpr int NWAVES = 8, NTHR = 512;
constexpr int LDS_BYTES = 147456;
constexpr int MTOK = 12288, NCTXROWS = 4096, DM = 1024, DFF = 2816, DUP = 5632;
constexpr float EPSN = 1e-6f;
constexpr float LOG2E = 1.4426950408889634f;
constexpr float SCL2 = 0.125f * 1.4426950408889634f;

constexpr size_t MiB = 1u << 20;
constexpr size_t WS_MOD = 0;
constexpr size_t WS_ROPE = 256 * 1024;
constexpr size_t WS_BAR = 512 * 1024;
constexpr size_t WS_KCA = 1 * MiB;
constexpr size_t WS_VTCA = 1 * MiB + 512 * 1024;
constexpr size_t WS_KCB = 2 * MiB;
constexpr size_t WS_VTCB = 4 * MiB;
constexpr size_t WS_WQKVA = 6 * MiB, WS_WQKVB = 9 * MiB, WS_WOA = 15 * MiB, WS_WOB = 17 * MiB;
constexpr size_t WS_WUP0 = 19 * MiB, WS_WUP1 = 30 * MiB, WS_WDN0 = 41 * MiB, WS_WDN1 = 46 * MiB + 512 * 1024;
constexpr size_t WS_H = 52 * MiB;
constexpr size_t WS_ACT = 118 * MiB;
constexpr size_t WS_U = 118 * MiB;
constexpr size_t WS_Q = 118 * MiB, WS_K = 142 * MiB, WS_VT = 166 * MiB, WS_O = 190 * MiB;
constexpr size_t WS_END = 250 * MiB;
constexpr size_t OUT_Y = 0, OUT_KA = 12582912, OUT_VA = 13631488, OUT_KB = 14680064, OUT_VB = 18874368;

__device__ __forceinline__ unsigned f2bf(float f) { unsigned u = __builtin_bit_cast(unsigned, f); return (u + 0x7fffu + ((u >> 16) & 1u)) >> 16; }
__device__ __forceinline__ float bflo(unsigned w) { return __builtin_bit_cast(float, w << 16); }
__device__ __forceinline__ float bfhi(unsigned w) { return __builtin_bit_cast(float, w & 0xffff0000u); }
__device__ __forceinline__ float wave_sum(float v) {
#pragma unroll
    for (int o = 1; o < 64; o <<= 1) v += __shfl_xor(v, o);
    return v;
}
__device__ __forceinline__ float fast_exp2(float x) { return __builtin_amdgcn_exp2f(x); }
__device__ __forceinline__ float silu_f(float x) { return x * __builtin_amdgcn_rcpf(1.0f + __expf(-x)); }

struct Args { const float* in[26]; float* out; unsigned char* ws; };

#define XB_TMO      128
#define XB_XCNT(j)  (256  + 64 * (j))
#define XB_XSUB(j)  (1280 + 64 * (j))
#define XB_XGEN(j)  (2304 + 64 * (j))
#define XB_TOP      3328
#define XB_TOPGEN   3392
#define XCD_BAR_WORDS 3456
#define XB_SPIN_CAP (1u << 18)

__device__ __forceinline__ unsigned xb_ld(unsigned* p)              { return __hip_atomic_load(p, __ATOMIC_RELAXED, __HIP_MEMORY_SCOPE_AGENT); }
__device__ __forceinline__ unsigned xb_add(unsigned* p, unsigned v) { return __hip_atomic_fetch_add(p, v, __ATOMIC_RELAXED, __HIP_MEMORY_SCOPE_AGENT); }
__device__ __forceinline__ unsigned xb_xcc_id() { return (unsigned)__builtin_amdgcn_s_getreg((3 << 11) | 20) & 0xFu; }
#define XB_SPIN(cond, bar) do { unsigned _sp = 0; while (cond) { __builtin_amdgcn_s_sleep(1); \
    if ((++_sp & 255u) == 0u) { if (xb_ld(&(bar)[XB_TMO])) break; if (_sp > XB_SPIN_CAP) { atomicAdd(&(bar)[XB_TMO], 1u); break; } } } } while (0)

struct XcdBarrier {
    unsigned* bar; unsigned x;
    volatile LAS unsigned* st;
};

__device__ __forceinline__ XcdBarrier xcd_barrier_post(unsigned* bar, volatile LAS unsigned* st) {
    XcdBarrier b; b.bar = bar; b.x = xb_xcc_id(); b.st = st;
    if (threadIdx.x == 0) (void)xb_add(&bar[XB_XCNT(b.x)], 1u);
    return b;
}
__device__ __forceinline__ void xcd_barrier_complete(unsigned* bar, unsigned x, unsigned& nloc, unsigned& nx) {
    const unsigned G = gridDim.x * gridDim.y * gridDim.z;
    unsigned sum, cnt, mine, sp = 0u;
    for (;;) {
        sum = 0u; cnt = 0u; mine = 0u;
#pragma unroll
        for (unsigned j = 0; j < 16; ++j) { const unsigned c = xb_ld(&bar[XB_XCNT(j)]); sum += c; cnt += (c > 0u) ? 1u : 0u; mine = (j == x) ? c : mine; }
        if (sum == G) break;
        __builtin_amdgcn_s_sleep(1);
        if ((++sp & 255u) == 0u) { if (xb_ld(&bar[XB_TMO])) break; if (sp > XB_SPIN_CAP) { atomicAdd(&bar[XB_TMO], 1u); break; } }
    }
    nloc = mine > 0u ? mine : 1u; nx = cnt > 0u ? cnt : 1u;
}

__device__ __forceinline__ void xcd_barrier(const XcdBarrier& b) {
    asm volatile("s_waitcnt vmcnt(0)" ::: "memory");
    __syncthreads();
    if (threadIdx.x == 0) {
        unsigned* bar = b.bar;
        __builtin_amdgcn_s_waitcnt(0);
        unsigned nloc = b.st[0], nx = b.st[1];
        if (nloc == 0u) { xcd_barrier_complete(bar, b.x, nloc, nx); b.st[0] = nloc; b.st[1] = nx; }
        const unsigned old = xb_add(&bar[XB_XSUB(b.x)], 1u);
        const unsigned gen = old / nloc;
        if (old + 1u == (gen + 1u) * nloc) {
            __builtin_amdgcn_fence(__ATOMIC_RELEASE, "agent");
            asm volatile("s_waitcnt vmcnt(0)" ::: "memory");
            const unsigned og = xb_add(&bar[XB_TOP], 1u);
            const unsigned tg = og / nx;
            if (og + 1u == (tg + 1u) * nx) xb_add(&bar[XB_TOPGEN], 1u);
            else XB_SPIN(xb_ld(&bar[XB_TOPGEN]) == tg, bar);
            __builtin_amdgcn_fence(__ATOMIC_ACQUIRE, "agent");
            xb_add(&bar[XB_XGEN(b.x)], 1u);
            asm volatile("s_waitcnt vmcnt(0)" ::: "memory");
        } else {
            XB_SPIN(xb_ld(&bar[XB_XGEN(b.x)]) == gen, bar);
            __builtin_amdgcn_fence(__ATOMIC_ACQUIRE, "agent");
            asm volatile("s_waitcnt vmcnt(0)" ::: "memory");
        }
    }
    __syncthreads();
}


using pg8::Unit;
struct EpiUp {
    static constexpr bool PERM = true, AFTER_DRAIN = false;
    static __device__ __forceinline__ int a_row0(int pm) { return pm * 256; }
    bf16_t* O; int ldc;
    __device__ __forceinline__ void operator()(const f32x4 (&acc)[2][2][4][2], const Unit& u, int wr, int wc, int fr, int fq) const {
        const int row0 = u.pm * 256 + wr * 64 + fr, col0 = u.pn * 256 + wc * 32 + 8 * fq;
#pragma unroll
        for (int ai = 0; ai < 2; ++ai)
#pragma unroll
            for (int m = 0; m < 4; ++m) { bf16_t* rowp = O + (size_t)(row0 + ai * 128 + m * 16) * ldc + col0;
#pragma unroll
                for (int bj = 0; bj < 2; ++bj) { const f32x4 v0 = acc[ai][bj][m][0], v1 = acc[ai][bj][m][1];
                    u32x4 w; w.x = cvt_pk_bf16(v0[0], v0[1]); w.y = cvt_pk_bf16(v0[2], v0[3]); w.z = cvt_pk_bf16(v1[0], v1[1]); w.w = cvt_pk_bf16(v1[2], v1[3]);
                    *(u32x4*)(rowp + bj * 128) = w; } }
    }
};
struct EpiResid {
    static constexpr bool PERM = false, AFTER_DRAIN = false;
    static __device__ __forceinline__ int a_row0(int pm) { return pm * 256; }
    const float* xa; const float* xb; float* out; const float* gate;
    __device__ __forceinline__ void operator()(const f32x4 (&acc)[2][2][4][2], const Unit& u, int wr, int wc, int fr, int fq) const {
        const int rbase = u.pm * 256;
        const float* xin = rbase < NCTXROWS ? xa + (size_t)rbase * DM : xb + (size_t)(rbase - NCTXROWS) * DM;
        const int cond = rbase < NCTXROWS ? 0 : 1 + ((rbase - NCTXROWS) >> 12);
        const int col0 = u.pn * 256 + wc * 32 + 4 * fq;
        const float* g = gate + cond * 6144 + col0;
        float* o = out + (size_t)rbase * DM;
        f32x4 gv[2][2];
#pragma unroll
        for (int bj = 0; bj < 2; ++bj)
#pragma unroll
            for (int n = 0; n < 2; ++n) gv[bj][n] = *(const f32x4*)(g + bj * 128 + n * 16);
#pragma unroll
        for (int ai = 0; ai < 2; ++ai)
#pragma unroll
            for (int m = 0; m < 4; ++m) { const size_t off = (size_t)(ai * 128 + wr * 64 + m * 16 + fr) * DM + col0;
#pragma unroll
                for (int bj = 0; bj < 2; ++bj)
#pragma unroll
                    for (int n = 0; n < 2; ++n) { const f32x4 x = *(const f32x4*)(xin + off + bj * 128 + n * 16);
                        *(f32x4*)(o + off + bj * 128 + n * 16) = x + gv[bj][n] * acc[ai][bj][m][n]; }
                if (m & 1) asm volatile("" ::: "memory"); }
    }
};

struct EpiUpConv {
    static constexpr bool PERM = false, AFTER_DRAIN = false;
    static __device__ __forceinline__ int a_row0(int pm) {
        if (pm < 16) return pm * 256;
        const int s = (pm - 16) / 17, j = (pm - 16) % 17; int st = 254 * j - 1; st = st > 3841 ? 3841 : st;
        return NCTXROWS + 4096 * s + st;
    }
    bf16_t* ACT; const float* cw; const float* cb; LAS float* xch;
    __device__ __forceinline__ void operator()(const f32x4 (&acc)[2][2][4][2], const Unit& u, int wr, int wc, int fr, int fq) const {
        const bool latent = u.pm >= 16;
        const int j17 = latent ? (u.pm - 16) % 17 : -1;
        const bool zr0 = (j17 == 0) && (wr == 0) && (fr == 0), zr255 = (j17 == 16) && (wr == 1) && (fr == 15);
        const int grow0 = a_row0(u.pm);
        const int lane = fq * 16 + fr;
        const int src_prev = (lane & 48) | ((fr + 15) & 15), src_next = (lane & 48) | ((fr + 1) & 15);
        const f32x4 z4 = (f32x4){0.f, 0.f, 0.f, 0.f};
#pragma unroll
        for (int ai = 0; ai < 2; ++ai) { const int g = ai * 2 + wr;
#pragma unroll
            for (int bj = 0; bj < 2; ++bj)
#pragma unroll
                for (int n = 0; n < 2; ++n) { const int col = bj * 128 + 32 * wc + 16 * n + 4 * fq;
                    if (fr == 0) *(LAS f32x4*)(xch + (g * 2 + 0) * 256 + col) = (ai == 0 && zr0) ? z4 : acc[ai][bj][0][n];
                    if (fr == 15) *(LAS f32x4*)(xch + (g * 2 + 1) * 256 + col) = (ai == 1 && zr255) ? z4 : acc[ai][bj][3][n]; } }
        asm volatile("s_waitcnt lgkmcnt(0)" ::: "memory"); __builtin_amdgcn_s_barrier(); asm volatile("" ::: "memory");
        const int fbase = u.pn * 128 + 32 * wc + 4 * fq;
#pragma unroll
        for (int n = 0; n < 2; ++n) {
            const int f0 = fbase + 16 * n;
            f32x4 wg[3], wv[3];
#pragma unroll
            for (int o = 0; o < 3; ++o) { wg[o] = *(const f32x4*)(cw + o * DUP + f0); wv[o] = *(const f32x4*)(cw + o * DUP + DFF + f0); }
            const f32x4 bg = *(const f32x4*)(cb + f0), bv = *(const f32x4*)(cb + DFF + f0);
#pragma unroll
            for (int ai = 0; ai < 2; ++ai) {
                const int g = ai * 2 + wr;
                f32x4 bp[2], bn[2];
#pragma unroll
                for (int bj = 0; bj < 2; ++bj) { const int col = bj * 128 + 32 * wc + 16 * n + 4 * fq;
                    bp[bj] = g > 0 ? *(const LAS f32x4*)(xch + ((g - 1) * 2 + 1) * 256 + col) : z4;
                    bn[bj] = g < 3 ? *(const LAS f32x4*)(xch + ((g + 1) * 2 + 0) * 256 + col) : z4; }
#pragma unroll
                for (int m = 0; m < 4; ++m) {
                    f32x4 cv[2];
#pragma unroll
                    for (int bj = 0; bj < 2; ++bj) {
                        f32x4 cur = acc[ai][bj][m][n];
                        if (ai == 0 && m == 0) cur = zr0 ? z4 : cur;
                        if (ai == 1 && m == 3) cur = zr255 ? z4 : cur;
                        f32x4 ps = m > 0 ? acc[ai][bj][m - 1][n] : bp[bj];
                        f32x4 ns = m < 3 ? acc[ai][bj][m + 1][n] : bn[bj];
                        f32x4 tp, tn, pv, nv;
#pragma unroll
                        for (int i = 0; i < 4; ++i) { tp[i] = fr == 15 ? ps[i] : cur[i]; tn[i] = fr == 0 ? ns[i] : cur[i]; }
#pragma unroll
                        for (int i = 0; i < 4; ++i) { pv[i] = __shfl(tp[i], src_prev); nv[i] = __shfl(tn[i], src_next); }
                        const f32x4 w0 = bj ? wv[0] : wg[0], w1 = bj ? wv[1] : wg[1], w2 = bj ? wv[2] : wg[2], bb = bj ? bv : bg;
                        cv[bj] = w0 * pv + w1 * cur + w2 * nv + bb;
                    }
                    f32x4 r;
#pragma unroll
                    for (int i = 0; i < 4; ++i) r[i] = silu_f(cv[0][i]) * cv[1][i];
                    const int R = ai * 128 + wr * 64 + m * 16 + fr;
                    const bool halo = latent && ((ai == 0 && m == 0 && wr == 0 && fr == 0) || (ai == 1 && m == 3 && wr == 1 && fr == 15));
                    if (!halo) { u32x2 w; w.x = cvt_pk_bf16(r[0], r[1]); w.y = cvt_pk_bf16(r[2], r[3]); *(u32x2*)(ACT + (size_t)(grow0 + R) * DFF + f0) = w; }
                }
            }
            asm volatile("" ::: "memory");
        }
    }
};
template <int NKV>
struct EpiQKV {
    static constexpr bool PERM = false, AFTER_DRAIN = false;
    static __device__ __forceinline__ int a_row0(int pm) { return pm * 256; }
    bf16_t* Q; bf16_t* K; bf16_t* VT; float* newk; float* newv; const float* qn; const float* kn; const float* rope;
    __device__ __forceinline__ void operator()(const f32x4 (&acc)[2][2][4][2], const Unit& u, int wr, int wc, int fr, int fq) const {
        constexpr int KLD = NKV * 64;
        const int hs = 4 * u.pn + wc;
        const int rbase = u.pm * 256 + wr * 64 + fr;
        const bool latent = u.pm >= 16;
        if (hs < 16 + NKV) {
            const bool isq = hs < 16;
            const float* nw = isq ? qn : kn;
            f32x4 wn[2][2];
#pragma unroll
            for (int bj = 0; bj < 2; ++bj)
#pragma unroll
                for (int n = 0; n < 2; ++n) wn[bj][n] = *(const f32x4*)(nw + 32 * bj + 16 * n + 4 * fq);
#pragma unroll
            for (int ai = 0; ai < 2; ++ai)
#pragma unroll
                for (int m = 0; m < 4; ++m) {
                    const int row = rbase + ai * 128 + m * 16;
                    f32x4 v[2][2]; float ss = 0.f;
#pragma unroll
                    for (int bj = 0; bj < 2; ++bj)
#pragma unroll
                        for (int n = 0; n < 2; ++n) { v[bj][n] = acc[ai][bj][m][n]; const f32x4 t = v[bj][n] * v[bj][n]; ss += (t[0] + t[1]) + (t[2] + t[3]); }
                    ss += __shfl_xor(ss, 16); ss += __shfl_xor(ss, 32);
                    const float rinv = rsqrtf(ss * (1.0f / 64.0f) + EPSN);
#pragma unroll
                    for (int bj = 0; bj < 2; ++bj)
#pragma unroll
                        for (int n = 0; n < 2; ++n) v[bj][n] = v[bj][n] * rinv * wn[bj][n];
                    if (latent && NKV == 4) {
                        const int pr = ((row - NCTXROWS) & 4095) >> 6, pc = row & 63;
#pragma unroll
                        for (int bj = 0; bj < 2; ++bj) {
                            const int pos = bj ? pc : pr;
                            const f32x4* t = (const f32x4*)(rope + (pos * 16 + 4 * fq) * 2);
                            const f32x4 t0 = t[0], t1 = t[1];
                            const f32x4 cs = (f32x4){t0[0], t0[2], t1[0], t1[2]}, sn = (f32x4){t0[1], t0[3], t1[1], t1[3]};
                            const f32x4 x1 = v[bj][0], x2 = v[bj][1];
                            v[bj][0] = x1 * cs - x2 * sn; v[bj][1] = x2 * cs + x1 * sn;
                        }
                    }
                    if (isq) {
                        bf16_t* p = Q + (size_t)row * DM + hs * 64 + 4 * fq;
#pragma unroll
                        for (int bj = 0; bj < 2; ++bj)
#pragma unroll
                            for (int n = 0; n < 2; ++n) { u32x2 w; w.x = cvt_pk_bf16(v[bj][n][0], v[bj][n][1]); w.y = cvt_pk_bf16(v[bj][n][2], v[bj][n][3]); *(u32x2*)(p + 32 * bj + 16 * n) = w; }
                    } else {
                        const int kvh = hs - 16;
                        bf16_t* p = K + (size_t)row * KLD + kvh * 64 + 4 * fq;
#pragma unroll
                        for (int bj = 0; bj < 2; ++bj)
#pragma unroll
                            for (int n = 0; n < 2; ++n) { u32x2 w; w.x = cvt_pk_bf16(v[bj][n][0], v[bj][n][1]); w.y = cvt_pk_bf16(v[bj][n][2], v[bj][n][3]); *(u32x2*)(p + 32 * bj + 16 * n) = w; }
                        if (!latent) {
                            float* o = newk + (size_t)row * KLD + kvh * 64 + 4 * fq;
#pragma unroll
                            for (int bj = 0; bj < 2; ++bj)
#pragma unroll
                                for (int n = 0; n < 2; ++n) *(f32x4*)(o + 32 * bj + 16 * n) = v[bj][n];
                        }
                    }
                    asm volatile("" ::: "memory");
                }
        } else {
            const int kvh = hs - 16 - NKV;
#pragma unroll
            for (int ai = 0; ai < 2; ++ai)
#pragma unroll
                for (int m = 0; m < 4; ++m) {
                    const int row = rbase + ai * 128 + m * 16;
                    bf16_t* p = VT + ((size_t)(row >> 5) * NKV + kvh) * 2048 + (row & 31) + (4 * fq) * 32;
#pragma unroll
                    for (int bj = 0; bj < 2; ++bj)
#pragma unroll
                        for (int n = 0; n < 2; ++n)
#pragma unroll
                            for (int i = 0; i < 4; ++i) p[(32 * bj + 16 * n + i) * 32] = (bf16_t)f2bf(acc[ai][bj][m][n][i]);
                    if (!latent) {
                        float* o = newv + (size_t)row * KLD + kvh * 64 + 4 * fq;
#pragma unroll
                        for (int bj = 0; bj < 2; ++bj)
#pragma unroll
                            for (int n = 0; n < 2; ++n) *(f32x4*)(o + 32 * bj + 16 * n) = acc[ai][bj][m][n];
                    }
                    asm volatile("" ::: "memory");
                }
        }
    }
};

struct AttnState { f32x4 o[2][4]; float m[2]; float l[2]; };
#define MFMA16(a, b, c) __builtin_amdgcn_mfma_f32_16x16x32_bf16((a), (b), (c), 0, 0, 0)
struct KVFrag { bf16x8 kf[2][2]; bf16x8 vf[4]; };
__device__ __forceinline__ void attn_load(KVFrag& f, const bf16_t* kp, int kld, const bf16_t* vp, int fr, int fq) {
#pragma unroll
    for (int t = 0; t < 2; ++t)
#pragma unroll
        for (int h2 = 0; h2 < 2; ++h2) f.kf[t][h2] = *(const bf16x8*)(kp + (size_t)(16 * t + fr) * kld + 32 * h2 + 8 * fq);
#pragma unroll
    for (int dt = 0; dt < 4; ++dt) { const bf16_t* v = vp + (16 * dt + fr) * 32 + 4 * fq; const u32x2 lo = *(const u32x2*)v, hi = *(const u32x2*)(v + 16);
        f.vf[dt] = __builtin_bit_cast(bf16x8, ((u32x4){lo.x, lo.y, hi.x, hi.y})); }
}
template <int MASK>
__device__ __forceinline__ void attn_compute(AttnState& st, const bf16x8 (&qf)[2][2], const KVFrag& f, int fr, int fq, int mk0, int mk1, const LAS float* bias) {
#pragma unroll
    for (int qb = 0; qb < 2; ++qb) {
        f32x4 s0 = (f32x4){0.f, 0.f, 0.f, 0.f}, s1 = (f32x4){0.f, 0.f, 0.f, 0.f};
        s0 = MFMA16(f.kf[0][0], qf[qb][0], s0); s0 = MFMA16(f.kf[0][1], qf[qb][1], s0);
        s1 = MFMA16(f.kf[1][0], qf[qb][0], s1); s1 = MFMA16(f.kf[1][1], qf[qb][1], s1);
        float sv[8];
#pragma unroll
        for (int j = 0; j < 4; ++j) { sv[j] = s0[j] * SCL2; sv[4 + j] = s1[j] * SCL2; }
        if (MASK == 1) {
            const int d0 = mk0 + 4 * fq - 16 * qb - fr;
#pragma unroll
            for (int t = 0; t < 2; ++t)
#pragma unroll
                for (int j = 0; j < 4; ++j) { const int df = d0 + 16 * t + j; if (df > 128 || df < -128) sv[4 * t + j] = -INFINITY; }
        }
        if (MASK == 2) {
            const int qc = mk1 + 16 * qb + fr; int cs = qc - 8; cs = cs < 0 ? 0 : (cs > 48 ? 48 : cs);
#pragma unroll
            for (int t = 0; t < 2; ++t)
#pragma unroll
                for (int j = 0; j < 4; ++j) { const int kc = mk0 + 16 * t + 4 * fq + j; const bool ok = (kc >= cs) && (kc < cs + 16);
                    int bi = kc - qc + 15; bi = bi < 0 ? 0 : (bi > 30 ? 30 : bi);
                    const float bv = bias[bi];
                    sv[4 * t + j] = ok ? sv[4 * t + j] + bv : -INFINITY; }
        }
        float cmax = fmaxf(fmaxf(fmaxf(sv[0], sv[1]), fmaxf(sv[2], sv[3])), fmaxf(fmaxf(sv[4], sv[5]), fmaxf(sv[6], sv[7])));
        cmax = fmaxf(cmax, __shfl_xor(cmax, 16)); cmax = fmaxf(cmax, __shfl_xor(cmax, 32));
        const float mnew = fmaxf(st.m[qb], cmax);
        const float msafe = (mnew == -INFINITY) ? 0.f : mnew;
        const float alpha = fast_exp2(st.m[qb] - msafe);
        st.m[qb] = mnew;
        float p[8]; float ps = 0.f;
#pragma unroll
        for (int j = 0; j < 8; ++j) { p[j] = fast_exp2(sv[j] - msafe); ps += p[j]; }
        st.l[qb] = st.l[qb] * alpha + ps;
        u32x4 pw; pw.x = cvt_pk_bf16(p[0], p[1]); pw.y = cvt_pk_bf16(p[2], p[3]); pw.z = cvt_pk_bf16(p[4], p[5]); pw.w = cvt_pk_bf16(p[6], p[7]);
        const bf16x8 pf = __builtin_bit_cast(bf16x8, pw);
#pragma unroll
        for (int dt = 0; dt < 4; ++dt) { st.o[qb][dt] = st.o[qb][dt] * alpha; st.o[qb][dt] = MFMA16(f.vf[dt], pf, st.o[qb][dt]); }
    }
}
__device__ __forceinline__ void attn_init(AttnState& st, bf16x8 (&qf)[2][2], const bf16_t* Q, int qrow0, int head, int fr, int fq) {
#pragma unroll
    for (int qb = 0; qb < 2; ++qb) { st.m[qb] = -INFINITY; st.l[qb] = 0.f;
#pragma unroll
        for (int dt = 0; dt < 4; ++dt) st.o[qb][dt] = (f32x4){0.f, 0.f, 0.f, 0.f};
#pragma unroll
        for (int h2 = 0; h2 < 2; ++h2) qf[qb][h2] = *(const bf16x8*)(Q + (size_t)(qrow0 + 16 * qb + fr) * DM + head * 64 + 32 * h2 + 8 * fq); }
}
__device__ __forceinline__ void attn_finish(AttnState& st, bf16_t* O, int qrow0, int head, int fr, int fq, bool has_sink, float sink) {
#pragma unroll
    for (int qb = 0; qb < 2; ++qb) {
        float l = st.l[qb]; l += __shfl_xor(l, 16); l += __shfl_xor(l, 32);
        if (has_sink) l += fast_exp2(sink * LOG2E - st.m[qb]);
        const float inv = 1.0f / l;
        bf16_t* o = O + (size_t)(qrow0 + 16 * qb + fr) * DM + head * 64 + 4 * fq;
#pragma unroll
        for (int dt = 0; dt < 4; ++dt) { const f32x4 v = st.o[qb][dt] * inv; u32x2 w; w.x = cvt_pk_bf16(v[0], v[1]); w.y = cvt_pk_bf16(v[2], v[3]); *(u32x2*)(o + 16 * dt) = w; }
    }
}
__device__ __forceinline__ void attn_phase_a(const bf16_t* Q, const bf16_t* K, const bf16_t* VT, const bf16_t* Kc, const bf16_t* VTc, const float* sinkp, bf16_t* O, int gw, int ngw, int lane) {
    const int fr = lane & 15, fq = lane >> 4;
    for (int t = gw; t < 4096; t += ngw) {
        const int b = t >> 11, rem = t & 2047, kvh = rem >> 9, rem2 = rem & 511, qblk = ((rem2 >> 3) << 1) | (rem2 & 1), g = (rem2 & 7) >> 1;
        const int head = kvh * 4 + g, qpos0 = qblk * 32, seq0 = NCTXROWS + b * 4096, qrow0 = seq0 + qpos0;
        AttnState st; bf16x8 qf[2][2]; KVFrag cur, nxt;
        attn_init(st, qf, Q, qrow0, head, fr, fq);
        const int c0 = qblk - 4 < 0 ? 0 : qblk - 4, c1 = qblk + 4 > 127 ? 127 : qblk + 4;
        const bf16_t* kcp = Kc + (size_t)(b * 512) * 256 + kvh * 64; const bf16_t* vcp = VTc + (size_t)(b * 16 * 4 + kvh) * 2048;
        const bf16_t* klp = K + (size_t)seq0 * 256 + kvh * 64; const bf16_t* vlp = VT + (size_t)((seq0 >> 5) * 4 + kvh) * 2048;
        attn_load(cur, kcp, 256, vcp, fr, fq);
        for (int c = 0; c < 16; ++c) {
            if (c < 15) attn_load(nxt, kcp + (size_t)(32 * (c + 1)) * 256, 256, vcp + (size_t)(c + 1) * 4 * 2048, fr, fq);
            else attn_load(nxt, klp + (size_t)(32 * c0) * 256, 256, vlp + (size_t)c0 * 4 * 2048, fr, fq);
            attn_compute<0>(st, qf, cur, fr, fq, 0, 0, nullptr);
            cur = nxt;
        }
        for (int c = c0; c <= c1; ++c) {
            if (c < c1) attn_load(nxt, klp + (size_t)(32 * (c + 1)) * 256, 256, vlp + (size_t)(c + 1) * 4 * 2048, fr, fq);
            attn_compute<1>(st, qf, cur, fr, fq, 32 * c - qpos0, 0, nullptr);
            cur = nxt;
        }
        attn_finish(st, O, qrow0, head, fr, fq, true, sinkp[head]);
    }
    for (int t = gw; t < 2048; t += ngw) {
        const int b = t >> 7, rem = t & 127, kvh = rem >> 5, rem2 = rem & 31, qblk = ((rem2 >> 3) << 1) | (rem2 & 1), g = (rem2 & 7) >> 1;
        const int head = kvh * 4 + g, qrow0 = b * 256 + qblk * 32;
        AttnState st; bf16x8 qf[2][2]; KVFrag cur, nxt;
        attn_init(st, qf, Q, qrow0, head, fr, fq);
        const bf16_t* kp = K + (size_t)(b * 256) * 256 + kvh * 64; const bf16_t* vp = VT + (size_t)((b * 8) * 4 + kvh) * 2048;
        attn_load(cur, kp, 256, vp, fr, fq);
        for (int c = 0; c < 8; ++c) {
            if (c < 7) attn_load(nxt, kp + (size_t)(32 * (c + 1)) * 256, 256, vp + (size_t)(c + 1) * 4 * 2048, fr, fq);
            attn_compute<0>(st, qf, cur, fr, fq, 0, 0, nullptr);
            cur = nxt;
        }
        attn_finish(st, O, qrow0, head, fr, fq, true, sinkp[head]);
    }
}
__device__ __forceinline__ void attn_phase_b(const bf16_t* Q, const bf16_t* K, const bf16_t* VT, const bf16_t* Kc, const bf16_t* VTc, const float* rpb, bf16_t* O, int gw, int ngw, int lane, LAS float* btab) {
    const int fr = lane & 15, fq = lane >> 4;
    int cur_head = -1;
    for (int t = gw; t < 4096; t += ngw) {
        const int b = t >> 11, rem = t & 2047, head = rem >> 7, qblk = rem & 127, r = qblk >> 1, half = qblk & 1;
        const int seq0 = NCTXROWS + b * 4096, qrow0 = seq0 + qblk * 32;
        if (head != cur_head) { for (int i = lane; i < 465; i += 64) btab[i] = rpb[head * 465 + i] * LOG2E; cur_head = head; asm volatile("s_waitcnt lgkmcnt(0)" ::: "memory"); }
        AttnState st; bf16x8 qf[2][2]; KVFrag cur, nxt;
        attn_init(st, qf, Q, qrow0, head, fr, fq);
        int rs = r - 4; rs = rs < 0 ? 0 : (rs > 56 ? 56 : rs);
        const bf16_t* kcp = Kc + (size_t)(b * 512) * 1024 + head * 64; const bf16_t* vcp = VTc + (size_t)(b * 16 * 16 + head) * 2048;
        const bf16_t* klp = K + (size_t)(seq0 + rs * 64) * 1024 + head * 64; const bf16_t* vlp = VT + (size_t)(((seq0 + rs * 64) >> 5) * 16 + head) * 2048;
        attn_load(cur, kcp, 1024, vcp, fr, fq);
        for (int c = 0; c < 16; ++c) {
            if (c < 15) attn_load(nxt, kcp + (size_t)(32 * (c + 1)) * 1024, 1024, vcp + (size_t)(c + 1) * 16 * 2048, fr, fq);
            else attn_load(nxt, klp, 1024, vlp, fr, fq);
            attn_compute<0>(st, qf, cur, fr, fq, 0, 0, nullptr);
            cur = nxt;
        }
        for (int c = 0; c < 16; ++c) {
            if (c < 15) attn_load(nxt, klp + (size_t)(32 * (c + 1)) * 1024, 1024, vlp + (size_t)(c + 1) * 16 * 2048, fr, fq);
            attn_compute<2>(st, qf, cur, fr, fq, 32 * (c & 1), 32 * half, btab + (rs + (c >> 1) - r + 7) * 31);
            cur = nxt;
        }
        attn_finish(st, O, qrow0, head, fr, fq, false, 0.f);
    }
    for (int t = gw; t < 2048; t += ngw) {
        const int b = t >> 7, rem = t & 127, head = rem >> 3, qblk = rem & 7;
        const int qrow0 = b * 256 + qblk * 32;
        AttnState st; bf16x8 qf[2][2]; KVFrag cur, nxt;
        attn_init(st, qf, Q, qrow0, head, fr, fq);
        const bf16_t* kp = K + (size_t)(b * 256) * 1024 + head * 64; const bf16_t* vp = VT + (size_t)((b * 8) * 16 + head) * 2048;
        attn_load(cur, kp, 1024, vp, fr, fq);
        for (int c = 0; c < 8; ++c) {
            if (c < 7) attn_load(nxt, kp + (size_t)(32 * (c + 1)) * 1024, 1024, vp + (size_t)(c + 1) * 16 * 2048, fr, fq);
            attn_compute<0>(st, qf, cur, fr, fq, 0, 0, nullptr);
            cur = nxt;
        }
        attn_finish(st, O, qrow0, head, fr, fq, false, 0.f);
    }
}


constexpr int KV_LDS_OFF = 16384, KV_BUF_BYTES = 9728, KROW_B = 144, VROW_B = 80, V_OFF = 4608;
__device__ __forceinline__ u32x4 stage_load(const bf16_t* kp, int kld, const bf16_t* vp, int tid) {
    if (tid < 256) return *(const u32x4*)(kp + (size_t)(tid >> 3) * kld + (tid & 7) * 8);
    return *(const u32x4*)(vp + (tid - 256) * 8);
}
__device__ __forceinline__ void stage_store(LAS unsigned char* buf, u32x4 v, int tid) {
    if (tid < 256) *(LAS u32x4*)(buf + (tid >> 3) * KROW_B + (tid & 7) * 16) = v;
    else { const int e = tid - 256; *(LAS u32x4*)(buf + V_OFF + (e >> 2) * VROW_B + (e & 3) * 16) = v; }
}
__device__ __forceinline__ void frag_load(KVFrag& f, const LAS unsigned char* buf, int fr, int fq) {
#pragma unroll
    for (int t = 0; t < 2; ++t)
#pragma unroll
        for (int h2 = 0; h2 < 2; ++h2) f.kf[t][h2] = *(const LAS bf16x8*)(buf + (16 * t + fr) * KROW_B + 64 * h2 + 16 * fq);
#pragma unroll
    for (int dt = 0; dt < 4; ++dt) { const LAS unsigned char* v = buf + V_OFF + (16 * dt + fr) * VROW_B + 8 * fq; const u32x2 lo = *(const LAS u32x2*)v, hi = *(const LAS u32x2*)(v + 32);
        f.vf[dt] = __builtin_bit_cast(bf16x8, ((u32x4){lo.x, lo.y, hi.x, hi.y})); }
}
__device__ __forceinline__ void attn_groups_a(const bf16_t* Q, const bf16_t* K, const bf16_t* VT, const bf16_t* Kc, const bf16_t* VTc, const float* sinkp, bf16_t* O, int vb, int nb, int tid, LAS unsigned char* lds) {
    const int lane = tid & 63, wave = __builtin_amdgcn_readfirstlane(tid >> 6), fr = lane & 15, fq = lane >> 4;
    LAS unsigned char* kvb = lds + KV_LDS_OFF;
    for (int g = vb; g < 512; g += nb) {
        const int t = g * 8 + wave;
        const int b = t >> 11, rem = t & 2047, kvh = rem >> 9, rem2 = rem & 511, qp = rem2 >> 3, qblk = (qp << 1) | (rem2 & 1), gh = (rem2 & 7) >> 1;
        const int head = kvh * 4 + gh, qpos0 = qblk * 32, seq0 = NCTXROWS + b * 4096, qrow0 = seq0 + qpos0;
        const int cmin = 2 * qp - 4 < 0 ? 0 : 2 * qp - 4, cmax = 2 * qp + 5 > 127 ? 127 : 2 * qp + 5, nsteps = 16 + (cmax - cmin + 1);
        AttnState st; bf16x8 qf[2][2]; KVFrag f;
        attn_init(st, qf, Q, qrow0, head, fr, fq);
        const bf16_t* kcp = Kc + (size_t)(b * 512) * 256 + kvh * 64; const bf16_t* vcp = VTc + (size_t)(b * 16 * 4 + kvh) * 2048;
        const bf16_t* klp = K + (size_t)seq0 * 256 + kvh * 64; const bf16_t* vlp = VT + (size_t)((seq0 >> 5) * 4 + kvh) * 2048;
        u32x4 sr = stage_load(kcp, 256, vcp, tid);
        stage_store(kvb, sr, tid);
        __syncthreads();
        for (int i = 0; i < nsteps; ++i) {
            if (i + 1 < nsteps) { const int j = i + 1;
                if (j < 16) sr = stage_load(kcp + (size_t)(32 * j) * 256, 256, vcp + (size_t)j * 4 * 2048, tid);
                else { const int c = cmin + j - 16; sr = stage_load(klp + (size_t)(32 * c) * 256, 256, vlp + (size_t)c * 4 * 2048, tid); } }
            const LAS unsigned char* buf = kvb + (i & 1) * KV_BUF_BYTES;
            if (i < 16) { frag_load(f, buf, fr, fq); attn_compute<0>(st, qf, f, fr, fq, 0, 0, nullptr); }
            else { const int c = cmin + i - 16;
                if (c >= qblk - 4 && c <= qblk + 4) { frag_load(f, buf, fr, fq); attn_compute<1>(st, qf, f, fr, fq, 32 * c - qpos0, 0, nullptr); } }
            if (i + 1 < nsteps) stage_store(kvb + ((i + 1) & 1) * KV_BUF_BYTES, sr, tid);
            __syncthreads();
        }
        attn_finish(st, O, qrow0, head, fr, fq, true, sinkp[head]);
    }
    for (int g = vb; g < 256; g += nb) {
        const int t = g * 8 + wave;
        const int b = t >> 7, rem = t & 127, kvh = rem >> 5, rem2 = rem & 31, qblk = ((rem2 >> 3) << 1) | (rem2 & 1), gh = (rem2 & 7) >> 1;
        const int head = kvh * 4 + gh, qrow0 = b * 256 + qblk * 32;
        AttnState st; bf16x8 qf[2][2]; KVFrag f;
        attn_init(st, qf, Q, qrow0, head, fr, fq);
        const bf16_t* kp = K + (size_t)(b * 256) * 256 + kvh * 64; const bf16_t* vp = VT + (size_t)((b * 8) * 4 + kvh) * 2048;
        u32x4 sr = stage_load(kp, 256, vp, tid);
        stage_store(kvb, sr, tid);
        __syncthreads();
        for (int i = 0; i < 8; ++i) {
            if (i < 7) sr = stage_load(kp + (size_t)(32 * (i + 1)) * 256, 256, vp + (size_t)(i + 1) * 4 * 2048, tid);
            frag_load(f, kvb + (i & 1) * KV_BUF_BYTES, fr, fq); attn_compute<0>(st, qf, f, fr, fq, 0, 0, nullptr);
            if (i < 7) stage_store(kvb + ((i + 1) & 1) * KV_BUF_BYTES, sr, tid);
            __syncthreads();
        }
        attn_finish(st, O, qrow0, head, fr, fq, true, sinkp[head]);
    }
}
__device__ __forceinline__ void attn_groups_b(const bf16_t* Q, const bf16_t* K, const bf16_t* VT, const bf16_t* Kc, const bf16_t* VTc, const float* rpb, bf16_t* O, int vb, int nb, int tid, LAS unsigned char* lds) {
    const int lane = tid & 63, wave = __builtin_amdgcn_readfirstlane(tid >> 6), fr = lane & 15, fq = lane >> 4;
    LAS unsigned char* kvb = lds + KV_LDS_OFF;
    LAS float* btab = (LAS float*)(lds + wave * 2048);
    for (int g = vb; g < 512; g += nb) {
        const int b = g >> 8, head = (g >> 4) & 15, r0 = 4 * (g & 15), qblk = 2 * r0 + wave, r = r0 + (wave >> 1), half = wave & 1;
        const int seq0 = NCTXROWS + b * 4096, qrow0 = seq0 + qblk * 32;
        for (int i = lane; i < 465; i += 64) btab[i] = rpb[head * 465 + i] * LOG2E;
        int rmin = r0 - 4; rmin = rmin < 0 ? 0 : (rmin > 56 ? 56 : rmin);
        int rmax = r0 - 1; rmax = (rmax < 0 ? 0 : (rmax > 56 ? 56 : rmax)) + 7;
        int rs = r - 4; rs = rs < 0 ? 0 : (rs > 56 ? 56 : rs);
        const int nsteps = 16 + 2 * (rmax - rmin + 1);
        AttnState st; bf16x8 qf[2][2]; KVFrag f;
        attn_init(st, qf, Q, qrow0, head, fr, fq);
        const bf16_t* kcp = Kc + (size_t)(b * 512) * 1024 + head * 64; const bf16_t* vcp = VTc + (size_t)(b * 16 * 16 + head) * 2048;
        const bf16_t* klp = K + (size_t)(seq0 + rmin * 64) * 1024 + head * 64; const bf16_t* vlp = VT + (size_t)(((seq0 + rmin * 64) >> 5) * 16 + head) * 2048;
        u32x4 sr = stage_load(kcp, 1024, vcp, tid);
        stage_store(kvb, sr, tid);
        __syncthreads();
        for (int i = 0; i < nsteps; ++i) {
            if (i + 1 < nsteps) { const int j = i + 1;
                if (j < 16) sr = stage_load(kcp + (size_t)(32 * j) * 1024, 1024, vcp + (size_t)j * 16 * 2048, tid);
                else { const int lc = j - 16; sr = stage_load(klp + (size_t)(32 * lc) * 1024, 1024, vlp + (size_t)lc * 16 * 2048, tid); } }
            const LAS unsigned char* buf = kvb + (i & 1) * KV_BUF_BYTES;
            if (i < 16) { frag_load(f, buf, fr, fq); attn_compute<0>(st, qf, f, fr, fq, 0, 0, nullptr); }
            else { const int lc = i - 16, kr = rmin + (lc >> 1);
                if (kr >= rs && kr <= rs + 7) { frag_load(f, buf, fr, fq); attn_compute<2>(st, qf, f, fr, fq, 32 * (lc & 1), 32 * half, btab + (kr - r + 7) * 31); } }
            if (i + 1 < nsteps) stage_store(kvb + ((i + 1) & 1) * KV_BUF_BYTES, sr, tid);
            __syncthreads();
        }
        attn_finish(st, O, qrow0, head, fr, fq, false, 0.f);
    }
    for (int g = vb; g < 256; g += nb) {
        const int b = g >> 4, head = g & 15, qblk = wave;
        const int qrow0 = b * 256 + qblk * 32;
        AttnState st; bf16x8 qf[2][2]; KVFrag f;
        attn_init(st, qf, Q, qrow0, head, fr, fq);
        const bf16_t* kp = K + (size_t)(b * 256) * 1024 + head * 64; const bf16_t* vp = VT + (size_t)((b * 8) * 16 + head) * 2048;
        u32x4 sr = stage_load(kp, 1024, vp, tid);
        stage_store(kvb, sr, tid);
        __syncthreads();
        for (int i = 0; i < 8; ++i) {
            if (i < 7) sr = stage_load(kp + (size_t)(32 * (i + 1)) * 1024, 1024, vp + (size_t)(i + 1) * 16 * 2048, tid);
            frag_load(f, kvb + (i & 1) * KV_BUF_BYTES, fr, fq); attn_compute<0>(st, qf, f, fr, fq, 0, 0, nullptr);
            if (i < 7) stage_store(kvb + ((i + 1) & 1) * KV_BUF_BYTES, sr, tid);
            __syncthreads();
        }
        attn_finish(st, O, qrow0, head, fr, fq, false, 0.f);
    }
}

__device__ __forceinline__ void transpose_item(const float* W, int K, int N, bf16_t* WT, int kb, int nb, int dst_n0, LAS float* scr, int lane) {
    const int k0 = 64 * kb, n0 = 32 * nb;
#pragma unroll 8
    for (int i = 0; i < 32; ++i) { const int kk = 2 * i + (lane >> 5); scr[kk * 33 + (lane & 31)] = W[(size_t)(k0 + kk) * N + n0 + (lane & 31)]; }
    asm volatile("s_waitcnt lgkmcnt(0)" ::: "memory");
    const int c = lane & 7;
#pragma unroll
    for (int j = 0; j < 4; ++j) { const int n = (lane >> 3) + 8 * j; const LAS float* s = scr + (8 * c) * 33 + n;
        u32x4 o; o.x = cvt_pk_bf16(s[0 * 33], s[1 * 33]); o.y = cvt_pk_bf16(s[2 * 33], s[3 * 33]); o.z = cvt_pk_bf16(s[4 * 33], s[5 * 33]); o.w = cvt_pk_bf16(s[6 * 33], s[7 * 33]);
        *(u32x4*)(WT + (size_t)(dst_n0 + n) * K + k0 + 8 * c) = o; }
    asm volatile("s_waitcnt lgkmcnt(0)" ::: "memory");
}
__device__ __forceinline__ int up_perm(int o) { return o < DFF ? 256 * (o / 128) + (o % 128) : 256 * ((o - DFF) / 128) + 128 + ((o - DFF) % 128); }
__device__ __forceinline__ int qkv_perm(int o) { return (o & ~255) + 128 * ((o >> 5) & 1) + 32 * ((o >> 6) & 3); }

__device__ __forceinline__ void prologue(const Args& a, LAS unsigned char* lds, int tid, int lane, int wave) {
    unsigned char* ws = a.ws;
    const int G = gridDim.x, bx = blockIdx.x;
    {
        LAS float* sc = (LAS float*)lds;
        LAS float* red = (LAS float*)(lds + 16384);
        bool have = false;
        for (int it = bx; it < 192; it += G) {
            if (!have) { for (int k = tid; k < 3072; k += NTHR) { const int cnd = k >> 10, kk = k & 1023; const float x = cnd == 0 ? a.in[7][kk] : a.in[6][(cnd - 1) * 1024 + kk]; sc[k] = silu_f(x); } have = true; }
            __syncthreads();
            const int l = it / 96, n0 = (it % 96) * 64;
            const float* W = a.in[10] + (size_t)l * 1024 * 6144 + n0;
            const int c4 = tid & 15, ks = tid >> 4;
            f32x4 a0 = (f32x4){0.f, 0.f, 0.f, 0.f}, a1 = a0, a2 = a0;
#pragma unroll 8
            for (int kk = 0; kk < 32; ++kk) { const int k = ks * 32 + kk; const f32x4 w = *(const f32x4*)(W + (size_t)k * 6144 + 4 * c4);
                a0 += w * sc[k]; a1 += w * sc[1024 + k]; a2 += w * sc[2048 + k]; }
#pragma unroll
            for (int j = 0; j < 4; ++j) { red[(ks * 3 + 0) * 64 + 4 * c4 + j] = a0[j]; red[(ks * 3 + 1) * 64 + 4 * c4 + j] = a1[j]; red[(ks * 3 + 2) * 64 + 4 * c4 + j] = a2[j]; }
            __syncthreads();
            if (tid < 192) { const int cnd = tid >> 6, col = tid & 63; float s = 0.f;
#pragma unroll 8
                for (int q = 0; q < 32; ++q) s += red[(q * 3 + cnd) * 64 + col];
                ((float*)(ws + WS_MOD))[(l * 3 + cnd) * 6144 + n0 + col] = s + a.in[11][l * 6144 + n0 + col]; }
        }
        __syncthreads();
    }
    const int gw = bx * NWAVES + wave, NGW = G * NWAVES;
    const size_t gt = (size_t)bx * NTHR + tid, NT = (size_t)G * NTHR;
    if (gt < 1024) { const int pos = (int)gt >> 4, f = (int)gt & 15; const float freq = exp2f(-(float)f * (13.287712379549449f / 16.0f)); const float ang = (float)pos * freq;
        float* rp = (float*)(ws + WS_ROPE); rp[2 * gt] = cosf(ang); rp[2 * gt + 1] = sinf(ang); }
    {
        LAS float* scr = (LAS float*)(lds + wave * 16384);
        constexpr int I_QA = 16 * 48, I_QB = 16 * 96, I_O = 16 * 32, I_UP = 16 * 176, I_DN = 44 * 32;
        constexpr int NITEMS = I_QA + I_QB + 2 * I_O + 2 * I_UP + 2 * I_DN;
        for (int it = gw; it < NITEMS; it += NGW) {
            int r = it;
            if (r < I_QA) { const int kb = r / 48, nb = r % 48; transpose_item(a.in[12], 1024, 1536, (bf16_t*)(ws + WS_WQKVA), kb, nb, qkv_perm(32 * nb), scr, lane); continue; } r -= I_QA;
            if (r < I_QB) { const int kb = r / 96, nb = r % 96; transpose_item(a.in[17], 1024, 3072, (bf16_t*)(ws + WS_WQKVB), kb, nb, qkv_perm(32 * nb), scr, lane); continue; } r -= I_QB;
            if (r < I_O) { const int kb = r / 32, nb = r % 32; transpose_item(a.in[16], 1024, 1024, (bf16_t*)(ws + WS_WOA), kb, nb, 32 * nb, scr, lane); continue; } r -= I_O;
            if (r < I_O) { const int kb = r / 32, nb = r % 32; transpose_item(a.in[21], 1024, 1024, (bf16_t*)(ws + WS_WOB), kb, nb, 32 * nb, scr, lane); continue; } r -= I_O;
            if (r < 2 * I_UP) { const int l = r / I_UP; r -= l * I_UP; const int kb = r / 176, nb = r % 176;
                transpose_item(a.in[22] + (size_t)l * 1024 * 5632, 1024, 5632, (bf16_t*)(ws + (l ? WS_WUP1 : WS_WUP0)), kb, nb, up_perm(32 * nb), scr, lane); continue; } r -= 2 * I_UP;
            { const int l = r / I_DN; r -= l * I_DN; const int kb = r / 32, nb = r % 32;
                transpose_item(a.in[25] + (size_t)l * 2816 * 1024, 2816, 1024, (bf16_t*)(ws + (l ? WS_WDN1 : WS_WDN0)), kb, nb, 32 * nb, scr, lane); }
        }
    }
    {
        bf16_t* kca = (bf16_t*)(ws + WS_KCA); bf16_t* kcb = (bf16_t*)(ws + WS_KCB); bf16_t* vca = (bf16_t*)(ws + WS_VTCA); bf16_t* vcb = (bf16_t*)(ws + WS_VTCB);
        for (size_t i = gt; i < 262144; i += NT) kca[i] = (bf16_t)f2bf(a.in[2][i]);
        for (size_t i = gt; i < 1048576; i += NT) kcb[i] = (bf16_t)f2bf(a.in[4][i]);
        for (size_t i = gt; i < 262144; i += NT) { const int tt = (int)i & 31, d = ((int)i >> 5) & 63, kvh = ((int)i >> 11) & 3, c = ((int)i >> 13) & 15, b = (int)i >> 17;
            vca[i] = (bf16_t)f2bf(a.in[3][((size_t)(b * 512 + c * 32 + tt) * 4 + kvh) * 64 + d]); }
        for (size_t i = gt; i < 1048576; i += NT) { const int tt = (int)i & 31, d = ((int)i >> 5) & 63, kvh = ((int)i >> 11) & 15, c = ((int)i >> 15) & 15, b = (int)i >> 19;
            vcb[i] = (bf16_t)f2bf(a.in[5][((size_t)(b * 512 + c * 32 + tt) * 16 + kvh) * 64 + d]); }
    }
}
__device__ __forceinline__ void norm_mod_phase(const float* xa, const float* xb, const float* nw, const float* shift, const float* scale, bf16_t* H, int gw, int ngw, int lane) {
    for (int row = gw; row < MTOK; row += ngw) {
        const float* xr = row < NCTXROWS ? xa + (size_t)row * DM : xb + (size_t)(row - NCTXROWS) * DM;
        const int cond = row < NCTXROWS ? 0 : 1 + ((row - NCTXROWS) >> 12);
        f32x4 v[4]; float s = 0.f;
#pragma unroll
        for (int j = 0; j < 4; ++j) { v[j] = *(const f32x4*)(xr + 4 * (lane + 64 * j)); const f32x4 t = v[j] * v[j]; s += (t[0] + t[1]) + (t[2] + t[3]); }
        const float rinv = rsqrtf(wave_sum(s) * (1.0f / DM) + EPSN);
#pragma unroll
        for (int j = 0; j < 4; ++j) { const int col = 4 * (lane + 64 * j);
            const f32x4 w = *(const f32x4*)(nw + col), sc = *(const f32x4*)(scale + cond * 6144 + col), sh = *(const f32x4*)(shift + cond * 6144 + col);
            const f32x4 y = (v[j] * rinv * w) * (sc + 1.0f) + sh;
            u32x2 o; o.x = cvt_pk_bf16(y[0], y[1]); o.y = cvt_pk_bf16(y[2], y[3]);
            *(u32x2*)(H + (size_t)row * DM + col) = o; }
    }
}
__device__ __forceinline__ void conv_act_phase(const bf16_t* U, const float* cw, const float* cb, bf16_t* ACT, size_t gt, size_t nt) {
    for (size_t item = gt; item < (size_t)384 * 352; item += nt) {
        const int rb = (int)(item / 352), fg = (int)(item % 352), r0 = rb * 32, f0 = fg * 8;
        const int pos0 = r0 < NCTXROWS ? (r0 & 255) : (r0 & 4095), L = r0 < NCTXROWS ? 256 : 4096;
        const bool has_prev = pos0 > 0, has_next = pos0 + 32 < L;
        float wg[3][8], wv[3][8], bg[8], bv[8];
#pragma unroll
        for (int o = 0; o < 3; ++o)
#pragma unroll
            for (int j = 0; j < 8; ++j) { wg[o][j] = cw[o * DUP + f0 + j]; wv[o][j] = cw[o * DUP + DFF + f0 + j]; }
#pragma unroll
        for (int j = 0; j < 8; ++j) { bg[j] = cb[f0 + j]; bv[j] = cb[DFF + f0 + j]; }
        const u32x4 z4 = (u32x4){0u, 0u, 0u, 0u};
        const bf16_t* up = U + (size_t)r0 * DUP + f0;
        u32x4 gp = z4, vp = z4, gc, vc, gn, vn;
        if (has_prev) { gp = *(const u32x4*)(up - DUP); vp = *(const u32x4*)(up - DUP + DFF); }
        gc = *(const u32x4*)up; vc = *(const u32x4*)(up + DFF);
        for (int r = 0; r < 32; ++r) {
            gn = z4; vn = z4;
            if (r < 31 || has_next) { gn = *(const u32x4*)(up + (size_t)(r + 1) * DUP); vn = *(const u32x4*)(up + (size_t)(r + 1) * DUP + DFF); }
            float res[8];
#pragma unroll
            for (int q = 0; q < 4; ++q) {
                const float g0 = wg[0][2 * q] * bflo(gp[q]) + wg[1][2 * q] * bflo(gc[q]) + wg[2][2 * q] * bflo(gn[q]) + bg[2 * q];
                const float g1 = wg[0][2 * q + 1] * bfhi(gp[q]) + wg[1][2 * q + 1] * bfhi(gc[q]) + wg[2][2 * q + 1] * bfhi(gn[q]) + bg[2 * q + 1];
                const float v0 = wv[0][2 * q] * bflo(vp[q]) + wv[1][2 * q] * bflo(vc[q]) + wv[2][2 * q] * bflo(vn[q]) + bv[2 * q];
                const float v1 = wv[0][2 * q + 1] * bfhi(vp[q]) + wv[1][2 * q + 1] * bfhi(vc[q]) + wv[2][2 * q + 1] * bfhi(vn[q]) + bv[2 * q + 1];
                res[2 * q] = silu_f(g0) * v0; res[2 * q + 1] = silu_f(g1) * v1;
            }
            u32x4 o; o.x = cvt_pk_bf16(res[0], res[1]); o.y = cvt_pk_bf16(res[2], res[3]); o.z = cvt_pk_bf16(res[4], res[5]); o.w = cvt_pk_bf16(res[6], res[7]);
            *(u32x4*)(ACT + (size_t)(r0 + r) * DFF + f0) = o;
            gp = gc; vp = vc; gc = gn; vc = vn;
        }
    }
}

__global__ void __launch_bounds__(NTHR, 2) mk_fwd(Args a) {
    extern __shared__ __attribute__((aligned(16))) unsigned char lds_raw[];
    cg::grid_group grid = cg::this_grid();
    LAS unsigned char* lds = (LAS unsigned char*)lds_raw;
    const int tid = threadIdx.x, lane = tid & 63, wave = __builtin_amdgcn_readfirstlane(tid >> 6);
    const int G = gridDim.x, bx = blockIdx.x;
    const int gw = bx * NWAVES + wave, NGW = G * NWAVES;
    const size_t gt = (size_t)bx * NTHR + tid, NT = (size_t)G * NTHR;
    unsigned char* ws = a.ws;
    float* out = a.out;
    bf16_t* H = (bf16_t*)(ws + WS_H); bf16_t* ACT = (bf16_t*)(ws + WS_ACT); bf16_t* U = (bf16_t*)(ws + WS_U);
    bf16_t* Qb = (bf16_t*)(ws + WS_Q); bf16_t* Kb = (bf16_t*)(ws + WS_K); bf16_t* VTb = (bf16_t*)(ws + WS_VT); bf16_t* Ob = (bf16_t*)(ws + WS_O);
    const float* rope = (const float*)(ws + WS_ROPE);

#ifndef NO_PRO
    for (int rep = 0; rep < REP_THIN; ++rep) { prologue(a, lds, tid, lane, wave); __syncthreads(); }
#endif
    volatile LAS unsigned* bst = (volatile LAS unsigned*)(lds + 131072 + 64);
    if (tid < 2) bst[tid] = 0u;
    unsigned* barw = (unsigned*)(ws + WS_BAR);
    if (bx == 0) for (int i = tid; i < XCD_BAR_WORDS; i += NTHR) barw[i] = 0u;
    grid.sync();
    const XcdBarrier xbar = xcd_barrier_post(barw, bst);
#define GSYNC() xcd_barrier(xbar)

#pragma unroll 1
    for (int layer = 0; layer < 2; ++layer) {
        const float* mod = (const float*)(ws + WS_MOD) + layer * 3 * 6144;
        const float* xa = layer == 0 ? a.in[0] : out;
        const float* xb = layer == 0 ? a.in[1] : out + (size_t)NCTXROWS * DM;
#ifndef NO_NORM
        for (int rep = 0; rep < REP_THIN; ++rep)
        { int tl = tid; asm volatile("" : "+v"(tl)); const int wv = __builtin_amdgcn_readfirstlane(tl >> 6);
          norm_mod_phase(xa, xb, a.in[8] + layer * DM, mod + 0 * 1024, mod + 1 * 1024, H, bx * NWAVES + wv, NGW, tl & 63); }
#endif
        GSYNC();
#ifndef NO_QKV
        if (layer == 0) {
            pg8::Gemm g{H, (const bf16_t*)(ws + WS_WQKVA), MTOK, 1536, 1024}; pg8::StaticOrder S; int bxl = bx; asm volatile("" : "+s"(bxl)); int tl = tid; asm volatile("" : "+v"(tl)); S.init(MTOK, 1536, G, bxl);
            EpiQKV<4> E{Qb, Kb, VTb, out + OUT_KA, out + OUT_VA, a.in[13], a.in[14], rope};
            pg8::gemm_phase<EpiQKV<4>, pg8::StaticOrder, true, true>(lds, g, S, E, tl);
        } else {
            pg8::Gemm g{H, (const bf16_t*)(ws + WS_WQKVB), MTOK, 3072, 1024}; pg8::StaticOrder S; int bxl = bx; asm volatile("" : "+s"(bxl)); int tl = tid; asm volatile("" : "+v"(tl)); S.init(MTOK, 3072, G, bxl);
            EpiQKV<16> E{Qb, Kb, VTb, out + OUT_KB, out + OUT_VB, a.in[18], a.in[19], rope};
            pg8::gemm_phase<EpiQKV<16>, pg8::StaticOrder, true, true>(lds, g, S, E, tl);
        }
#endif
        GSYNC();
#ifndef NO_ATTN
        for (int rep = 0; rep < REP_ATTN; ++rep)
        { int tl = tid; asm volatile("" : "+v"(tl));
        if (layer == 0) attn_groups_a(Qb, Kb, VTb, (const bf16_t*)(ws + WS_KCA), (const bf16_t*)(ws + WS_VTCA), a.in[15], Ob, bx, G, tl, lds);
        else attn_groups_b(Qb, Kb, VTb, (const bf16_t*)(ws + WS_KCB), (const bf16_t*)(ws + WS_VTCB), a.in[20], Ob, bx, G, tl, lds); }
#endif
        GSYNC();
#ifndef NO_OPROJ
        {
            pg8::Gemm g{Ob, (const bf16_t*)(ws + (layer ? WS_WOB : WS_WOA)), MTOK, 1024, 1024}; pg8::StaticOrder S; int bxl = bx; asm volatile("" : "+s"(bxl)); int tl = tid; asm volatile("" : "+v"(tl)); S.init(MTOK, 1024, G, bxl);
            EpiResid E{xa, xb, out, mod + 2 * 1024};
            pg8::gemm_phase<EpiResid, pg8::StaticOrder, true, true>(lds, g, S, E, tl);
        }
#endif
        GSYNC();
#ifndef NO_NORM
        for (int rep = 0; rep < REP_THIN; ++rep)
        { int tl = tid; asm volatile("" : "+v"(tl)); const int wv = __builtin_amdgcn_readfirstlane(tl >> 6);
          norm_mod_phase(out, out + (size_t)NCTXROWS * DM, a.in[9] + layer * DM, mod + 3 * 1024, mod + 4 * 1024, H, bx * NWAVES + wv, NGW, tl & 63); }
#endif
        GSYNC();
#ifndef NO_UP
        {
            pg8::Gemm g{H, (const bf16_t*)(ws + (layer ? WS_WUP1 : WS_WUP0)), 50 * 256, DUP, 1024}; pg8::StaticOrder S; int bxl = bx; asm volatile("" : "+s"(bxl)); int tl = tid; asm volatile("" : "+v"(tl)); S.init(50 * 256, DUP, G, bxl);
            EpiUpConv E{ACT, a.in[23] + (size_t)layer * 3 * DUP, a.in[24] + (size_t)layer * DUP, (LAS float*)(lds + 131072 + 1024)};
            pg8::gemm_phase<EpiUpConv, pg8::StaticOrder, true, true>(lds, g, S, E, tl);
        }
#endif
        GSYNC();
#ifndef NO_DOWN
        {
            pg8::Gemm g{ACT, (const bf16_t*)(ws + (layer ? WS_WDN1 : WS_WDN0)), MTOK, 1024, DFF}; pg8::StaticOrder S; int bxl = bx; asm volatile("" : "+s"(bxl)); int tl = tid; asm volatile("" : "+v"(tl)); S.init(MTOK, 1024, G, bxl);
            EpiResid E{out, out + (size_t)NCTXROWS * DM, out, mod + 5 * 1024};
            pg8::gemm_phase<EpiResid, pg8::StaticOrder, true, true>(lds, g, S, E, tl);
        }
#endif
        if (layer == 0) GSYNC();
    }
}

extern "C" void kernel_launch(void* const* d_in, const int* in_sizes, int n_in, void* d_out, int out_size, void* d_ws, size_t ws_size, hipStream_t stream) {
    static int grid = 0;
    if (grid == 0) {
        if (n_in != 26 || out_size != 23068672 || ws_size < WS_END) { fprintf(stderr, "kernel_launch: unexpected shapes n_in %d out %d ws %zu\n", n_in, out_size, ws_size); grid = -1; return; }
        int dev = 0, cus = 0, per_cu = 0;
        hipGetDevice(&dev);
        hipDeviceGetAttribute(&cus, hipDeviceAttributeMultiprocessorCount, dev);
        hipFuncSetAttribute((const void*)mk_fwd, hipFuncAttributeMaxDynamicSharedMemorySize, LDS_BYTES);
        hipOccupancyMaxActiveBlocksPerMultiprocessor(&per_cu, (const void*)mk_fwd, NTHR, LDS_BYTES);
        if (per_cu < 1) per_cu = 1;
        grid = cus * per_cu;
    }
    if (grid < 0) return;
    Args a{};
    for (int i = 0; i < 26; ++i) a.in[i] = (const float*)d_in[i];
    a.out = (float*)d_out; a.ws = (unsigned char*)d_ws;
    void* args[] = {&a};
    hipError_t e = hipLaunchCooperativeKernel((const void*)mk_fwd, dim3(grid), dim3(NTHR), args, LDS_BYTES, stream);
    if (e != hipSuccess) fprintf(stderr, "cooperative launch failed: %s (grid %d)\n", hipGetErrorString(e), grid);
}
```

```cpp
#include <hip/hip_runtime.h>
#include <hip/hip_cooperative_groups.h>
#include <cstdio>
#include <cstdint>
namespace cg = cooperative_groups;
namespace pg8 {
#define PG8_LAS __attribute__((address_space(3)))
typedef unsigned short bf16_t;
typedef short bf16x8 __attribute__((ext_vector_type(8)));
typedef float f32x4 __attribute__((ext_vector_type(4)));
typedef unsigned u32x4 __attribute__((ext_vector_type(4)));
constexpr int BM = 256, BK = 64, HALF = 128, HTB = HALF * BK * 2  , STAGE_BYTES = 8 * HTB, NXCD = 8, WGM = 8;

__host__ __device__ __forceinline__ int lds_byte(int r, int c) { const int st = (r >> 4) * 2 + (c >> 5), rr = r & 15, cc = c & 31, ob = rr * 64 + cc * 2; return st * 1024 + (ob ^ (((ob >> 9) & 1) << 5)); }
__host__ __device__ __forceinline__ void stage_rc(int b, int& R, int& C) { const int st = b / 1024, sb = b % 1024, swz = sb ^ (((sb >> 9) & 1) << 5); R = (st >> 1) * 16 + swz / 64; C = (st & 1) * 32 + (swz % 64) / 2; }
__host__ __device__ __forceinline__ int perm32(int rho) { const int n = rho >> 4, i = rho & 15; return 8 * (i >> 2) + 4 * n + (i & 3); }

struct Unit { int pm, pn; };
struct Gemm { const bf16_t* A; const bf16_t* Bt; int M, N, K; };

struct StaticOrder {
    int nM, nN, nwg, G, c;
    __host__ __device__ void init(int M, int N, int G_, int c_) { nM = M / BM; nN = N / BM; nwg = nM * nN; G = G_; c = c_; }
    __host__ __device__ bool next(int i, Unit& u) const {
        const long L = (long)i * G + c; if (L >= nwg) return false;
        int wgid = (int)L; { const int q = nwg / NXCD, r = nwg % NXCD, xcd = wgid % NXCD, off = wgid / NXCD; wgid = (xcd < r ? xcd * (q + 1) : r * (q + 1) + (xcd - r) * q) + off; }
        const int nig = WGM * nN, gid = wgid / nig, fm = gid * WGM, gsz = (nM - fm) < WGM ? (nM - fm) : WGM;
        u.pm = fm + ((wgid % nig) % gsz); u.pn = (wgid % nig) / gsz; return true;
    }
    __device__ __forceinline__ void a_ready(const Unit&) const {}
    __device__ __forceinline__ void done(const Unit&) const {}
};

__device__ __forceinline__ unsigned cvt_pk_bf16(float lo, float hi) { unsigned r; asm volatile("v_cvt_pk_bf16_f32 %0, %1, %2" : "=v"(r) : "v"(lo), "v"(hi)); return r; }
template <class Epi, class Sched, bool ALIGN_EPI = false, bool SP2 = false>
__device__ __forceinline__ void gemm_phase(PG8_LAS unsigned char* lds, const Gemm g, const Sched& S, const Epi& E, const int tid_in) {
    const int tid = tid_in, wid = __builtin_amdgcn_readfirstlane(tid >> 6), lane = tid & 63, wr = wid >> 2, wc = wid & 3, fr = lane & 15, fq = lane >> 4;
    const int K = g.K, nt = K / BK;
    unsigned voffA[2], voffB[2];
#pragma unroll
    for (int i = 0; i < 2; ++i) { int R, C; stage_rc(tid * 16 + i * 8192, R, C); const int Rb = Epi::PERM ? ((R & ~31) + perm32(R & 31)) : R;
        voffA[i] = (unsigned)(R * K + C) * 2u; voffB[i] = (unsigned)(Rb * K + C) * 2u; }
    const size_t kstep = (size_t)(BK * 2);
    const size_t hstep = (size_t)HALF * K * 2;
    const size_t tstep = 2 * hstep;
    const unsigned ldsw = (unsigned)wid * 1024u;
    const int aoff = lds_byte(wr * 64 + fr, fq * 8), boff = lds_byte(wc * 32 + fr, fq * 8);
#define PG8_SA(b, h) (((b) * 2 + (h)) * HTB)
#define PG8_SB(b, h) ((4 + (b) * 2 + (h)) * HTB)
#define PG8_STAGE(bufoff, gbase, voff) do { _Pragma("unroll") for (int _i = 0; _i < 2; ++_i) \
        __builtin_amdgcn_global_load_lds((const unsigned*)((const char*)(gbase) + (voff)[_i]), (PG8_LAS unsigned*)(lds + (bufoff) + ldsw + _i * 8192), 16, 0, 0); } while (0)
#define PG8_LDA(dst, b, h) do { _Pragma("unroll") for (int m = 0; m < 4; ++m) _Pragma("unroll") for (int k = 0; k < 2; ++k) dst[m][k] = *(const PG8_LAS bf16x8*)(lds + PG8_SA(b, h) + aoff + m * 2048 + k * 1024); } while (0)
#define PG8_LDB(dst, b, h) do { _Pragma("unroll") for (int n = 0; n < 2; ++n) _Pragma("unroll") for (int k = 0; k < 2; ++k) dst[n][k] = *(const PG8_LAS bf16x8*)(lds + PG8_SB(b, h) + boff + n * 2048 + k * 1024); } while (0)
#define PG8_MMA(ai, bj, At, Bt) do { __builtin_amdgcn_s_setprio(1); _Pragma("unroll") for (int m = 0; m < 4; ++m) _Pragma("unroll") for (int n = 0; n < 2; ++n) _Pragma("unroll") for (int k = 0; k < 2; ++k) \
        acc[ai][bj][m][n] = __builtin_amdgcn_mfma_f32_16x16x32_bf16(Bt[n][k], At[m][k], acc[ai][bj][m][n], 0, 0, 0); __builtin_amdgcn_s_setprio(0); } while (0)
#define PG8_WAIT_V(n) asm volatile("s_waitcnt vmcnt(" #n ")" ::: "memory")
#define PG8_WAIT_L(n) asm volatile("s_waitcnt lgkmcnt(" #n ")" ::: "memory")
#define PG8_BAR __builtin_amdgcn_s_barrier()
#define PG8_SCHED __builtin_amdgcn_sched_barrier(0)
    Unit cur, nxt; int ui = 0;
    if (!S.next(0, cur)) return;
    f32x4 acc[2][2][4][2];
#pragma unroll
    for (int a = 0; a < 2; ++a)
#pragma unroll
        for (int b = 0; b < 2; ++b)
#pragma unroll
            for (int m = 0; m < 4; ++m)
#pragma unroll
                for (int n = 0; n < 2; ++n) acc[a][b][m][n] = (f32x4){0.f, 0.f, 0.f, 0.f};
    bf16x8 At[4][2], B0[2][2], B1[2][2];
    const char* cA = (const char*)g.A + (size_t)Epi::a_row0(cur.pm) * ((size_t)K * 2); const char* cB = (const char*)g.Bt + (size_t)cur.pn * tstep;
    S.a_ready(cur);
    if constexpr (SP2) {
        PG8_STAGE(PG8_SB(0, 0), cB, voffB); PG8_STAGE(PG8_SB(0, 1), cB + hstep, voffB); PG8_STAGE(PG8_SA(0, 0), cA, voffA); PG8_STAGE(PG8_SA(0, 1), cA + hstep, voffA);
        if (wr == 1) PG8_BAR;
        PG8_WAIT_V(2); PG8_BAR;
        PG8_STAGE(PG8_SB(1, 0), cB + kstep, voffB); PG8_STAGE(PG8_SA(1, 0), cA + kstep, voffA); PG8_STAGE(PG8_SB(1, 1), cB + hstep + kstep, voffB);
        PG8_WAIT_V(6); PG8_BAR;
    } else {
        PG8_STAGE(PG8_SB(0, 0), cB, voffB); PG8_STAGE(PG8_SA(0, 0), cA, voffA); PG8_STAGE(PG8_SB(0, 1), cB + hstep, voffB); PG8_STAGE(PG8_SA(0, 1), cA + hstep, voffA);
        if (wr == 1) PG8_BAR;
        PG8_WAIT_V(4); PG8_BAR;
        PG8_STAGE(PG8_SB(1, 0), cB + kstep, voffB); PG8_STAGE(PG8_SA(1, 0), cA + kstep, voffA); PG8_STAGE(PG8_SB(1, 1), cB + hstep + kstep, voffB);
        PG8_WAIT_V(6); PG8_BAR;
    }
    for (;;) {
        const bool has_next = S.next(ui + 1, nxt);
        const char* nA = has_next ? (const char*)g.A + (size_t)Epi::a_row0(nxt.pm) * ((size_t)K * 2) : cA; const char* nB = has_next ? (const char*)g.Bt + (size_t)nxt.pn * tstep : cB;
        for (int t = 0; t < nt; t += 2) {
            const bool last = (t == nt - 2);
            const char* a1 = cA + (size_t)(t + 1) * kstep;
            const char* a2 = last ? nA : cA + (size_t)(t + 2) * kstep; const char* b2 = last ? nB : cB + (size_t)(t + 2) * kstep;
            const char* a3 = a2 + kstep; const char* b3 = b2 + kstep;
            if (last && has_next) S.a_ready(nxt);
            if constexpr (SP2) {
            PG8_LDB(B0, 0, 0); PG8_LDB(B1, 0, 1); PG8_SCHED; PG8_LDA(At, 0, 0); PG8_STAGE(PG8_SA(1, 1), a1 + hstep, voffA);
            PG8_WAIT_V(8); PG8_WAIT_L(0); PG8_BAR; PG8_MMA(0, 0, At, B0); PG8_MMA(0, 1, At, B1); PG8_BAR; PG8_SCHED;
            PG8_LDA(At, 0, 1); PG8_STAGE(PG8_SB(0, 0), b2, voffB); PG8_STAGE(PG8_SB(0, 1), b2 + hstep, voffB); PG8_STAGE(PG8_SA(0, 0), a2, voffA);
            PG8_WAIT_V(8); PG8_WAIT_L(0); PG8_BAR; PG8_MMA(1, 0, At, B0); PG8_MMA(1, 1, At, B1); PG8_BAR; PG8_SCHED;
            PG8_LDB(B0, 1, 0); PG8_LDB(B1, 1, 1); PG8_SCHED; PG8_LDA(At, 1, 0); PG8_STAGE(PG8_SA(0, 1), a2 + hstep, voffA);
            PG8_WAIT_V(8); PG8_WAIT_L(0); PG8_BAR; PG8_MMA(0, 0, At, B0); PG8_MMA(0, 1, At, B1); PG8_BAR; PG8_SCHED;
            PG8_LDA(At, 1, 1); PG8_STAGE(PG8_SB(1, 0), b3, voffB); PG8_STAGE(PG8_SB(1, 1), b3 + hstep, voffB); PG8_STAGE(PG8_SA(1, 0), a3, voffA);
            PG8_WAIT_V(8); PG8_WAIT_L(0); PG8_BAR; PG8_MMA(1, 0, At, B0); PG8_MMA(1, 1, At, B1); PG8_BAR; PG8_SCHED;
            } else {
            PG8_LDB(B0, 0, 0); PG8_SCHED; PG8_LDA(At, 0, 0); PG8_STAGE(PG8_SA(1, 1), a1 + hstep, voffA);
            PG8_WAIT_L(8); PG8_BAR; PG8_WAIT_L(0); PG8_MMA(0, 0, At, B0); PG8_BAR; PG8_SCHED;
            PG8_LDB(B1, 0, 1); PG8_STAGE(PG8_SB(0, 0), b2, voffB);
            PG8_BAR; PG8_WAIT_L(0); PG8_MMA(0, 1, At, B1); PG8_BAR;
            PG8_LDA(At, 0, 1); PG8_STAGE(PG8_SA(0, 0), a2, voffA);
            PG8_BAR; PG8_WAIT_L(0); PG8_MMA(1, 0, At, B0); PG8_BAR; PG8_SCHED;
            PG8_STAGE(PG8_SB(0, 1), b2 + hstep, voffB);
            PG8_WAIT_V(6); PG8_BAR; PG8_MMA(1, 1, At, B1); PG8_BAR;
            PG8_LDB(B0, 1, 0); PG8_SCHED; PG8_LDA(At, 1, 0); PG8_STAGE(PG8_SA(0, 1), a2 + hstep, voffA);
            PG8_WAIT_L(8); PG8_BAR; PG8_WAIT_L(0); PG8_MMA(0, 0, At, B0); PG8_BAR; PG8_SCHED;
            PG8_LDB(B1, 1, 1); PG8_STAGE(PG8_SB(1, 0), b3, voffB);
            PG8_BAR; PG8_WAIT_L(0); PG8_MMA(0, 1, At, B1); PG8_BAR;
            PG8_LDA(At, 1, 1); PG8_STAGE(PG8_SA(1, 0), a3, voffA);
            PG8_BAR; PG8_WAIT_L(0); PG8_MMA(1, 0, At, B0); PG8_BAR; PG8_SCHED;
            PG8_STAGE(PG8_SB(1, 1), b3 + hstep, voffB);
            PG8_WAIT_V(6); PG8_BAR; PG8_MMA(1, 1, At, B1); PG8_BAR;
            }
        }
        if constexpr (ALIGN_EPI) { if (wr == 0) PG8_BAR; }
        if constexpr (!Epi::AFTER_DRAIN) { E(acc, cur, wr, wc, fr, fq); S.done(cur); }
        if (!has_next) break;
#pragma unroll
        for (int a = 0; a < 2; ++a)
#pragma unroll
            for (int b = 0; b < 2; ++b)
#pragma unroll
                for (int m = 0; m < 4; ++m)
#pragma unroll
                    for (int n = 0; n < 2; ++n) acc[a][b][m][n] = (f32x4){0.f, 0.f, 0.f, 0.f};
        cur = nxt; cA = nA; cB = nB; ++ui;
        if constexpr (ALIGN_EPI) { if (wr == 1) PG8_BAR; }
    }
    PG8_WAIT_V(0);
    if constexpr (!ALIGN_EPI) { if (wr == 0) PG8_BAR; }
    PG8_BAR;
    if constexpr (Epi::AFTER_DRAIN) { E.fused(acc, cur, wr, wc, fr, fq, lds, wid, lane); S.done(cur); }
#undef PG8_SA
#undef PG8_SB
#undef PG8_STAGE
#undef PG8_LDA
#undef PG8_LDB
#undef PG8_MMA
#undef PG8_WAIT_V
#undef PG8_WAIT_L
#undef PG8_BAR
#undef PG8_SCHED
}
}

#define LAS __attribute__((address_space(3)))
typedef unsigned short bf16_t;
typedef short bf16x8 __attribute__((ext_vector_type(8)));
typedef float f32x4 __attribute__((ext_vector_type(4)));
typedef float f32x2 __attribute__((ext_vector_type(2)));
typedef unsigned u32x4 __attribute__((ext_vector_type(4)));
typedef unsigned u32x2 __attribute__((ext_vector_type(2)));
using pg8::cvt_pk_bf16;

#ifndef REP_ATTN
#define REP_ATTN 1
#endif
#ifndef REP_THIN
#define REP_THIN 1
#endif
constexpr int NWAVES = 8, NTHR = 512;
constexpr int LDS_BYTES = 147456;
constexpr int MTOK = 12288, NCTXROWS = 4096, DM = 1024, DFF = 2816, DUP = 5632;
constexpr float EPSN = 1e-6f;
constexpr float LOG2E = 1.4426950408889634f;
constexpr float SCL2 = 0.125f * 1.4426950408889634f;

constexpr size_t MiB = 1u << 20;
constexpr size_t WS_MOD = 0;
constexpr size_t WS_ROPE = 256 * 1024;
constexpr size_t WS_BAR = 512 * 1024;
constexpr size_t WS_KCA = 1 * MiB;
constexpr size_t WS_VTCA = 1 * MiB + 512 * 1024;
constexpr size_t WS_KCB = 2 * MiB;
constexpr size_t WS_VTCB = 4 * MiB;
constexpr size_t WS_WQKVA = 6 * MiB, WS_WQKVB = 9 * MiB, WS_WOA = 15 * MiB, WS_WOB = 17 * MiB;
constexpr size_t WS_WUP0 = 19 * MiB, WS_WUP1 = 30 * MiB, WS_WDN0 = 41 * MiB, WS_WDN1 = 46 * MiB + 512 * 1024;
constexpr size_t WS_H = 52 * MiB;
constexpr size_t WS_ACT = 118 * MiB;
constexpr size_t WS_U = 118 * MiB;
constexpr size_t WS_Q = 118 * MiB, WS_K = 142 * MiB, WS_VT = 166 * MiB, WS_O = 190 * MiB;
constexpr size_t WS_END = 250 * MiB;
constexpr size_t OUT_Y = 0, OUT_KA = 12582912, OUT_VA = 13631488, OUT_KB = 14680064, OUT_VB = 18874368;

__device__ __forceinline__ unsigned f2bf(float f) { unsigned u = __builtin_bit_cast(unsigned, f); return (u + 0x7fffu + ((u >> 16) & 1u)) >> 16; }
__device__ __forceinline__ float bflo(unsigned w) { return __builtin_bit_cast(float, w << 16); }
__device__ __forceinline__ float bfhi(unsigned w) { return __builtin_bit_cast(float, w & 0xffff0000u); }
__device__ __forceinline__ float wave_sum(float v) {
#pragma unroll
    for (int o = 1; o < 64; o <<= 1) v += __shfl_xor(v, o);
    return v;
}
__device__ __forceinline__ float fast_exp2(float x) { return __builtin_amdgcn_exp2f(x); }
__device__ __forceinline__ float silu_f(float x) { return x * __builtin_amdgcn_rcpf(1.0f + __expf(-x)); }

struct Args { const float* in[26]; float* out; unsigned char* ws; };

#define XB_TMO      128
#define XB_XCNT(j)  (256  + 64 * (j))
#define XB_XSUB(j)  (1280 + 64 * (j))
#define XB_XGEN(j)  (2304 + 64 * (j))
#define XB_TOP      3328
#define XB_TOPGEN   3392
#define XCD_BAR_WORDS 3456
#define XB_SPIN_CAP (1u << 18)

__device__ __forceinline__ unsigned xb_ld(unsigned* p)              { return __hip_atomic_load(p, __ATOMIC_RELAXED, __HIP_MEMORY_SCOPE_AGENT); }
__device__ __forceinline__ unsigned xb_add(unsigned* p, unsigned v) { return __hip_atomic_fetch_add(p, v, __ATOMIC_RELAXED, __HIP_MEMORY_SCOPE_AGENT); }
__device__ __forceinline__ unsigned xb_xcc_id() { return (unsigned)__builtin_amdgcn_s_getreg((3 << 11) | 20) & 0xFu; }
#define XB_SPIN(cond, bar) do { unsigned _sp = 0; while (cond) { __builtin_amdgcn_s_sleep(1); \
    if ((++_sp & 255u) == 0u) { if (xb_ld(&(bar)[XB_TMO])) break; if (_sp > XB_SPIN_CAP) { atomicAdd(&(bar)[XB_TMO], 1u); break; } } } } while (0)

struct XcdBarrier {
    unsigned* bar; unsigned x;
    volatile LAS unsigned* st;
};

__device__ __forceinline__ XcdBarrier xcd_barrier_post(unsigned* bar, volatile LAS unsigned* st) {
    XcdBarrier b; b.bar = bar; b.x = xb_xcc_id(); b.st = st;
    if (threadIdx.x == 0) (void)xb_add(&bar[XB_XCNT(b.x)], 1u);
    return b;
}
__device__ __forceinline__ void xcd_barrier_complete(unsigned* bar, unsigned x, unsigned& nloc, unsigned& nx) {
    const unsigned G = gridDim.x * gridDim.y * gridDim.z;
    unsigned sum, cnt, mine, sp = 0u;
    for (;;) {
        sum = 0u; cnt = 0u; mine = 0u;
#pragma unroll
        for (unsigned j = 0; j < 16; ++j) { const unsigned c = xb_ld(&bar[XB_XCNT(j)]); sum += c; cnt += (c > 0u) ? 1u : 0u; mine = (j == x) ? c : mine; }
        if (sum == G) break;
        __builtin_amdgcn_s_sleep(1);
        if ((++sp & 255u) == 0u) { if (xb_ld(&bar[XB_TMO])) break; if (sp > XB_SPIN_CAP) { atomicAdd(&bar[XB_TMO], 1u); break; } }
    }
    nloc = mine > 0u ? mine : 1u; nx = cnt > 0u ? cnt : 1u;
}

__device__ __forceinline__ void xcd_barrier(const XcdBarrier& b) {
    asm volatile("s_waitcnt vmcnt(0)" ::: "memory");
    __syncthreads();
    if (threadIdx.x == 0) {
        unsigned* bar = b.bar;
        __builtin_amdgcn_s_waitcnt(0);
        unsigned nloc = b.st[0], nx = b.st[1];
        if (nloc == 0u) { xcd_barrier_complete(bar, b.x, nloc, nx); b.st[0] = nloc; b.st[1] = nx; }
        const unsigned old = xb_add(&bar[XB_XSUB(b.x)], 1u);
        const unsigned gen = old / nloc;
        if (old + 1u == (gen + 1u) * nloc) {
            __builtin_amdgcn_fence(__ATOMIC_RELEASE, "agent");
            asm volatile("s_waitcnt vmcnt(0)" ::: "memory");
            const unsigned og = xb_add(&bar[XB_TOP], 1u);
            const unsigned tg = og / nx;
            if (og + 1u == (tg + 1u) * nx) xb_add(&bar[XB_TOPGEN], 1u);
            else XB_SPIN(xb_ld(&bar[XB_TOPGEN]) == tg, bar);
            __builtin_amdgcn_fence(__ATOMIC_ACQUIRE, "agent");
            xb_add(&bar[XB_XGEN(b.x)], 1u);
            asm volatile("s_waitcnt vmcnt(0)" ::: "memory");
        } else {
            XB_SPIN(xb_ld(&bar[XB_XGEN(b.x)]) == gen, bar);
            __builtin_amdgcn_fence(__ATOMIC_ACQUIRE, "agent");
            asm volatile("s_waitcnt vmcnt(0)" ::: "memory");
        }
    }
    __syncthreads();
}


using pg8::Unit;
struct EpiUp {
    static constexpr bool PERM = true, AFTER_DRAIN = false;
    static __device__ __forceinline__ int a_row0(int pm) { return pm * 256; }
    bf16_t* O; int ldc;
    __device__ __forceinline__ void operator()(const f32x4 (&acc)[2][2][4][2], const Unit& u, int wr, int wc, int fr, int fq) const {
        const int row0 = u.pm * 256 + wr * 64 + fr, col0 = u.pn * 256 + wc * 32 + 8 * fq;
#pragma unroll
        for (int ai = 0; ai < 2; ++ai)
#pragma unroll
            for (int m = 0; m < 4; ++m) { bf16_t* rowp = O + (size_t)(row0 + ai * 128 + m * 16) * ldc + col0;
#pragma unroll
                for (int bj = 0; bj < 2; ++bj) { const f32x4 v0 = acc[ai][bj][m][0], v1 = acc[ai][bj][m][1];
                    u32x4 w; w.x = cvt_pk_bf16(v0[0], v0[1]); w.y = cvt_pk_bf16(v0[2], v0[3]); w.z = cvt_pk_bf16(v1[0], v1[1]); w.w = cvt_pk_bf16(v1[2], v1[3]);
                    *(u32x4*)(rowp + bj * 128) = w; } }
    }
};
struct EpiResid {
    static constexpr bool PERM = false, AFTER_DRAIN = false;
    static __device__ __forceinline__ int a_row0(int pm) { return pm * 256; }
    const float* xa; const float* xb; float* out; const float* gate;
    __device__ __forceinline__ void operator()(const f32x4 (&acc)[2][2][4][2], const Unit& u, int wr, int wc, int fr, int fq) const {
        const int rbase = u.pm * 256;
        const float* xin = rbase < NCTXROWS ? xa + (size_t)rbase * DM : xb + (size_t)(rbase - NCTXROWS) * DM;
        const int cond = rbase < NCTXROWS ? 0 : 1 + ((rbase - NCTXROWS) >> 12);
        const int col0 = u.pn * 256 + wc * 32 + 4 * fq;
        const float* g = gate + cond * 6144 + col0;
        float* o = out + (size_t)rbase * DM;
        f32x4 gv[2][2];
#pragma unroll
        for (int bj = 0; bj < 2; ++bj)
#pragma unroll
            for (int n = 0; n < 2; ++n) gv[bj][n] = *(const f32x4*)(g + bj * 128 + n * 16);
#pragma unroll
        for (int ai = 0; ai < 2; ++ai)
#pragma unroll
            for (int m = 0; m < 4; ++m) { const size_t off = (size_t)(ai * 128 + wr * 64 + m * 16 + fr) * DM + col0;
#pragma unroll
                for (int bj = 0; bj < 2; ++bj)
#pragma unroll
                    for (int n = 0; n < 2; ++n) { const f32x4 x = *(const f32x4*)(xin + off + bj * 128 + n * 16);
                        *(f32x4*)(o + off + bj * 128 + n * 16) = x + gv[bj][n] * acc[ai][bj][m][n]; }
                if (m & 1) asm volatile("" ::: "memory"); }
    }
};

struct EpiUpConv {
    static constexpr bool PERM = false, AFTER_DRAIN = false;
    static __device__ __forceinline__ int a_row0(int pm) {
        if (pm < 16) return pm * 256;
        const int s = (pm - 16) / 17, j = (pm - 16) % 17; int st = 254 * j - 1; st = st > 3841 ? 3841 : st;
        return NCTXROWS + 4096 * s + st;
    }
    bf16_t* ACT; const float* cw; const float* cb; LAS float* xch;
    __device__ __forceinline__ void operator()(const f32x4 (&acc)[2][2][4][2], const Unit& u, int wr, int wc, int fr, int fq) const {
        const bool latent = u.pm >= 16;
        const int j17 = latent ? (u.pm - 16) % 17 : -1;
        const bool zr0 = (j17 == 0) && (wr == 0) && (fr == 0), zr255 = (j17 == 16) && (wr == 1) && (fr == 15);
        const int grow0 = a_row0(u.pm);
        const int lane = fq * 16 + fr;
        const int src_prev = (lane & 48) | ((fr + 15) & 15), src_next = (lane & 48) | ((fr + 1) & 15);
        const f32x4 z4 = (f32x4){0.f, 0.f, 0.f, 0.f};
#pragma unroll
        for (int ai = 0; ai < 2; ++ai) { const int g = ai * 2 + wr;
#pragma unroll
            for (int bj = 0; bj < 2; ++bj)
#pragma unroll
                for (int n = 0; n < 2; ++n) { const int col = bj * 128 + 32 * wc + 16 * n + 4 * fq;
                    if (fr == 0) *(LAS f32x4*)(xch + (g * 2 + 0) * 256 + col) = (ai == 0 && zr0) ? z4 : acc[ai][bj][0][n];
                    if (fr == 15) *(LAS f32x4*)(xch + (g * 2 + 1) * 256 + col) = (ai == 1 && zr255) ? z4 : acc[ai][bj][3][n]; } }
        asm volatile("s_waitcnt lgkmcnt(0)" ::: "memory"); __builtin_amdgcn_s_barrier(); asm volatile("" ::: "memory");
        const int fbase = u.pn * 128 + 32 * wc + 4 * fq;
#pragma unroll
        for (int n = 0; n < 2; ++n) {
            const int f0 = fbase + 16 * n;
            f32x4 wg[3], wv[3];
#pragma unroll
            for (int o = 0; o < 3; ++o) { wg[o] = *(const f32x4*)(cw + o * DUP + f0); wv[o] = *(const f32x4*)(cw + o * DUP + DFF + f0); }
            const f32x4 bg = *(const f32x4*)(cb + f0), bv = *(const f32x4*)(cb + DFF + f0);
#pragma unroll
            for (int ai = 0; ai < 2; ++ai) {
                const int g = ai * 2 + wr;
                f32x4 bp[2], bn[2];
#pragma unroll
                for (int bj = 0; bj < 2; ++bj) { const int col = bj * 128 + 32 * wc + 16 * n + 4 * fq;
                    bp[bj] = g > 0 ? *(const LAS f32x4*)(xch + ((g - 1) * 2 + 1) * 256 + col) : z4;
                    bn[bj] = g < 3 ? *(const LAS f32x4*)(xch + ((g + 1) * 2 + 0) * 256 + col) : z4; }
#pragma unroll
                for (int m = 0; m < 4; ++m) {
                    f32x4 cv[2];
#pragma unroll
                    for (int bj = 0; bj < 2; ++bj) {
                        f32x4 cur = acc[ai][bj][m][n];
                        if (ai == 0 && m == 0) cur = zr0 ? z4 : cur;
                        if (ai == 1 && m == 3) cur = zr255 ? z4 : cur;
                        f32x4 ps = m > 0 ? acc[ai][bj][m - 1][n] : bp[bj];
                        f32x4 ns = m < 3 ? acc[ai][bj][m + 1][n] : bn[bj];
                        f32x4 tp, tn, pv, nv;
#pragma unroll
                        for (int i = 0; i < 4; ++i) { tp[i] = fr == 15 ? ps[i] : cur[i]; tn[i] = fr == 0 ? ns[i] : cur[i]; }
#pragma unroll
                        for (int i = 0; i < 4; ++i) { pv[i] = __shfl(tp[i], src_prev); nv[i] = __shfl(tn[i], src_next); }
                        const f32x4 w0 = bj ? wv[0] : wg[0], w1 = bj ? wv[1] : wg[1], w2 = bj ? wv[2] : wg[2], bb = bj ? bv : bg;
                        cv[bj] = w0 * pv + w1 * cur + w2 * nv + bb;
                    }
                    f32x4 r;
#pragma unroll
                    for (int i = 0; i < 4; ++i) r[i] = silu_f(cv[0][i]) * cv[1][i];
                    const int R = ai * 128 + wr * 64 + m * 16 + fr;
                    const bool halo = latent && ((ai == 0 && m == 0 && wr == 0 && fr == 0) || (ai == 1 && m == 3 && wr == 1 && fr == 15));
                    if (!halo) { u32x2 w; w.x = cvt_pk_bf16(r[0], r[1]); w.y = cvt_pk_bf16(r[2], r[3]); *(u32x2*)(ACT + (size_t)(grow0 + R) * DFF + f0) = w; }
                }
            }
            asm volatile("" ::: "memory");
        }
    }
};
template <int NKV>
struct EpiQKV {
    static constexpr bool PERM = false, AFTER_DRAIN = false;
    static __device__ __forceinline__ int a_row0(int pm) { return pm * 256; }
    bf16_t* Q; bf16_t* K; bf16_t* VT; float* newk; float* newv; const float* qn; const float* kn; const float* rope;
    __device__ __forceinline__ void operator()(const f32x4 (&acc)[2][2][4][2], const Unit& u, int wr, int wc, int fr, int fq) const {
        constexpr int KLD = NKV * 64;
        const int hs = 4 * u.pn + wc;
        const int rbase = u.pm * 256 + wr * 64 + fr;
        const bool latent = u.pm >= 16;
        if (hs < 16 + NKV) {
            const bool isq = hs < 16;
            const float* nw = isq ? qn : kn;
            f32x4 wn[2][2];
#pragma unroll
            for (int bj = 0; bj < 2; ++bj)
#pragma unroll
                for (int n = 0; n < 2; ++n) wn[bj][n] = *(const f32x4*)(nw + 32 * bj + 16 * n + 4 * fq);
#pragma unroll
            for (int ai = 0; ai < 2; ++ai)
#pragma unroll
                for (int m = 0; m < 4; ++m) {
                    const int row = rbase + ai * 128 + m * 16;
                    f32x4 v[2][2]; float ss = 0.f;
#pragma unroll
                    for (int bj = 0; bj < 2; ++bj)
#pragma unroll
                        for (int n = 0; n < 2; ++n) { v[bj][n] = acc[ai][bj][m][n]; const f32x4 t = v[bj][n] * v[bj][n]; ss += (t[0] + t[1]) + (t[2] + t[3]); }
                    ss += __shfl_xor(ss, 16); ss += __shfl_xor(ss, 32);
                    const float rinv = rsqrtf(ss * (1.0f / 64.0f) + EPSN);
#pragma unroll
                    for (int bj = 0; bj < 2; ++bj)
#pragma unroll
                        for (int n = 0; n < 2; ++n) v[bj][n] = v[bj][n] * rinv * wn[bj][n];
                    if (latent && NKV == 4) {
                        const int pr = ((row - NCTXROWS) & 4095) >> 6, pc = row & 63;
#pragma unroll
                        for (int bj = 0; bj < 2; ++bj) {
                            const int pos = bj ? pc : pr;
                            const f32x4* t = (const f32x4*)(rope + (pos * 16 + 4 * fq) * 2);
                            const f32x4 t0 = t[0], t1 = t[1];
                            const f32x4 cs = (f32x4){t0[0], t0[2], t1[0], t1[2]}, sn = (f32x4){t0[1], t0[3], t1[1], t1[3]};
                            const f32x4 x1 = v[bj][0], x2 = v[bj][1];
                            v[bj][0] = x1 * cs - x2 * sn; v[bj][1] = x2 * cs + x1 * sn;
                        }
                    }
                    if (isq) {
                        bf16_t* p = Q + (size_t)row * DM + hs * 64 + 4 * fq;
#pragma unroll
                        for (int bj = 0; bj < 2; ++bj)
#pragma unroll
                            for (int n = 0; n < 2; ++n) { u32x2 w; w.x = cvt_pk_bf16(v[bj][n][0], v[bj][n][1]); w.y = cvt_pk_bf16(v[bj][n][2], v[bj][n][3]); *(u32x2*)(p + 32 * bj + 16 * n) = w; }
                    } else {
                        const int kvh = hs - 16;
                        bf16_t* p = K + (size_t)row * KLD + kvh * 64 + 4 * fq;
#pragma unroll
                        for (int bj = 0; bj < 2; ++bj)
#pragma unroll
                            for (int n = 0; n < 2; ++n) { u32x2 w; w.x = cvt_pk_bf16(v[bj][n][0], v[bj][n][1]); w.y = cvt_pk_bf16(v[bj][n][2], v[bj][n][3]); *(u32x2*)(p + 32 * bj + 16 * n) = w; }
                        if (!latent) {
                            float* o = newk + (size_t)row * KLD + kvh * 64 + 4 * fq;
#pragma unroll
                            for (int bj = 0; bj < 2; ++bj)
#pragma unroll
                                for (int n = 0; n < 2; ++n) *(f32x4*)(o + 32 * bj + 16 * n) = v[bj][n];
                        }
                    }
                    asm volatile("" ::: "memory");
                }
        } else {
            const int kvh = hs - 16 - NKV;
#pragma unroll
            for (int ai = 0; ai < 2; ++ai)
#pragma unroll
                for (int m = 0; m < 4; ++m) {
                    const int row = rbase + ai * 128 + m * 16;
                    bf16_t* p = VT + ((size_t)(row >> 5) * NKV + kvh) * 2048 + (row & 31) + (4 * fq) * 32;
#pragma unroll
                    for (int bj = 0; bj < 2; ++bj)
#pragma unroll
                        for (int n = 0; n < 2; ++n)
#pragma unroll
                            for (int i = 0; i < 4; ++i) p[(32 * bj + 16 * n + i) * 32] = (bf16_t)f2bf(acc[ai][bj][m][n][i]);
                    if (!latent) {
                        float* o = newv + (size_t)row * KLD + kvh * 64 + 4 * fq;
#pragma unroll
                        for (int bj = 0; bj < 2; ++bj)
#pragma unroll
                            for (int n = 0; n < 2; ++n) *(f32x4*)(o + 32 * bj + 16 * n) = acc[ai][bj][m][n];
                    }
                    asm volatile("" ::: "memory");
                }
        }
    }
};

struct AttnState { f32x4 o[2][4]; float m[2]; float l[2]; };
#define MFMA16(a, b, c) __builtin_amdgcn_mfma_f32_16x16x32_bf16((a), (b), (c), 0, 0, 0)
struct KVFrag { bf16x8 kf[2][2]; bf16x8 vf[4]; };
__device__ __forceinline__ void attn_load(KVFrag& f, const bf16_t* kp, int kld, const bf16_t* vp, int fr, int fq) {
#pragma unroll
    for (int t = 0; t < 2; ++t)
#pragma unroll
        for (int h2 = 0; h2 < 2; ++h2) f.kf[t][h2] = *(const bf16x8*)(kp + (size_t)(16 * t + fr) * kld + 32 * h2 + 8 * fq);
#pragma unroll
    for (int dt = 0; dt < 4; ++dt) { const bf16_t* v = vp + (16 * dt + fr) * 32 + 4 * fq; const u32x2 lo = *(const u32x2*)v, hi = *(const u32x2*)(v + 16);
        f.vf[dt] = __builtin_bit_cast(bf16x8, ((u32x4){lo.x, lo.y, hi.x, hi.y})); }
}
template <int MASK>
__device__ __forceinline__ void attn_compute(AttnState& st, const bf16x8 (&qf)[2][2], const KVFrag& f, int fr, int fq, int mk0, int mk1, const LAS float* bias) {
#pragma unroll
    for (int qb = 0; qb < 2; ++qb) {
        f32x4 s0 = (f32x4){0.f, 0.f, 0.f, 0.f}, s1 = (f32x4){0.f, 0.f, 0.f, 0.f};
        s0 = MFMA16(f.kf[0][0], qf[qb][0], s0); s0 = MFMA16(f.kf[0][1], qf[qb][1], s0);
        s1 = MFMA16(f.kf[1][0], qf[qb][0], s1); s1 = MFMA16(f.kf[1][1], qf[qb][1], s1);
        float sv[8];
#pragma unroll
        for (int j = 0; j < 4; ++j) { sv[j] = s0[j] * SCL2; sv[4 + j] = s1[j] * SCL2; }
        if (MASK == 1) {
            const int d0 = mk0 + 4 * fq - 16 * qb - fr;
#pragma unroll
            for (int t = 0; t < 2; ++t)
#pragma unroll
                for (int j = 0; j < 4; ++j) { const int df = d0 + 16 * t + j; if (df > 128 || df < -128) sv[4 * t + j] = -INFINITY; }
        }
        if (MASK == 2) {
            const int qc = mk1 + 16 * qb + fr; int cs = qc - 8; cs = cs < 0 ? 0 : (cs > 48 ? 48 : cs);
#pragma unroll
            for (int t = 0; t < 2; ++t)
#pragma unroll
                for (int j = 0; j < 4; ++j) { const int kc = mk0 + 16 * t + 4 * fq + j; const bool ok = (kc >= cs) && (kc < cs + 16);
                    int bi = kc - qc + 15; bi = bi < 0 ? 0 : (bi > 30 ? 30 : bi);
                    const float bv = bias[bi];
                    sv[4 * t + j] = ok ? sv[4 * t + j] + bv : -INFINITY; }
        }
        float cmax = fmaxf(fmaxf(fmaxf(sv[0], sv[1]), fmaxf(sv[2], sv[3])), fmaxf(fmaxf(sv[4], sv[5]), fmaxf(sv[6], sv[7])));
        cmax = fmaxf(cmax, __shfl_xor(cmax, 16)); cmax = fmaxf(cmax, __shfl_xor(cmax, 32));
        const float mnew = fmaxf(st.m[qb], cmax);
        const float msafe = (mnew == -INFINITY) ? 0.f : mnew;
        const float alpha = fast_exp2(st.m[qb] - msafe);
        st.m[qb] = mnew;
        float p[8]; float ps = 0.f;
#pragma unroll
        for (int j = 0; j < 8; ++j) { p[j] = fast_exp2(sv[j] - msafe); ps += p[j]; }
        st.l[qb] = st.l[qb] * alpha + ps;
        u32x4 pw; pw.x = cvt_pk_bf16(p[0], p[1]); pw.y = cvt_pk_bf16(p[2], p[3]); pw.z = cvt_pk_bf16(p[4], p[5]); pw.w = cvt_pk_bf16(p[6], p[7]);
        const bf16x8 pf = __builtin_bit_cast(bf16x8, pw);
#pragma unroll
        for (int dt = 0; dt < 4; ++dt) { st.o[qb][dt] = st.o[qb][dt] * alpha; st.o[qb][dt] = MFMA16(f.vf[dt], pf, st.o[qb][dt]); }
    }
}
__device__ __forceinline__ void attn_init(AttnState& st, bf16x8 (&qf)[2][2], const bf16_t* Q, int qrow0, int head, int fr, int fq) {
#pragma unroll
    for (int qb = 0; qb < 2; ++qb) { st.m[qb] = -INFINITY; st.l[qb] = 0.f;
#pragma unroll
        for (int dt = 0; dt < 4; ++dt) st.o[qb][dt] = (f32x4){0.f, 0.f, 0.f, 0.f};
#pragma unroll
        for (int h2 = 0; h2 < 2; ++h2) qf[qb][h2] = *(const bf16x8*)(Q + (size_t)(qrow0 + 16 * qb + fr) * DM + head * 64 + 32 * h2 + 8 * fq); }
}
__device__ __forceinline__ void attn_finish(AttnState& st, bf16_t* O, int qrow0, int head, int fr, int fq, bool has_sink, float sink) {
#pragma unroll
    for (int qb = 0; qb < 2; ++qb) {
        float l = st.l[qb]; l += __shfl_xor(l, 16); l += __shfl_xor(l, 32);
        if (has_sink) l += fast_exp2(sink * LOG2E - st.m[qb]);
        const float inv = 1.0f / l;
        bf16_t* o = O + (size_t)(qrow0 + 16 * qb + fr) * DM + head * 64 + 4 * fq;
#pragma unroll
        for (int dt = 0; dt < 4; ++dt) { const f32x4 v = st.o[qb][dt] * inv; u32x2 w; w.x = cvt_pk_bf16(v[0], v[1]); w.y = cvt_pk_bf16(v[2], v[3]); *(u32x2*)(o + 16 * dt) = w; }
    }
}
__device__ __forceinline__ void attn_phase_a(const bf16_t* Q, const bf16_t* K, const bf16_t* VT, const bf16_t* Kc, const bf16_t* VTc, const float* sinkp, bf16_t* O, int gw, int ngw, int lane) {
    const int fr = lane & 15, fq = lane >> 4;
    for (int t = gw; t < 4096; t += ngw) {
        const int b = t >> 11, rem = t & 2047, kvh = rem >> 9, rem2 = rem & 511, qblk = ((rem2 >> 3) << 1) | (rem2 & 1), g = (rem2 & 7) >> 1;
        const int head = kvh * 4 + g, qpos0 = qblk * 32, seq0 = NCTXROWS + b * 4096, qrow0 = seq0 + qpos0;
        AttnState st; bf16x8 qf[2][2]; KVFrag cur, nxt;
        attn_init(st, qf, Q, qrow0, head, fr, fq);
        const int c0 = qblk - 4 < 0 ? 0 : qblk - 4, c1 = qblk + 4 > 127 ? 127 : qblk + 4;
        const bf16_t* kcp = Kc + (size_t)(b * 512) * 256 + kvh * 64; const bf16_t* vcp = VTc + (size_t)(b * 16 * 4 + kvh) * 2048;
        const bf16_t* klp = K + (size_t)seq0 * 256 + kvh * 64; const bf16_t* vlp = VT + (size_t)((seq0 >> 5) * 4 + kvh) * 2048;
        attn_load(cur, kcp, 256, vcp, fr, fq);
        for (int c = 0; c < 16; ++c) {
            if (c < 15) attn_load(nxt, kcp + (size_t)(32 * (c + 1)) * 256, 256, vcp + (size_t)(c + 1) * 4 * 2048, fr, fq);
            else attn_load(nxt, klp + (size_t)(32 * c0) * 256, 256, vlp + (size_t)c0 * 4 * 2048, fr, fq);
            attn_compute<0>(st, qf, cur, fr, fq, 0, 0, nullptr);
            cur = nxt;
        }
        for (int c = c0; c <= c1; ++c) {
            if (c < c1) attn_load(nxt, klp + (size_t)(32 * (c + 1)) * 256, 256, vlp + (size_t)(c + 1) * 4 * 2048, fr, fq);
            attn_compute<1>(st, qf, cur, fr, fq, 32 * c - qpos0, 0, nullptr);
            cur = nxt;
        }
        attn_finish(st, O, qrow0, head, fr, fq, true, sinkp[head]);
    }
    for (int t = gw; t < 2048; t += ngw) {
        const int b = t >> 7, rem = t & 127, kvh = rem >> 5, rem2 = rem & 31, qblk = ((rem2 >> 3) << 1) | (rem2 & 1), g = (rem2 & 7) >> 1;
        const int head = kvh * 4 + g, qrow0 = b * 256 + qblk * 32;
        AttnState st; bf16x8 qf[2][2]; KVFrag cur, nxt;
        attn_init(st, qf, Q, qrow0, head, fr, fq);
        const bf16_t* kp = K + (size_t)(b * 256) * 256 + kvh * 64; const bf16_t* vp = VT + (size_t)((b * 8) * 4 + kvh) * 2048;
        attn_load(cur, kp, 256, vp, fr, fq);
        for (int c = 0; c < 8; ++c) {
            if (c < 7) attn_load(nxt, kp + (size_t)(32 * (c + 1)) * 256, 256, vp + (size_t)(c + 1) * 4 * 2048, fr, fq);
            attn_compute<0>(st, qf, cur, fr, fq, 0, 0, nullptr);
            cur = nxt;
        }
        attn_finish(st, O, qrow0, head, fr, fq, true, sinkp[head]);
    }
}
__device__ __forceinline__ void attn_phase_b(const bf16_t* Q, const bf16_t* K, const bf16_t* VT, const bf16_t* Kc, const bf16_t* VTc, const float* rpb, bf16_t* O, int gw, int ngw, int lane, LAS float* btab) {
    const int fr = lane & 15, fq = lane >> 4;
    int cur_head = -1;
    for (int t = gw; t < 4096; t += ngw) {
        const int b = t >> 11, rem = t & 2047, head = rem >> 7, qblk = rem & 127, r = qblk >> 1, half = qblk & 1;
        const int seq0 = NCTXROWS + b * 4096, qrow0 = seq0 + qblk * 32;
        if (head != cur_head) { for (int i = lane; i < 465; i += 64) btab[i] = rpb[head * 465 + i] * LOG2E; cur_head = head; asm volatile("s_waitcnt lgkmcnt(0)" ::: "memory"); }
        AttnState st; bf16x8 qf[2][2]; KVFrag cur, nxt;
        attn_init(st, qf, Q, qrow0, head, fr, fq);
        int rs = r - 4; rs = rs < 0 ? 0 : (rs > 56 ? 56 : rs);
        const bf16_t* kcp = Kc + (size_t)(b * 512) * 1024 + head * 64; const bf16_t* vcp = VTc + (size_t)(b * 16 * 16 + head) * 2048;
        const bf16_t* klp = K + (size_t)(seq0 + rs * 64) * 1024 + head * 64; const bf16_t* vlp = VT + (size_t)(((seq0 + rs * 64) >> 5) * 16 + head) * 2048;
        attn_load(cur, kcp, 1024, vcp, fr, fq);
        for (int c = 0; c < 16; ++c) {
            if (c < 15) attn_load(nxt, kcp + (size_t)(32 * (c + 1)) * 1024, 1024, vcp + (size_t)(c + 1) * 16 * 2048, fr, fq);
            else attn_load(nxt, klp, 1024, vlp, fr, fq);
            attn_compute<0>(st, qf, cur, fr, fq, 0, 0, nullptr);
            cur = nxt;
        }
        for (int c = 0; c < 16; ++c) {
            if (c < 15) attn_load(nxt, klp + (size_t)(32 * (c + 1)) * 1024, 1024, vlp + (size_t)(c + 1) * 16 * 2048, fr, fq);
            attn_compute<2>(st, qf, cur, fr, fq, 32 * (c & 1), 32 * half, btab + (rs + (c >> 1) - r + 7) * 31);
            cur = nxt;
        }
        attn_finish(st, O, qrow0, head, fr, fq, false, 0.f);
    }
    for (int t = gw; t < 2048; t += ngw) {
        const int b = t >> 7, rem = t & 127, head = rem >> 3, qblk = rem & 7;
        const int qrow0 = b * 256 + qblk * 32;
        AttnState st; bf16x8 qf[2][2]; KVFrag cur, nxt;
        attn_init(st, qf, Q, qrow0, head, fr, fq);
        const bf16_t* kp = K + (size_t)(b * 256) * 1024 + head * 64; const bf16_t* vp = VT + (size_t)((b * 8) * 16 + head) * 2048;
        attn_load(cur, kp, 1024, vp, fr, fq);
        for (int c = 0; c < 8; ++c) {
            if (c < 7) attn_load(nxt, kp + (size_t)(32 * (c + 1)) * 1024, 1024, vp + (size_t)(c + 1) * 16 * 2048, fr, fq);
            attn_compute<0>(st, qf, cur, fr, fq, 0, 0, nullptr);
            cur = nxt;
        }
        attn_finish(st, O, qrow0, head, fr, fq, false, 0.f);
    }
}


constexpr int KV_LDS_OFF = 16384, KV_BUF_BYTES = 9728, KROW_B = 144, VROW_B = 80, V_OFF = 4608;
__device__ __forceinline__ u32x4 stage_load(const bf16_t* kp, int kld, const bf16_t* vp, int tid) {
    if (tid < 256) return *(const u32x4*)(kp + (size_t)(tid >> 3) * kld + (tid & 7) * 8);
    return *(const u32x4*)(vp + (tid - 256) * 8);
}
__device__ __forceinline__ void stage_store(LAS unsigned char* buf, u32x4 v, int tid) {
    if (tid < 256) *(LAS u32x4*)(buf + (tid >> 3) * KROW_B + (tid & 7) * 16) = v;
    else { const int e = tid - 256; *(LAS u32x4*)(buf + V_OFF + (e >> 2) * VROW_B + (e & 3) * 16) = v; }
}
__device__ __forceinline__ void frag_load(KVFrag& f, const LAS unsigned char* buf, int fr, int fq) {
#pragma unroll
    for (int t = 0; t < 2; ++t)
#pragma unroll
        for (int h2 = 0; h2 < 2; ++h2) f.kf[t][h2] = *(const LAS bf16x8*)(buf + (16 * t + fr) * KROW_B + 64 * h2 + 16 * fq);
#pragma unroll
    for (int dt = 0; dt < 4; ++dt) { const LAS unsigned char* v = buf + V_OFF + (16 * dt + fr) * VROW_B + 8 * fq; const u32x2 lo = *(const LAS u32x2*)v, hi = *(const LAS u32x2*)(v + 32);
        f.vf[dt] = __builtin_bit_cast(bf16x8, ((u32x4){lo.x, lo.y, hi.x, hi.y})); }
}

__device__ __forceinline__ void attn_compute_pair(AttnState& st, const bf16x8 (&qf)[2][2], const LAS unsigned char* ba, const LAS unsigned char* bb, int fr, int fq) {
    bf16x8 pfa[2], pfb[2]; float alpha[2];
    {
        bf16x8 ka[2][2], kb[2][2];
#pragma unroll
        for (int t = 0; t < 2; ++t)
#pragma unroll
            for (int h2 = 0; h2 < 2; ++h2) { ka[t][h2] = *(const LAS bf16x8*)(ba + (16 * t + fr) * KROW_B + 64 * h2 + 16 * fq); kb[t][h2] = *(const LAS bf16x8*)(bb + (16 * t + fr) * KROW_B + 64 * h2 + 16 * fq); }
#pragma unroll
        for (int qb = 0; qb < 2; ++qb) {
            const f32x4 z = (f32x4){0.f, 0.f, 0.f, 0.f};
            f32x4 s0 = MFMA16(ka[0][0], qf[qb][0], z); s0 = MFMA16(ka[0][1], qf[qb][1], s0);
            f32x4 s1 = MFMA16(ka[1][0], qf[qb][0], z); s1 = MFMA16(ka[1][1], qf[qb][1], s1);
            f32x4 s2 = MFMA16(kb[0][0], qf[qb][0], z); s2 = MFMA16(kb[0][1], qf[qb][1], s2);
            f32x4 s3 = MFMA16(kb[1][0], qf[qb][0], z); s3 = MFMA16(kb[1][1], qf[qb][1], s3);
            float sv[16];
#pragma unroll
            for (int j = 0; j < 4; ++j) { sv[j] = s0[j] * SCL2; sv[4 + j] = s1[j] * SCL2; sv[8 + j] = s2[j] * SCL2; sv[12 + j] = s3[j] * SCL2; }
            float cmax = sv[0];
#pragma unroll
            for (int j = 1; j < 16; ++j) cmax = fmaxf(cmax, sv[j]);
            cmax = fmaxf(cmax, __shfl_xor(cmax, 16)); cmax = fmaxf(cmax, __shfl_xor(cmax, 32));
            const float mnew = fmaxf(st.m[qb], cmax);
            alpha[qb] = fast_exp2(st.m[qb] - mnew);
            st.m[qb] = mnew;
            float p[16]; float ps = 0.f;
#pragma unroll
            for (int j = 0; j < 16; ++j) { p[j] = fast_exp2(sv[j] - mnew); ps += p[j]; }
            st.l[qb] = st.l[qb] * alpha[qb] + ps;
            u32x4 pa, pb;
            pa.x = cvt_pk_bf16(p[0], p[1]); pa.y = cvt_pk_bf16(p[2], p[3]); pa.z = cvt_pk_bf16(p[4], p[5]); pa.w = cvt_pk_bf16(p[6], p[7]);
            pb.x = cvt_pk_bf16(p[8], p[9]); pb.y = cvt_pk_bf16(p[10], p[11]); pb.z = cvt_pk_bf16(p[12], p[13]); pb.w = cvt_pk_bf16(p[14], p[15]);
            pfa[qb] = __builtin_bit_cast(bf16x8, pa); pfb[qb] = __builtin_bit_cast(bf16x8, pb);
        }
    }
#pragma unroll
    for (int dt = 0; dt < 4; ++dt) {
        const LAS unsigned char* va = ba + V_OFF + (16 * dt + fr) * VROW_B + 8 * fq; const LAS unsigned char* vb_ = bb + V_OFF + (16 * dt + fr) * VROW_B + 8 * fq;
        const u32x2 alo = *(const LAS u32x2*)va, ahi = *(const LAS u32x2*)(va + 32), blo = *(const LAS u32x2*)vb_, bhi = *(const LAS u32x2*)(vb_ + 32);
        const bf16x8 vfa = __builtin_bit_cast(bf16x8, ((u32x4){alo.x, alo.y, ahi.x, ahi.y})), vfb = __builtin_bit_cast(bf16x8, ((u32x4){blo.x, blo.y, bhi.x, bhi.y}));
#pragma unroll
        for (int qb = 0; qb < 2; ++qb) { st.o[qb][dt] = st.o[qb][dt] * alpha[qb]; st.o[qb][dt] = MFMA16(vfa, pfa[qb], st.o[qb][dt]); st.o[qb][dt] = MFMA16(vfb, pfb[qb], st.o[qb][dt]); }
    }
}
__device__ __forceinline__ void attn_pairs(AttnState& st, const bf16x8 (&qf)[2][2], const bf16_t* kp, int kld, const bf16_t* vp, int vstride, int NP, bool has_next, const bf16_t* kp2, const bf16_t* vp2,
                                           LAS unsigned char* kvb, int tid, int fr, int fq) {
    u32x4 sr0 = stage_load(kp, kld, vp, tid), sr1 = stage_load(kp + (size_t)32 * kld, kld, vp + vstride, tid);
    stage_store(kvb, sr0, tid); stage_store(kvb + KV_BUF_BYTES, sr1, tid);
    __syncthreads();
    for (int sp = 0; sp < NP; ++sp) {
        const bool more = sp + 1 < NP;
        if (more) { sr0 = stage_load(kp + (size_t)(32 * (2 * sp + 2)) * kld, kld, vp + (size_t)(2 * sp + 2) * vstride, tid); sr1 = stage_load(kp + (size_t)(32 * (2 * sp + 3)) * kld, kld, vp + (size_t)(2 * sp + 3) * vstride, tid); }
        else if (has_next) sr0 = stage_load(kp2, kld, vp2, tid);
        const LAS unsigned char* buf = kvb + (sp & 1) * 2 * KV_BUF_BYTES;
        attn_compute_pair(st, qf, buf, buf + KV_BUF_BYTES, fr, fq);
        LAS unsigned char* nb_ = kvb + ((sp + 1) & 1) * 2 * KV_BUF_BYTES;
        if (more) { stage_store(nb_, sr0, tid); stage_store(nb_ + KV_BUF_BYTES, sr1, tid); }
        else if (has_next) stage_store(nb_, sr0, tid);
        __syncthreads();
    }
}
__device__ __forceinline__ void attn_groups_a(const bf16_t* Q, const bf16_t* K, const bf16_t* VT, const bf16_t* Kc, const bf16_t* VTc, const float* sinkp, bf16_t* O, int vb, int nb, int tid, LAS unsigned char* lds) {
    const int lane = tid & 63, wave = __builtin_amdgcn_readfirstlane(tid >> 6), fr = lane & 15, fq = lane >> 4;
    LAS unsigned char* kvb = lds + KV_LDS_OFF;
    for (int g = vb; g < 512; g += nb) {
        const int t = g * 8 + wave;
        const int b = t >> 11, rem = t & 2047, kvh = rem >> 9, rem2 = rem & 511, qp = rem2 >> 3, qblk = (qp << 1) | (rem2 & 1), gh = (rem2 & 7) >> 1;
        const int head = kvh * 4 + gh, qpos0 = qblk * 32, seq0 = NCTXROWS + b * 4096, qrow0 = seq0 + qpos0;
        const int cmin = 2 * qp - 4 < 0 ? 0 : 2 * qp - 4, cmax = 2 * qp + 5 > 127 ? 127 : 2 * qp + 5, nsteps = 16 + (cmax - cmin + 1);
        AttnState st; bf16x8 qf[2][2]; KVFrag f;
        attn_init(st, qf, Q, qrow0, head, fr, fq);
        const bf16_t* kcp = Kc + (size_t)(b * 512) * 256 + kvh * 64; const bf16_t* vcp = VTc + (size_t)(b * 16 * 4 + kvh) * 2048;
        const bf16_t* klp = K + (size_t)seq0 * 256 + kvh * 64; const bf16_t* vlp = VT + (size_t)((seq0 >> 5) * 4 + kvh) * 2048;
        attn_pairs(st, qf, kcp, 256, vcp, 4 * 2048, 8, true, klp + (size_t)(32 * cmin) * 256, vlp + (size_t)cmin * 4 * 2048, kvb, tid, fr, fq);
        { const int nloc = nsteps - 16; u32x4 sr;
        for (int i = 0; i < nloc; ++i) { const int c = cmin + i;
            if (i + 1 < nloc) sr = stage_load(klp + (size_t)(32 * (c + 1)) * 256, 256, vlp + (size_t)(c + 1) * 4 * 2048, tid);
            if (c >= qblk - 4 && c <= qblk + 4) { frag_load(f, kvb + (i & 1) * 2 * KV_BUF_BYTES, fr, fq); attn_compute<1>(st, qf, f, fr, fq, 32 * c - qpos0, 0, nullptr); }
            if (i + 1 < nloc) stage_store(kvb + ((i + 1) & 1) * 2 * KV_BUF_BYTES, sr, tid);
            __syncthreads(); } }
        attn_finish(st, O, qrow0, head, fr, fq, true, sinkp[head]);
    }
    for (int g = vb; g < 256; g += nb) {
        const int t = g * 8 + wave;
        const int b = t >> 7, rem = t & 127, kvh = rem >> 5, rem2 = rem & 31, qblk = ((rem2 >> 3) << 1) | (rem2 & 1), gh = (rem2 & 7) >> 1;
        const int head = kvh * 4 + gh, qrow0 = b * 256 + qblk * 32;
        AttnState st; bf16x8 qf[2][2]; KVFrag f;
        attn_init(st, qf, Q, qrow0, head, fr, fq);
        const bf16_t* kp = K + (size_t)(b * 256) * 256 + kvh * 64; const bf16_t* vp = VT + (size_t)((b * 8) * 4 + kvh) * 2048;
        attn_pairs(st, qf, kp, 256, vp, 4 * 2048, 4, false, kp, vp, kvb, tid, fr, fq);
        attn_finish(st, O, qrow0, head, fr, fq, true, sinkp[head]);
    }
}
__device__ __forceinline__ void attn_groups_b(const bf16_t* Q, const bf16_t* K, const bf16_t* VT, const bf16_t* Kc, const bf16_t* VTc, const float* rpb, bf16_t* O, int vb, int nb, int tid, LAS unsigned char* lds) {
    const int lane = tid & 63, wave = __builtin_amdgcn_readfirstlane(tid >> 6), fr = lane & 15, fq = lane >> 4;
    LAS unsigned char* kvb = lds + KV_LDS_OFF;
    LAS float* btab = (LAS float*)(lds + wave * 2048);
    for (int g = vb; g < 512; g += nb) {
        const int b = g >> 8, head = (g >> 4) & 15, r0 = 4 * (g & 15), qblk = 2 * r0 + wave, r = r0 + (wave >> 1), half = wave & 1;
        const int seq0 = NCTXROWS + b * 4096, qrow0 = seq0 + qblk * 32;
        for (int i = lane; i < 465; i += 64) btab[i] = rpb[head * 465 + i] * LOG2E;
        int rmin = r0 - 4; rmin = rmin < 0 ? 0 : (rmin > 56 ? 56 : rmin);
        int rmax = r0 - 1; rmax = (rmax < 0 ? 0 : (rmax > 56 ? 56 : rmax)) + 7;
        int rs = r - 4; rs = rs < 0 ? 0 : (rs > 56 ? 56 : rs);
        const int nsteps = 16 + 2 * (rmax - rmin + 1);
        AttnState st; bf16x8 qf[2][2]; KVFrag f;
        attn_init(st, qf, Q, qrow0, head, fr, fq);
        const bf16_t* kcp = Kc + (size_t)(b * 512) * 1024 + head * 64; const bf16_t* vcp = VTc + (size_t)(b * 16 * 16 + head) * 2048;
        const bf16_t* klp = K + (size_t)(seq0 + rmin * 64) * 1024 + head * 64; const bf16_t* vlp = VT + (size_t)(((seq0 + rmin * 64) >> 5) * 16 + head) * 2048;
        attn_pairs(st, qf, kcp, 1024, vcp, 16 * 2048, 8, true, klp, vlp, kvb, tid, fr, fq);
        { const int nloc = nsteps - 16; u32x4 sr;
        for (int i = 0; i < nloc; ++i) { const int kr = rmin + (i >> 1);
            if (i + 1 < nloc) sr = stage_load(klp + (size_t)(32 * (i + 1)) * 1024, 1024, vlp + (size_t)(i + 1) * 16 * 2048, tid);
            if (kr >= rs && kr <= rs + 7) { frag_load(f, kvb + (i & 1) * 2 * KV_BUF_BYTES, fr, fq); attn_compute<2>(st, qf, f, fr, fq, 32 * (i & 1), 32 * half, btab + (kr - r + 7) * 31); }
            if (i + 1 < nloc) stage_store(kvb + ((i + 1) & 1) * 2 * KV_BUF_BYTES, sr, tid);
            __syncthreads(); } }
        attn_finish(st, O, qrow0, head, fr, fq, false, 0.f);
    }
    for (int g = vb; g < 256; g += nb) {
        const int b = g >> 4, head = g & 15, qblk = wave;
        const int qrow0 = b * 256 + qblk * 32;
        AttnState st; bf16x8 qf[2][2]; KVFrag f;
        attn_init(st, qf, Q, qrow0, head, fr, fq);
        const bf16_t* kp = K + (size_t)(b * 256) * 1024 + head * 64; const bf16_t* vp = VT + (size_t)((b * 8) * 16 + head) * 2048;
        attn_pairs(st, qf, kp, 1024, vp, 16 * 2048, 4, false, kp, vp, kvb, tid, fr, fq);
        attn_finish(st, O, qrow0, head, fr, fq, false, 0.f);
    }
}

__device__ __forceinline__ void transpose_item(const float* W, int K, int N, bf16_t* WT, int kb, int nb, int dst_n0, LAS float* scr, int lane) {
    const int k0 = 64 * kb, n0 = 32 * nb;
#pragma unroll 8
    for (int i = 0; i < 32; ++i) { const int kk = 2 * i + (lane >> 5); scr[kk * 33 + (lane & 31)] = W[(size_t)(k0 + kk) * N + n0 + (lane & 31)]; }
    asm volatile("s_waitcnt lgkmcnt(0)" ::: "memory");
    const int c = lane & 7;
#pragma unroll
    for (int j = 0; j < 4; ++j) { const int n = (lane >> 3) + 8 * j; const LAS float* s = scr + (8 * c) * 33 + n;
        u32x4 o; o.x = cvt_pk_bf16(s[0 * 33], s[1 * 33]); o.y = cvt_pk_bf16(s[2 * 33], s[3 * 33]); o.z = cvt_pk_bf16(s[4 * 33], s[5 * 33]); o.w = cvt_pk_bf16(s[6 * 33], s[7 * 33]);
        *(u32x4*)(WT + (size_t)(dst_n0 + n) * K + k0 + 8 * c) = o; }
    asm volatile("s_waitcnt lgkmcnt(0)" ::: "memory");
}
__device__ __forceinline__ int up_perm(int o) { return o < DFF ? 256 * (o / 128) + (o % 128) : 256 * ((o - DFF) / 128) + 128 + ((o - DFF) % 128); }
__device__ __forceinline__ int qkv_perm(int o) { return (o & ~255) + 128 * ((o >> 5) & 1) + 32 * ((o >> 6) & 3); }

__device__ __forceinline__ void prologue(const Args& a, LAS unsigned char* lds, int tid, int lane, int wave) {
    unsigned char* ws = a.ws;
    const int G = gridDim.x, bx = blockIdx.x;
    {
        LAS float* sc = (LAS float*)lds;
        LAS float* red = (LAS float*)(lds + 16384);
        bool have = false;
        for (int it = bx; it < 192; it += G) {
            if (!have) { for (int k = tid; k < 3072; k += NTHR) { const int cnd = k >> 10, kk = k & 1023; const float x = cnd == 0 ? a.in[7][kk] : a.in[6][(cnd - 1) * 1024 + kk]; sc[k] = silu_f(x); } have = true; }
            __syncthreads();
            const int l = it / 96, n0 = (it % 96) * 64;
            const float* W = a.in[10] + (size_t)l * 1024 * 6144 + n0;
            const int c4 = tid & 15, ks = tid >> 4;
            f32x4 a0 = (f32x4){0.f, 0.f, 0.f, 0.f}, a1 = a0, a2 = a0;
#pragma unroll 8
            for (int kk = 0; kk < 32; ++kk) { const int k = ks * 32 + kk; const f32x4 w = *(const f32x4*)(W + (size_t)k * 6144 + 4 * c4);
                a0 += w * sc[k]; a1 += w * sc[1024 + k]; a2 += w * sc[2048 + k]; }
#pragma unroll
            for (int j = 0; j < 4; ++j) { red[(ks * 3 + 0) * 64 + 4 * c4 + j] = a0[j]; red[(ks * 3 + 1) * 64 + 4 * c4 + j] = a1[j]; red[(ks * 3 + 2) * 64 + 4 * c4 + j] = a2[j]; }
            __syncthreads();
            if (tid < 192) { const int cnd = tid >> 6, col = tid & 63; float s = 0.f;
#pragma unroll 8
                for (int q = 0; q < 32; ++q) s += red[(q * 3 + cnd) * 64 + col];
                ((float*)(ws + WS_MOD))[(l * 3 + cnd) * 6144 + n0 + col] = s + a.in[11][l * 6144 + n0 + col]; }
        }
        __syncthreads();
    }
    const int gw = bx * NWAVES + wave, NGW = G * NWAVES;
    const size_t gt = (size_t)bx * NTHR + tid, NT = (size_t)G * NTHR;
    if (gt < 1024) { const int pos = (int)gt >> 4, f = (int)gt & 15; const float freq = exp2f(-(float)f * (13.287712379549449f / 16.0f)); const float ang = (float)pos * freq;
        float* rp = (float*)(ws + WS_ROPE); rp[2 * gt] = cosf(ang); rp[2 * gt + 1] = sinf(ang); }
    {
        LAS float* scr = (LAS float*)(lds + wave * 16384);
        constexpr int I_QA = 16 * 48, I_QB = 16 * 96, I_O = 16 * 32, I_UP = 16 * 176, I_DN = 44 * 32;
        constexpr int NITEMS = I_QA + I_QB + 2 * I_O + 2 * I_UP + 2 * I_DN;
        for (int it = gw; it < NITEMS; it += NGW) {
            int r = it;
            if (r < I_QA) { const int kb = r / 48, nb = r % 48; transpose_item(a.in[12], 1024, 1536, (bf16_t*)(ws + WS_WQKVA), kb, nb, qkv_perm(32 * nb), scr, lane); continue; } r -= I_QA;
            if (r < I_QB) { const int kb = r / 96, nb = r % 96; transpose_item(a.in[17], 1024, 3072, (bf16_t*)(ws + WS_WQKVB), kb, nb, qkv_perm(32 * nb), scr, lane); continue; } r -= I_QB;
            if (r < I_O) { const int kb = r / 32, nb = r % 32; transpose_item(a.in[16], 1024, 1024, (bf16_t*)(ws + WS_WOA), kb, nb, 32 * nb, scr, lane); continue; } r -= I_O;
            if (r < I_O) { const int kb = r / 32, nb = r % 32; transpose_item(a.in[21], 1024, 1024, (bf16_t*)(ws + WS_WOB), kb, nb, 32 * nb, scr, lane); continue; } r -= I_O;
            if (r < 2 * I_UP) { const int l = r / I_UP; r -= l * I_UP; const int kb = r / 176, nb = r % 176;
                transpose_item(a.in[22] + (size_t)l * 1024 * 5632, 1024, 5632, (bf16_t*)(ws + (l ? WS_WUP1 : WS_WUP0)), kb, nb, up_perm(32 * nb), scr, lane); continue; } r -= 2 * I_UP;
            { const int l = r / I_DN; r -= l * I_DN; const int kb = r / 32, nb = r % 32;
                transpose_item(a.in[25] + (size_t)l * 2816 * 1024, 2816, 1024, (bf16_t*)(ws + (l ? WS_WDN1 : WS_WDN0)), kb, nb, 32 * nb, scr, lane); }
        }
    }
    {
        bf16_t* kca = (bf16_t*)(ws + WS_KCA); bf16_t* kcb = (bf16_t*)(ws + WS_KCB); bf16_t* vca = (bf16_t*)(ws + WS_VTCA); bf16_t* vcb = (bf16_t*)(ws + WS_VTCB);
        for (size_t i = gt; i < 262144; i += NT) kca[i] = (bf16_t)f2bf(a.in[2][i]);
        for (size_t i = gt; i < 1048576; i += NT) kcb[i] = (bf16_t)f2bf(a.in[4][i]);
        for (size_t i = gt; i < 262144; i += NT) { const int tt = (int)i & 31, d = ((int)i >> 5) & 63, kvh = ((int)i >> 11) & 3, c = ((int)i >> 13) & 15, b = (int)i >> 17;
            vca[i] = (bf16_t)f2bf(a.in[3][((size_t)(b * 512 + c * 32 + tt) * 4 + kvh) * 64 + d]); }
        for (size_t i = gt; i < 1048576; i += NT) { const int tt = (int)i & 31, d = ((int)i >> 5) & 63, kvh = ((int)i >> 11) & 15, c = ((int)i >> 15) & 15, b = (int)i >> 19;
            vcb[i] = (bf16_t)f2bf(a.in[5][((size_t)(b * 512 + c * 32 + tt) * 16 + kvh) * 64 + d]); }
    }
}
__device__ __forceinline__ void norm_mod_phase(const float* xa, const float* xb, const float* nw, const float* shift, const float* scale, bf16_t* H, int gw, int ngw, int lane) {
    for (int row = gw; row < MTOK; row += ngw) {
        const float* xr = row < NCTXROWS ? xa + (size_t)row * DM : xb + (size_t)(row - NCTXROWS) * DM;
        const int cond = row < NCTXROWS ? 0 : 1 + ((row - NCTXROWS) >> 12);
        f32x4 v[4]; float s = 0.f;
#pragma unroll
        for (int j = 0; j < 4; ++j) { v[j] = *(const f32x4*)(xr + 4 * (lane + 64 * j)); const f32x4 t = v[j] * v[j]; s += (t[0] + t[1]) + (t[2] + t[3]); }
        const float rinv = rsqrtf(wave_sum(s) * (1.0f / DM) + EPSN);
#pragma unroll
        for (int j = 0; j < 4; ++j) { const int col = 4 * (lane + 64 * j);
            const f32x4 w = *(const f32x4*)(nw + col), sc = *(const f32x4*)(scale + cond * 6144 + col), sh = *(const f32x4*)(shift + cond * 6144 + col);
            const f32x4 y = (v[j] * rinv * w) * (sc + 1.0f) + sh;
            u32x2 o; o.x = cvt_pk_bf16(y[0], y[1]); o.y = cvt_pk_bf16(y[2], y[3]);
            *(u32x2*)(H + (size_t)row * DM + col) = o; }
    }
}
__device__ __forceinline__ void conv_act_phase(const bf16_t* U, const float* cw, const float* cb, bf16_t* ACT, size_t gt, size_t nt) {
    for (size_t item = gt; item < (size_t)384 * 352; item += nt) {
        const int rb = (int)(item / 352), fg = (int)(item % 352), r0 = rb * 32, f0 = fg * 8;
        const int pos0 = r0 < NCTXROWS ? (r0 & 255) : (r0 & 4095), L = r0 < NCTXROWS ? 256 : 4096;
        const bool has_prev = pos0 > 0, has_next = pos0 + 32 < L;
        float wg[3][8], wv[3][8], bg[8], bv[8];
#pragma unroll
        for (int o = 0; o < 3; ++o)
#pragma unroll
            for (int j = 0; j < 8; ++j) { wg[o][j] = cw[o * DUP + f0 + j]; wv[o][j] = cw[o * DUP + DFF + f0 + j]; }
#pragma unroll
        for (int j = 0; j < 8; ++j) { bg[j] = cb[f0 + j]; bv[j] = cb[DFF + f0 + j]; }
        const u32x4 z4 = (u32x4){0u, 0u, 0u, 0u};
        const bf16_t* up = U + (size_t)r0 * DUP + f0;
        u32x4 gp = z4, vp = z4, gc, vc, gn, vn;
        if (has_prev) { gp = *(const u32x4*)(up - DUP); vp = *(const u32x4*)(up - DUP + DFF); }
        gc = *(const u32x4*)up; vc = *(const u32x4*)(up + DFF);
        for (int r = 0; r < 32; ++r) {
            gn = z4; vn = z4;
            if (r < 31 || has_next) { gn = *(const u32x4*)(up + (size_t)(r + 1) * DUP); vn = *(const u32x4*)(up + (size_t)(r + 1) * DUP + DFF); }
            float res[8];
#pragma unroll
            for (int q = 0; q < 4; ++q) {
                const float g0 = wg[0][2 * q] * bflo(gp[q]) + wg[1][2 * q] * bflo(gc[q]) + wg[2][2 * q] * bflo(gn[q]) + bg[2 * q];
                const float g1 = wg[0][2 * q + 1] * bfhi(gp[q]) + wg[1][2 * q + 1] * bfhi(gc[q]) + wg[2][2 * q + 1] * bfhi(gn[q]) + bg[2 * q + 1];
                const float v0 = wv[0][2 * q] * bflo(vp[q]) + wv[1][2 * q] * bflo(vc[q]) + wv[2][2 * q] * bflo(vn[q]) + bv[2 * q];
                const float v1 = wv[0][2 * q + 1] * bfhi(vp[q]) + wv[1][2 * q + 1] * bfhi(vc[q]) + wv[2][2 * q + 1] * bfhi(vn[q]) + bv[2 * q + 1];
                res[2 * q] = silu_f(g0) * v0; res[2 * q + 1] = silu_f(g1) * v1;
            }
            u32x4 o; o.x = cvt_pk_bf16(res[0], res[1]); o.y = cvt_pk_bf16(res[2], res[3]); o.z = cvt_pk_bf16(res[4], res[5]); o.w = cvt_pk_bf16(res[6], res[7]);
            *(u32x4*)(ACT + (size_t)(r0 + r) * DFF + f0) = o;
            gp = gc; vp = vc; gc = gn; vc = vn;
        }
    }
}

__global__ void __launch_bounds__(NTHR, 2) mk_fwd(Args a) {
    extern __shared__ __attribute__((aligned(16))) unsigned char lds_raw[];
    cg::grid_group grid = cg::this_grid();
    LAS unsigned char* lds = (LAS unsigned char*)lds_raw;
    const int tid = threadIdx.x, lane = tid & 63, wave = __builtin_amdgcn_readfirstlane(tid >> 6);
    const int G = gridDim.x, bx = blockIdx.x;
    const int gw = bx * NWAVES + wave, NGW = G * NWAVES;
    const size_t gt = (size_t)bx * NTHR + tid, NT = (size_t)G * NTHR;
    unsigned char* ws = a.ws;
    float* out = a.out;
    bf16_t* H = (bf16_t*)(ws + WS_H); bf16_t* ACT = (bf16_t*)(ws + WS_ACT); bf16_t* U = (bf16_t*)(ws + WS_U);
    bf16_t* Qb = (bf16_t*)(ws + WS_Q); bf16_t* Kb = (bf16_t*)(ws + WS_K); bf16_t* VTb = (bf16_t*)(ws + WS_VT); bf16_t* Ob = (bf16_t*)(ws + WS_O);
    const float* rope = (const float*)(ws + WS_ROPE);

#ifndef NO_PRO
    for (int rep = 0; rep < REP_THIN; ++rep) { prologue(a, lds, tid, lane, wave); __syncthreads(); }
#endif
    volatile LAS unsigned* bst = (volatile LAS unsigned*)(lds + 131072 + 64);
    if (tid < 2) bst[tid] = 0u;
    unsigned* barw = (unsigned*)(ws + WS_BAR);
    if (bx == 0) for (int i = tid; i < XCD_BAR_WORDS; i += NTHR) barw[i] = 0u;
    grid.sync();
    const XcdBarrier xbar = xcd_barrier_post(barw, bst);
#define GSYNC() xcd_barrier(xbar)

#pragma unroll 1
    for (int layer = 0; layer < 2; ++layer) {
        const float* mod = (const float*)(ws + WS_MOD) + layer * 3 * 6144;
        const float* xa = layer == 0 ? a.in[0] : out;
        const float* xb = layer == 0 ? a.in[1] : out + (size_t)NCTXROWS * DM;
#ifndef NO_NORM
        for (int rep = 0; rep < REP_THIN; ++rep)
        { int tl = tid; asm volatile("" : "+v"(tl)); const int wv = __builtin_amdgcn_readfirstlane(tl >> 6);
          norm_mod_phase(xa, xb, a.in[8] + layer * DM, mod + 0 * 1024, mod + 1 * 1024, H, bx * NWAVES + wv, NGW, tl & 63); }
#endif
        GSYNC();
#ifndef NO_QKV
        if (layer == 0) {
            pg8::Gemm g{H, (const bf16_t*)(ws + WS_WQKVA), MTOK, 1536, 1024}; pg8::StaticOrder S; int bxl = bx; asm volatile("" : "+s"(bxl)); int tl = tid; asm volatile("" : "+v"(tl)); S.init(MTOK, 1536, G, bxl);
            EpiQKV<4> E{Qb, Kb, VTb, out + OUT_KA, out + OUT_VA, a.in[13], a.in[14], rope};
            pg8::gemm_phase<EpiQKV<4>, pg8::StaticOrder, true, true>(lds, g, S, E, tl);
        } else {
            pg8::Gemm g{H, (const bf16_t*)(ws + WS_WQKVB), MTOK, 3072, 1024}; pg8::StaticOrder S; int bxl = bx; asm volatile("" : "+s"(bxl)); int tl = tid; asm volatile("" : "+v"(tl)); S.init(MTOK, 3072, G, bxl);
            EpiQKV<16> E{Qb, Kb, VTb, out + OUT_KB, out + OUT_VB, a.in[18], a.in[19], rope};
            pg8::gemm_phase<EpiQKV<16>, pg8::StaticOrder, true, true>(lds, g, S, E, tl);
        }
#endif
        GSYNC();
#ifndef NO_ATTN
        for (int rep = 0; rep < REP_ATTN; ++rep)
        { int tl = tid; asm volatile("" : "+v"(tl));
        if (layer == 0) attn_groups_a(Qb, Kb, VTb, (const bf16_t*)(ws + WS_KCA), (const bf16_t*)(ws + WS_VTCA), a.in[15], Ob, bx, G, tl, lds);
        else attn_groups_b(Qb, Kb, VTb, (const bf16_t*)(ws + WS_KCB), (const bf16_t*)(ws + WS_VTCB), a.in[20], Ob, bx, G, tl, lds); }
#endif
        GSYNC();
#ifndef NO_OPROJ
        {
            pg8::Gemm g{Ob, (const bf16_t*)(ws + (layer ? WS_WOB : WS_WOA)), MTOK, 1024, 1024}; pg8::StaticOrder S; int bxl = bx; asm volatile("" : "+s"(bxl)); int tl = tid; asm volatile("" : "+v"(tl)); S.init(MTOK, 1024, G, bxl);
            EpiResid E{xa, xb, out, mod + 2 * 1024};
            pg8::gemm_phase<EpiResid, pg8::StaticOrder, true, true>(lds, g, S, E, tl);
        }
#endif
        GSYNC();
#ifndef NO_NORM
        for (int rep = 0; rep < REP_THIN; ++rep)
        { int tl = tid; asm volatile("" : "+v"(tl)); const int wv = __builtin_amdgcn_readfirstlane(tl >> 6);
          norm_mod_phase(out, out + (size_t)NCTXROWS * DM, a.in[9] + layer * DM, mod + 3 * 1024, mod + 4 * 1024, H, bx * NWAVES + wv, NGW, tl & 63); }
#endif
        GSYNC();
#ifndef NO_UP
        {
            pg8::Gemm g{H, (const bf16_t*)(ws + (layer ? WS_WUP1 : WS_WUP0)), 50 * 256, DUP, 1024}; pg8::StaticOrder S; int bxl = bx; asm volatile("" : "+s"(bxl)); int tl = tid; asm volatile("" : "+v"(tl)); S.init(50 * 256, DUP, G, bxl);
            EpiUpConv E{ACT, a.in[23] + (size_t)layer * 3 * DUP, a.in[24] + (size_t)layer * DUP, (LAS float*)(lds + 131072 + 1024)};
            pg8::gemm_phase<EpiUpConv, pg8::StaticOrder, true, true>(lds, g, S, E, tl);
        }
#endif
        GSYNC();
#ifndef NO_DOWN
        {
            pg8::Gemm g{ACT, (const bf16_t*)(ws + (layer ? WS_WDN1 : WS_WDN0)), MTOK, 1024, DFF}; pg8::StaticOrder S; int bxl = bx; asm volatile("" : "+s"(bxl)); int tl = tid; asm volatile("" : "+v"(tl)); S.init(MTOK, 1024, G, bxl);
            EpiResid E{out, out + (size_t)NCTXROWS * DM, out, mod + 5 * 1024};
            pg8::gemm_phase<EpiResid, pg8::StaticOrder, true, true>(lds, g, S, E, tl);
        }
#endif
        if (layer == 0) GSYNC();
    }
}

extern "C" void kernel_launch(void* const* d_in, const int* in_sizes, int n_in, void* d_out, int out_size, void* d_ws, size_t ws_size, hipStream_t stream) {
    static int grid = 0;
    if (grid == 0) {
        if (n_in != 26 || out_size != 23068672 || ws_size < WS_END) { fprintf(stderr, "kernel_launch: unexpected shapes n_in %d out %d ws %zu\n", n_in, out_size, ws_size); grid = -1; return; }
        int dev = 0, cus = 0, per_cu = 0;
        hipGetDevice(&dev);
        hipDeviceGetAttribute(&cus, hipDeviceAttributeMultiprocessorCount, dev);
        hipFuncSetAttribute((const void*)mk_fwd, hipFuncAttributeMaxDynamicSharedMemorySize, LDS_BYTES);
        hipOccupancyMaxActiveBlocksPerMultiprocessor(&per_cu, (const void*)mk_fwd, NTHR, LDS_BYTES);
        if (per_cu < 1) per_cu = 1;
        grid = cus * per_cu;
    }
    if (grid < 0) return;
    Args a{};
    for (int i = 0; i < 26; ++i) a.in[i] = (const float*)d_in[i];
    a.out = (float*)d_out; a.ws = (unsigned char*)d_ws;
    void* args[] = {&a};
    hipError_t e = hipLaunchCooperativeKernel((const void*)mk_fwd, dim3(grid), dim3(NTHR), args, LDS_BYTES, stream);
    if (e != hipSuccess) fprintf(stderr, "cooperative launch failed: %s (grid %d)\n", hipGetErrorString(e), grid);
}
```

```cpp
#include <hip/hip_runtime.h>
#include <hip/hip_cooperative_groups.h>
#include <cstdio>
#include <cstdint>
namespace cg = cooperative_groups;
namespace pg8 {
#define PG8_LAS __attribute__((address_space(3)))
typedef unsigned short bf16_t;
typedef short bf16x8 __attribute__((ext_vector_type(8)));
typedef float f32x4 __attribute__((ext_vector_type(4)));
typedef unsigned u32x4 __attribute__((ext_vector_type(4)));
constexpr int BM = 256, BK = 64, HALF = 128, HTB = HALF * BK * 2  , STAGE_BYTES = 8 * HTB, NXCD = 8, WGM = 8;

__host__ __device__ __forceinline__ int lds_byte(int r, int c) { const int st = (r >> 4) * 2 + (c >> 5), rr = r & 15, cc = c & 31, ob = rr * 64 + cc * 2; return st * 1024 + (ob ^ (((ob >> 9) & 1) << 5)); }
__host__ __device__ __forceinline__ void stage_rc(int b, int& R, int& C) { const int st = b / 1024, sb = b % 1024, swz = sb ^ (((sb >> 9) & 1) << 5); R = (st >> 1) * 16 + swz / 64; C = (st & 1) * 32 + (swz % 64) / 2; }
__host__ __device__ __forceinline__ int perm32(int rho) { const int n = rho >> 4, i = rho & 15; return 8 * (i >> 2) + 4 * n + (i & 3); }

struct Unit { int pm, pn; };
struct Gemm { const bf16_t* A; const bf16_t* Bt; int M, N, K; };

struct StaticOrder {
    int nM, nN, nwg, G, c;
    __host__ __device__ void init(int M, int N, int G_, int c_) { nM = M / BM; nN = N / BM; nwg = nM * nN; G = G_; c = c_; }
    __host__ __device__ bool next(int i, Unit& u) const {
        const long L = (long)i * G + c; if (L >= nwg) return false;
        int wgid = (int)L; { const int q = nwg / NXCD, r = nwg % NXCD, xcd = wgid % NXCD, off = wgid / NXCD; wgid = (xcd < r ? xcd * (q + 1) : r * (q + 1) + (xcd - r) * q) + off; }
        const int nig = WGM * nN, gid = wgid / nig, fm = gid * WGM, gsz = (nM - fm) < WGM ? (nM - fm) : WGM;
        u.pm = fm + ((wgid % nig) % gsz); u.pn = (wgid % nig) / gsz; return true;
    }
    __device__ __forceinline__ void a_ready(const Unit&) const {}
    __device__ __forceinline__ void done(const Unit&) const {}
};

__device__ __forceinline__ unsigned cvt_pk_bf16(float lo, float hi) { unsigned r; asm volatile("v_cvt_pk_bf16_f32 %0, %1, %2" : "=v"(r) : "v"(lo), "v"(hi)); return r; }
template <class Epi, class Sched, bool ALIGN_EPI = false, bool SP2 = false>
__device__ __forceinline__ void gemm_phase(PG8_LAS unsigned char* lds, const Gemm g, const Sched& S, const Epi& E, const int tid_in) {
    const int tid = tid_in, wid = __builtin_amdgcn_readfirstlane(tid >> 6), lane = tid & 63, wr = wid >> 2, wc = wid & 3, fr = lane & 15, fq = lane >> 4;
    const int K = g.K, nt = K / BK;
    unsigned voffA[2], voffB[2];
#pragma unroll
    for (int i = 0; i < 2; ++i) { int R, C; stage_rc(tid * 16 + i * 8192, R, C); const int Rb = Epi::PERM ? ((R & ~31) + perm32(R & 31)) : R;
        voffA[i] = (unsigned)(R * K + C) * 2u; voffB[i] = (unsigned)(Rb * K + C) * 2u; }
    const size_t kstep = (size_t)(BK * 2);
    const size_t hstep = (size_t)HALF * K * 2;
    const size_t tstep = 2 * hstep;
    const unsigned ldsw = (unsigned)wid * 1024u;
    const int aoff = lds_byte(wr * 64 + fr, fq * 8), boff = lds_byte(wc * 32 + fr, fq * 8);
#define PG8_SA(b, h) (((b) * 2 + (h)) * HTB)
#define PG8_SB(b, h) ((4 + (b) * 2 + (h)) * HTB)
#define PG8_STAGE(bufoff, gbase, voff) do { _Pragma("unroll") for (int _i = 0; _i < 2; ++_i) \
        __builtin_amdgcn_global_load_lds((const unsigned*)((const char*)(gbase) + (voff)[_i]), (PG8_LAS unsigned*)(lds + (bufoff) + ldsw + _i * 8192), 16, 0, 0); } while (0)
#define PG8_LDA(dst, b, h) do { _Pragma("unroll") for (int m = 0; m < 4; ++m) _Pragma("unroll") for (int k = 0; k < 2; ++k) dst[m][k] = *(const PG8_LAS bf16x8*)(lds + PG8_SA(b, h) + aoff + m * 2048 + k * 1024); } while (0)
#define PG8_LDB(dst, b, h) do { _Pragma("unroll") for (int n = 0; n < 2; ++n) _Pragma("unroll") for (int k = 0; k < 2; ++k) dst[n][k] = *(const PG8_LAS bf16x8*)(lds + PG8_SB(b, h) + boff + n * 2048 + k * 1024); } while (0)
#define PG8_MMA(ai, bj, At, Bt) do { __builtin_amdgcn_s_setprio(1); _Pragma("unroll") for (int m = 0; m < 4; ++m) _Pragma("unroll") for (int n = 0; n < 2; ++n) _Pragma("unroll") for (int k = 0; k < 2; ++k) \
        acc[ai][bj][m][n] = __builtin_amdgcn_mfma_f32_16x16x32_bf16(Bt[n][k], At[m][k], acc[ai][bj][m][n], 0, 0, 0); __builtin_amdgcn_s_setprio(0); } while (0)
#define PG8_WAIT_V(n) asm volatile("s_waitcnt vmcnt(" #n ")" ::: "memory")
#define PG8_WAIT_L(n) asm volatile("s_waitcnt lgkmcnt(" #n ")" ::: "memory")
#define PG8_BAR __builtin_amdgcn_s_barrier()
#define PG8_SCHED __builtin_amdgcn_sched_barrier(0)
    Unit cur, nxt; int ui = 0;
    if (!S.next(0, cur)) return;
    f32x4 acc[2][2][4][2];
#pragma unroll
    for (int a = 0; a < 2; ++a)
#pragma unroll
        for (int b = 0; b < 2; ++b)
#pragma unroll
            for (int m = 0; m < 4; ++m)
#pragma unroll
                for (int n = 0; n < 2; ++n) acc[a][b][m][n] = (f32x4){0.f, 0.f, 0.f, 0.f};
    bf16x8 At[4][2], B0[2][2], B1[2][2];
    const char* cA = (const char*)g.A + (size_t)Epi::a_row0(cur.pm) * ((size_t)K * 2); const char* cB = (const char*)g.Bt + (size_t)cur.pn * tstep;
    S.a_ready(cur);
    if constexpr (SP2) {
        PG8_STAGE(PG8_SB(0, 0), cB, voffB); PG8_STAGE(PG8_SB(0, 1), cB + hstep, voffB); PG8_STAGE(PG8_SA(0, 0), cA, voffA); PG8_STAGE(PG8_SA(0, 1), cA + hstep, voffA);
        if (wr == 1) PG8_BAR;
        PG8_WAIT_V(2); PG8_BAR;
        PG8_STAGE(PG8_SB(1, 0), cB + kstep, voffB); PG8_STAGE(PG8_SA(1, 0), cA + kstep, voffA); PG8_STAGE(PG8_SB(1, 1), cB + hstep + kstep, voffB);
        PG8_WAIT_V(6); PG8_BAR;
    } else {
        PG8_STAGE(PG8_SB(0, 0), cB, voffB); PG8_STAGE(PG8_SA(0, 0), cA, voffA); PG8_STAGE(PG8_SB(0, 1), cB + hstep, voffB); PG8_STAGE(PG8_SA(0, 1), cA + hstep, voffA);
        if (wr == 1) PG8_BAR;
        PG8_WAIT_V(4); PG8_BAR;
        PG8_STAGE(PG8_SB(1, 0), cB + kstep, voffB); PG8_STAGE(PG8_SA(1, 0), cA + kstep, voffA); PG8_STAGE(PG8_SB(1, 1), cB + hstep + kstep, voffB);
        PG8_WAIT_V(6); PG8_BAR;
    }
    for (;;) {
        const bool has_next = S.next(ui + 1, nxt);
        const char* nA = has_next ? (const char*)g.A + (size_t)Epi::a_row0(nxt.pm) * ((size_t)K * 2) : cA; const char* nB = has_next ? (const char*)g.Bt + (size_t)nxt.pn * tstep : cB;
        for (int t = 0; t < nt; t += 2) {
            const bool last = (t == nt - 2);
            const char* a1 = cA + (size_t)(t + 1) * kstep;
            const char* a2 = last ? nA : cA + (size_t)(t + 2) * kstep; const char* b2 = last ? nB : cB + (size_t)(t + 2) * kstep;
            const char* a3 = a2 + kstep; const char* b3 = b2 + kstep;
            if (last && has_next) S.a_ready(nxt);
            if constexpr (SP2) {
            PG8_LDB(B0, 0, 0); PG8_LDB(B1, 0, 1); PG8_SCHED; PG8_LDA(At, 0, 0); PG8_STAGE(PG8_SA(1, 1), a1 + hstep, voffA);
            PG8_WAIT_V(8); PG8_WAIT_L(0); PG8_BAR; PG8_MMA(0, 0, At, B0); PG8_MMA(0, 1, At, B1); PG8_BAR; PG8_SCHED;
            PG8_LDA(At, 0, 1); PG8_STAGE(PG8_SB(0, 0), b2, voffB); PG8_STAGE(PG8_SB(0, 1), b2 + hstep, voffB); PG8_STAGE(PG8_SA(0, 0), a2, voffA);
            PG8_WAIT_V(8); PG8_WAIT_L(0); PG8_BAR; PG8_MMA(1, 0, At, B0); PG8_MMA(1, 1, At, B1); PG8_BAR; PG8_SCHED;
            PG8_LDB(B0, 1, 0); PG8_LDB(B1, 1, 1); PG8_SCHED; PG8_LDA(At, 1, 0); PG8_STAGE(PG8_SA(0, 1), a2 + hstep, voffA);
            PG8_WAIT_V(8); PG8_WAIT_L(0); PG8_BAR; PG8_MMA(0, 0, At, B0); PG8_MMA(0, 1, At, B1); PG8_BAR; PG8_SCHED;
            PG8_LDA(At, 1, 1); PG8_STAGE(PG8_SB(1, 0), b3, voffB); PG8_STAGE(PG8_SB(1, 1), b3 + hstep, voffB); PG8_STAGE(PG8_SA(1, 0), a3, voffA);
            PG8_WAIT_V(8); PG8_WAIT_L(0); PG8_BAR; PG8_MMA(1, 0, At, B0); PG8_MMA(1, 1, At, B1); PG8_BAR; PG8_SCHED;
            } else {
            PG8_LDB(B0, 0, 0); PG8_SCHED; PG8_LDA(At, 0, 0); PG8_STAGE(PG8_SA(1, 1), a1 + hstep, voffA);
            PG8_WAIT_L(8); PG8_BAR; PG8_WAIT_L(0); PG8_MMA(0, 0, At, B0); PG8_BAR; PG8_SCHED;
            PG8_LDB(B1, 0, 1); PG8_STAGE(PG8_SB(0, 0), b2, voffB);
            PG8_BAR; PG8_WAIT_L(0); PG8_MMA(0, 1, At, B1); PG8_BAR;
            PG8_LDA(At, 0, 1); PG8_STAGE(PG8_SA(0, 0), a2, voffA);
            PG8_BAR; PG8_WAIT_L(0); PG8_MMA(1, 0, At, B0); PG8_BAR; PG8_SCHED;
            PG8_STAGE(PG8_SB(0, 1), b2 + hstep, voffB);
            PG8_WAIT_V(6); PG8_BAR; PG8_MMA(1, 1, At, B1); PG8_BAR;
            PG8_LDB(B0, 1, 0); PG8_SCHED; PG8_LDA(At, 1, 0); PG8_STAGE(PG8_SA(0, 1), a2 + hstep, voffA);
            PG8_WAIT_L(8); PG8_BAR; PG8_WAIT_L(0); PG8_MMA(0, 0, At, B0); PG8_BAR; PG8_SCHED;
            PG8_LDB(B1, 1, 1); PG8_STAGE(PG8_SB(1, 0), b3, voffB);
            PG8_BAR; PG8_WAIT_L(0); PG8_MMA(0, 1, At, B1); PG8_BAR;
            PG8_LDA(At, 1, 1); PG8_STAGE(PG8_SA(1, 0), a3, voffA);
            PG8_BAR; PG8_WAIT_L(0); PG8_MMA(1, 0, At, B0); PG8_BAR; PG8_SCHED;
            PG8_STAGE(PG8_SB(1, 1), b3 + hstep, voffB);
            PG8_WAIT_V(6); PG8_BAR; PG8_MMA(1, 1, At, B1); PG8_BAR;
            }
        }
        if constexpr (ALIGN_EPI) { if (wr == 0) PG8_BAR; }
        if constexpr (!Epi::AFTER_DRAIN) { E(acc, cur, wr, wc, fr, fq); S.done(cur); }
        if (!has_next) break;
#pragma unroll
        for (int a = 0; a < 2; ++a)
#pragma unroll
            for (int b = 0; b < 2; ++b)
#pragma unroll
                for (int m = 0; m < 4; ++m)
#pragma unroll
                    for (int n = 0; n < 2; ++n) acc[a][b][m][n] = (f32x4){0.f, 0.f, 0.f, 0.f};
        cur = nxt; cA = nA; cB = nB; ++ui;
        if constexpr (ALIGN_EPI) { if (wr == 1) PG8_BAR; }
    }
    PG8_WAIT_V(0);
    if constexpr (!ALIGN_EPI) { if (wr == 0) PG8_BAR; }
    PG8_BAR;
    if constexpr (Epi::AFTER_DRAIN) { E.fused(acc, cur, wr, wc, fr, fq, lds, wid, lane); S.done(cur); }
#undef PG8_SA
#undef PG8_SB
#undef PG8_STAGE
#undef PG8_LDA
#undef PG8_LDB
#undef PG8_MMA
#undef PG8_WAIT_V
#undef PG8_WAIT_L
#undef PG8_BAR
#undef PG8_SCHED
}
}

#define LAS __attribute__((address_space(3)))
typedef unsigned short bf16_t;
typedef short bf16x8 __attribute__((ext_vector_type(8)));
typedef float f32x4 __attribute__((ext_vector_type(4)));
typedef float f32x2 __attribute__((ext_vector_type(2)));
typedef unsigned u32x4 __attribute__((ext_vector_type(4)));
typedef unsigned u32x2 __attribute__((ext_vector_type(2)));
using pg8::cvt_pk_bf16;

#ifndef REP_ATTN
#define REP_ATTN 1
#endif
#ifndef REP_THIN
#define REP_THIN 1
#endif
constexpr int NWAVES = 8, NTHR = 512;
constexpr int LDS_BYTES = 147456;
constexpr int MTOK = 12288, NCTXROWS = 4096, DM = 1024, DFF = 2816, DUP = 5632;
constexpr float EPSN = 1e-6f;
constexpr float LOG2E = 1.4426950408889634f;
constexpr float SCL2 = 0.125f * 1.4426950408889634f;

constexpr size_t MiB = 1u << 20;
constexpr size_t WS_MOD = 0;
constexpr size_t WS_ROPE = 256 * 1024;
constexpr size_t WS_BAR = 512 * 1024;
constexpr size_t WS_KCA = 1 * MiB;
constexpr size_t WS_VTCA = 1 * MiB + 512 * 1024;
constexpr size_t WS_KCB = 2 * MiB;
constexpr size_t WS_VTCB = 4 * MiB;
constexpr size_t WS_WQKVA = 6 * MiB, WS_WQKVB = 9 * MiB, WS_WOA = 15 * MiB, WS_WOB = 17 * MiB;
constexpr size_t WS_WUP0 = 19 * MiB, WS_WUP1 = 30 * MiB, WS_WDN0 = 41 * MiB, WS_WDN1 = 46 * MiB + 512 * 1024;
constexpr size_t WS_H = 52 * MiB;
constexpr size_t WS_ACT = 118 * MiB;
constexpr size_t WS_U = 118 * MiB;
constexpr size_t WS_Q = 118 * MiB, WS_K = 142 * MiB, WS_VT = 166 * MiB, WS_O = 190 * MiB;
constexpr size_t WS_END = 250 * MiB;
constexpr size_t OUT_Y = 0, OUT_KA = 12582912, OUT_VA = 13631488, OUT_KB = 14680064, OUT_VB = 18874368;

__device__ __forceinline__ unsigned f2bf(float f) { unsigned u = __builtin_bit_cast(unsigned, f); return (u + 0x7fffu + ((u >> 16) & 1u)) >> 16; }
__device__ __forceinline__ float bflo(unsigned w) { return __builtin_bit_cast(float, w << 16); }
__device__ __forceinline__ float bfhi(unsigned w) { return __builtin_bit_cast(float, w & 0xffff0000u); }
__device__ __forceinline__ float wave_sum(float v) {
#pragma unroll
    for (int o = 1; o < 64; o <<= 1) v += __shfl_xor(v, o);
    return v;
}
__device__ __forceinline__ float fast_exp2(float x) { return __builtin_amdgcn_exp2f(x); }
__device__ __forceinline__ float silu_f(float x) { return x * __builtin_amdgcn_rcpf(1.0f + __expf(-x)); }

struct Args { const float* in[26]; float* out; unsigned char* ws; };

#define XB_TMO      128
#define XB_XCNT(j)  (256  + 64 * (j))
#define XB_XSUB(j)  (1280 + 64 * (j))
#define XB_XGEN(j)  (2304 + 64 * (j))
#define XB_TOP      3328
#define XB_TOPGEN   3392
#define XCD_BAR_WORDS 3456
#define XB_SPIN_CAP (1u << 18)

__device__ __forceinline__ unsigned xb_ld(unsigned* p)              { return __hip_atomic_load(p, __ATOMIC_RELAXED, __HIP_MEMORY_SCOPE_AGENT); }
__device__ __forceinline__ unsigned xb_add(unsigned* p, unsigned v) { return __hip_atomic_fetch_add(p, v, __ATOMIC_RELAXED, __HIP_MEMORY_SCOPE_AGENT); }
__device__ __forceinline__ unsigned xb_xcc_id() { return (unsigned)__builtin_amdgcn_s_getreg((3 << 11) | 20) & 0xFu; }
#define XB_SPIN(cond, bar) do { unsigned _sp = 0; while (cond) { __builtin_amdgcn_s_sleep(1); \
    if ((++_sp & 255u) == 0u) { if (xb_ld(&(bar)[XB_TMO])) break; if (_sp > XB_SPIN_CAP) { atomicAdd(&(bar)[XB_TMO], 1u); break; } } } } while (0)

struct XcdBarrier {
    unsigned* bar; unsigned x;
    volatile LAS unsigned* st;
};

__device__ __forceinline__ XcdBarrier xcd_barrier_post(unsigned* bar, volatile LAS unsigned* st) {
    XcdBarrier b; b.bar = bar; b.x = xb_xcc_id(); b.st = st;
    if (threadIdx.x == 0) (void)xb_add(&bar[XB_XCNT(b.x)], 1u);
    return b;
}
__device__ __forceinline__ void xcd_barrier_complete(unsigned* bar, unsigned x, unsigned& nloc, unsigned& nx) {
    const unsigned G = gridDim.x * gridDim.y * gridDim.z;
    unsigned sum, cnt, mine, sp = 0u;
    for (;;) {
        sum = 0u; cnt = 0u; mine = 0u;
#pragma unroll
        for (unsigned j = 0; j < 16; ++j) { const unsigned c = xb_ld(&bar[XB_XCNT(j)]); sum += c; cnt += (c > 0u) ? 1u : 0u; mine = (j == x) ? c : mine; }
        if (sum == G) break;
        __builtin_amdgcn_s_sleep(1);
        if ((++sp & 255u) == 0u) { if (xb_ld(&bar[XB_TMO])) break; if (sp > XB_SPIN_CAP) { atomicAdd(&bar[XB_TMO], 1u); break; } }
    }
    nloc = mine > 0u ? mine : 1u; nx = cnt > 0u ? cnt : 1u;
}

__device__ __forceinline__ void xcd_barrier(const XcdBarrier& b) {
    asm volatile("s_waitcnt vmcnt(0)" ::: "memory");
    __syncthreads();
    if (threadIdx.x == 0) {
        unsigned* bar = b.bar;
        __builtin_amdgcn_s_waitcnt(0);
        unsigned nloc = b.st[0], nx = b.st[1];
        if (nloc == 0u) { xcd_barrier_complete(bar, b.x, nloc, nx); b.st[0] = nloc; b.st[1] = nx; }
        const unsigned old = xb_add(&bar[XB_XSUB(b.x)], 1u);
        const unsigned gen = old / nloc;
        if (old + 1u == (gen + 1u) * nloc) {
            __builtin_amdgcn_fence(__ATOMIC_RELEASE, "agent");
            asm volatile("s_waitcnt vmcnt(0)" ::: "memory");
            const unsigned og = xb_add(&bar[XB_TOP], 1u);
            const unsigned tg = og / nx;
            if (og + 1u == (tg + 1u) * nx) xb_add(&bar[XB_TOPGEN], 1u);
            else XB_SPIN(xb_ld(&bar[XB_TOPGEN]) == tg, bar);
            __builtin_amdgcn_fence(__ATOMIC_ACQUIRE, "agent");
            xb_add(&bar[XB_XGEN(b.x)], 1u);
            asm volatile("s_waitcnt vmcnt(0)" ::: "memory");
        } else {
            XB_SPIN(xb_ld(&bar[XB_XGEN(b.x)]) == gen, bar);
            __builtin_amdgcn_fence(__ATOMIC_ACQUIRE, "agent");
            asm volatile("s_waitcnt vmcnt(0)" ::: "memory");
        }
    }
    __syncthreads();
}


using pg8::Unit;
struct EpiUp {
    static constexpr bool PERM = true, AFTER_DRAIN = false;
    static __device__ __forceinline__ int a_row0(int pm) { return pm * 256; }
    bf16_t* O; int ldc;
    __device__ __forceinline__ void operator()(const f32x4 (&acc)[2][2][4][2], const Unit& u, int wr, int wc, int fr, int fq) const {
        const int row0 = u.pm * 256 + wr * 64 + fr, col0 = u.pn * 256 + wc * 32 + 8 * fq;
#pragma unroll
        for (int ai = 0; ai < 2; ++ai)
#pragma unroll
            for (int m = 0; m < 4; ++m) { bf16_t* rowp = O + (size_t)(row0 + ai * 128 + m * 16) * ldc + col0;
#pragma unroll
                for (int bj = 0; bj < 2; ++bj) { const f32x4 v0 = acc[ai][bj][m][0], v1 = acc[ai][bj][m][1];
                    u32x4 w; w.x = cvt_pk_bf16(v0[0], v0[1]); w.y = cvt_pk_bf16(v0[2], v0[3]); w.z = cvt_pk_bf16(v1[0], v1[1]); w.w = cvt_pk_bf16(v1[2], v1[3]);
                    *(u32x4*)(rowp + bj * 128) = w; } }
    }
};
struct EpiResid {
    static constexpr bool PERM = false, AFTER_DRAIN = false;
    static __device__ __forceinline__ int a_row0(int pm) { return pm * 256; }
    const float* xa; const float* xb; float* out; const float* gate;
    __device__ __forceinline__ void operator()(const f32x4 (&acc)[2][2][4][2], const Unit& u, int wr, int wc, int fr, int fq) const {
        const int rbase = u.pm * 256;
        const float* xin = rbase < NCTXROWS ? xa + (size_t)rbase * DM : xb + (size_t)(rbase - NCTXROWS) * DM;
        const int cond = rbase < NCTXROWS ? 0 : 1 + ((rbase - NCTXROWS) >> 12);
        const int col0 = u.pn * 256 + wc * 32 + 4 * fq;
        const float* g = gate + cond * 6144 + col0;
        float* o = out + (size_t)rbase * DM;
        f32x4 gv[2][2];
#pragma unroll
        for (int bj = 0; bj < 2; ++bj)
#pragma unroll
            for (int n = 0; n < 2; ++n) gv[bj][n] = *(const f32x4*)(g + bj * 128 + n * 16);
#pragma unroll
        for (int ai = 0; ai < 2; ++ai)
#pragma unroll
            for (int m = 0; m < 4; ++m) { const size_t off = (size_t)(ai * 128 + wr * 64 + m * 16 + fr) * DM + col0;
#pragma unroll
                for (int bj = 0; bj < 2; ++bj)
#pragma unroll
                    for (int n = 0; n < 2; ++n) { const f32x4 x = *(const f32x4*)(xin + off + bj * 128 + n * 16);
                        *(f32x4*)(o + off + bj * 128 + n * 16) = x + gv[bj][n] * acc[ai][bj][m][n]; }
                if (m & 1) asm volatile("" ::: "memory"); }
    }
};

struct EpiUpConv {
    static constexpr bool PERM = false, AFTER_DRAIN = false;
    static __device__ __forceinline__ int a_row0(int pm) {
        if (pm < 16) return pm * 256;
        const int s = (pm - 16) / 17, j = (pm - 16) % 17; int st = 254 * j - 1; st = st > 3841 ? 3841 : st;
        return NCTXROWS + 4096 * s + st;
    }
    bf16_t* ACT; const float* cw; const float* cb; LAS float* xch;
    __device__ __forceinline__ void operator()(const f32x4 (&acc)[2][2][4][2], const Unit& u, int wr, int wc, int fr, int fq) const {
        const bool latent = u.pm >= 16;
        const int j17 = latent ? (u.pm - 16) % 17 : -1;
        const bool zr0 = (j17 == 0) && (wr == 0) && (fr == 0), zr255 = (j17 == 16) && (wr == 1) && (fr == 15);
        const int grow0 = a_row0(u.pm);
        const int lane = fq * 16 + fr;
        const int src_prev = (lane & 48) | ((fr + 15) & 15), src_next = (lane & 48) | ((fr + 1) & 15);
        const f32x4 z4 = (f32x4){0.f, 0.f, 0.f, 0.f};
#pragma unroll
        for (int ai = 0; ai < 2; ++ai) { const int g = ai * 2 + wr;
#pragma unroll
            for (int bj = 0; bj < 2; ++bj)
#pragma unroll
                for (int n = 0; n < 2; ++n) { const int col = bj * 128 + 32 * wc + 16 * n + 4 * fq;
                    if (fr == 0) *(LAS f32x4*)(xch + (g * 2 + 0) * 256 + col) = (ai == 0 && zr0) ? z4 : acc[ai][bj][0][n];
                    if (fr == 15) *(LAS f32x4*)(xch + (g * 2 + 1) * 256 + col) = (ai == 1 && zr255) ? z4 : acc[ai][bj][3][n]; } }
        asm volatile("s_waitcnt lgkmcnt(0)" ::: "memory"); __builtin_amdgcn_s_barrier(); asm volatile("" ::: "memory");
        const int fbase = u.pn * 128 + 32 * wc + 4 * fq;
#pragma unroll
        for (int n = 0; n < 2; ++n) {
            const int f0 = fbase + 16 * n;
            f32x4 wg[3], wv[3];
#pragma unroll
            for (int o = 0; o < 3; ++o) { wg[o] = *(const f32x4*)(cw + o * DUP + f0); wv[o] = *(const f32x4*)(cw + o * DUP + DFF + f0); }
            const f32x4 bg = *(const f32x4*)(cb + f0), bv = *(const f32x4*)(cb + DFF + f0);
#pragma unroll
            for (int ai = 0; ai < 2; ++ai) {
                const int g = ai * 2 + wr;
                f32x4 bp[2], bn[2];
#pragma unroll
                for (int bj = 0; bj < 2; ++bj) { const int col = bj * 128 + 32 * wc + 16 * n + 4 * fq;
                    bp[bj] = g > 0 ? *(const LAS f32x4*)(xch + ((g - 1) * 2 + 1) * 256 + col) : z4;
                    bn[bj] = g < 3 ? *(const LAS f32x4*)(xch + ((g + 1) * 2 + 0) * 256 + col) : z4; }
#pragma unroll
                for (int m = 0; m < 4; ++m) {
                    f32x4 cv[2];
#pragma unroll
                    for (int bj = 0; bj < 2; ++bj) {
                        f32x4 cur = acc[ai][bj][m][n];
                        if (ai == 0 && m == 0) cur = zr0 ? z4 : cur;
                        if (ai == 1 && m == 3) cur = zr255 ? z4 : cur;
                        f32x4 ps = m > 0 ? acc[ai][bj][m - 1][n] : bp[bj];
                        f32x4 ns = m < 3 ? acc[ai][bj][m + 1][n] : bn[bj];
                        f32x4 tp, tn, pv, nv;
#pragma unroll
                        for (int i = 0; i < 4; ++i) { tp[i] = fr == 15 ? ps[i] : cur[i]; tn[i] = fr == 0 ? ns[i] : cur[i]; }
#pragma unroll
                        for (int i = 0; i < 4; ++i) { pv[i] = __shfl(tp[i], src_prev); nv[i] = __shfl(tn[i], src_next); }
                        const f32x4 w0 = bj ? wv[0] : wg[0], w1 = bj ? wv[1] : wg[1], w2 = bj ? wv[2] : wg[2], bb = bj ? bv : bg;
                        cv[bj] = w0 * pv + w1 * cur + w2 * nv + bb;
                    }
                    f32x4 r;
#pragma unroll
                    for (int i = 0; i < 4; ++i) r[i] = silu_f(cv[0][i]) * cv[1][i];
                    const int R = ai * 128 + wr * 64 + m * 16 + fr;
                    const bool halo = latent && ((ai == 0 && m == 0 && wr == 0 && fr == 0) || (ai == 1 && m == 3 && wr == 1 && fr == 15));
                    if (!halo) { u32x2 w; w.x = cvt_pk_bf16(r[0], r[1]); w.y = cvt_pk_bf16(r[2], r[3]); *(u32x2*)(ACT + (size_t)(grow0 + R) * DFF + f0) = w; }
                }
            }
            asm volatile("" ::: "memory");
        }
    }
};
template <int NKV>
struct EpiQKV {
    static constexpr bool PERM = false, AFTER_DRAIN = false;
    static __device__ __forceinline__ int a_row0(int pm) { return pm * 256; }
    bf16_t* Q; bf16_t* K; bf16_t* VT; float* newk; float* newv; const float* qn; const float* kn; const float* rope;
    __device__ __forceinline__ void operator()(const f32x4 (&acc)[2][2][4][2], const Unit& u, int wr, int wc, int fr, int fq) const {
        constexpr int KLD = NKV * 64;
        const int hs = 4 * u.pn + wc;
        const int rbase = u.pm * 256 + wr * 64 + fr;
        const bool latent = u.pm >= 16;
        if (hs < 16 + NKV) {
            const bool isq = hs < 16;
            const float* nw = isq ? qn : kn;
            f32x4 wn[2][2];
#pragma unroll
            for (int bj = 0; bj < 2; ++bj)
#pragma unroll
                for (int n = 0; n < 2; ++n) wn[bj][n] = *(const f32x4*)(nw + 32 * bj + 16 * n + 4 * fq);
#pragma unroll
            for (int ai = 0; ai < 2; ++ai)
#pragma unroll
                for (int m = 0; m < 4; ++m) {
                    const int row = rbase + ai * 128 + m * 16;
                    f32x4 v[2][2]; float ss = 0.f;
#pragma unroll
                    for (int bj = 0; bj < 2; ++bj)
#pragma unroll
                        for (int n = 0; n < 2; ++n) { v[bj][n] = acc[ai][bj][m][n]; const f32x4 t = v[bj][n] * v[bj][n]; ss += (t[0] + t[1]) + (t[2] + t[3]); }
                    ss += __shfl_xor(ss, 16); ss += __shfl_xor(ss, 32);
                    const float rinv = rsqrtf(ss * (1.0f / 64.0f) + EPSN);
#pragma unroll
                    for (int bj = 0; bj < 2; ++bj)
#pragma unroll
                        for (int n = 0; n < 2; ++n) v[bj][n] = v[bj][n] * rinv * wn[bj][n];
                    if (latent && NKV == 4) {
                        const int pr = ((row - NCTXROWS) & 4095) >> 6, pc = row & 63;
#pragma unroll
                        for (int bj = 0; bj < 2; ++bj) {
                            const int pos = bj ? pc : pr;
                            const f32x4* t = (const f32x4*)(rope + (pos * 16 + 4 * fq) * 2);
                            const f32x4 t0 = t[0], t1 = t[1];
                            const f32x4 cs = (f32x4){t0[0], t0[2], t1[0], t1[2]}, sn = (f32x4){t0[1], t0[3], t1[1], t1[3]};
                            const f32x4 x1 = v[bj][0], x2 = v[bj][1];
                            v[bj][0] = x1 * cs - x2 * sn; v[bj][1] = x2 * cs + x1 * sn;
                        }
                    }
                    if (isq) {
                        bf16_t* p = Q + (size_t)row * DM + hs * 64 + 4 * fq;
#pragma unroll
                        for (int bj = 0; bj < 2; ++bj)
#pragma unroll
                            for (int n = 0; n < 2; ++n) { u32x2 w; w.x = cvt_pk_bf16(v[bj][n][0], v[bj][n][1]); w.y = cvt_pk_bf16(v[bj][n][2], v[bj][n][3]); *(u32x2*)(p + 32 * bj + 16 * n) = w; }
                    } else {
                        const int kvh = hs - 16;
                        bf16_t* p = K + (size_t)row * KLD + kvh * 64 + 4 * fq;
#pragma unroll
                        for (int bj = 0; bj < 2; ++bj)
#pragma unroll
                            for (int n = 0; n < 2; ++n) { u32x2 w; w.x = cvt_pk_bf16(v[bj][n][0], v[bj][n][1]); w.y = cvt_pk_bf16(v[bj][n][2], v[bj][n][3]); *(u32x2*)(p + 32 * bj + 16 * n) = w; }
                        if (!latent) {
                            float* o = newk + (size_t)row * KLD + kvh * 64 + 4 * fq;
#pragma unroll
                            for (int bj = 0; bj < 2; ++bj)
#pragma unroll
                                for (int n = 0; n < 2; ++n) *(f32x4*)(o + 32 * bj + 16 * n) = v[bj][n];
                        }
                    }
                    asm volatile("" ::: "memory");
                }
        } else {
            const int kvh = hs - 16 - NKV;
#pragma unroll
            for (int ai = 0; ai < 2; ++ai)
#pragma unroll
                for (int m = 0; m < 4; ++m) {
                    const int row = rbase + ai * 128 + m * 16;
                    bf16_t* p = VT + ((size_t)(row >> 5) * NKV + kvh) * 2048 + (row & 31) + (4 * fq) * 32;
#pragma unroll
                    for (int bj = 0; bj < 2; ++bj)
#pragma unroll
                        for (int n = 0; n < 2; ++n)
#pragma unroll
                            for (int i = 0; i < 4; ++i) p[(32 * bj + 16 * n + i) * 32] = (bf16_t)f2bf(acc[ai][bj][m][n][i]);
                    if (!latent) {
                        float* o = newv + (size_t)row * KLD + kvh * 64 + 4 * fq;
#pragma unroll
                        for (int bj = 0; bj < 2; ++bj)
#pragma unroll
                            for (int n = 0; n < 2; ++n) *(f32x4*)(o + 32 * bj + 16 * n) = acc[ai][bj][m][n];
                    }
                    asm volatile("" ::: "memory");
                }
        }
    }
};

struct AttnState { f32x4 o[2][4]; float m[2]; float l[2]; };
#define MFMA16(a, b, c) __builtin_amdgcn_mfma_f32_16x16x32_bf16((a), (b), (c), 0, 0, 0)
struct KVFrag { bf16x8 kf[2][2]; bf16x8 vf[4]; };
__device__ __forceinline__ void attn_load(KVFrag& f, const bf16_t* kp, int kld, const bf16_t* vp, int fr, int fq) {
#pragma unroll
    for (int t = 0; t < 2; ++t)
#pragma unroll
        for (int h2 = 0; h2 < 2; ++h2) f.kf[t][h2] = *(const bf16x8*)(kp + (size_t)(16 * t + fr) * kld + 32 * h2 + 8 * fq);
#pragma unroll
    for (int dt = 0; dt < 4; ++dt) { const bf16_t* v = vp + (16 * dt + fr) * 32 + 4 * fq; const u32x2 lo = *(const u32x2*)v, hi = *(const u32x2*)(v + 16);
        f.vf[dt] = __builtin_bit_cast(bf16x8, ((u32x4){lo.x, lo.y, hi.x, hi.y})); }
}
template <int MASK>
__device__ __forceinline__ void attn_compute(AttnState& st, const bf16x8 (&qf)[2][2], const KVFrag& f, int fr, int fq, int mk0, int mk1, const LAS float* bias) {
#pragma unroll
    for (int qb = 0; qb < 2; ++qb) {
        f32x4 s0 = (f32x4){0.f, 0.f, 0.f, 0.f}, s1 = (f32x4){0.f, 0.f, 0.f, 0.f};
        s0 = MFMA16(f.kf[0][0], qf[qb][0], s0); s0 = MFMA16(f.kf[0][1], qf[qb][1], s0);
        s1 = MFMA16(f.kf[1][0], qf[qb][0], s1); s1 = MFMA16(f.kf[1][1], qf[qb][1], s1);
        float sv[8];
#pragma unroll
        for (int j = 0; j < 4; ++j) { sv[j] = s0[j] * SCL2; sv[4 + j] = s1[j] * SCL2; }
        if (MASK == 1) {
            const int d0 = mk0 + 4 * fq - 16 * qb - fr;
#pragma unroll
            for (int t = 0; t < 2; ++t)
#pragma unroll
                for (int j = 0; j < 4; ++j) { const int df = d0 + 16 * t + j; if (df > 128 || df < -128) sv[4 * t + j] = -INFINITY; }
        }
        if (MASK == 2) {
            const int qc = mk1 + 16 * qb + fr; int cs = qc - 8; cs = cs < 0 ? 0 : (cs > 48 ? 48 : cs);
#pragma unroll
            for (int t = 0; t < 2; ++t)
#pragma unroll
                for (int j = 0; j < 4; ++j) { const int kc = mk0 + 16 * t + 4 * fq + j; const bool ok = (kc >= cs) && (kc < cs + 16);
                    int bi = kc - qc + 15; bi = bi < 0 ? 0 : (bi > 30 ? 30 : bi);
                    const float bv = bias[bi];
                    sv[4 * t + j] = ok ? sv[4 * t + j] + bv : -INFINITY; }
        }
        float cmax = fmaxf(fmaxf(fmaxf(sv[0], sv[1]), fmaxf(sv[2], sv[3])), fmaxf(fmaxf(sv[4], sv[5]), fmaxf(sv[6], sv[7])));
        cmax = fmaxf(cmax, __shfl_xor(cmax, 16)); cmax = fmaxf(cmax, __shfl_xor(cmax, 32));
        const float mnew = fmaxf(st.m[qb], cmax);
        const float msafe = (mnew == -INFINITY) ? 0.f : mnew;
        const float alpha = fast_exp2(st.m[qb] - msafe);
        st.m[qb] = mnew;
        float p[8]; float ps = 0.f;
#pragma unroll
        for (int j = 0; j < 8; ++j) { p[j] = fast_exp2(sv[j] - msafe); ps += p[j]; }
        st.l[qb] = st.l[qb] * alpha + ps;
        u32x4 pw; pw.x = cvt_pk_bf16(p[0], p[1]); pw.y = cvt_pk_bf16(p[2], p[3]); pw.z = cvt_pk_bf16(p[4], p[5]); pw.w = cvt_pk_bf16(p[6], p[7]);
        const bf16x8 pf = __builtin_bit_cast(bf16x8, pw);
#pragma unroll
        for (int dt = 0; dt < 4; ++dt) { st.o[qb][dt] = st.o[qb][dt] * alpha; st.o[qb][dt] = MFMA16(f.vf[dt], pf, st.o[qb][dt]); }
    }
}
__device__ __forceinline__ void attn_init(AttnState& st, bf16x8 (&qf)[2][2], const bf16_t* Q, int qrow0, int head, int fr, int fq) {
#pragma unroll
    for (int qb = 0; qb < 2; ++qb) { st.m[qb] = -INFINITY; st.l[qb] = 0.f;
#pragma unroll
        for (int dt = 0; dt < 4; ++dt) st.o[qb][dt] = (f32x4){0.f, 0.f, 0.f, 0.f};
#pragma unroll
        for (int h2 = 0; h2 < 2; ++h2) qf[qb][h2] = *(const bf16x8*)(Q + (size_t)(qrow0 + 16 * qb + fr) * DM + head * 64 + 32 * h2 + 8 * fq); }
}
__device__ __forceinline__ void attn_finish(AttnState& st, bf16_t* O, int qrow0, int head, int fr, int fq, bool has_sink, float sink) {
#pragma unroll
    for (int qb = 0; qb < 2; ++qb) {
        float l = st.l[qb]; l += __shfl_xor(l, 16); l += __shfl_xor(l, 32);
        if (has_sink) l += fast_exp2(sink * LOG2E - st.m[qb]);
        const float inv = 1.0f / l;
        bf16_t* o = O + (size_t)(qrow0 + 16 * qb + fr) * DM + head * 64 + 4 * fq;
#pragma unroll
        for (int dt = 0; dt < 4; ++dt) { const f32x4 v = st.o[qb][dt] * inv; u32x2 w; w.x = cvt_pk_bf16(v[0], v[1]); w.y = cvt_pk_bf16(v[2], v[3]); *(u32x2*)(o + 16 * dt) = w; }
    }
}
__device__ __forceinline__ void attn_phase_a(const bf16_t* Q, const bf16_t* K, const bf16_t* VT, const bf16_t* Kc, const bf16_t* VTc, const float* sinkp, bf16_t* O, int gw, int ngw, int lane) {
    const int fr = lane & 15, fq = lane >> 4;
    for (int t = gw; t < 4096; t += ngw) {
        const int b = t >> 11, rem = t & 2047, kvh = rem >> 9, rem2 = rem & 511, qblk = ((rem2 >> 3) << 1) | (rem2 & 1), g = (rem2 & 7) >> 1;
        const int head = kvh * 4 + g, qpos0 = qblk * 32, seq0 = NCTXROWS + b * 4096, qrow0 = seq0 + qpos0;
        AttnState st; bf16x8 qf[2][2]; KVFrag cur, nxt;
        attn_init(st, qf, Q, qrow0, head, fr, fq);
        const int c0 = qblk - 4 < 0 ? 0 : qblk - 4, c1 = qblk + 4 > 127 ? 127 : qblk + 4;
        const bf16_t* kcp = Kc + (size_t)(b * 512) * 256 + kvh * 64; const bf16_t* vcp = VTc + (size_t)(b * 16 * 4 + kvh) * 2048;
        const bf16_t* klp = K + (size_t)seq0 * 256 + kvh * 64; const bf16_t* vlp = VT + (size_t)((seq0 >> 5) * 4 + kvh) * 2048;
        attn_load(cur, kcp, 256, vcp, fr, fq);
        for (int c = 0; c < 16; ++c) {
            if (c < 15) attn_load(nxt, kcp + (size_t)(32 * (c + 1)) * 256, 256, vcp + (size_t)(c + 1) * 4 * 2048, fr, fq);
            else attn_load(nxt, klp + (size_t)(32 * c0) * 256, 256, vlp + (size_t)c0 * 4 * 2048, fr, fq);
            attn_compute<0>(st, qf, cur, fr, fq, 0, 0, nullptr);
            cur = nxt;
        }
        for (int c = c0; c <= c1; ++c) {
            if (c < c1) attn_load(nxt, klp + (size_t)(32 * (c + 1)) * 256, 256, vlp + (size_t)(c + 1) * 4 * 2048, fr, fq);
            attn_compute<1>(st, qf, cur, fr, fq, 32 * c - qpos0, 0, nullptr);
            cur = nxt;
        }
        attn_finish(st, O, qrow0, head, fr, fq, true, sinkp[head]);
    }
    for (int t = gw; t < 2048; t += ngw) {
        const int b = t >> 7, rem = t & 127, kvh = rem >> 5, rem2 = rem & 31, qblk = ((rem2 >> 3) << 1) | (rem2 & 1), g = (rem2 & 7) >> 1;
        const int head = kvh * 4 + g, qrow0 = b * 256 + qblk * 32;
        AttnState st; bf16x8 qf[2][2]; KVFrag cur, nxt;
        attn_init(st, qf, Q, qrow0, head, fr, fq);
        const bf16_t* kp = K + (size_t)(b * 256) * 256 + kvh * 64; const bf16_t* vp = VT + (size_t)((b * 8) * 4 + kvh) * 2048;
        attn_load(cur, kp, 256, vp, fr, fq);
        for (int c = 0; c < 8; ++c) {
            if (c < 7) attn_load(nxt, kp + (size_t)(32 * (c + 1)) * 256, 256, vp + (size_t)(c + 1) * 4 * 2048, fr, fq);
            attn_compute<0>(st, qf, cur, fr, fq, 0, 0, nullptr);
            cur = nxt;
        }
        attn_finish(st, O, qrow0, head, fr, fq, true, sinkp[head]);
    }
}
__device__ __forceinline__ void attn_phase_b(const bf16_t* Q, const bf16_t* K, const bf16_t* VT, const bf16_t* Kc, const bf16_t* VTc, const float* rpb, bf16_t* O, int gw, int ngw, int lane, LAS float* btab) {
    const int fr = lane & 15, fq = lane >> 4;
    int cur_head = -1;
    for (int t = gw; t < 4096; t += ngw) {
        const int b = t >> 11, rem = t & 2047, head = rem >> 7, qblk = rem & 127, r = qblk >> 1, half = qblk & 1;
        const int seq0 = NCTXROWS + b * 4096, qrow0 = seq0 + qblk * 32;
        if (head != cur_head) { for (int i = lane; i < 465; i += 64) btab[i] = rpb[head * 465 + i] * LOG2E; cur_head = head; asm volatile("s_waitcnt lgkmcnt(0)" ::: "memory"); }
        AttnState st; bf16x8 qf[2][2]; KVFrag cur, nxt;
        attn_init(st, qf, Q, qrow0, head, fr, fq);
        int rs = r - 4; rs = rs < 0 ? 0 : (rs > 56 ? 56 : rs);
        const bf16_t* kcp = Kc + (size_t)(b * 512) * 1024 + head * 64; const bf16_t* vcp = VTc + (size_t)(b * 16 * 16 + head) * 2048;
        const bf16_t* klp = K + (size_t)(seq0 + rs * 64) * 1024 + head * 64; const bf16_t* vlp = VT + (size_t)(((seq0 + rs * 64) >> 5) * 16 + head) * 2048;
        attn_load(cur, kcp, 1024, vcp, fr, fq);
        for (int c = 0; c < 16; ++c) {
            if (c < 15) attn_load(nxt, kcp + (size_t)(32 * (c + 1)) * 1024, 1024, vcp + (size_t)(c + 1) * 16 * 2048, fr, fq);
            else attn_load(nxt, klp, 1024, vlp, fr, fq);
            attn_compute<0>(st, qf, cur, fr, fq, 0, 0, nullptr);
            cur = nxt;
        }
        for (int c = 0; c < 16; ++c) {
            if (c < 15) attn_load(nxt, klp + (size_t)(32 * (c + 1)) * 1024, 1024, vlp + (size_t)(c + 1) * 16 * 2048, fr, fq);
            attn_compute<2>(st, qf, cur, fr, fq, 32 * (c & 1), 32 * half, btab + (rs + (c >> 1) - r + 7) * 31);
            cur = nxt;
        }
        attn_finish(st, O, qrow0, head, fr, fq, false, 0.f);
    }
    for (int t = gw; t < 2048; t += ngw) {
        const int b = t >> 7, rem = t & 127, head = rem >> 3, qblk = rem & 7;
        const int qrow0 = b * 256 + qblk * 32;
        AttnState st; bf16x8 qf[2][2]; KVFrag cur, nxt;
        attn_init(st, qf, Q, qrow0, head, fr, fq);
        const bf16_t* kp = K + (size_t)(b * 256) * 1024 + head * 64; const bf16_t* vp = VT + (size_t)((b * 8) * 16 + head) * 2048;
        attn_load(cur, kp, 1024, vp, fr, fq);
        for (int c = 0; c < 8; ++c) {
            if (c < 7) attn_load(nxt, kp + (size_t)(32 * (c + 1)) * 1024, 1024, vp + (size_t)(c + 1) * 16 * 2048, fr, fq);
            attn_compute<0>(st, qf, cur, fr, fq, 0, 0, nullptr);
            cur = nxt;
        }
        attn_finish(st, O, qrow0, head, fr, fq, false, 0.f);
    }
}


constexpr int KV_LDS_OFF = 16384, KV_BUF_BYTES = 9728, KROW_B = 144, VROW_B = 80, V_OFF = 4608;
__device__ __forceinline__ u32x4 stage_load(const bf16_t* kp, int kld, const bf16_t* vp, int tid) {
    if (tid < 256) return *(const u32x4*)(kp + (size_t)(tid >> 3) * kld + (tid & 7) * 8);
    return *(const u32x4*)(vp + (tid - 256) * 8);
}
__device__ __forceinline__ void stage_store(LAS unsigned char* buf, u32x4 v, int tid) {
    if (tid < 256) *(LAS u32x4*)(buf + (tid >> 3) * KROW_B + (tid & 7) * 16) = v;
    else { const int e = tid - 256; *(LAS u32x4*)(buf + V_OFF + (e >> 2) * VROW_B + (e & 3) * 16) = v; }
}
__device__ __forceinline__ void frag_load(KVFrag& f, const LAS unsigned char* buf, int fr, int fq) {
#pragma unroll
    for (int t = 0; t < 2; ++t)
#pragma unroll
        for (int h2 = 0; h2 < 2; ++h2) f.kf[t][h2] = *(const LAS bf16x8*)(buf + (16 * t + fr) * KROW_B + 64 * h2 + 16 * fq);
#pragma unroll
    for (int dt = 0; dt < 4; ++dt) { const LAS unsigned char* v = buf + V_OFF + (16 * dt + fr) * VROW_B + 8 * fq; const u32x2 lo = *(const LAS u32x2*)v, hi = *(const LAS u32x2*)(v + 32);
        f.vf[dt] = __builtin_bit_cast(bf16x8, ((u32x4){lo.x, lo.y, hi.x, hi.y})); }
}

__device__ __forceinline__ void attn_compute_pair(AttnState& st, const bf16x8 (&qf)[2][2], const LAS unsigned char* ba, const LAS unsigned char* bb, int fr, int fq) {
    bf16x8 pfa[2], pfb[2]; float alpha[2];
    {
        bf16x8 ka[2][2], kb[2][2];
#pragma unroll
        for (int t = 0; t < 2; ++t)
#pragma unroll
            for (int h2 = 0; h2 < 2; ++h2) { ka[t][h2] = *(const LAS bf16x8*)(ba + (16 * t + fr) * KROW_B + 64 * h2 + 16 * fq); kb[t][h2] = *(const LAS bf16x8*)(bb + (16 * t + fr) * KROW_B + 64 * h2 + 16 * fq); }
#pragma unroll
        for (int qb = 0; qb < 2; ++qb) {
            const f32x4 z = (f32x4){0.f, 0.f, 0.f, 0.f};
            f32x4 s0 = MFMA16(ka[0][0], qf[qb][0], z); s0 = MFMA16(ka[0][1], qf[qb][1], s0);
            f32x4 s1 = MFMA16(ka[1][0], qf[qb][0], z); s1 = MFMA16(ka[1][1], qf[qb][1], s1);
            f32x4 s2 = MFMA16(kb[0][0], qf[qb][0], z); s2 = MFMA16(kb[0][1], qf[qb][1], s2);
            f32x4 s3 = MFMA16(kb[1][0], qf[qb][0], z); s3 = MFMA16(kb[1][1], qf[qb][1], s3);
            float sv[16];
#pragma unroll
            for (int j = 0; j < 4; ++j) { sv[j] = s0[j] * SCL2; sv[4 + j] = s1[j] * SCL2; sv[8 + j] = s2[j] * SCL2; sv[12 + j] = s3[j] * SCL2; }
            float cmax = sv[0];
#pragma unroll
            for (int j = 1; j < 16; ++j) cmax = fmaxf(cmax, sv[j]);
            cmax = fmaxf(cmax, __shfl_xor(cmax, 16)); cmax = fmaxf(cmax, __shfl_xor(cmax, 32));
            const float mnew = fmaxf(st.m[qb], cmax);
            alpha[qb] = fast_exp2(st.m[qb] - mnew);
            st.m[qb] = mnew;
            float p[16]; float ps = 0.f;
#pragma unroll
            for (int j = 0; j < 16; ++j) { p[j] = fast_exp2(sv[j] - mnew); ps += p[j]; }
            st.l[qb] = st.l[qb] * alpha[qb] + ps;
            u32x4 pa, pb;
            pa.x = cvt_pk_bf16(p[0], p[1]); pa.y = cvt_pk_bf16(p[2], p[3]); pa.z = cvt_pk_bf16(p[4], p[5]); pa.w = cvt_pk_bf16(p[6], p[7]);
            pb.x = cvt_pk_bf16(p[8], p[9]); pb.y = cvt_pk_bf16(p[10], p[11]); pb.z = cvt_pk_bf16(p[12], p[13]); pb.w = cvt_pk_bf16(p[14], p[15]);
            pfa[qb] = __builtin_bit_cast(bf16x8, pa); pfb[qb] = __builtin_bit_cast(bf16x8, pb);
        }
    }
#pragma unroll
    for (int dt = 0; dt < 4; ++dt) {
        const LAS unsigned char* va = ba + V_OFF + (16 * dt + fr) * VROW_B + 8 * fq; const LAS unsigned char* vb_ = bb + V_OFF + (16 * dt + fr) * VROW_B + 8 * fq;
        const u32x2 alo = *(const LAS u32x2*)va, ahi = *(const LAS u32x2*)(va + 32), blo = *(const LAS u32x2*)vb_, bhi = *(const LAS u32x2*)(vb_ + 32);
        const bf16x8 vfa = __builtin_bit_cast(bf16x8, ((u32x4){alo.x, alo.y, ahi.x, ahi.y})), vfb = __builtin_bit_cast(bf16x8, ((u32x4){blo.x, blo.y, bhi.x, bhi.y}));
#pragma unroll
        for (int qb = 0; qb < 2; ++qb) { st.o[qb][dt] = st.o[qb][dt] * alpha[qb]; st.o[qb][dt] = MFMA16(vfa, pfa[qb], st.o[qb][dt]); st.o[qb][dt] = MFMA16(vfb, pfb[qb], st.o[qb][dt]); }
    }
}
__device__ __forceinline__ void attn_pairs(AttnState& st, const bf16x8 (&qf)[2][2], const bf16_t* kp, int kld, const bf16_t* vp, int vstride, int NP, bool has_next, const bf16_t* kp2, const bf16_t* vp2,
                                           LAS unsigned char* kvb, int tid, int fr, int fq) {
    u32x4 sr0 = stage_load(kp, kld, vp, tid), sr1 = stage_load(kp + (size_t)32 * kld, kld, vp + vstride, tid);
    stage_store(kvb, sr0, tid); stage_store(kvb + KV_BUF_BYTES, sr1, tid);
    __syncthreads();
    for (int sp = 0; sp < NP; ++sp) {
        const bool more = sp + 1 < NP;
        if (more) { sr0 = stage_load(kp + (size_t)(32 * (2 * sp + 2)) * kld, kld, vp + (size_t)(2 * sp + 2) * vstride, tid); sr1 = stage_load(kp + (size_t)(32 * (2 * sp + 3)) * kld, kld, vp + (size_t)(2 * sp + 3) * vstride, tid); }
        else if (has_next) sr0 = stage_load(kp2, kld, vp2, tid);
        const LAS unsigned char* buf = kvb + (sp & 1) * 2 * KV_BUF_BYTES;
        attn_compute_pair(st, qf, buf, buf + KV_BUF_BYTES, fr, fq);
        LAS unsigned char* nb_ = kvb + ((sp + 1) & 1) * 2 * KV_BUF_BYTES;
        if (more) { stage_store(nb_, sr0, tid); stage_store(nb_ + KV_BUF_BYTES, sr1, tid); }
        else if (has_next) stage_store(nb_, sr0, tid);
        __syncthreads();
    }
}
__device__ __forceinline__ void attn_groups_a(const bf16_t* Q, const bf16_t* K, const bf16_t* VT, const bf16_t* Kc, const bf16_t* VTc, const float* sinkp, bf16_t* O, int vb, int nb, int tid, LAS unsigned char* lds) {
    const int lane = tid & 63, wave = __builtin_amdgcn_readfirstlane(tid >> 6), fr = lane & 15, fq = lane >> 4;
    LAS unsigned char* kvb = lds + KV_LDS_OFF;
    for (int g = vb; g < 512; g += nb) {
        const int t = g * 8 + wave;
        const int b = t >> 11, rem = t & 2047, kvh = rem >> 9, rem2 = rem & 511, qp = rem2 >> 3, qblk = (qp << 1) | (rem2 & 1), gh = (rem2 & 7) >> 1;
        const int head = kvh * 4 + gh, qpos0 = qblk * 32, seq0 = NCTXROWS + b * 4096, qrow0 = seq0 + qpos0;
        const int cmin = 2 * qp - 4 < 0 ? 0 : 2 * qp - 4, cmax = 2 * qp + 5 > 127 ? 127 : 2 * qp + 5, nsteps = 16 + (cmax - cmin + 1);
        AttnState st; bf16x8 qf[2][2]; KVFrag f;
        attn_init(st, qf, Q, qrow0, head, fr, fq);
        const bf16_t* kcp = Kc + (size_t)(b * 512) * 256 + kvh * 64; const bf16_t* vcp = VTc + (size_t)(b * 16 * 4 + kvh) * 2048;
        const bf16_t* klp = K + (size_t)seq0 * 256 + kvh * 64; const bf16_t* vlp = VT + (size_t)((seq0 >> 5) * 4 + kvh) * 2048;
        attn_pairs(st, qf, kcp, 256, vcp, 4 * 2048, 8, true, klp + (size_t)(32 * cmin) * 256, vlp + (size_t)cmin * 4 * 2048, kvb, tid, fr, fq);
        { const int nloc = nsteps - 16; u32x4 sr;
        for (int i = 0; i < nloc; ++i) { const int c = cmin + i;
            if (i + 1 < nloc) sr = stage_load(klp + (size_t)(32 * (c + 1)) * 256, 256, vlp + (size_t)(c + 1) * 4 * 2048, tid);
            if (c >= qblk - 4 && c <= qblk + 4) { frag_load(f, kvb + (i & 1) * 2 * KV_BUF_BYTES, fr, fq); attn_compute<1>(st, qf, f, fr, fq, 32 * c - qpos0, 0, nullptr); }
            if (i + 1 < nloc) stage_store(kvb + ((i + 1) & 1) * 2 * KV_BUF_BYTES, sr, tid);
            __syncthreads(); } }
        attn_finish(st, O, qrow0, head, fr, fq, true, sinkp[head]);
    }
    for (int g = vb; g < 256; g += nb) {
        const int t = g * 8 + wave;
        const int b = t >> 7, rem = t & 127, kvh = rem >> 5, rem2 = rem & 31, qblk = ((rem2 >> 3) << 1) | (rem2 & 1), gh = (rem2 & 7) >> 1;
        const int head = kvh * 4 + gh, qrow0 = b * 256 + qblk * 32;
        AttnState st; bf16x8 qf[2][2]; KVFrag f;
        attn_init(st, qf, Q, qrow0, head, fr, fq);
        const bf16_t* kp = K + (size_t)(b * 256) * 256 + kvh * 64; const bf16_t* vp = VT + (size_t)((b * 8) * 4 + kvh) * 2048;
        attn_pairs(st, qf, kp, 256, vp, 4 * 2048, 4, false, kp, vp, kvb, tid, fr, fq);
        attn_finish(st, O, qrow0, head, fr, fq, true, sinkp[head]);
    }
}
__device__ __forceinline__ void attn_groups_b(const bf16_t* Q, const bf16_t* K, const bf16_t* VT, const bf16_t* Kc, const bf16_t* VTc, const float* rpb, bf16_t* O, int vb, int nb, int tid, LAS unsigned char* lds) {
    const int lane = tid & 63, wave = __builtin_amdgcn_readfirstlane(tid >> 6), fr = lane & 15, fq = lane >> 4;
    LAS unsigned char* kvb = lds + KV_LDS_OFF;
    LAS float* btab = (LAS float*)(lds + wave * 2048);
    for (int g = vb; g < 512; g += nb) {
        const int b = g >> 8, head = (g >> 4) & 15, r0 = 4 * (g & 15), qblk = 2 * r0 + wave, r = r0 + (wave >> 1), half = wave & 1;
        const int seq0 = NCTXROWS + b * 4096, qrow0 = seq0 + qblk * 32;
        for (int i = lane; i < 465; i += 64) btab[i] = rpb[head * 465 + i] * LOG2E;
        int rmin = r0 - 4; rmin = rmin < 0 ? 0 : (rmin > 56 ? 56 : rmin);
        int rmax = r0 - 1; rmax = (rmax < 0 ? 0 : (rmax > 56 ? 56 : rmax)) + 7;
        int rs = r - 4; rs = rs < 0 ? 0 : (rs > 56 ? 56 : rs);
        const int nsteps = 16 + 2 * (rmax - rmin + 1);
        AttnState st; bf16x8 qf[2][2]; KVFrag f;
        attn_init(st, qf, Q, qrow0, head, fr, fq);
        const bf16_t* kcp = Kc + (size_t)(b * 512) * 1024 + head * 64; const bf16_t* vcp = VTc + (size_t)(b * 16 * 16 + head) * 2048;
        const bf16_t* klp = K + (size_t)(seq0 + rmin * 64) * 1024 + head * 64; const bf16_t* vlp = VT + (size_t)(((seq0 + rmin * 64) >> 5) * 16 + head) * 2048;
        attn_pairs(st, qf, kcp, 1024, vcp, 16 * 2048, 8, true, klp, vlp, kvb, tid, fr, fq);
        { const int nloc = nsteps - 16; u32x4 sr;
        for (int i = 0; i < nloc; ++i) { const int kr = rmin + (i >> 1);
            if (i + 1 < nloc) sr = stage_load(klp + (size_t)(32 * (i + 1)) * 1024, 1024, vlp + (size_t)(i + 1) * 16 * 2048, tid);
            if (kr >= rs && kr <= rs + 7) { frag_load(f, kvb + (i & 1) * 2 * KV_BUF_BYTES, fr, fq); attn_compute<2>(st, qf, f, fr, fq, 32 * (i & 1), 32 * half, btab + (kr - r + 7) * 31); }
            if (i + 1 < nloc) stage_store(kvb + ((i + 1) & 1) * 2 * KV_BUF_BYTES, sr, tid);
            __syncthreads(); } }
        attn_finish(st, O, qrow0, head, fr, fq, false, 0.f);
    }
    for (int g = vb; g < 256; g += nb) {
        const int b = g >> 4, head = g & 15, qblk = wave;
        const int qrow0 = b * 256 + qblk * 32;
        AttnState st; bf16x8 qf[2][2]; KVFrag f;
        attn_init(st, qf, Q, qrow0, head, fr, fq);
        const bf16_t* kp = K + (size_t)(b * 256) * 1024 + head * 64; const bf16_t* vp = VT + (size_t)((b * 8) * 16 + head) * 2048;
        attn_pairs(st, qf, kp, 1024, vp, 16 * 2048, 4, false, kp, vp, kvb, tid, fr, fq);
        attn_finish(st, O, qrow0, head, fr, fq, false, 0.f);
    }
}

__device__ __forceinline__ void transpose_item(const float* W, int K, int N, bf16_t* WT, int kb, int nb, int dst_n0, LAS float* scr, int lane) {
    const int k0 = 64 * kb, n0 = 32 * nb;
#pragma unroll 8
    for (int i = 0; i < 32; ++i) { const int kk = 2 * i + (lane >> 5); scr[kk * 33 + (lane & 31)] = W[(size_t)(k0 + kk) * N + n0 + (lane & 31)]; }
    asm volatile("s_waitcnt lgkmcnt(0)" ::: "memory");
    const int c = lane & 7;
#pragma unroll
    for (int j = 0; j < 4; ++j) { const int n = (lane >> 3) + 8 * j; const LAS float* s = scr + (8 * c) * 33 + n;
        u32x4 o; o.x = cvt_pk_bf16(s[0 * 33], s[1 * 33]); o.y = cvt_pk_bf16(s[2 * 33], s[3 * 33]); o.z = cvt_pk_bf16(s[4 * 33], s[5 * 33]); o.w = cvt_pk_bf16(s[6 * 33], s[7 * 33]);
        *(u32x4*)(WT + (size_t)(dst_n0 + n) * K + k0 + 8 * c) = o; }
    asm volatile("s_waitcnt lgkmcnt(0)" ::: "memory");
}
__device__ __forceinline__ int up_perm(int o) { return o < DFF ? 256 * (o / 128) + (o % 128) : 256 * ((o - DFF) / 128) + 128 + ((o - DFF) % 128); }
__device__ __forceinline__ int qkv_perm(int o) { return (o & ~255) + 128 * ((o >> 5) & 1) + 32 * ((o >> 6) & 3); }

__device__ __forceinline__ void prologue(const Args& a, LAS unsigned char* lds, int tid, int lane, int wave) {
    unsigned char* ws = a.ws;
    const int G = gridDim.x, bx = blockIdx.x;
    {
        LAS float* sc = (LAS float*)lds;
        LAS float* red = (LAS float*)(lds + 16384);
        bool have = false;
        for (int it = bx; it < 192; it += G) {
            if (!have) { for (int k = tid; k < 3072; k += NTHR) { const int cnd = k >> 10, kk = k & 1023; const float x = cnd == 0 ? a.in[7][kk] : a.in[6][(cnd - 1) * 1024 + kk]; sc[k] = silu_f(x); } have = true; }
            __syncthreads();
            const int l = it / 96, n0 = (it % 96) * 64;
            const float* W = a.in[10] + (size_t)l * 1024 * 6144 + n0;
            const int c4 = tid & 15, ks = tid >> 4;
            f32x4 a0 = (f32x4){0.f, 0.f, 0.f, 0.f}, a1 = a0, a2 = a0;
#pragma unroll 8
            for (int kk = 0; kk < 32; ++kk) { const int k = ks * 32 + kk; const f32x4 w = *(const f32x4*)(W + (size_t)k * 6144 + 4 * c4);
                a0 += w * sc[k]; a1 += w * sc[1024 + k]; a2 += w * sc[2048 + k]; }
#pragma unroll
            for (int j = 0; j < 4; ++j) { red[(ks * 3 + 0) * 64 + 4 * c4 + j] = a0[j]; red[(ks * 3 + 1) * 64 + 4 * c4 + j] = a1[j]; red[(ks * 3 + 2) * 64 + 4 * c4 + j] = a2[j]; }
            __syncthreads();
            if (tid < 192) { const int cnd = tid >> 6, col = tid & 63; float s = 0.f;
#pragma unroll 8
                for (int q = 0; q < 32; ++q) s += red[(q * 3 + cnd) * 64 + col];
                ((float*)(ws + WS_MOD))[(l * 3 + cnd) * 6144 + n0 + col] = s + a.in[11][l * 6144 + n0 + col]; }
        }
        __syncthreads();
    }
    const int gw = bx * NWAVES + wave, NGW = G * NWAVES;
    const size_t gt = (size_t)bx * NTHR + tid, NT = (size_t)G * NTHR;
    if (gt < 1024) { const int pos = (int)gt >> 4, f = (int)gt & 15; const float freq = exp2f(-(float)f * (13.287712379549449f / 16.0f)); const float ang = (float)pos * freq;
        float* rp = (float*)(ws + WS_ROPE); rp[2 * gt] = cosf(ang); rp[2 * gt + 1] = sinf(ang); }
    {
        LAS float* scr = (LAS float*)(lds + wave * 16384);
        constexpr int I_QA = 16 * 48, I_QB = 16 * 96, I_O = 16 * 32, I_UP = 16 * 176, I_DN = 44 * 32;
        constexpr int NITEMS = I_QA + I_QB + 2 * I_O + 2 * I_UP + 2 * I_DN;
        for (int it = gw; it < NITEMS; it += NGW) {
            int r = it;
            if (r < I_QA) { const int kb = r / 48, nb = r % 48; transpose_item(a.in[12], 1024, 1536, (bf16_t*)(ws + WS_WQKVA), kb, nb, qkv_perm(32 * nb), scr, lane); continue; } r -= I_QA;
            if (r < I_QB) { const int kb = r / 96, nb = r % 96; transpose_item(a.in[17], 1024, 3072, (bf16_t*)(ws + WS_WQKVB), kb, nb, qkv_perm(32 * nb), scr, lane); continue; } r -= I_QB;
            if (r < I_O) { const int kb = r / 32, nb = r % 32; transpose_item(a.in[16], 1024, 1024, (bf16_t*)(ws + WS_WOA), kb, nb, 32 * nb, scr, lane); continue; } r -= I_O;
            if (r < I_O) { const int kb = r / 32, nb = r % 32; transpose_item(a.in[21], 1024, 1024, (bf16_t*)(ws + WS_WOB), kb, nb, 32 * nb, scr, lane); continue; } r -= I_O;
            if (r < 2 * I_UP) { const int l = r / I_UP; r -= l * I_UP; const int kb = r / 176, nb = r % 176;
                transpose_item(a.in[22] + (size_t)l * 1024 * 5632, 1024, 5632, (bf16_t*)(ws + (l ? WS_WUP1 : WS_WUP0)), kb, nb, up_perm(32 * nb), scr, lane); continue; } r -= 2 * I_UP;
            { const int l = r / I_DN; r -= l * I_DN; const int kb = r / 32, nb = r % 32;
                transpose_item(a.in[25] + (size_t)l * 2816 * 1024, 2816, 1024, (bf16_t*)(ws + (l ? WS_WDN1 : WS_WDN0)), kb, nb, 32 * nb, scr, lane); }
        }
    }
    {
        bf16_t* kca = (bf16_t*)(ws + WS_KCA); bf16_t* kcb = (bf16_t*)(ws + WS_KCB); bf16_t* vca = (bf16_t*)(ws + WS_VTCA); bf16_t* vcb = (bf16_t*)(ws + WS_VTCB);
        for (size_t i = gt; i < 262144; i += NT) kca[i] = (bf16_t)f2bf(a.in[2][i]);
        for (size_t i = gt; i < 1048576; i += NT) kcb[i] = (bf16_t)f2bf(a.in[4][i]);
        for (size_t i = gt; i < 262144; i += NT) { const int tt = (int)i & 31, d = ((int)i >> 5) & 63, kvh = ((int)i >> 11) & 3, c = ((int)i >> 13) & 15, b = (int)i >> 17;
            vca[i] = (bf16_t)f2bf(a.in[3][((size_t)(b * 512 + c * 32 + tt) * 4 + kvh) * 64 + d]); }
        for (size_t i = gt; i < 1048576; i += NT) { const int tt = (int)i & 31, d = ((int)i >> 5) & 63, kvh = ((int)i >> 11) & 15, c = ((int)i >> 15) & 15, b = (int)i >> 19;
            vcb[i] = (bf16_t)f2bf(a.in[5][((size_t)(b * 512 + c * 32 + tt) * 16 + kvh) * 64 + d]); }
    }
}
__device__ __forceinline__ void norm_mod_phase(const float* xa, const float* xb, const float* nw, const float* shift, const float* scale, bf16_t* H, int gw, int ngw, int lane) {
    for (int row0 = gw; row0 < MTOK; row0 += 2 * ngw) {
        const int row1 = row0 + ngw; const bool two = row1 < MTOK; const int rowb = two ? row1 : row0;
        const float* xr0 = row0 < NCTXROWS ? xa + (size_t)row0 * DM : xb + (size_t)(row0 - NCTXROWS) * DM;
        const float* xr1 = rowb < NCTXROWS ? xa + (size_t)rowb * DM : xb + (size_t)(rowb - NCTXROWS) * DM;
        const int cond0 = row0 < NCTXROWS ? 0 : 1 + ((row0 - NCTXROWS) >> 12), cond1 = rowb < NCTXROWS ? 0 : 1 + ((rowb - NCTXROWS) >> 12);
        f32x4 v0[4], v1[4]; float s0 = 0.f, s1 = 0.f;
#pragma unroll
        for (int j = 0; j < 4; ++j) { v0[j] = *(const f32x4*)(xr0 + 4 * (lane + 64 * j)); v1[j] = *(const f32x4*)(xr1 + 4 * (lane + 64 * j)); }
#pragma unroll
        for (int j = 0; j < 4; ++j) { const f32x4 t0 = v0[j] * v0[j], t1 = v1[j] * v1[j]; s0 += (t0[0] + t0[1]) + (t0[2] + t0[3]); s1 += (t1[0] + t1[1]) + (t1[2] + t1[3]); }
#pragma unroll
        for (int o = 1; o < 64; o <<= 1) { s0 += __shfl_xor(s0, o); s1 += __shfl_xor(s1, o); }
        const float r0 = rsqrtf(s0 * (1.0f / DM) + EPSN), r1 = rsqrtf(s1 * (1.0f / DM) + EPSN);
#pragma unroll
        for (int j = 0; j < 4; ++j) { const int col = 4 * (lane + 64 * j);
            const f32x4 w = *(const f32x4*)(nw + col);
            const f32x4 sc0 = *(const f32x4*)(scale + cond0 * 6144 + col), sh0 = *(const f32x4*)(shift + cond0 * 6144 + col);
            const f32x4 y0 = (v0[j] * r0 * w) * (sc0 + 1.0f) + sh0;
            u32x2 o0; o0.x = cvt_pk_bf16(y0[0], y0[1]); o0.y = cvt_pk_bf16(y0[2], y0[3]);
            *(u32x2*)(H + (size_t)row0 * DM + col) = o0;
            if (two) { const f32x4 sc1 = *(const f32x4*)(scale + cond1 * 6144 + col), sh1 = *(const f32x4*)(shift + cond1 * 6144 + col);
                const f32x4 y1 = (v1[j] * r1 * w) * (sc1 + 1.0f) + sh1;
                u32x2 o1; o1.x = cvt_pk_bf16(y1[0], y1[1]); o1.y = cvt_pk_bf16(y1[2], y1[3]);
                *(u32x2*)(H + (size_t)row1 * DM + col) = o1; } }
    }
}
__device__ __forceinline__ void conv_act_phase(const bf16_t* U, const float* cw, const float* cb, bf16_t* ACT, size_t gt, size_t nt) {
    for (size_t item = gt; item < (size_t)384 * 352; item += nt) {
        const int rb = (int)(item / 352), fg = (int)(item % 352), r0 = rb * 32, f0 = fg * 8;
        const int pos0 = r0 < NCTXROWS ? (r0 & 255) : (r0 & 4095), L = r0 < NCTXROWS ? 256 : 4096;
        const bool has_prev = pos0 > 0, has_next = pos0 + 32 < L;
        float wg[3][8], wv[3][8], bg[8], bv[8];
#pragma unroll
        for (int o = 0; o < 3; ++o)
#pragma unroll
            for (int j = 0; j < 8; ++j) { wg[o][j] = cw[o * DUP + f0 + j]; wv[o][j] = cw[o * DUP + DFF + f0 + j]; }
#pragma unroll
        for (int j = 0; j < 8; ++j) { bg[j] = cb[f0 + j]; bv[j] = cb[DFF + f0 + j]; }
        const u32x4 z4 = (u32x4){0u, 0u, 0u, 0u};
        const bf16_t* up = U + (size_t)r0 * DUP + f0;
        u32x4 gp = z4, vp = z4, gc, vc, gn, vn;
        if (has_prev) { gp = *(const u32x4*)(up - DUP); vp = *(const u32x4*)(up - DUP + DFF); }
        gc = *(const u32x4*)up; vc = *(const u32x4*)(up + DFF);
        for (int r = 0; r < 32; ++r) {
            gn = z4; vn = z4;
            if (r < 31 || has_next) { gn = *(const u32x4*)(up + (size_t)(r + 1) * DUP); vn = *(const u32x4*)(up + (size_t)(r + 1) * DUP + DFF); }
            float res[8];
#pragma unroll
            for (int q = 0; q < 4; ++q) {
                const float g0 = wg[0][2 * q] * bflo(gp[q]) + wg[1][2 * q] * bflo(gc[q]) + wg[2][2 * q] * bflo(gn[q]) + bg[2 * q];
                const float g1 = wg[0][2 * q + 1] * bfhi(gp[q]) + wg[1][2 * q + 1] * bfhi(gc[q]) + wg[2][2 * q + 1] * bfhi(gn[q]) + bg[2 * q + 1];
                const float v0 = wv[0][2 * q] * bflo(vp[q]) + wv[1][2 * q] * bflo(vc[q]) + wv[2][2 * q] * bflo(vn[q]) + bv[2 * q];
                const float v1 = wv[0][2 * q + 1] * bfhi(vp[q]) + wv[1][2 * q + 1] * bfhi(vc[q]) + wv[2][2 * q + 1] * bfhi(vn[q]) + bv[2 * q + 1];
                res[2 * q] = silu_f(g0) * v0; res[2 * q + 1] = silu_f(g1) * v1;
            }
            u32x4 o; o.x = cvt_pk_bf16(res[0], res[1]); o.y = cvt_pk_bf16(res[2], res[3]); o.z = cvt_pk_bf16(res[4], res[5]); o.w = cvt_pk_bf16(res[6], res[7]);
            *(u32x4*)(ACT + (size_t)(r0 + r) * DFF + f0) = o;
            gp = gc; vp = vc; gc = gn; vc = vn;
        }
    }
}

__global__ void __launch_bounds__(NTHR, 2) mk_fwd(Args a) {
    extern __shared__ __attribute__((aligned(16))) unsigned char lds_raw[];
    cg::grid_group grid = cg::this_grid();
    LAS unsigned char* lds = (LAS unsigned char*)lds_raw;
    const int tid = threadIdx.x, lane = tid & 63, wave = __builtin_amdgcn_readfirstlane(tid >> 6);
    const int G = gridDim.x, bx = blockIdx.x;
    const int gw = bx * NWAVES + wave, NGW = G * NWAVES;
    const size_t gt = (size_t)bx * NTHR + tid, NT = (size_t)G * NTHR;
    unsigned char* ws = a.ws;
    float* out = a.out;
    bf16_t* H = (bf16_t*)(ws + WS_H); bf16_t* ACT = (bf16_t*)(ws + WS_ACT); bf16_t* U = (bf16_t*)(ws + WS_U);
    bf16_t* Qb = (bf16_t*)(ws + WS_Q); bf16_t* Kb = (bf16_t*)(ws + WS_K); bf16_t* VTb = (bf16_t*)(ws + WS_VT); bf16_t* Ob = (bf16_t*)(ws + WS_O);
    const float* rope = (const float*)(ws + WS_ROPE);

#ifndef NO_PRO
    for (int rep = 0; rep < REP_THIN; ++rep) { prologue(a, lds, tid, lane, wave); __syncthreads(); }
#endif
    volatile LAS unsigned* bst = (volatile LAS unsigned*)(lds + 131072 + 64);
    if (tid < 2) bst[tid] = 0u;
    unsigned* barw = (unsigned*)(ws + WS_BAR);
    if (bx == 0) for (int i = tid; i < XCD_BAR_WORDS; i += NTHR) barw[i] = 0u;
    grid.sync();
    const XcdBarrier xbar = xcd_barrier_post(barw, bst);
#define GSYNC() xcd_barrier(xbar)

#pragma unroll 1
    for (int layer = 0; layer < 2; ++layer) {
        const float* mod = (const float*)(ws + WS_MOD) + layer * 3 * 6144;
        const float* xa = layer == 0 ? a.in[0] : out;
        const float* xb = layer == 0 ? a.in[1] : out + (size_t)NCTXROWS * DM;
#ifndef NO_NORM
        for (int rep = 0; rep < REP_THIN; ++rep)
        { int tl = tid; asm volatile("" : "+v"(tl)); const int wv = __builtin_amdgcn_readfirstlane(tl >> 6);
          norm_mod_phase(xa, xb, a.in[8] + layer * DM, mod + 0 * 1024, mod + 1 * 1024, H, bx * NWAVES + wv, NGW, tl & 63); }
#endif
        GSYNC();
#ifndef NO_QKV
        if (layer == 0) {
            pg8::Gemm g{H, (const bf16_t*)(ws + WS_WQKVA), MTOK, 1536, 1024}; pg8::StaticOrder S; int bxl = bx; asm volatile("" : "+s"(bxl)); int tl = tid; asm volatile("" : "+v"(tl)); S.init(MTOK, 1536, G, bxl);
            EpiQKV<4> E{Qb, Kb, VTb, out + OUT_KA, out + OUT_VA, a.in[13], a.in[14], rope};
            pg8::gemm_phase<EpiQKV<4>, pg8::StaticOrder, true, true>(lds, g, S, E, tl);
        } else {
            pg8::Gemm g{H, (const bf16_t*)(ws + WS_WQKVB), MTOK, 3072, 1024}; pg8::StaticOrder S; int bxl = bx; asm volatile("" : "+s"(bxl)); int tl = tid; asm volatile("" : "+v"(tl)); S.init(MTOK, 3072, G, bxl);
            EpiQKV<16> E{Qb, Kb, VTb, out + OUT_KB, out + OUT_VB, a.in[18], a.in[19], rope};
            pg8::gemm_phase<EpiQKV<16>, pg8::StaticOrder, true, true>(lds, g, S, E, tl);
        }
#endif
        GSYNC();
#ifndef NO_ATTN
        for (int rep = 0; rep < REP_ATTN; ++rep)
        { int tl = tid; asm volatile("" : "+v"(tl));
        if (layer == 0) attn_groups_a(Qb, Kb, VTb, (const bf16_t*)(ws + WS_KCA), (const bf16_t*)(ws + WS_VTCA), a.in[15], Ob, bx, G, tl, lds);
        else attn_groups_b(Qb, Kb, VTb, (const bf16_t*)(ws + WS_KCB), (const bf16_t*)(ws + WS_VTCB), a.in[20], Ob, bx, G, tl, lds); }
#endif
        GSYNC();
#ifndef NO_OPROJ
        {
            pg8::Gemm g{Ob, (const bf16_t*)(ws + (layer ? WS_WOB : WS_WOA)), MTOK, 1024, 1024}; pg8::StaticOrder S; int bxl = bx; asm volatile("" : "+s"(bxl)); int tl = tid; asm volatile("" : "+v"(tl)); S.init(MTOK, 1024, G, bxl);
            EpiResid E{xa, xb, out, mod + 2 * 1024};
            pg8::gemm_phase<EpiResid, pg8::StaticOrder, true, true>(lds, g, S, E, tl);
        }
#endif
        GSYNC();
#ifndef NO_NORM
        for (int rep = 0; rep < REP_THIN; ++rep)
        { int tl = tid; asm volatile("" : "+v"(tl)); const int wv = __builtin_amdgcn_readfirstlane(tl >> 6);
          norm_mod_phase(out, out + (size_t)NCTXROWS * DM, a.in[9] + layer * DM, mod + 3 * 1024, mod + 4 * 1024, H, bx * NWAVES + wv, NGW, tl & 63); }
#endif
        GSYNC();
#ifndef NO_UP
        {
            pg8::Gemm g{H, (const bf16_t*)(ws + (layer ? WS_WUP1 : WS_WUP0)), 50 * 256, DUP, 1024}; pg8::StaticOrder S; int bxl = bx; asm volatile("" : "+s"(bxl)); int tl = tid; asm volatile("" : "+v"(tl)); S.init(50 * 256, DUP, G, bxl);
            EpiUpConv E{ACT, a.in[23] + (size_t)layer * 3 * DUP, a.in[24] + (size_t)layer * DUP, (LAS float*)(lds + 131072 + 1024)};
            pg8::gemm_phase<EpiUpConv, pg8::StaticOrder, true, true>(lds, g, S, E, tl);
        }
#endif
        GSYNC();
#ifndef NO_DOWN
        {
            pg8::Gemm g{ACT, (const bf16_t*)(ws + (layer ? WS_WDN1 : WS_WDN0)), MTOK, 1024, DFF}; pg8::StaticOrder S; int bxl = bx; asm volatile("" : "+s"(bxl)); int tl = tid; asm volatile("" : "+v"(tl)); S.init(MTOK, 1024, G, bxl);
            EpiResid E{out, out + (size_t)NCTXROWS * DM, out, mod + 5 * 1024};
            pg8::gemm_phase<EpiResid, pg8::StaticOrder, true, true>(lds, g, S, E, tl);
        }
#endif
        if (layer == 0) GSYNC();
    }
}

extern "C" void kernel_launch(void* const* d_in, const int* in_sizes, int n_in, void* d_out, int out_size, void* d_ws, size_t ws_size, hipStream_t stream) {
    static int grid = 0;
    if (grid == 0) {
        if (n_in != 26 || out_size != 23068672 || ws_size < WS_END) { fprintf(stderr, "kernel_launch: unexpected shapes n_in %d out %d ws %zu\n", n_in, out_size, ws_size); grid = -1; return; }
        int dev = 0, cus = 0, per_cu = 0;
        hipGetDevice(&dev);
        hipDeviceGetAttribute(&cus, hipDeviceAttributeMultiprocessorCount, dev);
        hipFuncSetAttribute((const void*)mk_fwd, hipFuncAttributeMaxDynamicSharedMemorySize, LDS_BYTES);
        hipOccupancyMaxActiveBlocksPerMultiprocessor(&per_cu, (const void*)mk_fwd, NTHR, LDS_BYTES);
        if (per_cu < 1) per_cu = 1;
        grid = cus * per_cu;
    }
    if (grid < 0) return;
    Args a{};
    for (int i = 0; i < 26; ++i) a.in[i] = (const float*)d_in[i];
    a.out = (float*)d_out; a.ws = (unsigned char*)d_ws;
    void* args[] = {&a};
    hipError_t e = hipLaunchCooperativeKernel((const void*)mk_fwd, dim3(grid), dim3(NTHR), args, LDS_BYTES, stream);
    if (e != hipSuccess) fprintf(stderr, "cooperative launch failed: %s (grid %d)\n", hipGetErrorString(e), grid);
}
```

```cpp
#include <hip/hip_runtime.h>
#include <hip/hip_cooperative_groups.h>
#include <cstdio>
#include <cstdint>
namespace cg = cooperative_groups;
namespace pg8 {
#define PG8_LAS __attribute__((address_space(3)))
typedef unsigned short bf16_t;
typedef short bf16x8 __attribute__((ext_vector_type(8)));
typedef float f32x4 __attribute__((ext_vector_type(4)));
typedef unsigned u32x4 __attribute__((ext_vector_type(4)));
constexpr int BM = 256, BK = 64, HALF = 128, HTB = HALF * BK * 2  , STAGE_BYTES = 8 * HTB, NXCD = 8, WGM = 8;

__host__ __device__ __forceinline__ int lds_byte(int r, int c) { const int st = (r >> 4) * 2 + (c >> 5), rr = r & 15, cc = c & 31, ob = rr * 64 + cc * 2; return st * 1024 + (ob ^ (((ob >> 9) & 1) << 5)); }
__host__ __device__ __forceinline__ void stage_rc(int b, int& R, int& C) { const int st = b / 1024, sb = b % 1024, swz = sb ^ (((sb >> 9) & 1) << 5); R = (st >> 1) * 16 + swz / 64; C = (st & 1) * 32 + (swz % 64) / 2; }
__host__ __device__ __forceinline__ int perm32(int rho) { const int n = rho >> 4, i = rho & 15; return 8 * (i >> 2) + 4 * n + (i & 3); }

struct Unit { int pm, pn; };
struct Gemm { const bf16_t* A; const bf16_t* Bt; int M, N, K; };

struct StaticOrder {
    int nM, nN, nwg, G, c;
    __host__ __device__ void init(int M, int N, int G_, int c_) { nM = M / BM; nN = N / BM; nwg = nM * nN; G = G_; c = c_; }
    __host__ __device__ bool next(int i, Unit& u) const {
        const long L = (long)i * G + c; if (L >= nwg) return false;
        int wgid = (int)L; { const int q = nwg / NXCD, r = nwg % NXCD, xcd = wgid % NXCD, off = wgid / NXCD; wgid = (xcd < r ? xcd * (q + 1) : r * (q + 1) + (xcd - r) * q) + off; }
        const int nig = WGM * nN, gid = wgid / nig, fm = gid * WGM, gsz = (nM - fm) < WGM ? (nM - fm) : WGM;
        u.pm = fm + ((wgid % nig) % gsz); u.pn = (wgid % nig) / gsz; return true;
    }
    __device__ __forceinline__ void a_ready(const Unit&) const {}
    __device__ __forceinline__ void done(const Unit&) const {}
};

__device__ __forceinline__ unsigned cvt_pk_bf16(float lo, float hi) { unsigned r; asm volatile("v_cvt_pk_bf16_f32 %0, %1, %2" : "=v"(r) : "v"(lo), "v"(hi)); return r; }
template <class Epi, class Sched, bool ALIGN_EPI = false, bool SP2 = false>
__device__ __forceinline__ void gemm_phase(PG8_LAS unsigned char* lds, const Gemm g, const Sched& S, const Epi& E, const int tid_in) {
    const int tid = tid_in, wid = __builtin_amdgcn_readfirstlane(tid >> 6), lane = tid & 63, wr = wid >> 2, wc = wid & 3, fr = lane & 15, fq = lane >> 4;
    const int K = g.K, nt = K / BK;
    unsigned voffA[2], voffB[2];
#pragma unroll
    for (int i = 0; i < 2; ++i) { int R, C; stage_rc(tid * 16 + i * 8192, R, C); const int Rb = Epi::PERM ? ((R & ~31) + perm32(R & 31)) : R;
        voffA[i] = (unsigned)(R * K + C) * 2u; voffB[i] = (unsigned)(Rb * K + C) * 2u; }
    const size_t kstep = (size_t)(BK * 2);
    const size_t hstep = (size_t)HALF * K * 2;
    const size_t tstep = 2 * hstep;
    const unsigned ldsw = (unsigned)wid * 1024u;
    const int aoff = lds_byte(wr * 64 + fr, fq * 8), boff = lds_byte(wc * 32 + fr, fq * 8);
#define PG8_SA(b, h) (((b) * 2 + (h)) * HTB)
#define PG8_SB(b, h) ((4 + (b) * 2 + (h)) * HTB)
#define PG8_STAGE(bufoff, gbase, voff) do { _Pragma("unroll") for (int _i = 0; _i < 2; ++_i) \
        __builtin_amdgcn_global_load_lds((const unsigned*)((const char*)(gbase) + (voff)[_i]), (PG8_LAS unsigned*)(lds + (bufoff) + ldsw + _i * 8192), 16, 0, 0); } while (0)
#define PG8_LDA(dst, b, h) do { _Pragma("unroll") for (int m = 0; m < 4; ++m) _Pragma("unroll") for (int k = 0; k < 2; ++k) dst[m][k] = *(const PG8_LAS bf16x8*)(lds + PG8_SA(b, h) + aoff + m * 2048 + k * 1024); } while (0)
#define PG8_LDB(dst, b, h) do { _Pragma("unroll") for (int n = 0; n < 2; ++n) _Pragma("unroll") for (int k = 0; k < 2; ++k) dst[n][k] = *(const PG8_LAS bf16x8*)(lds + PG8_SB(b, h) + boff + n * 2048 + k * 1024); } while (0)
#define PG8_MMA(ai, bj, At, Bt) do { __builtin_amdgcn_s_setprio(1); _Pragma("unroll") for (int m = 0; m < 4; ++m) _Pragma("unroll") for (int n = 0; n < 2; ++n) _Pragma("unroll") for (int k = 0; k < 2; ++k) \
        acc[ai][bj][m][n] = __builtin_amdgcn_mfma_f32_16x16x32_bf16(Bt[n][k], At[m][k], acc[ai][bj][m][n], 0, 0, 0); __builtin_amdgcn_s_setprio(0); } while (0)
#define PG8_WAIT_V(n) asm volatile("s_waitcnt vmcnt(" #n ")" ::: "memory")
#define PG8_WAIT_L(n) asm volatile("s_waitcnt lgkmcnt(" #n ")" ::: "memory")
#define PG8_BAR __builtin_amdgcn_s_barrier()
#define PG8_SCHED __builtin_amdgcn_sched_barrier(0)
    Unit cur, nxt; int ui = 0;
    if (!S.next(0, cur)) return;
    f32x4 acc[2][2][4][2];
#pragma unroll
    for (int a = 0; a < 2; ++a)
#pragma unroll
        for (int b = 0; b < 2; ++b)
#pragma unroll
            for (int m = 0; m < 4; ++m)
#pragma unroll
                for (int n = 0; n < 2; ++n) acc[a][b][m][n] = (f32x4){0.f, 0.f, 0.f, 0.f};
    bf16x8 At[4][2], B0[2][2], B1[2][2];
    const char* cA = (const char*)g.A + (size_t)Epi::a_row0(cur.pm) * ((size_t)K * 2); const char* cB = (const char*)g.Bt + (size_t)cur.pn * tstep;
    S.a_ready(cur);
    if constexpr (SP2) {
        PG8_STAGE(PG8_SB(0, 0), cB, voffB); PG8_STAGE(PG8_SB(0, 1), cB + hstep, voffB); PG8_STAGE(PG8_SA(0, 0), cA, voffA); PG8_STAGE(PG8_SA(0, 1), cA + hstep, voffA);
        if (wr == 1) PG8_BAR;
        PG8_WAIT_V(2); PG8_BAR;
        PG8_STAGE(PG8_SB(1, 0), cB + kstep, voffB); PG8_STAGE(PG8_SA(1, 0), cA + kstep, voffA); PG8_STAGE(PG8_SB(1, 1), cB + hstep + kstep, voffB);
        PG8_WAIT_V(6); PG8_BAR;
    } else {
        PG8_STAGE(PG8_SB(0, 0), cB, voffB); PG8_STAGE(PG8_SA(0, 0), cA, voffA); PG8_STAGE(PG8_SB(0, 1), cB + hstep, voffB); PG8_STAGE(PG8_SA(0, 1), cA + hstep, voffA);
        if (wr == 1) PG8_BAR;
        PG8_WAIT_V(4); PG8_BAR;
        PG8_STAGE(PG8_SB(1, 0), cB + kstep, voffB); PG8_STAGE(PG8_SA(1, 0), cA + kstep, voffA); PG8_STAGE(PG8_SB(1, 1), cB + hstep + kstep, voffB);
        PG8_WAIT_V(6); PG8_BAR;
    }
    for (;;) {
        const bool has_next = S.next(ui + 1, nxt);
        const char* nA = has_next ? (const char*)g.A + (size_t)Epi::a_row0(nxt.pm) * ((size_t)K * 2) : cA; const char* nB = has_next ? (const char*)g.Bt + (size_t)nxt.pn * tstep : cB;
        for (int t = 0; t < nt; t += 2) {
            const bool last = (t == nt - 2);
            const char* a1 = cA + (size_t)(t + 1) * kstep;
            const char* a2 = last ? nA : cA + (size_t)(t + 2) * kstep; const char* b2 = last ? nB : cB + (size_t)(t + 2) * kstep;
            const char* a3 = a2 + kstep; const char* b3 = b2 + kstep;
            if (last && has_next) S.a_ready(nxt);
            if constexpr (SP2) {
            PG8_LDB(B0, 0, 0); PG8_LDB(B1, 0, 1); PG8_SCHED; PG8_LDA(At, 0, 0); PG8_STAGE(PG8_SA(1, 1), a1 + hstep, voffA);
            PG8_WAIT_V(8); PG8_WAIT_L(0); PG8_BAR; PG8_MMA(0, 0, At, B0); PG8_MMA(0, 1, At, B1); PG8_BAR; PG8_SCHED;
            PG8_LDA(At, 0, 1); PG8_STAGE(PG8_SB(0, 0), b2, voffB); PG8_STAGE(PG8_SB(0, 1), b2 + hstep, voffB); PG8_STAGE(PG8_SA(0, 0), a2, voffA);
            PG8_WAIT_V(8); PG8_WAIT_L(0); PG8_BAR; PG8_MMA(1, 0, At, B0); PG8_MMA(1, 1, At, B1); PG8_BAR; PG8_SCHED;
            PG8_LDB(B0, 1, 0); PG8_LDB(B1, 1, 1); PG8_SCHED; PG8_LDA(At, 1, 0); PG8_STAGE(PG8_SA(0, 1), a2 + hstep, voffA);
            PG8_WAIT_V(8); PG8_WAIT_L(0); PG8_BAR; PG8_MMA(0, 0, At, B0); PG8_MMA(0, 1, At, B1); PG8_BAR; PG8_SCHED;
            PG8_LDA(At, 1, 1); PG8_STAGE(PG8_SB(1, 0), b3, voffB); PG8_STAGE(PG8_SB(1, 1), b3 + hstep, voffB); PG8_STAGE(PG8_SA(1, 0), a3, voffA);
            PG8_WAIT_V(8); PG8_WAIT_L(0); PG8_BAR; PG8_MMA(1, 0, At, B0); PG8_MMA(1, 1, At, B1); PG8_BAR; PG8_SCHED;
            } else {
            PG8_LDB(B0, 0, 0); PG8_SCHED; PG8_LDA(At, 0, 0); PG8_STAGE(PG8_SA(1, 1), a1 + hstep, voffA);
            PG8_WAIT_L(8); PG8_BAR; PG8_WAIT_L(0); PG8_MMA(0, 0, At, B0); PG8_BAR; PG8_SCHED;
            PG8_LDB(B1, 0, 1); PG8_STAGE(PG8_SB(0, 0), b2, voffB);
            PG8_BAR; PG8_WAIT_L(0); PG8_MMA(0, 1, At, B1); PG8_BAR;
            PG8_LDA(At, 0, 1); PG8_STAGE(PG8_SA(0, 0), a2, voffA);
            PG8_BAR; PG8_WAIT_L(0); PG8_MMA(1, 0, At, B0); PG8_BAR; PG8_SCHED;
            PG8_STAGE(PG8_SB(0, 1), b2 + hstep, voffB);
            PG8_WAIT_V(6); PG8_BAR; PG8_MMA(1, 1, At, B1); PG8_BAR;
            PG8_LDB(B0, 1, 0); PG8_SCHED; PG8_LDA(At, 1, 0); PG8_STAGE(PG8_SA(0, 1), a2 + hstep, voffA);
            PG8_WAIT_L(8); PG8_BAR; PG8_WAIT_L(0); PG8_MMA(0, 0, At, B0); PG8_BAR; PG8_SCHED;
            PG8_LDB(B1, 1, 1); PG8_STAGE(PG8_SB(1, 0), b3, voffB);
            PG8_BAR; PG8_WAIT_L(0); PG8_MMA(0, 1, At, B1); PG8_BAR;
            PG8_LDA(At, 1, 1); PG8_STAGE(PG8_SA(1, 0), a3, voffA);
            PG8_BAR; PG8_WAIT_L(0); PG8_MMA(1, 0, At, B0); PG8_BAR; PG8_SCHED;
            PG8_STAGE(PG8_SB(1, 1), b3 + hstep, voffB);
            PG8_WAIT_V(6); PG8_BAR; PG8_MMA(1, 1, At, B1); PG8_BAR;
            }
        }
        if constexpr (ALIGN_EPI) { if (wr == 0) PG8_BAR; }
        if constexpr (!Epi::AFTER_DRAIN) { E(acc, cur, wr, wc, fr, fq); S.done(cur); }
        if (!has_next) break;
#pragma unroll
        for (int a = 0; a < 2; ++a)
#pragma unroll
            for (int b = 0; b < 2; ++b)
#pragma unroll
                for (int m = 0; m < 4; ++m)
#pragma unroll
                    for (int n = 0; n < 2; ++n) acc[a][b][m][n] = (f32x4){0.f, 0.f, 0.f, 0.f};
        cur = nxt; cA = nA; cB = nB; ++ui;
        if constexpr (ALIGN_EPI) { if (wr == 1) PG8_BAR; }
    }
    PG8_WAIT_V(0);
    if constexpr (!ALIGN_EPI) { if (wr == 0) PG8_BAR; }
    PG8_BAR;
    if constexpr (Epi::AFTER_DRAIN) { E.fused(acc, cur, wr, wc, fr, fq, lds, wid, lane); S.done(cur); }
#undef PG8_SA
#undef PG8_SB
#undef PG8_STAGE
#undef PG8_LDA
#undef PG8_LDB
#undef PG8_MMA
#undef PG8_WAIT_V
#undef PG8_WAIT_L
#undef PG8_BAR
#undef PG8_SCHED
}
}

#define LAS __attribute__((address_space(3)))
typedef unsigned short bf16_t;
typedef short bf16x8 __attribute__((ext_vector_type(8)));
typedef float f32x4 __attribute__((ext_vector_type(4)));
typedef float f32x2 __attribute__((ext_vector_type(2)));
typedef unsigned u32x4 __attribute__((ext_vector_type(4)));
typedef unsigned u32x2 __attribute__((ext_vector_type(2)));
using pg8::cvt_pk_bf16;

#ifndef REP_ATTN
#define REP_ATTN 1
#endif
#ifndef REP_THIN
#define REP_THIN 1
#endif
constexpr int NWAVES = 8, NTHR = 512;
constexpr int LDS_BYTES = 147456;
constexpr int MTOK = 12288, NCTXROWS = 4096, DM = 1024, DFF = 2816, DUP = 5632;
constexpr float EPSN = 1e-6f;
constexpr float LOG2E = 1.4426950408889634f;
constexpr float SCL2 = 0.125f * 1.4426950408889634f;

constexpr size_t MiB = 1u << 20;
constexpr size_t WS_MOD = 0;
constexpr size_t WS_ROPE = 256 * 1024;
constexpr size_t WS_BAR = 512 * 1024;
constexpr size_t WS_KCA = 1 * MiB;
constexpr size_t WS_VTCA = 1 * MiB + 512 * 1024;
constexpr size_t WS_KCB = 2 * MiB;
constexpr size_t WS_VTCB = 4 * MiB;
constexpr size_t WS_WQKVA = 6 * MiB, WS_WQKVB = 9 * MiB, WS_WOA = 15 * MiB, WS_WOB = 17 * MiB;
constexpr size_t WS_WUP0 = 19 * MiB, WS_WUP1 = 30 * MiB, WS_WDN0 = 41 * MiB, WS_WDN1 = 46 * MiB + 512 * 1024;
constexpr size_t WS_H = 52 * MiB;
constexpr size_t WS_ACT = 118 * MiB;
constexpr size_t WS_U = 118 * MiB;
constexpr size_t WS_Q = 118 * MiB, WS_K = 142 * MiB, WS_VT = 166 * MiB, WS_O = 190 * MiB;
constexpr size_t WS_END = 250 * MiB;
constexpr size_t OUT_Y = 0, OUT_KA = 12582912, OUT_VA = 13631488, OUT_KB = 14680064, OUT_VB = 18874368;

__device__ __forceinline__ unsigned f2bf(float f) { unsigned u = __builtin_bit_cast(unsigned, f); return (u + 0x7fffu + ((u >> 16) & 1u)) >> 16; }
__device__ __forceinline__ float bflo(unsigned w) { return __builtin_bit_cast(float, w << 16); }
__device__ __forceinline__ float bfhi(unsigned w) { return __builtin_bit_cast(float, w & 0xffff0000u); }
__device__ __forceinline__ float wave_sum(float v) {
#pragma unroll
    for (int o = 1; o < 64; o <<= 1) v += __shfl_xor(v, o);
    return v;
}
__device__ __forceinline__ float fast_exp2(float x) { return __builtin_amdgcn_exp2f(x); }
__device__ __forceinline__ float silu_f(float x) { return x * __builtin_amdgcn_rcpf(1.0f + __expf(-x)); }

struct Args { const float* in[26]; float* out; unsigned char* ws; };

#define XB_TMO      128
#define XB_XCNT(j)  (256  + 64 * (j))
#define XB_XSUB(j)  (1280 + 64 * (j))
#define XB_XGEN(j)  (2304 + 64 * (j))
#define XB_TOP      3328
#define XB_TOPGEN   3392
#define XCD_BAR_WORDS 3456
#define XB_SPIN_CAP (1u << 18)

__device__ __forceinline__ unsigned xb_ld(unsigned* p)              { return __hip_atomic_load(p, __ATOMIC_RELAXED, __HIP_MEMORY_SCOPE_AGENT); }
__device__ __forceinline__ unsigned xb_add(unsigned* p, unsigned v) { return __hip_atomic_fetch_add(p, v, __ATOMIC_RELAXED, __HIP_MEMORY_SCOPE_AGENT); }
__device__ __forceinline__ unsigned xb_xcc_id() { return (unsigned)__builtin_amdgcn_s_getreg((3 << 11) | 20) & 0xFu; }
#define XB_SPIN(cond, bar) do { unsigned _sp = 0; while (cond) { __builtin_amdgcn_s_sleep(1); \
    if ((++_sp & 255u) == 0u) { if (xb_ld(&(bar)[XB_TMO])) break; if (_sp > XB_SPIN_CAP) { atomicAdd(&(bar)[XB_TMO], 1u); break; } } } } while (0)

struct XcdBarrier {
    unsigned* bar; unsigned x;
    volatile LAS unsigned* st;
};

__device__ __forceinline__ XcdBarrier xcd_barrier_post(unsigned* bar, volatile LAS unsigned* st) {
    XcdBarrier b; b.bar = bar; b.x = xb_xcc_id(); b.st = st;
    if (threadIdx.x == 0) (void)xb_add(&bar[XB_XCNT(b.x)], 1u);
    return b;
}
__device__ __forceinline__ void xcd_barrier_complete(unsigned* bar, unsigned x, unsigned& nloc, unsigned& nx) {
    const unsigned G = gridDim.x * gridDim.y * gridDim.z;
    unsigned sum, cnt, mine, sp = 0u;
    for (;;) {
        sum = 0u; cnt = 0u; mine = 0u;
#pragma unroll
        for (unsigned j = 0; j < 16; ++j) { const unsigned c = xb_ld(&bar[XB_XCNT(j)]); sum += c; cnt += (c > 0u) ? 1u : 0u; mine = (j == x) ? c : mine; }
        if (sum == G) break;
        __builtin_amdgcn_s_sleep(1);
        if ((++sp & 255u) == 0u) { if (xb_ld(&bar[XB_TMO])) break; if (sp > XB_SPIN_CAP) { atomicAdd(&bar[XB_TMO], 1u); break; } }
    }
    nloc = mine > 0u ? mine : 1u; nx = cnt > 0u ? cnt : 1u;
}

__device__ __forceinline__ void xcd_barrier(const XcdBarrier& b) {
    asm volatile("s_waitcnt vmcnt(0)" ::: "memory");
    __syncthreads();
    if (threadIdx.x == 0) {
        unsigned* bar = b.bar;
        __builtin_amdgcn_s_waitcnt(0);
        unsigned nloc = b.st[0], nx = b.st[1];
        if (nloc == 0u) { xcd_barrier_complete(bar, b.x, nloc, nx); b.st[0] = nloc; b.st[1] = nx; }
        const unsigned old = xb_add(&bar[XB_XSUB(b.x)], 1u);
        const unsigned gen = old / nloc;
        if (old + 1u == (gen + 1u) * nloc) {
            __builtin_amdgcn_fence(__ATOMIC_RELEASE, "agent");
            asm volatile("s_waitcnt vmcnt(0)" ::: "memory");
            const unsigned og = xb_add(&bar[XB_TOP], 1u);
            const unsigned tg = og / nx;
            if (og + 1u == (tg + 1u) * nx) xb_add(&bar[XB_TOPGEN], 1u);
            else XB_SPIN(xb_ld(&bar[XB_TOPGEN]) == tg, bar);
            __builtin_amdgcn_fence(__ATOMIC_ACQUIRE, "agent");
            xb_add(&bar[XB_XGEN(b.x)], 1u);
            asm volatile("s_waitcnt vmcnt(0)" ::: "memory");
        } else {
            XB_SPIN(xb_ld(&bar[XB_XGEN(b.x)]) == gen, bar);
            __builtin_amdgcn_fence(__ATOMIC_ACQUIRE, "agent");
            asm volatile("s_waitcnt vmcnt(0)" ::: "memory");
        }
    }
    __syncthreads();
}


using pg8::Unit;
struct EpiUp {
    static constexpr bool PERM = true, AFTER_DRAIN = false;
    static __device__ __forceinline__ int a_row0(int pm) { return pm * 256; }
    bf16_t* O; int ldc;
    __device__ __forceinline__ void operator()(const f32x4 (&acc)[2][2][4][2], const Unit& u, int wr, int wc, int fr, int fq) const {
        const int row0 = u.pm * 256 + wr * 64 + fr, col0 = u.pn * 256 + wc * 32 + 8 * fq;
#pragma unroll
        for (int ai = 0; ai < 2; ++ai)
#pragma unroll
            for (int m = 0; m < 4; ++m) { bf16_t* rowp = O + (size_t)(row0 + ai * 128 + m * 16) * ldc + col0;
#pragma unroll
                for (int bj = 0; bj < 2; ++bj) { const f32x4 v0 = acc[ai][bj][m][0], v1 = acc[ai][bj][m][1];
                    u32x4 w; w.x = cvt_pk_bf16(v0[0], v0[1]); w.y = cvt_pk_bf16(v0[2], v0[3]); w.z = cvt_pk_bf16(v1[0], v1[1]); w.w = cvt_pk_bf16(v1[2], v1[3]);
                    *(u32x4*)(rowp + bj * 128) = w; } }
    }
};
struct EpiResid {
    static constexpr bool PERM = false, AFTER_DRAIN = false;
    static __device__ __forceinline__ int a_row0(int pm) { return pm * 256; }
    const float* xa; const float* xb; float* out; const float* gate;
    __device__ __forceinline__ void operator()(const f32x4 (&acc)[2][2][4][2], const Unit& u, int wr, int wc, int fr, int fq) const {
        const int rbase = u.pm * 256;
        const float* xin = rbase < NCTXROWS ? xa + (size_t)rbase * DM : xb + (size_t)(rbase - NCTXROWS) * DM;
        const int cond = rbase < NCTXROWS ? 0 : 1 + ((rbase - NCTXROWS) >> 12);
        const int col0 = u.pn * 256 + wc * 32 + 4 * fq;
        const float* g = gate + cond * 6144 + col0;
        float* o = out + (size_t)rbase * DM;
        f32x4 gv[2][2];
#pragma unroll
        for (int bj = 0; bj < 2; ++bj)
#pragma unroll
            for (int n = 0; n < 2; ++n) gv[bj][n] = *(const f32x4*)(g + bj * 128 + n * 16);
#pragma unroll
        for (int ai = 0; ai < 2; ++ai)
#pragma unroll
            for (int m = 0; m < 4; ++m) { const size_t off = (size_t)(ai * 128 + wr * 64 + m * 16 + fr) * DM + col0;
#pragma unroll
                for (int bj = 0; bj < 2; ++bj)
#pragma unroll
                    for (int n = 0; n < 2; ++n) { const f32x4 x = *(const f32x4*)(xin + off + bj * 128 + n * 16);
                        *(f32x4*)(o + off + bj * 128 + n * 16) = x + gv[bj][n] * acc[ai][bj][m][n]; }
                if (m & 1) asm volatile("" ::: "memory"); }
    }
};

struct EpiUpConv {
    static constexpr bool PERM = false, AFTER_DRAIN = false;
    static __device__ __forceinline__ int a_row0(int pm) {
        if (pm < 16) return pm * 256;
        const int s = (pm - 16) / 17, j = (pm - 16) % 17; int st = 254 * j - 1; st = st > 3841 ? 3841 : st;
        return NCTXROWS + 4096 * s + st;
    }
    bf16_t* ACT; const float* cw; const float* cb; LAS float* xch;
    __device__ __forceinline__ void operator()(const f32x4 (&acc)[2][2][4][2], const Unit& u, int wr, int wc, int fr, int fq) const {
        const bool latent = u.pm >= 16;
        const int j17 = latent ? (u.pm - 16) % 17 : -1;
        const bool zr0 = (j17 == 0) && (wr == 0) && (fr == 0), zr255 = (j17 == 16) && (wr == 1) && (fr == 15);
        const int grow0 = a_row0(u.pm);
        const int lane = fq * 16 + fr;
        const int src_prev = (lane & 48) | ((fr + 15) & 15), src_next = (lane & 48) | ((fr + 1) & 15);
        const f32x4 z4 = (f32x4){0.f, 0.f, 0.f, 0.f};
#pragma unroll
        for (int ai = 0; ai < 2; ++ai) { const int g = ai * 2 + wr;
#pragma unroll
            for (int bj = 0; bj < 2; ++bj)
#pragma unroll
                for (int n = 0; n < 2; ++n) { const int col = bj * 128 + 32 * wc + 16 * n + 4 * fq;
                    if (fr == 0) *(LAS f32x4*)(xch + (g * 2 + 0) * 256 + col) = (ai == 0 && zr0) ? z4 : acc[ai][bj][0][n];
                    if (fr == 15) *(LAS f32x4*)(xch + (g * 2 + 1) * 256 + col) = (ai == 1 && zr255) ? z4 : acc[ai][bj][3][n]; } }
        asm volatile("s_waitcnt lgkmcnt(0)" ::: "memory"); __builtin_amdgcn_s_barrier(); asm volatile("" ::: "memory");
        const int fbase = u.pn * 128 + 32 * wc + 4 * fq;
#pragma unroll
        for (int n = 0; n < 2; ++n) {
            const int f0 = fbase + 16 * n;
            f32x4 wg[3], wv[3];
#pragma unroll
            for (int o = 0; o < 3; ++o) { wg[o] = *(const f32x4*)(cw + o * DUP + f0); wv[o] = *(const f32x4*)(cw + o * DUP + DFF + f0); }
            const f32x4 bg = *(const f32x4*)(cb + f0), bv = *(const f32x4*)(cb + DFF + f0);
#pragma unroll
            for (int ai = 0; ai < 2; ++ai) {
                const int g = ai * 2 + wr;
                f32x4 bp[2], bn[2];
#pragma unroll
                for (int bj = 0; bj < 2; ++bj) { const int col = bj * 128 + 32 * wc + 16 * n + 4 * fq;
                    bp[bj] = g > 0 ? *(const LAS f32x4*)(xch + ((g - 1) * 2 + 1) * 256 + col) : z4;
                    bn[bj] = g < 3 ? *(const LAS f32x4*)(xch + ((g + 1) * 2 + 0) * 256 + col) : z4; }
#pragma unroll
                for (int m = 0; m < 4; ++m) {
                    f32x4 cv[2];
#pragma unroll
                    for (int bj = 0; bj < 2; ++bj) {
                        f32x4 cur = acc[ai][bj][m][n];
                        if (ai == 0 && m == 0) cur = zr0 ? z4 : cur;
                        if (ai == 1 && m == 3) cur = zr255 ? z4 : cur;
                        f32x4 ps = m > 0 ? acc[ai][bj][m - 1][n] : bp[bj];
                        f32x4 ns = m < 3 ? acc[ai][bj][m + 1][n] : bn[bj];
                        f32x4 tp, tn, pv, nv;
#pragma unroll
                        for (int i = 0; i < 4; ++i) { tp[i] = fr == 15 ? ps[i] : cur[i]; tn[i] = fr == 0 ? ns[i] : cur[i]; }
#pragma unroll
                        for (int i = 0; i < 4; ++i) { pv[i] = __shfl(tp[i], src_prev); nv[i] = __shfl(tn[i], src_next); }
                        const f32x4 w0 = bj ? wv[0] : wg[0], w1 = bj ? wv[1] : wg[1], w2 = bj ? wv[2] : wg[2], bb = bj ? bv : bg;
                        cv[bj] = w0 * pv + w1 * cur + w2 * nv + bb;
                    }
                    f32x4 r;
#pragma unroll
                    for (int i = 0; i < 4; ++i) r[i] = silu_f(cv[0][i]) * cv[1][i];
                    const int R = ai * 128 + wr * 64 + m * 16 + fr;
                    const bool halo = latent && ((ai == 0 && m == 0 && wr == 0 && fr == 0) || (ai == 1 && m == 3 && wr == 1 && fr == 15));
                    if (!halo) { u32x2 w; w.x = cvt_pk_bf16(r[0], r[1]); w.y = cvt_pk_bf16(r[2], r[3]); *(u32x2*)(ACT + (size_t)(grow0 + R) * DFF + f0) = w; }
                }
            }
            asm volatile("" ::: "memory");
        }
    }
};
template <int NKV>
struct EpiQKV {
    static constexpr bool PERM = false, AFTER_DRAIN = false;
    static __device__ __forceinline__ int a_row0(int pm) { return pm * 256; }
    bf16_t* Q; bf16_t* K; bf16_t* VT; float* newk; float* newv; const float* qn; const float* kn; const float* rope;
    __device__ __forceinline__ void operator()(const f32x4 (&acc)[2][2][4][2], const Unit& u, int wr, int wc, int fr, int fq) const {
        constexpr int KLD = NKV * 64;
        const int hs = 4 * u.pn + wc;
        const int rbase = u.pm * 256 + wr * 64 + fr;
        const bool latent = u.pm >= 16;
        if (hs < 16 + NKV) {
            const bool isq = hs < 16;
            const float* nw = isq ? qn : kn;
            f32x4 wn[2][2];
#pragma unroll
            for (int bj = 0; bj < 2; ++bj)
#pragma unroll
                for (int n = 0; n < 2; ++n) wn[bj][n] = *(const f32x4*)(nw + 32 * bj + 16 * n + 4 * fq);
#pragma unroll
            for (int ai = 0; ai < 2; ++ai)
#pragma unroll
                for (int m = 0; m < 4; ++m) {
                    const int row = rbase + ai * 128 + m * 16;
                    f32x4 v[2][2]; float ss = 0.f;
#pragma unroll
                    for (int bj = 0; bj < 2; ++bj)
#pragma unroll
                        for (int n = 0; n < 2; ++n) { v[bj][n] = acc[ai][bj][m][n]; const f32x4 t = v[bj][n] * v[bj][n]; ss += (t[0] + t[1]) + (t[2] + t[3]); }
                    ss += __shfl_xor(ss, 16); ss += __shfl_xor(ss, 32);
                    const float rinv = rsqrtf(ss * (1.0f / 64.0f) + EPSN);
#pragma unroll
                    for (int bj = 0; bj < 2; ++bj)
#pragma unroll
                        for (int n = 0; n < 2; ++n) v[bj][n] = v[bj][n] * rinv * wn[bj][n];
                    if (latent && NKV == 4) {
                        const int pr = ((row - NCTXROWS) & 4095) >> 6, pc = row & 63;
#pragma unroll
                        for (int bj = 0; bj < 2; ++bj) {
                            const int pos = bj ? pc : pr;
                            const f32x4* t = (const f32x4*)(rope + (pos * 16 + 4 * fq) * 2);
                            const f32x4 t0 = t[0], t1 = t[1];
                            const f32x4 cs = (f32x4){t0[0], t0[2], t1[0], t1[2]}, sn = (f32x4){t0[1], t0[3], t1[1], t1[3]};
                            const f32x4 x1 = v[bj][0], x2 = v[bj][1];
                            v[bj][0] = x1 * cs - x2 * sn; v[bj][1] = x2 * cs + x1 * sn;
                        }
                    }
                    if (isq) {
                        bf16_t* p = Q + (size_t)row * DM + hs * 64 + 4 * fq;
#pragma unroll
                        for (int bj = 0; bj < 2; ++bj)
#pragma unroll
                            for (int n = 0; n < 2; ++n) { u32x2 w; w.x = cvt_pk_bf16(v[bj][n][0], v[bj][n][1]); w.y = cvt_pk_bf16(v[bj][n][2], v[bj][n][3]); *(u32x2*)(p + 32 * bj + 16 * n) = w; }
                    } else {
                        const int kvh = hs - 16;
                        bf16_t* p = K + (size_t)row * KLD + kvh * 64 + 4 * fq;
#pragma unroll
                        for (int bj = 0; bj < 2; ++bj)
#pragma unroll
                            for (int n = 0; n < 2; ++n) { u32x2 w; w.x = cvt_pk_bf16(v[bj][n][0], v[bj][n][1]); w.y = cvt_pk_bf16(v[bj][n][2], v[bj][n][3]); *(u32x2*)(p + 32 * bj + 16 * n) = w; }
                        if (!latent) {
                            float* o = newk + (size_t)row * KLD + kvh * 64 + 4 * fq;
#pragma unroll
                            for (int bj = 0; bj < 2; ++bj)
#pragma unroll
                                for (int n = 0; n < 2; ++n) *(f32x4*)(o + 32 * bj + 16 * n) = v[bj][n];
                        }
                    }
                    asm volatile("" ::: "memory");
                }
        } else {
            const int kvh = hs - 16 - NKV;
#pragma unroll
            for (int ai = 0; ai < 2; ++ai)
#pragma unroll
                for (int m = 0; m < 4; ++m) {
                    const int row = rbase + ai * 128 + m * 16;
                    bf16_t* p = VT + ((size_t)(row >> 5) * NKV + kvh) * 2048 + (row & 31) + (4 * fq) * 32;
#pragma unroll
                    for (int bj = 0; bj < 2; ++bj)
#pragma unroll
                        for (int n = 0; n < 2; ++n)
#pragma unroll
                            for (int i = 0; i < 4; ++i) p[(32 * bj + 16 * n + i) * 32] = (bf16_t)f2bf(acc[ai][bj][m][n][i]);
                    if (!latent) {
                        float* o = newv + (size_t)row * KLD + kvh * 64 + 4 * fq;
#pragma unroll
                        for (int bj = 0; bj < 2; ++bj)
#pragma unroll
                            for (int n = 0; n < 2; ++n) *(f32x4*)(o + 32 * bj + 16 * n) = acc[ai][bj][m][n];
                    }
                    asm volatile("" ::: "memory");
                }
        }
    }
};

struct AttnState { f32x4 o[2][4]; float m[2]; float l[2]; };
#define MFMA16(a, b, c) __builtin_amdgcn_mfma_f32_16x16x32_bf16((a), (b), (c), 0, 0, 0)
struct KVFrag { bf16x8 kf[2][2]; bf16x8 vf[4]; };
__device__ __forceinline__ void attn_load(KVFrag& f, const bf16_t* kp, int kld, const bf16_t* vp, int fr, int fq) {
#pragma unroll
    for (int t = 0; t < 2; ++t)
#pragma unroll
        for (int h2 = 0; h2 < 2; ++h2) f.kf[t][h2] = *(const bf16x8*)(kp + (size_t)(16 * t + fr) * kld + 32 * h2 + 8 * fq);
#pragma unroll
    for (int dt = 0; dt < 4; ++dt) { const bf16_t* v = vp + (16 * dt + fr) * 32 + 4 * fq; const u32x2 lo = *(const u32x2*)v, hi = *(const u32x2*)(v + 16);
        f.vf[dt] = __builtin_bit_cast(bf16x8, ((u32x4){lo.x, lo.y, hi.x, hi.y})); }
}
template <int MASK>
__device__ __forceinline__ void attn_compute(AttnState& st, const bf16x8 (&qf)[2][2], const KVFrag& f, int fr, int fq, int mk0, int mk1, const LAS float* bias) {
#pragma unroll
    for (int qb = 0; qb < 2; ++qb) {
        f32x4 s0 = (f32x4){0.f, 0.f, 0.f, 0.f}, s1 = (f32x4){0.f, 0.f, 0.f, 0.f};
        s0 = MFMA16(f.kf[0][0], qf[qb][0], s0); s0 = MFMA16(f.kf[0][1], qf[qb][1], s0);
        s1 = MFMA16(f.kf[1][0], qf[qb][0], s1); s1 = MFMA16(f.kf[1][1], qf[qb][1], s1);
        float sv[8];
#pragma unroll
        for (int j = 0; j < 4; ++j) { sv[j] = s0[j] * SCL2; sv[4 + j] = s1[j] * SCL2; }
        if (MASK == 1) {
            const int d0 = mk0 + 4 * fq - 16 * qb - fr;
#pragma unroll
            for (int t = 0; t < 2; ++t)
#pragma unroll
                for (int j = 0; j < 4; ++j) { const int df = d0 + 16 * t + j; if (df > 128 || df < -128) sv[4 * t + j] = -INFINITY; }
        }
        if (MASK == 2) {
            const int qc = mk1 + 16 * qb + fr; int cs = qc - 8; cs = cs < 0 ? 0 : (cs > 48 ? 48 : cs);
#pragma unroll
            for (int t = 0; t < 2; ++t)
#pragma unroll
                for (int j = 0; j < 4; ++j) { const int kc = mk0 + 16 * t + 4 * fq + j; const bool ok = (kc >= cs) && (kc < cs + 16);
                    int bi = kc - qc + 15; bi = bi < 0 ? 0 : (bi > 30 ? 30 : bi);
                    const float bv = bias[bi];
                    sv[4 * t + j] = ok ? sv[4 * t + j] + bv : -INFINITY; }
        }
        float cmax = fmaxf(fmaxf(fmaxf(sv[0], sv[1]), fmaxf(sv[2], sv[3])), fmaxf(fmaxf(sv[4], sv[5]), fmaxf(sv[6], sv[7])));
        cmax = fmaxf(cmax, __shfl_xor(cmax, 16)); cmax = fmaxf(cmax, __shfl_xor(cmax, 32));
        const float mnew = fmaxf(st.m[qb], cmax);
        const float msafe = (mnew == -INFINITY) ? 0.f : mnew;
        const float alpha = fast_exp2(st.m[qb] - msafe);
        st.m[qb] = mnew;
        float p[8]; float ps = 0.f;
#pragma unroll
        for (int j = 0; j < 8; ++j) { p[j] = fast_exp2(sv[j] - msafe); ps += p[j]; }
        st.l[qb] = st.l[qb] * alpha + ps;
        u32x4 pw; pw.x = cvt_pk_bf16(p[0], p[1]); pw.y = cvt_pk_bf16(p[2], p[3]); pw.z = cvt_pk_bf16(p[4], p[5]); pw.w = cvt_pk_bf16(p[6], p[7]);
        const bf16x8 pf = __builtin_bit_cast(bf16x8, pw);
#pragma unroll
        for (int dt = 0; dt < 4; ++dt) { st.o[qb][dt] = st.o[qb][dt] * alpha; st.o[qb][dt] = MFMA16(f.vf[dt], pf, st.o[qb][dt]); }
    }
}
__device__ __forceinline__ void attn_init(AttnState& st, bf16x8 (&qf)[2][2], const bf16_t* Q, int qrow0, int head, int fr, int fq) {
#pragma unroll
    for (int qb = 0; qb < 2; ++qb) { st.m[qb] = -INFINITY; st.l[qb] = 0.f;
#pragma unroll
        for (int dt = 0; dt < 4; ++dt) st.o[qb][dt] = (f32x4){0.f, 0.f, 0.f, 0.f};
#pragma unroll
        for (int h2 = 0; h2 < 2; ++h2) qf[qb][h2] = *(const bf16x8*)(Q + (size_t)(qrow0 + 16 * qb + fr) * DM + head * 64 + 32 * h2 + 8 * fq); }
}
__device__ __forceinline__ void attn_finish(AttnState& st, bf16_t* O, int qrow0, int head, int fr, int fq, bool has_sink, float sink) {
#pragma unroll
    for (int qb = 0; qb < 2; ++qb) {
        float l = st.l[qb]; l += __shfl_xor(l, 16); l += __shfl_xor(l, 32);
        if (has_sink) l += fast_exp2(sink * LOG2E - st.m[qb]);
        const float inv = 1.0f / l;
        bf16_t* o = O + (size_t)(qrow0 + 16 * qb + fr) * DM + head * 64 + 4 * fq;
#pragma unroll
        for (int dt = 0; dt < 4; ++dt) { const f32x4 v = st.o[qb][dt] * inv; u32x2 w; w.x = cvt_pk_bf16(v[0], v[1]); w.y = cvt_pk_bf16(v[2], v[3]); *(u32x2*)(o + 16 * dt) = w; }
    }
}
__device__ __forceinline__ void attn_phase_a(const bf16_t* Q, const bf16_t* K, const bf16_t* VT, const bf16_t* Kc, const bf16_t* VTc, const float* sinkp, bf16_t* O, int gw, int ngw, int lane) {
    const int fr = lane & 15, fq = lane >> 4;
    for (int t = gw; t < 4096; t += ngw) {
        const int b = t >> 11, rem = t & 2047, kvh = rem >> 9, rem2 = rem & 511, qblk = ((rem2 >> 3) << 1) | (rem2 & 1), g = (rem2 & 7) >> 1;
        const int head = kvh * 4 + g, qpos0 = qblk * 32, seq0 = NCTXROWS + b * 4096, qrow0 = seq0 + qpos0;
        AttnState st; bf16x8 qf[2][2]; KVFrag cur, nxt;
        attn_init(st, qf, Q, qrow0, head, fr, fq);
        const int c0 = qblk - 4 < 0 ? 0 : qblk - 4, c1 = qblk + 4 > 127 ? 127 : qblk + 4;
        const bf16_t* kcp = Kc + (size_t)(b * 512) * 256 + kvh * 64; const bf16_t* vcp = VTc + (size_t)(b * 16 * 4 + kvh) * 2048;
        const bf16_t* klp = K + (size_t)seq0 * 256 + kvh * 64; const bf16_t* vlp = VT + (size_t)((seq0 >> 5) * 4 + kvh) * 2048;
        attn_load(cur, kcp, 256, vcp, fr, fq);
        for (int c = 0; c < 16; ++c) {
            if (c < 15) attn_load(nxt, kcp + (size_t)(32 * (c + 1)) * 256, 256, vcp + (size_t)(c + 1) * 4 * 2048, fr, fq);
            else attn_load(nxt, klp + (size_t)(32 * c0) * 256, 256, vlp + (size_t)c0 * 4 * 2048, fr, fq);
            attn_compute<0>(st, qf, cur, fr, fq, 0, 0, nullptr);
            cur = nxt;
        }
        for (int c = c0; c <= c1; ++c) {
            if (c < c1) attn_load(nxt, klp + (size_t)(32 * (c + 1)) * 256, 256, vlp + (size_t)(c + 1) * 4 * 2048, fr, fq);
            attn_compute<1>(st, qf, cur, fr, fq, 32 * c - qpos0, 0, nullptr);
            cur = nxt;
        }
        attn_finish(st, O, qrow0, head, fr, fq, true, sinkp[head]);
    }
    for (int t = gw; t < 2048; t += ngw) {
        const int b = t >> 7, rem = t & 127, kvh = rem >> 5, rem2 = rem & 31, qblk = ((rem2 >> 3) << 1) | (rem2 & 1), g = (rem2 & 7) >> 1;
        const int head = kvh * 4 + g, qrow0 = b * 256 + qblk * 32;
        AttnState st; bf16x8 qf[2][2]; KVFrag cur, nxt;
        attn_init(st, qf, Q, qrow0, head, fr, fq);
        const bf16_t* kp = K + (size_t)(b * 256) * 256 + kvh * 64; const bf16_t* vp = VT + (size_t)((b * 8) * 4 + kvh) * 2048;
        attn_load(cur, kp, 256, vp, fr, fq);
        for (int c = 0; c < 8; ++c) {
            if (c < 7) attn_load(nxt, kp + (size_t)(32 * (c + 1)) * 256, 256, vp + (size_t)(c + 1) * 4 * 2048, fr, fq);
            attn_compute<0>(st, qf, cur, fr, fq, 0, 0, nullptr);
            cur = nxt;
        }
        attn_finish(st, O, qrow0, head, fr, fq, true, sinkp[head]);
    }
}
__device__ __forceinline__ void attn_phase_b(const bf16_t* Q, const bf16_t* K, const bf16_t* VT, const bf16_t* Kc, const bf16_t* VTc, const float* rpb, bf16_t* O, int gw, int ngw, int lane, LAS float* btab) {
    const int fr = lane & 15, fq = lane >> 4;
    int cur_head = -1;
    for (int t = gw; t < 4096; t += ngw) {
        const int b = t >> 11, rem = t & 2047, head = rem >> 7, qblk = rem & 127, r = qblk >> 1, half = qblk & 1;
        const int seq0 = NCTXROWS + b * 4096, qrow0 = seq0 + qblk * 32;
        if (head != cur_head) { for (int i = lane; i < 465; i += 64) btab[i] = rpb[head * 465 + i] * LOG2E; cur_head = head; asm volatile("s_waitcnt lgkmcnt(0)" ::: "memory"); }
        AttnState st; bf16x8 qf[2][2]; KVFrag cur, nxt;
        attn_init(st, qf, Q, qrow0, head, fr, fq);
        int rs = r - 4; rs = rs < 0 ? 0 : (rs > 56 ? 56 : rs);
        const bf16_t* kcp = Kc + (size_t)(b * 512) * 1024 + head * 64; const bf16_t* vcp = VTc + (size_t)(b * 16 * 16 + head) * 2048;
        const bf16_t* klp = K + (size_t)(seq0 + rs * 64) * 1024 + head * 64; const bf16_t* vlp = VT + (size_t)(((seq0 + rs * 64) >> 5) * 16 + head) * 2048;
        attn_load(cur, kcp, 1024, vcp, fr, fq);
        for (int c = 0; c < 16; ++c) {
            if (c < 15) attn_load(nxt, kcp + (size_t)(32 * (c + 1)) * 1024, 1024, vcp + (size_t)(c + 1) * 16 * 2048, fr, fq);
            else attn_load(nxt, klp, 1024, vlp, fr, fq);
            attn_compute<0>(st, qf, cur, fr, fq, 0, 0, nullptr);
            cur = nxt;
        }
        for (int c = 0; c < 16; ++c) {
            if (c < 15) attn_load(nxt, klp + (size_t)(32 * (c + 1)) * 1024, 1024, vlp + (size_t)(c + 1) * 16 * 2048, fr, fq);
            attn_compute<2>(st, qf, cur, fr, fq, 32 * (c & 1), 32 * half, btab + (rs + (c >> 1) - r + 7) * 31);
            cur = nxt;
        }
        attn_finish(st, O, qrow0, head, fr, fq, false, 0.f);
    }
    for (int t = gw; t < 2048; t += ngw) {
        const int b = t >> 7, rem = t & 127, head = rem >> 3, qblk = rem & 7;
        const int qrow0 = b * 256 + qblk * 32;
        AttnState st; bf16x8 qf[2][2]; KVFrag cur, nxt;
        attn_init(st, qf, Q, qrow0, head, fr, fq);
        const bf16_t* kp = K + (size_t)(b * 256) * 1024 + head * 64; const bf16_t* vp = VT + (size_t)((b * 8) * 16 + head) * 2048;
        attn_load(cur, kp, 1024, vp, fr, fq);
        for (int c = 0; c < 8; ++c) {
            if (c < 7) attn_load(nxt, kp + (size_t)(32 * (c + 1)) * 1024, 1024, vp + (size_t)(c + 1) * 16 * 2048, fr, fq);
            attn_compute<0>(st, qf, cur, fr, fq, 0, 0, nullptr);
            cur = nxt;
        }
        attn_finish(st, O, qrow0, head, fr, fq, false, 0.f);
    }
}


constexpr int KV_LDS_OFF = 16384, KV_BUF_BYTES = 9728, KROW_B = 144, VROW_B = 80, V_OFF = 4608;
__device__ __forceinline__ u32x4 stage_load(const bf16_t* kp, int kld, const bf16_t* vp, int tid) {
    if (tid < 256) return *(const u32x4*)(kp + (size_t)(tid >> 3) * kld + (tid & 7) * 8);
    return *(const u32x4*)(vp + (tid - 256) * 8);
}
__device__ __forceinline__ void stage_store(LAS unsigned char* buf, u32x4 v, int tid) {
    if (tid < 256) *(LAS u32x4*)(buf + (tid >> 3) * KROW_B + (tid & 7) * 16) = v;
    else { const int e = tid - 256; *(LAS u32x4*)(buf + V_OFF + (e >> 2) * VROW_B + (e & 3) * 16) = v; }
}
__device__ __forceinline__ void frag_load(KVFrag& f, const LAS unsigned char* buf, int fr, int fq) {
#pragma unroll
    for (int t = 0; t < 2; ++t)
#pragma unroll
        for (int h2 = 0; h2 < 2; ++h2) f.kf[t][h2] = *(const LAS bf16x8*)(buf + (16 * t + fr) * KROW_B + 64 * h2 + 16 * fq);
#pragma unroll
    for (int dt = 0; dt < 4; ++dt) { const LAS unsigned char* v = buf + V_OFF + (16 * dt + fr) * VROW_B + 8 * fq; const u32x2 lo = *(const LAS u32x2*)v, hi = *(const LAS u32x2*)(v + 32);
        f.vf[dt] = __builtin_bit_cast(bf16x8, ((u32x4){lo.x, lo.y, hi.x, hi.y})); }
}

__device__ __forceinline__ void attn_compute_pair(AttnState& st, const bf16x8 (&qf)[2][2], const LAS unsigned char* ba, const LAS unsigned char* bb, int fr, int fq) {
    bf16x8 pfa[2], pfb[2]; float alpha[2];
    {
        bf16x8 ka[2][2], kb[2][2];
#pragma unroll
        for (int t = 0; t < 2; ++t)
#pragma unroll
            for (int h2 = 0; h2 < 2; ++h2) { ka[t][h2] = *(const LAS bf16x8*)(ba + (16 * t + fr) * KROW_B + 64 * h2 + 16 * fq); kb[t][h2] = *(const LAS bf16x8*)(bb + (16 * t + fr) * KROW_B + 64 * h2 + 16 * fq); }
#pragma unroll
        for (int qb = 0; qb < 2; ++qb) {
            const f32x4 z = (f32x4){0.f, 0.f, 0.f, 0.f};
            f32x4 s0 = MFMA16(ka[0][0], qf[qb][0], z); s0 = MFMA16(ka[0][1], qf[qb][1], s0);
            f32x4 s1 = MFMA16(ka[1][0], qf[qb][0], z); s1 = MFMA16(ka[1][1], qf[qb][1], s1);
            f32x4 s2 = MFMA16(kb[0][0], qf[qb][0], z); s2 = MFMA16(kb[0][1], qf[qb][1], s2);
            f32x4 s3 = MFMA16(kb[1][0], qf[qb][0], z); s3 = MFMA16(kb[1][1], qf[qb][1], s3);
            float sv[16];
#pragma unroll
            for (int j = 0; j < 4; ++j) { sv[j] = s0[j] * SCL2; sv[4 + j] = s1[j] * SCL2; sv[8 + j] = s2[j] * SCL2; sv[12 + j] = s3[j] * SCL2; }
            float cmax = sv[0];
#pragma unroll
            for (int j = 1; j < 16; ++j) cmax = fmaxf(cmax, sv[j]);
            cmax = fmaxf(cmax, __shfl_xor(cmax, 16)); cmax = fmaxf(cmax, __shfl_xor(cmax, 32));
            const float mnew = fmaxf(st.m[qb], cmax);
            alpha[qb] = fast_exp2(st.m[qb] - mnew);
            st.m[qb] = mnew;
            float p[16]; float ps = 0.f;
#pragma unroll
            for (int j = 0; j < 16; ++j) { p[j] = fast_exp2(sv[j] - mnew); ps += p[j]; }
            st.l[qb] = st.l[qb] * alpha[qb] + ps;
            u32x4 pa, pb;
            pa.x = cvt_pk_bf16(p[0], p[1]); pa.y = cvt_pk_bf16(p[2], p[3]); pa.z = cvt_pk_bf16(p[4], p[5]); pa.w = cvt_pk_bf16(p[6], p[7]);
            pb.x = cvt_pk_bf16(p[8], p[9]); pb.y = cvt_pk_bf16(p[10], p[11]); pb.z = cvt_pk_bf16(p[12], p[13]); pb.w = cvt_pk_bf16(p[14], p[15]);
            pfa[qb] = __builtin_bit_cast(bf16x8, pa); pfb[qb] = __builtin_bit_cast(bf16x8, pb);
        }
    }
#pragma unroll
    for (int dt = 0; dt < 4; ++dt) {
        const LAS unsigned char* va = ba + V_OFF + (16 * dt + fr) * VROW_B + 8 * fq; const LAS unsigned char* vb_ = bb + V_OFF + (16 * dt + fr) * VROW_B + 8 * fq;
        const u32x2 alo = *(const LAS u32x2*)va, ahi = *(const LAS u32x2*)(va + 32), blo = *(const LAS u32x2*)vb_, bhi = *(const LAS u32x2*)(vb_ + 32);
        const bf16x8 vfa = __builtin_bit_cast(bf16x8, ((u32x4){alo.x, alo.y, ahi.x, ahi.y})), vfb = __builtin_bit_cast(bf16x8, ((u32x4){blo.x, blo.y, bhi.x, bhi.y}));
#pragma unroll
        for (int qb = 0; qb < 2; ++qb) { st.o[qb][dt] = st.o[qb][dt] * alpha[qb]; st.o[qb][dt] = MFMA16(vfa, pfa[qb], st.o[qb][dt]); st.o[qb][dt] = MFMA16(vfb, pfb[qb], st.o[qb][dt]); }
    }
}
template <int MASK>
__device__ __forceinline__ void attn_compute_pair_m(AttnState& st, const bf16x8 (&qf)[2][2], const LAS unsigned char* ba, const LAS unsigned char* bb, int fr, int fq, int mk0a, int mk0b, int mk1, const LAS float* bias) {
    bf16x8 pfa[2], pfb[2]; float alpha[2];
    {
        bf16x8 ka[2][2], kb[2][2];
#pragma unroll
        for (int t = 0; t < 2; ++t)
#pragma unroll
            for (int h2 = 0; h2 < 2; ++h2) { ka[t][h2] = *(const LAS bf16x8*)(ba + (16 * t + fr) * KROW_B + 64 * h2 + 16 * fq); kb[t][h2] = *(const LAS bf16x8*)(bb + (16 * t + fr) * KROW_B + 64 * h2 + 16 * fq); }
#pragma unroll
        for (int qb = 0; qb < 2; ++qb) {
            const f32x4 z = (f32x4){0.f, 0.f, 0.f, 0.f};
            f32x4 s0 = MFMA16(ka[0][0], qf[qb][0], z); s0 = MFMA16(ka[0][1], qf[qb][1], s0);
            f32x4 s1 = MFMA16(ka[1][0], qf[qb][0], z); s1 = MFMA16(ka[1][1], qf[qb][1], s1);
            f32x4 s2 = MFMA16(kb[0][0], qf[qb][0], z); s2 = MFMA16(kb[0][1], qf[qb][1], s2);
            f32x4 s3 = MFMA16(kb[1][0], qf[qb][0], z); s3 = MFMA16(kb[1][1], qf[qb][1], s3);
            float sv[16];
#pragma unroll
            for (int j = 0; j < 4; ++j) { sv[j] = s0[j] * SCL2; sv[4 + j] = s1[j] * SCL2; sv[8 + j] = s2[j] * SCL2; sv[12 + j] = s3[j] * SCL2; }
            if (MASK == 1) {
#pragma unroll
                for (int h = 0; h < 2; ++h) { const int d0 = (h ? mk0b : mk0a) + 4 * fq - 16 * qb - fr;
#pragma unroll
                    for (int t = 0; t < 2; ++t)
#pragma unroll
                        for (int j = 0; j < 4; ++j) { const int df = d0 + 16 * t + j; if (df > 128 || df < -128) sv[8 * h + 4 * t + j] = -INFINITY; } }
            }
            if (MASK == 2) {
                const int qc = mk1 + 16 * qb + fr; int cs = qc - 8; cs = cs < 0 ? 0 : (cs > 48 ? 48 : cs);
#pragma unroll
                for (int h = 0; h < 2; ++h)
#pragma unroll
                    for (int t = 0; t < 2; ++t)
#pragma unroll
                        for (int j = 0; j < 4; ++j) { const int kc = (h ? mk0b : mk0a) + 16 * t + 4 * fq + j; const bool ok = (kc >= cs) && (kc < cs + 16);
                            int bi = kc - qc + 15; bi = bi < 0 ? 0 : (bi > 30 ? 30 : bi);
                            const float bv = bias[bi];
                            sv[8 * h + 4 * t + j] = ok ? sv[8 * h + 4 * t + j] + bv : -INFINITY; }
            }
            float cmax = sv[0];
#pragma unroll
            for (int j = 1; j < 16; ++j) cmax = fmaxf(cmax, sv[j]);
            cmax = fmaxf(cmax, __shfl_xor(cmax, 16)); cmax = fmaxf(cmax, __shfl_xor(cmax, 32));
            const float mnew = fmaxf(st.m[qb], cmax);
            const float msafe = (mnew == -INFINITY) ? 0.f : mnew;
            alpha[qb] = fast_exp2(st.m[qb] - msafe);
            st.m[qb] = mnew;
            float p[16]; float ps = 0.f;
#pragma unroll
            for (int j = 0; j < 16; ++j) { p[j] = fast_exp2(sv[j] - msafe); ps += p[j]; }
            st.l[qb] = st.l[qb] * alpha[qb] + ps;
            u32x4 pa, pb;
            pa.x = cvt_pk_bf16(p[0], p[1]); pa.y = cvt_pk_bf16(p[2], p[3]); pa.z = cvt_pk_bf16(p[4], p[5]); pa.w = cvt_pk_bf16(p[6], p[7]);
            pb.x = cvt_pk_bf16(p[8], p[9]); pb.y = cvt_pk_bf16(p[10], p[11]); pb.z = cvt_pk_bf16(p[12], p[13]); pb.w = cvt_pk_bf16(p[14], p[15]);
            pfa[qb] = __builtin_bit_cast(bf16x8, pa); pfb[qb] = __builtin_bit_cast(bf16x8, pb);
        }
    }
#pragma unroll
    for (int dt = 0; dt < 4; ++dt) {
        const LAS unsigned char* va = ba + V_OFF + (16 * dt + fr) * VROW_B + 8 * fq; const LAS unsigned char* vb_ = bb + V_OFF + (16 * dt + fr) * VROW_B + 8 * fq;
        const u32x2 alo = *(const LAS u32x2*)va, ahi = *(const LAS u32x2*)(va + 32), blo = *(const LAS u32x2*)vb_, bhi = *(const LAS u32x2*)(vb_ + 32);
        const bf16x8 vfa = __builtin_bit_cast(bf16x8, ((u32x4){alo.x, alo.y, ahi.x, ahi.y})), vfb = __builtin_bit_cast(bf16x8, ((u32x4){blo.x, blo.y, bhi.x, bhi.y}));
#pragma unroll
        for (int qb = 0; qb < 2; ++qb) { st.o[qb][dt] = st.o[qb][dt] * alpha[qb]; st.o[qb][dt] = MFMA16(vfa, pfa[qb], st.o[qb][dt]); st.o[qb][dt] = MFMA16(vfb, pfb[qb], st.o[qb][dt]); }
    }
}
__device__ __forceinline__ void attn_pairs(AttnState& st, const bf16x8 (&qf)[2][2], const bf16_t* kp, int kld, const bf16_t* vp, int vstride, int NP, bool has_next, const bf16_t* kp2, const bf16_t* vp2, const bf16_t* kp3, const bf16_t* vp3,
                                           LAS unsigned char* kvb, int tid, int fr, int fq) {
    u32x4 sr0 = stage_load(kp, kld, vp, tid), sr1 = stage_load(kp + (size_t)32 * kld, kld, vp + vstride, tid);
    stage_store(kvb, sr0, tid); stage_store(kvb + KV_BUF_BYTES, sr1, tid);
    __syncthreads();
    for (int sp = 0; sp < NP; ++sp) {
        const bool more = sp + 1 < NP;
        if (more) { sr0 = stage_load(kp + (size_t)(32 * (2 * sp + 2)) * kld, kld, vp + (size_t)(2 * sp + 2) * vstride, tid); sr1 = stage_load(kp + (size_t)(32 * (2 * sp + 3)) * kld, kld, vp + (size_t)(2 * sp + 3) * vstride, tid); }
        else if (has_next) { sr0 = stage_load(kp2, kld, vp2, tid); sr1 = stage_load(kp3, kld, vp3, tid); }
        const LAS unsigned char* buf = kvb + (sp & 1) * 2 * KV_BUF_BYTES;
        attn_compute_pair(st, qf, buf, buf + KV_BUF_BYTES, fr, fq);
        LAS unsigned char* nb_ = kvb + ((sp + 1) & 1) * 2 * KV_BUF_BYTES;
        if (more) { stage_store(nb_, sr0, tid); stage_store(nb_ + KV_BUF_BYTES, sr1, tid); }
        else if (has_next) { stage_store(nb_, sr0, tid); stage_store(nb_ + KV_BUF_BYTES, sr1, tid); }
        __syncthreads();
    }
}
__device__ __forceinline__ void attn_groups_a(const bf16_t* Q, const bf16_t* K, const bf16_t* VT, const bf16_t* Kc, const bf16_t* VTc, const float* sinkp, bf16_t* O, int vb, int nb, int tid, LAS unsigned char* lds) {
    const int lane = tid & 63, wave = __builtin_amdgcn_readfirstlane(tid >> 6), fr = lane & 15, fq = lane >> 4;
    LAS unsigned char* kvb = lds + KV_LDS_OFF;
    for (int g = vb; g < 512; g += nb) {
        const int t = g * 8 + wave;
        const int b = t >> 11, rem = t & 2047, kvh = rem >> 9, rem2 = rem & 511, qp = rem2 >> 3, qblk = (qp << 1) | (rem2 & 1), gh = (rem2 & 7) >> 1;
        const int head = kvh * 4 + gh, qpos0 = qblk * 32, seq0 = NCTXROWS + b * 4096, qrow0 = seq0 + qpos0;
        const int cmin = 2 * qp - 4 < 0 ? 0 : 2 * qp - 4, cmax = 2 * qp + 5 > 127 ? 127 : 2 * qp + 5, nsteps = 16 + (cmax - cmin + 1);
        AttnState st; bf16x8 qf[2][2]; KVFrag f;
        attn_init(st, qf, Q, qrow0, head, fr, fq);
        const bf16_t* kcp = Kc + (size_t)(b * 512) * 256 + kvh * 64; const bf16_t* vcp = VTc + (size_t)(b * 16 * 4 + kvh) * 2048;
        const bf16_t* klp = K + (size_t)seq0 * 256 + kvh * 64; const bf16_t* vlp = VT + (size_t)((seq0 >> 5) * 4 + kvh) * 2048;
        {
            const int np = (cmax - cmin + 2) >> 1;
#define A_KP(c) (klp + (size_t)(32 * ((c) > 127 ? 127 : (c))) * 256)
#define A_VP(c) (vlp + (size_t)((c) > 127 ? 127 : (c)) * 4 * 2048)
            attn_pairs(st, qf, kcp, 256, vcp, 4 * 2048, 8, true, A_KP(cmin), A_VP(cmin), A_KP(cmin + 1), A_VP(cmin + 1), kvb, tid, fr, fq);
            u32x4 sr0, sr1;
            for (int p = 0; p < np; ++p) { const int ca = cmin + 2 * p, cb = ca + 1;
                if (p + 1 < np) { sr0 = stage_load(A_KP(ca + 2), 256, A_VP(ca + 2), tid); sr1 = stage_load(A_KP(ca + 3), 256, A_VP(ca + 3), tid); }
                const LAS unsigned char* buf = kvb + (p & 1) * 2 * KV_BUF_BYTES;
                if (!(cb < qblk - 4 || ca > qblk + 4)) attn_compute_pair_m<1>(st, qf, buf, buf + KV_BUF_BYTES, fr, fq, 32 * ca - qpos0, 32 * cb - qpos0, 0, nullptr);
                LAS unsigned char* nb_ = kvb + ((p + 1) & 1) * 2 * KV_BUF_BYTES;
                if (p + 1 < np) { stage_store(nb_, sr0, tid); stage_store(nb_ + KV_BUF_BYTES, sr1, tid); }
                __syncthreads(); }
#undef A_KP
#undef A_VP
        }
        attn_finish(st, O, qrow0, head, fr, fq, true, sinkp[head]);
    }
    for (int g = vb; g < 256; g += nb) {
        const int t = g * 8 + wave;
        const int b = t >> 7, rem = t & 127, kvh = rem >> 5, rem2 = rem & 31, qblk = ((rem2 >> 3) << 1) | (rem2 & 1), gh = (rem2 & 7) >> 1;
        const int head = kvh * 4 + gh, qrow0 = b * 256 + qblk * 32;
        AttnState st; bf16x8 qf[2][2]; KVFrag f;
        attn_init(st, qf, Q, qrow0, head, fr, fq);
        const bf16_t* kp = K + (size_t)(b * 256) * 256 + kvh * 64; const bf16_t* vp = VT + (size_t)((b * 8) * 4 + kvh) * 2048;
        attn_pairs(st, qf, kp, 256, vp, 4 * 2048, 4, false, kp, vp, kp, vp, kvb, tid, fr, fq);
        attn_finish(st, O, qrow0, head, fr, fq, true, sinkp[head]);
    }
}
__device__ __forceinline__ void attn_groups_b(const bf16_t* Q, const bf16_t* K, const bf16_t* VT, const bf16_t* Kc, const bf16_t* VTc, const float* rpb, bf16_t* O, int vb, int nb, int tid, LAS unsigned char* lds) {
    const int lane = tid & 63, wave = __builtin_amdgcn_readfirstlane(tid >> 6), fr = lane & 15, fq = lane >> 4;
    LAS unsigned char* kvb = lds + KV_LDS_OFF;
    LAS float* btab = (LAS float*)(lds + wave * 2048);
    for (int g = vb; g < 512; g += nb) {
        const int b = g >> 8, head = (g >> 4) & 15, r0 = 4 * (g & 15), qblk = 2 * r0 + wave, r = r0 + (wave >> 1), half = wave & 1;
        const int seq0 = NCTXROWS + b * 4096, qrow0 = seq0 + qblk * 32;
        for (int i = lane; i < 465; i += 64) btab[i] = rpb[head * 465 + i] * LOG2E;
        int rmin = r0 - 4; rmin = rmin < 0 ? 0 : (rmin > 56 ? 56 : rmin);
        int rmax = r0 - 1; rmax = (rmax < 0 ? 0 : (rmax > 56 ? 56 : rmax)) + 7;
        int rs = r - 4; rs = rs < 0 ? 0 : (rs > 56 ? 56 : rs);
        const int nsteps = 16 + 2 * (rmax - rmin + 1);
        AttnState st; bf16x8 qf[2][2]; KVFrag f;
        attn_init(st, qf, Q, qrow0, head, fr, fq);
        const bf16_t* kcp = Kc + (size_t)(b * 512) * 1024 + head * 64; const bf16_t* vcp = VTc + (size_t)(b * 16 * 16 + head) * 2048;
        const bf16_t* klp = K + (size_t)(seq0 + rmin * 64) * 1024 + head * 64; const bf16_t* vlp = VT + (size_t)(((seq0 + rmin * 64) >> 5) * 16 + head) * 2048;
        {
            const int np = rmax - rmin + 1;
            attn_pairs(st, qf, kcp, 1024, vcp, 16 * 2048, 8, true, klp, vlp, klp + (size_t)32 * 1024, vlp + (size_t)16 * 2048, kvb, tid, fr, fq);
            u32x4 sr0, sr1;
            for (int p = 0; p < np; ++p) { const int kr = rmin + p;
                if (p + 1 < np) { sr0 = stage_load(klp + (size_t)(64 * (p + 1)) * 1024, 1024, vlp + (size_t)(2 * p + 2) * 16 * 2048, tid); sr1 = stage_load(klp + (size_t)(64 * (p + 1) + 32) * 1024, 1024, vlp + (size_t)(2 * p + 3) * 16 * 2048, tid); }
                const LAS unsigned char* buf = kvb + (p & 1) * 2 * KV_BUF_BYTES;
                if (kr >= rs && kr <= rs + 7) attn_compute_pair_m<2>(st, qf, buf, buf + KV_BUF_BYTES, fr, fq, 0, 32, 32 * half, btab + (kr - r + 7) * 31);
                else attn_compute_pair_m<1>(st, qf, buf, buf + KV_BUF_BYTES, fr, fq, 1000000, 1000000, 0, nullptr);
                LAS unsigned char* nb_ = kvb + ((p + 1) & 1) * 2 * KV_BUF_BYTES;
                if (p + 1 < np) { stage_store(nb_, sr0, tid); stage_store(nb_ + KV_BUF_BYTES, sr1, tid); }
                __syncthreads(); }
        }
        attn_finish(st, O, qrow0, head, fr, fq, false, 0.f);
    }
    for (int g = vb; g < 256; g += nb) {
        const int b = g >> 4, head = g & 15, qblk = wave;
        const int qrow0 = b * 256 + qblk * 32;
        AttnState st; bf16x8 qf[2][2]; KVFrag f;
        attn_init(st, qf, Q, qrow0, head, fr, fq);
        const bf16_t* kp = K + (size_t)(b * 256) * 1024 + head * 64; const bf16_t* vp = VT + (size_t)((b * 8) * 16 + head) * 2048;
        attn_pairs(st, qf, kp, 1024, vp, 16 * 2048, 4, false, kp, vp, kp, vp, kvb, tid, fr, fq);
        attn_finish(st, O, qrow0, head, fr, fq, false, 0.f);
    }
}

__device__ __forceinline__ void transpose_item(const float* W, int K, int N, bf16_t* WT, int kb, int nb, int dst_n0, LAS float* scr, int lane) {
    const int k0 = 64 * kb, n0 = 32 * nb;
#pragma unroll 8
    for (int i = 0; i < 32; ++i) { const int kk = 2 * i + (lane >> 5); scr[kk * 33 + (lane & 31)] = W[(size_t)(k0 + kk) * N + n0 + (lane & 31)]; }
    asm volatile("s_waitcnt lgkmcnt(0)" ::: "memory");
    const int c = lane & 7;
#pragma unroll
    for (int j = 0; j < 4; ++j) { const int n = (lane >> 3) + 8 * j; const LAS float* s = scr + (8 * c) * 33 + n;
        u32x4 o; o.x = cvt_pk_bf16(s[0 * 33], s[1 * 33]); o.y = cvt_pk_bf16(s[2 * 33], s[3 * 33]); o.z = cvt_pk_bf16(s[4 * 33], s[5 * 33]); o.w = cvt_pk_bf16(s[6 * 33], s[7 * 33]);
        *(u32x4*)(WT + (size_t)(dst_n0 + n) * K + k0 + 8 * c) = o; }
    asm volatile("s_waitcnt lgkmcnt(0)" ::: "memory");
}
__device__ __forceinline__ int up_perm(int o) { return o < DFF ? 256 * (o / 128) + (o % 128) : 256 * ((o - DFF) / 128) + 128 + ((o - DFF) % 128); }
__device__ __forceinline__ int qkv_perm(int o) { return (o & ~255) + 128 * ((o >> 5) & 1) + 32 * ((o >> 6) & 3); }

__device__ __forceinline__ void prologue(const Args& a, LAS unsigned char* lds, int tid, int lane, int wave) {
    unsigned char* ws = a.ws;
    const int G = gridDim.x, bx = blockIdx.x;
    {
        LAS float* sc = (LAS float*)lds;
        LAS float* red = (LAS float*)(lds + 16384);
        bool have = false;
        for (int it = bx; it < 192; it += G) {
            if (!have) { for (int k = tid; k < 3072; k += NTHR) { const int cnd = k >> 10, kk = k & 1023; const float x = cnd == 0 ? a.in[7][kk] : a.in[6][(cnd - 1) * 1024 + kk]; sc[k] = silu_f(x); } have = true; }
            __syncthreads();
            const int l = it / 96, n0 = (it % 96) * 64;
            const float* W = a.in[10] + (size_t)l * 1024 * 6144 + n0;
            const int c4 = tid & 15, ks = tid >> 4;
            f32x4 a0 = (f32x4){0.f, 0.f, 0.f, 0.f}, a1 = a0, a2 = a0;
#pragma unroll 8
            for (int kk = 0; kk < 32; ++kk) { const int k = ks * 32 + kk; const f32x4 w = *(const f32x4*)(W + (size_t)k * 6144 + 4 * c4);
                a0 += w * sc[k]; a1 += w * sc[1024 + k]; a2 += w * sc[2048 + k]; }
#pragma unroll
            for (int j = 0; j < 4; ++j) { red[(ks * 3 + 0) * 64 + 4 * c4 + j] = a0[j]; red[(ks * 3 + 1) * 64 + 4 * c4 + j] = a1[j]; red[(ks * 3 + 2) * 64 + 4 * c4 + j] = a2[j]; }
            __syncthreads();
            if (tid < 192) { const int cnd = tid >> 6, col = tid & 63; float s = 0.f;
#pragma unroll 8
                for (int q = 0; q < 32; ++q) s += red[(q * 3 + cnd) * 64 + col];
                ((float*)(ws + WS_MOD))[(l * 3 + cnd) * 6144 + n0 + col] = s + a.in[11][l * 6144 + n0 + col]; }
        }
        __syncthreads();
    }
    const int gw = bx * NWAVES + wave, NGW = G * NWAVES;
    const size_t gt = (size_t)bx * NTHR + tid, NT = (size_t)G * NTHR;
    if (gt < 1024) { const int pos = (int)gt >> 4, f = (int)gt & 15; const float freq = exp2f(-(float)f * (13.287712379549449f / 16.0f)); const float ang = (float)pos * freq;
        float* rp = (float*)(ws + WS_ROPE); rp[2 * gt] = cosf(ang); rp[2 * gt + 1] = sinf(ang); }
    {
        LAS float* scr = (LAS float*)(lds + wave * 16384);
        constexpr int I_QA = 16 * 48, I_QB = 16 * 96, I_O = 16 * 32, I_UP = 16 * 176, I_DN = 44 * 32;
        constexpr int NITEMS = I_QA + I_QB + 2 * I_O + 2 * I_UP + 2 * I_DN;
        for (int it = gw; it < NITEMS; it += NGW) {
            int r = it;
            if (r < I_QA) { const int kb = r / 48, nb = r % 48; transpose_item(a.in[12], 1024, 1536, (bf16_t*)(ws + WS_WQKVA), kb, nb, qkv_perm(32 * nb), scr, lane); continue; } r -= I_QA;
            if (r < I_QB) { const int kb = r / 96, nb = r % 96; transpose_item(a.in[17], 1024, 3072, (bf16_t*)(ws + WS_WQKVB), kb, nb, qkv_perm(32 * nb), scr, lane); continue; } r -= I_QB;
            if (r < I_O) { const int kb = r / 32, nb = r % 32; transpose_item(a.in[16], 1024, 1024, (bf16_t*)(ws + WS_WOA), kb, nb, 32 * nb, scr, lane); continue; } r -= I_O;
            if (r < I_O) { const int kb = r / 32, nb = r % 32; transpose_item(a.in[21], 1024, 1024, (bf16_t*)(ws + WS_WOB), kb, nb, 32 * nb, scr, lane); continue; } r -= I_O;
            if (r < 2 * I_UP) { const int l = r / I_UP; r -= l * I_UP; const int kb = r / 176, nb = r % 176;
                transpose_item(a.in[22] + (size_t)l * 1024 * 5632, 1024, 5632, (bf16_t*)(ws + (l ? WS_WUP1 : WS_WUP0)), kb, nb, up_perm(32 * nb), scr, lane); continue; } r -= 2 * I_UP;
            { const int l = r / I_DN; r -= l * I_DN; const int kb = r / 32, nb = r % 32;
                transpose_item(a.in[25] + (size_t)l * 2816 * 1024, 2816, 1024, (bf16_t*)(ws + (l ? WS_WDN1 : WS_WDN0)), kb, nb, 32 * nb, scr, lane); }
        }
    }
    {
        bf16_t* kca = (bf16_t*)(ws + WS_KCA); bf16_t* kcb = (bf16_t*)(ws + WS_KCB); bf16_t* vca = (bf16_t*)(ws + WS_VTCA); bf16_t* vcb = (bf16_t*)(ws + WS_VTCB);
        for (size_t i = gt; i < 262144; i += NT) kca[i] = (bf16_t)f2bf(a.in[2][i]);
        for (size_t i = gt; i < 1048576; i += NT) kcb[i] = (bf16_t)f2bf(a.in[4][i]);
        for (size_t i = gt; i < 262144; i += NT) { const int tt = (int)i & 31, d = ((int)i >> 5) & 63, kvh = ((int)i >> 11) & 3, c = ((int)i >> 13) & 15, b = (int)i >> 17;
            vca[i] = (bf16_t)f2bf(a.in[3][((size_t)(b * 512 + c * 32 + tt) * 4 + kvh) * 64 + d]); }
        for (size_t i = gt; i < 1048576; i += NT) { const int tt = (int)i & 31, d = ((int)i >> 5) & 63, kvh = ((int)i >> 11) & 15, c = ((int)i >> 15) & 15, b = (int)i >> 19;
            vcb[i] = (bf16_t)f2bf(a.in[5][((size_t)(b * 512 + c * 32 + tt) * 16 + kvh) * 64 + d]); }
    }
}
__device__ __forceinline__ void norm_mod_phase(const float* xa, const float* xb, const float* nw, const float* shift, const float* scale, bf16_t* H, int gw, int ngw, int lane) {
    for (int row0 = gw; row0 < MTOK; row0 += 2 * ngw) {
        const int row1 = row0 + ngw; const bool two = row1 < MTOK; const int rowb = two ? row1 : row0;
        const float* xr0 = row0 < NCTXROWS ? xa + (size_t)row0 * DM : xb + (size_t)(row0 - NCTXROWS) * DM;
        const float* xr1 = rowb < NCTXROWS ? xa + (size_t)rowb * DM : xb + (size_t)(rowb - NCTXROWS) * DM;
        const int cond0 = row0 < NCTXROWS ? 0 : 1 + ((row0 - NCTXROWS) >> 12), cond1 = rowb < NCTXROWS ? 0 : 1 + ((rowb - NCTXROWS) >> 12);
        f32x4 v0[4], v1[4]; float s0 = 0.f, s1 = 0.f;
#pragma unroll
        for (int j = 0; j < 4; ++j) { v0[j] = *(const f32x4*)(xr0 + 4 * (lane + 64 * j)); v1[j] = *(const f32x4*)(xr1 + 4 * (lane + 64 * j)); }
#pragma unroll
        for (int j = 0; j < 4; ++j) { const f32x4 t0 = v0[j] * v0[j], t1 = v1[j] * v1[j]; s0 += (t0[0] + t0[1]) + (t0[2] + t0[3]); s1 += (t1[0] + t1[1]) + (t1[2] + t1[3]); }
#pragma unroll
        for (int o = 1; o < 64; o <<= 1) { s0 += __shfl_xor(s0, o); s1 += __shfl_xor(s1, o); }
        const float r0 = rsqrtf(s0 * (1.0f / DM) + EPSN), r1 = rsqrtf(s1 * (1.0f / DM) + EPSN);
#pragma unroll
        for (int j = 0; j < 4; ++j) { const int col = 4 * (lane + 64 * j);
            const f32x4 w = *(const f32x4*)(nw + col);
            const f32x4 sc0 = *(const f32x4*)(scale + cond0 * 6144 + col), sh0 = *(const f32x4*)(shift + cond0 * 6144 + col);
            const f32x4 y0 = (v0[j] * r0 * w) * (sc0 + 1.0f) + sh0;
            u32x2 o0; o0.x = cvt_pk_bf16(y0[0], y0[1]); o0.y = cvt_pk_bf16(y0[2], y0[3]);
            *(u32x2*)(H + (size_t)row0 * DM + col) = o0;
            if (two) { const f32x4 sc1 = *(const f32x4*)(scale + cond1 * 6144 + col), sh1 = *(const f32x4*)(shift + cond1 * 6144 + col);
                const f32x4 y1 = (v1[j] * r1 * w) * (sc1 + 1.0f) + sh1;
                u32x2 o1; o1.x = cvt_pk_bf16(y1[0], y1[1]); o1.y = cvt_pk_bf16(y1[2], y1[3]);
                *(u32x2*)(H + (size_t)row1 * DM + col) = o1; } }
    }
}
__device__ __forceinline__ void conv_act_phase(const bf16_t* U, const float* cw, const float* cb, bf16_t* ACT, size_t gt, size_t nt) {
    for (size_t item = gt; item < (size_t)384 * 352; item += nt) {
        const int rb = (int)(item / 352), fg = (int)(item % 352), r0 = rb * 32, f0 = fg * 8;
        const int pos0 = r0 < NCTXROWS ? (r0 & 255) : (r0 & 4095), L = r0 < NCTXROWS ? 256 : 4096;
        const bool has_prev = pos0 > 0, has_next = pos0 + 32 < L;
        float wg[3][8], wv[3][8], bg[8], bv[8];
#pragma unroll
        for (int o = 0; o < 3; ++o)
#pragma unroll
            for (int j = 0; j < 8; ++j) { wg[o][j] = cw[o * DUP + f0 + j]; wv[o][j] = cw[o * DUP + DFF + f0 + j]; }
#pragma unroll
        for (int j = 0; j < 8; ++j) { bg[j] = cb[f0 + j]; bv[j] = cb[DFF + f0 + j]; }
        const u32x4 z4 = (u32x4){0u, 0u, 0u, 0u};
        const bf16_t* up = U + (size_t)r0 * DUP + f0;
        u32x4 gp = z4, vp = z4, gc, vc, gn, vn;
        if (has_prev) { gp = *(const u32x4*)(up - DUP); vp = *(const u32x4*)(up - DUP + DFF); }
        gc = *(const u32x4*)up; vc = *(const u32x4*)(up + DFF);
        for (int r = 0; r < 32; ++r) {
            gn = z4; vn = z4;
            if (r < 31 || has_next) { gn = *(const u32x4*)(up + (size_t)(r + 1) * DUP); vn = *(const u32x4*)(up + (size_t)(r + 1) * DUP + DFF); }
            float res[8];
#pragma unroll
            for (int q = 0; q < 4; ++q) {
                const float g0 = wg[0][2 * q] * bflo(gp[q]) + wg[1][2 * q] * bflo(gc[q]) + wg[2][2 * q] * bflo(gn[q]) + bg[2 * q];
                const float g1 = wg[0][2 * q + 1] * bfhi(gp[q]) + wg[1][2 * q + 1] * bfhi(gc[q]) + wg[2][2 * q + 1] * bfhi(gn[q]) + bg[2 * q + 1];
                const float v0 = wv[0][2 * q] * bflo(vp[q]) + wv[1][2 * q] * bflo(vc[q]) + wv[2][2 * q] * bflo(vn[q]) + bv[2 * q];
                const float v1 = wv[0][2 * q + 1] * bfhi(vp[q]) + wv[1][2 * q + 1] * bfhi(vc[q]) + wv[2][2 * q + 1] * bfhi(vn[q]) + bv[2 * q + 1];
                res[2 * q] = silu_f(g0) * v0; res[2 * q + 1] = silu_f(g1) * v1;
            }
            u32x4 o; o.x = cvt_pk_bf16(res[0], res[1]); o.y = cvt_pk_bf16(res[2], res[3]); o.z = cvt_pk_bf16(res[4], res[5]); o.w = cvt_pk_bf16(res[6], res[7]);
            *(u32x4*)(ACT + (size_t)(r0 + r) * DFF + f0) = o;
            gp = gc; vp = vc; gc = gn; vc = vn;
        }
    }
}

__global__ void __launch_bounds__(NTHR, 2) mk_fwd(Args a) {
    extern __shared__ __attribute__((aligned(16))) unsigned char lds_raw[];
    cg::grid_group grid = cg::this_grid();
    LAS unsigned char* lds = (LAS unsigned char*)lds_raw;
    const int tid = threadIdx.x, lane = tid & 63, wave = __builtin_amdgcn_readfirstlane(tid >> 6);
    const int G = gridDim.x, bx = blockIdx.x;
    const int gw = bx * NWAVES + wave, NGW = G * NWAVES;
    const size_t gt = (size_t)bx * NTHR + tid, NT = (size_t)G * NTHR;
    unsigned char* ws = a.ws;
    float* out = a.out;
    bf16_t* H = (bf16_t*)(ws + WS_H); bf16_t* ACT = (bf16_t*)(ws + WS_ACT); bf16_t* U = (bf16_t*)(ws + WS_U);
    bf16_t* Qb = (bf16_t*)(ws + WS_Q); bf16_t* Kb = (bf16_t*)(ws + WS_K); bf16_t* VTb = (bf16_t*)(ws + WS_VT); bf16_t* Ob = (bf16_t*)(ws + WS_O);
    const float* rope = (const float*)(ws + WS_ROPE);

#ifndef NO_PRO
    for (int rep = 0; rep < REP_THIN; ++rep) { prologue(a, lds, tid, lane, wave); __syncthreads(); }
#endif
    volatile LAS unsigned* bst = (volatile LAS unsigned*)(lds + 131072 + 64);
    if (tid < 2) bst[tid] = 0u;
    unsigned* barw = (unsigned*)(ws + WS_BAR);
    if (bx == 0) for (int i = tid; i < XCD_BAR_WORDS; i += NTHR) barw[i] = 0u;
    grid.sync();
    const XcdBarrier xbar = xcd_barrier_post(barw, bst);
#define GSYNC() xcd_barrier(xbar)

#pragma unroll 1
    for (int layer = 0; layer < 2; ++layer) {
        const float* mod = (const float*)(ws + WS_MOD) + layer * 3 * 6144;
        const float* xa = layer == 0 ? a.in[0] : out;
        const float* xb = layer == 0 ? a.in[1] : out + (size_t)NCTXROWS * DM;
#ifndef NO_NORM
        for (int rep = 0; rep < REP_THIN; ++rep)
        { int tl = tid; asm volatile("" : "+v"(tl)); const int wv = __builtin_amdgcn_readfirstlane(tl >> 6);
          norm_mod_phase(xa, xb, a.in[8] + layer * DM, mod + 0 * 1024, mod + 1 * 1024, H, bx * NWAVES + wv, NGW, tl & 63); }
#endif
        GSYNC();
#ifndef NO_QKV
        if (layer == 0) {
            pg8::Gemm g{H, (const bf16_t*)(ws + WS_WQKVA), MTOK, 1536, 1024}; pg8::StaticOrder S; int bxl = bx; asm volatile("" : "+s"(bxl)); int tl = tid; asm volatile("" : "+v"(tl)); S.init(MTOK, 1536, G, bxl);
            EpiQKV<4> E{Qb, Kb, VTb, out + OUT_KA, out + OUT_VA, a.in[13], a.in[14], rope};
            pg8::gemm_phase<EpiQKV<4>, pg8::StaticOrder, true, true>(lds, g, S, E, tl);
        } else {
            pg8::Gemm g{H, (const bf16_t*)(ws + WS_WQKVB), MTOK, 3072, 1024}; pg8::StaticOrder S; int bxl = bx; asm volatile("" : "+s"(bxl)); int tl = tid; asm volatile("" : "+v"(tl)); S.init(MTOK, 3072, G, bxl);
            EpiQKV<16> E{Qb, Kb, VTb, out + OUT_KB, out + OUT_VB, a.in[18], a.in[19], rope};
            pg8::gemm_phase<EpiQKV<16>, pg8::StaticOrder, true, true>(lds, g, S, E, tl);
        }
#endif
        GSYNC();
#ifndef NO_ATTN
        for (int rep = 0; rep < REP_ATTN; ++rep)
        { int tl = tid; asm volatile("" : "+v"(tl));
        if (layer == 0) attn_groups_a(Qb, Kb, VTb, (const bf16_t*)(ws + WS_KCA), (const bf16_t*)(ws + WS_VTCA), a.in[15], Ob, bx, G, tl, lds);
        else attn_groups_b(Qb, Kb, VTb, (const bf16_t*)(ws + WS_KCB), (const bf16_t*)(ws + WS_VTCB), a.in[20], Ob, bx, G, tl, lds); }
#endif
        GSYNC();
#ifndef NO_OPROJ
        {
            pg8::Gemm g{Ob, (const bf16_t*)(ws + (layer ? WS_WOB : WS_WOA)), MTOK, 1024, 1024}; pg8::StaticOrder S; int bxl = bx; asm volatile("" : "+s"(bxl)); int tl = tid; asm volatile("" : "+v"(tl)); S.init(MTOK, 1024, G, bxl);
            EpiResid E{xa, xb, out, mod + 2 * 1024};
            pg8::gemm_phase<EpiResid, pg8::StaticOrder, true, true>(lds, g, S, E, tl);
        }
#endif
        GSYNC();
#ifndef NO_NORM
        for (int rep = 0; rep < REP_THIN; ++rep)
        { int tl = tid; asm volatile("" : "+v"(tl)); const int wv = __builtin_amdgcn_readfirstlane(tl >> 6);
          norm_mod_phase(out, out + (size_t)NCTXROWS * DM, a.in[9] + layer * DM, mod + 3 * 1024, mod + 4 * 1024, H, bx * NWAVES + wv, NGW, tl & 63); }
#endif
        GSYNC();
#ifndef NO_UP
        {
            pg8::Gemm g{H, (const bf16_t*)(ws + (layer ? WS_WUP1 : WS_WUP0)), 50 * 256, DUP, 1024}; pg8::StaticOrder S; int bxl = bx; asm volatile("" : "+s"(bxl)); int tl = tid; asm volatile("" : "+v"(tl)); S.init(50 * 256, DUP, G, bxl);
            EpiUpConv E{ACT, a.in[23] + (size_t)layer * 3 * DUP, a.in[24] + (size_t)layer * DUP, (LAS float*)(lds + 131072 + 1024)};
            pg8::gemm_phase<EpiUpConv, pg8::StaticOrder, true, true>(lds, g, S, E, tl);
        }
#endif
        GSYNC();
#ifndef NO_DOWN
        {
            pg8::Gemm g{ACT, (const bf16_t*)(ws + (layer ? WS_WDN1 : WS_WDN0)), MTOK, 1024, DFF}; pg8::StaticOrder S; int bxl = bx; asm volatile("" : "+s"(bxl)); int tl = tid; asm volatile("" : "+v"(tl)); S.init(MTOK, 1024, G, bxl);
            EpiResid E{out, out + (size_t)NCTXROWS * DM, out, mod + 5 * 1024};
            pg8::gemm_phase<EpiResid, pg8::StaticOrder, true, true>(lds, g, S, E, tl);
        }
#endif
        if (layer == 0) GSYNC();
    }
}

extern "C" void kernel_launch(void* const* d_in, const int* in_sizes, int n_in, void* d_out, int out_size, void* d_ws, size_t ws_size, hipStream_t stream) {
    static int grid = 0;
    if (grid == 0) {
        if (n_in != 26 || out_size != 23068672 || ws_size < WS_END) { fprintf(stderr, "kernel_launch: unexpected shapes n_in %d out %d ws %zu\n", n_in, out_size, ws_size); grid = -1; return; }
        int dev = 0, cus = 0, per_cu = 0;
        hipGetDevice(&dev);
        hipDeviceGetAttribute(&cus, hipDeviceAttributeMultiprocessorCount, dev);
        hipFuncSetAttribute((const void*)mk_fwd, hipFuncAttributeMaxDynamicSharedMemorySize, LDS_BYTES);
        hipOccupancyMaxActiveBlocksPerMultiprocessor(&per_cu, (const void*)mk_fwd, NTHR, LDS_BYTES);
        if (per_cu < 1) per_cu = 1;
        grid = cus * per_cu;
    }
    if (grid < 0) return;
    Args a{};
    for (int i = 0; i < 26; ++i) a.in[i] = (const float*)d_in[i];
    a.out = (float*)d_out; a.ws = (unsigned char*)d_ws;
    void* args[] = {&a};
    hipError_t e = hipLaunchCooperativeKernel((const void*)mk_fwd, dim3(grid), dim3(NTHR), args, LDS_BYTES, stream);
    if (e != hipSuccess) fprintf(stderr, "cooperative launch failed: %s (grid %d)\n", hipGetErrorString(e), grid);
}
```

```cpp
#include <hip/hip_runtime.h>
#include <hip/hip_cooperative_groups.h>
#include <cstdio>
#include <cstdint>
namespace cg = cooperative_groups;
namespace pg8 {
#define PG8_LAS __attribute__((address_space(3)))
typedef unsigned short bf16_t;
typedef short bf16x8 __attribute__((ext_vector_type(8)));
typedef float f32x4 __attribute__((ext_vector_type(4)));
typedef unsigned u32x4 __attribute__((ext_vector_type(4)));
constexpr int BM = 256, BK = 64, HALF = 128, HTB = HALF * BK * 2  , STAGE_BYTES = 8 * HTB, NXCD = 8, WGM = 8;

__host__ __device__ __forceinline__ int lds_byte(int r, int c) { const int st = (r >> 4) * 2 + (c >> 5), rr = r & 15, cc = c & 31, ob = rr * 64 + cc * 2; return st * 1024 + (ob ^ (((ob >> 9) & 1) << 5)); }
__host__ __device__ __forceinline__ void stage_rc(int b, int& R, int& C) { const int st = b / 1024, sb = b % 1024, swz = sb ^ (((sb >> 9) & 1) << 5); R = (st >> 1) * 16 + swz / 64; C = (st & 1) * 32 + (swz % 64) / 2; }
__host__ __device__ __forceinline__ int perm32(int rho) { const int n = rho >> 4, i = rho & 15; return 8 * (i >> 2) + 4 * n + (i & 3); }

struct Unit { int pm, pn; };
struct Gemm { const bf16_t* A; const bf16_t* Bt; int M, N, K; };

struct StaticOrder {
    int nM, nN, nwg, G, c;
    __host__ __device__ void init(int M, int N, int G_, int c_) { nM = M / BM; nN = N / BM; nwg = nM * nN; G = G_; c = c_; }
    __host__ __device__ bool next(int i, Unit& u) const {
        const long L = (long)i * G + c; if (L >= nwg) return false;
        int wgid = (int)L; { const int q = nwg / NXCD, r = nwg % NXCD, xcd = wgid % NXCD, off = wgid / NXCD; wgid = (xcd < r ? xcd * (q + 1) : r * (q + 1) + (xcd - r) * q) + off; }
        const int nig = WGM * nN, gid = wgid / nig, fm = gid * WGM, gsz = (nM - fm) < WGM ? (nM - fm) : WGM;
        u.pm = fm + ((wgid % nig) % gsz); u.pn = (wgid % nig) / gsz; return true;
    }
    __device__ __forceinline__ void a_ready(const Unit&) const {}
    __device__ __forceinline__ void done(const Unit&) const {}
};

__device__ __forceinline__ unsigned cvt_pk_bf16(float lo, float hi) { unsigned r; asm volatile("v_cvt_pk_bf16_f32 %0, %1, %2" : "=v"(r) : "v"(lo), "v"(hi)); return r; }
template <class Epi, class Sched, bool ALIGN_EPI = false, bool SP2 = false>
__device__ __forceinline__ void gemm_phase(PG8_LAS unsigned char* lds, const Gemm g, const Sched& S, const Epi& E, const int tid_in) {
    const int tid = tid_in, wid = __builtin_amdgcn_readfirstlane(tid >> 6), lane = tid & 63, wr = wid >> 2, wc = wid & 3, fr = lane & 15, fq = lane >> 4;
    const int K = g.K, nt = K / BK;
    unsigned voffA[2], voffB[2];
#pragma unroll
    for (int i = 0; i < 2; ++i) { int R, C; stage_rc(tid * 16 + i * 8192, R, C); const int Rb = Epi::PERM ? ((R & ~31) + perm32(R & 31)) : R;
        voffA[i] = (unsigned)(R * K + C) * 2u; voffB[i] = (unsigned)(Rb * K + C) * 2u; }
    const size_t kstep = (size_t)(BK * 2);
    const size_t hstep = (size_t)HALF * K * 2;
    const size_t tstep = 2 * hstep;
    const unsigned ldsw = (unsigned)wid * 1024u;
    const int aoff = lds_byte(wr * 64 + fr, fq * 8), boff = lds_byte(wc * 32 + fr, fq * 8);
#define PG8_SA(b, h) (((b) * 2 + (h)) * HTB)
#define PG8_SB(b, h) ((4 + (b) * 2 + (h)) * HTB)
#define PG8_STAGE(bufoff, gbase, voff) do { _Pragma("unroll") for (int _i = 0; _i < 2; ++_i) \
        __builtin_amdgcn_global_load_lds((const unsigned*)((const char*)(gbase) + (voff)[_i]), (PG8_LAS unsigned*)(lds + (bufoff) + ldsw + _i * 8192), 16, 0, 0); } while (0)
#define PG8_LDA(dst, b, h) do { _Pragma("unroll") for (int m = 0; m < 4; ++m) _Pragma("unroll") for (int k = 0; k < 2; ++k) dst[m][k] = *(const PG8_LAS bf16x8*)(lds + PG8_SA(b, h) + aoff + m * 2048 + k * 1024); } while (0)
#define PG8_LDB(dst, b, h) do { _Pragma("unroll") for (int n = 0; n < 2; ++n) _Pragma("unroll") for (int k = 0; k < 2; ++k) dst[n][k] = *(const PG8_LAS bf16x8*)(lds + PG8_SB(b, h) + boff + n * 2048 + k * 1024); } while (0)
#define PG8_MMA(ai, bj, At, Bt) do { __builtin_amdgcn_s_setprio(1); _Pragma("unroll") for (int m = 0; m < 4; ++m) _Pragma("unroll") for (int n = 0; n < 2; ++n) _Pragma("unroll") for (int k = 0; k < 2; ++k) \
        acc[ai][bj][m][n] = __builtin_amdgcn_mfma_f32_16x16x32_bf16(Bt[n][k], At[m][k], acc[ai][bj][m][n], 0, 0, 0); __builtin_amdgcn_s_setprio(0); } while (0)
#define PG8_WAIT_V(n) asm volatile("s_waitcnt vmcnt(" #n ")" ::: "memory")
#define PG8_WAIT_L(n) asm volatile("s_waitcnt lgkmcnt(" #n ")" ::: "memory")
#define PG8_BAR __builtin_amdgcn_s_barrier()
#define PG8_SCHED __builtin_amdgcn_sched_barrier(0)
    Unit cur, nxt; int ui = 0;
    if (!S.next(0, cur)) return;
    f32x4 acc[2][2][4][2];
#pragma unroll
    for (int a = 0; a < 2; ++a)
#pragma unroll
        for (int b = 0; b < 2; ++b)
#pragma unroll
            for (int m = 0; m < 4; ++m)
#pragma unroll
                for (int n = 0; n < 2; ++n) acc[a][b][m][n] = (f32x4){0.f, 0.f, 0.f, 0.f};
    bf16x8 At[4][2], B0[2][2], B1[2][2];
    const char* cA = (const char*)g.A + (size_t)Epi::a_row0(cur.pm) * ((size_t)K * 2); const char* cB = (const char*)g.Bt + (size_t)cur.pn * tstep;
    S.a_ready(cur);
    if constexpr (SP2) {
        PG8_STAGE(PG8_SB(0, 0), cB, voffB); PG8_STAGE(PG8_SB(0, 1), cB + hstep, voffB); PG8_STAGE(PG8_SA(0, 0), cA, voffA); PG8_STAGE(PG8_SA(0, 1), cA + hstep, voffA);
        if (wr == 1) PG8_BAR;
        PG8_WAIT_V(2); PG8_BAR;
        PG8_STAGE(PG8_SB(1, 0), cB + kstep, voffB); PG8_STAGE(PG8_SA(1, 0), cA + kstep, voffA); PG8_STAGE(PG8_SB(1, 1), cB + hstep + kstep, voffB);
        PG8_WAIT_V(6); PG8_BAR;
    } else {
        PG8_STAGE(PG8_SB(0, 0), cB, voffB); PG8_STAGE(PG8_SA(0, 0), cA, voffA); PG8_STAGE(PG8_SB(0, 1), cB + hstep, voffB); PG8_STAGE(PG8_SA(0, 1), cA + hstep, voffA);
        if (wr == 1) PG8_BAR;
        PG8_WAIT_V(4); PG8_BAR;
        PG8_STAGE(PG8_SB(1, 0), cB + kstep, voffB); PG8_STAGE(PG8_SA(1, 0), cA + kstep, voffA); PG8_STAGE(PG8_SB(1, 1), cB + hstep + kstep, voffB);
        PG8_WAIT_V(6); PG8_BAR;
    }
    for (;;) {
        const bool has_next = S.next(ui + 1, nxt);
        const char* nA = has_next ? (const char*)g.A + (size_t)Epi::a_row0(nxt.pm) * ((size_t)K * 2) : cA; const char* nB = has_next ? (const char*)g.Bt + (size_t)nxt.pn * tstep : cB;
        for (int t = 0; t < nt; t += 2) {
            const bool last = (t == nt - 2);
            const char* a1 = cA + (size_t)(t + 1) * kstep;
            const char* a2 = last ? nA : cA + (size_t)(t + 2) * kstep; const char* b2 = last ? nB : cB + (size_t)(t + 2) * kstep;
            const char* a3 = a2 + kstep; const char* b3 = b2 + kstep;
            if (last && has_next) S.a_ready(nxt);
            if constexpr (SP2) {
            PG8_LDB(B0, 0, 0); PG8_LDB(B1, 0, 1); PG8_SCHED; PG8_LDA(At, 0, 0); PG8_STAGE(PG8_SA(1, 1), a1 + hstep, voffA);
            PG8_WAIT_V(8); PG8_WAIT_L(0); PG8_BAR; PG8_MMA(0, 0, At, B0); PG8_MMA(0, 1, At, B1); PG8_BAR; PG8_SCHED;
            PG8_LDA(At, 0, 1); PG8_STAGE(PG8_SB(0, 0), b2, voffB); PG8_STAGE(PG8_SB(0, 1), b2 + hstep, voffB); PG8_STAGE(PG8_SA(0, 0), a2, voffA);
            PG8_WAIT_V(8); PG8_WAIT_L(0); PG8_BAR; PG8_MMA(1, 0, At, B0); PG8_MMA(1, 1, At, B1); PG8_BAR; PG8_SCHED;
            PG8_LDB(B0, 1, 0); PG8_LDB(B1, 1, 1); PG8_SCHED; PG8_LDA(At, 1, 0); PG8_STAGE(PG8_SA(0, 1), a2 + hstep, voffA);
            PG8_WAIT_V(8); PG8_WAIT_L(0); PG8_BAR; PG8_MMA(0, 0, At, B0); PG8_MMA(0, 1, At, B1); PG8_BAR; PG8_SCHED;
            PG8_LDA(At, 1, 1); PG8_STAGE(PG8_SB(1, 0), b3, voffB); PG8_STAGE(PG8_SB(1, 1), b3 + hstep, voffB); PG8_STAGE(PG8_SA(1, 0), a3, voffA);
            PG8_WAIT_V(8); PG8_WAIT_L(0); PG8_BAR; PG8_MMA(1, 0, At, B0); PG8_MMA(1, 1, At, B1); PG8_BAR; PG8_SCHED;
            } else {
            PG8_LDB(B0, 0, 0); PG8_SCHED; PG8_LDA(At, 0, 0); PG8_STAGE(PG8_SA(1, 1), a1 + hstep, voffA);
            PG8_WAIT_L(8); PG8_BAR; PG8_WAIT_L(0); PG8_MMA(0, 0, At, B0); PG8_BAR; PG8_SCHED;
            PG8_LDB(B1, 0, 1); PG8_STAGE(PG8_SB(0, 0), b2, voffB);
            PG8_BAR; PG8_WAIT_L(0); PG8_MMA(0, 1, At, B1); PG8_BAR;
            PG8_LDA(At, 0, 1); PG8_STAGE(PG8_SA(0, 0), a2, voffA);
            PG8_BAR; PG8_WAIT_L(0); PG8_MMA(1, 0, At, B0); PG8_BAR; PG8_SCHED;
            PG8_STAGE(PG8_SB(0, 1), b2 + hstep, voffB);
            PG8_WAIT_V(6); PG8_BAR; PG8_MMA(1, 1, At, B1); PG8_BAR;
            PG8_LDB(B0, 1, 0); PG8_SCHED; PG8_LDA(At, 1, 0); PG8_STAGE(PG8_SA(0, 1), a2 + hstep, voffA);
            PG8_WAIT_L(8); PG8_BAR; PG8_WAIT_L(0); PG8_MMA(0, 0, At, B0); PG8_BAR; PG8_SCHED;
            PG8_LDB(B1, 1, 1); PG8_STAGE(PG8_SB(1, 0), b3, voffB);
            PG8_BAR; PG8_WAIT_L(0); PG8_MMA(0, 1, At, B1); PG8_BAR;
            PG8_LDA(At, 1, 1); PG8_STAGE(PG8_SA(1, 0), a3, voffA);
            PG8_BAR; PG8_WAIT_L(0); PG8_MMA(1, 0, At, B0); PG8_BAR; PG8_SCHED;
            PG8_STAGE(PG8_SB(1, 1), b3 + hstep, voffB);
            PG8_WAIT_V(6); PG8_BAR; PG8_MMA(1, 1, At, B1); PG8_BAR;
            }
        }
        if constexpr (ALIGN_EPI) { if (wr == 0) PG8_BAR; }
        if constexpr (!Epi::AFTER_DRAIN) { E(acc, cur, wr, wc, fr, fq); S.done(cur); }
        if (!has_next) break;
#pragma unroll
        for (int a = 0; a < 2; ++a)
#pragma unroll
            for (int b = 0; b < 2; ++b)
#pragma unroll
                for (int m = 0; m < 4; ++m)
#pragma unroll
                    for (int n = 0; n < 2; ++n) acc[a][b][m][n] = (f32x4){0.f, 0.f, 0.f, 0.f};
        cur = nxt; cA = nA; cB = nB; ++ui;
        if constexpr (ALIGN_EPI) { if (wr == 1) PG8_BAR; }
    }
    PG8_WAIT_V(0);
    if constexpr (!ALIGN_EPI) { if (wr == 0) PG8_BAR; }
    PG8_BAR;
    if constexpr (Epi::AFTER_DRAIN) { E.fused(acc, cur, wr, wc, fr, fq, lds, wid, lane); S.done(cur); }
#undef PG8_SA
#undef PG8_SB
#undef PG8_STAGE
#undef PG8_LDA
#undef PG8_LDB
#undef PG8_MMA
#undef PG8_WAIT_V
#undef PG8_WAIT_L
#undef PG8_BAR
#undef PG8_SCHED
}
}

#define LAS __attribute__((address_space(3)))
typedef unsigned short bf16_t;
typedef short bf16x8 __attribute__((ext_vector_type(8)));
typedef float f32x4 __attribute__((ext_vector_type(4)));
typedef float f32x2 __attribute__((ext_vector_type(2)));
typedef unsigned u32x4 __attribute__((ext_vector_type(4)));
typedef unsigned u32x2 __attribute__((ext_vector_type(2)));
using pg8::cvt_pk_bf16;

#ifndef REP_ATTN
#define REP_ATTN 1
#endif
#ifndef REP_THIN
#define REP_THIN 1
#endif
constexpr int NWAVES = 8, NTHR = 512;
constexpr int LDS_BYTES = 147456;
constexpr int MTOK = 12288, NCTXROWS = 4096, DM = 1024, DFF = 2816, DUP = 5632;
constexpr float EPSN = 1e-6f;
constexpr float LOG2E = 1.4426950408889634f;
constexpr float SCL2 = 0.125f * 1.4426950408889634f;

constexpr size_t MiB = 1u << 20;
constexpr size_t WS_MOD = 0;
constexpr size_t WS_ROPE = 256 * 1024;
constexpr size_t WS_BAR = 512 * 1024;
constexpr size_t WS_KCA = 1 * MiB;
constexpr size_t WS_VTCA = 1 * MiB + 512 * 1024;
constexpr size_t WS_KCB = 2 * MiB;
constexpr size_t WS_VTCB = 4 * MiB;
constexpr size_t WS_WQKVA = 6 * MiB, WS_WQKVB = 9 * MiB, WS_WOA = 15 * MiB, WS_WOB = 17 * MiB;
constexpr size_t WS_WUP0 = 19 * MiB, WS_WUP1 = 30 * MiB, WS_WDN0 = 41 * MiB, WS_WDN1 = 46 * MiB + 512 * 1024;
constexpr size_t WS_H = 52 * MiB;
constexpr size_t WS_ACT = 118 * MiB;
constexpr size_t WS_U = 118 * MiB;
constexpr size_t WS_Q = 118 * MiB, WS_K = 142 * MiB, WS_VT = 166 * MiB, WS_O = 190 * MiB;
constexpr size_t WS_END = 250 * MiB;
constexpr size_t OUT_Y = 0, OUT_KA = 12582912, OUT_VA = 13631488, OUT_KB = 14680064, OUT_VB = 18874368;

__device__ __forceinline__ unsigned f2bf(float f) { unsigned u = __builtin_bit_cast(unsigned, f); return (u + 0x7fffu + ((u >> 16) & 1u)) >> 16; }
__device__ __forceinline__ float bflo(unsigned w) { return __builtin_bit_cast(float, w << 16); }
__device__ __forceinline__ float bfhi(unsigned w) { return __builtin_bit_cast(float, w & 0xffff0000u); }
__device__ __forceinline__ float wave_sum(float v) {
#pragma unroll
    for (int o = 1; o < 64; o <<= 1) v += __shfl_xor(v, o);
    return v;
}
__device__ __forceinline__ float fast_exp2(float x) { return __builtin_amdgcn_exp2f(x); }
__device__ __forceinline__ float silu_f(float x) { return x * __builtin_amdgcn_rcpf(1.0f + __expf(-x)); }

struct Args { const float* in[26]; float* out; unsigned char* ws; };

#define XB_TMO      128
#define XB_XCNT(j)  (256  + 64 * (j))
#define XB_XSUB(j)  (1280 + 64 * (j))
#define XB_XGEN(j)  (2304 + 64 * (j))
#define XB_TOP      3328
#define XB_TOPGEN   3392
#define XCD_BAR_WORDS 3456
#define XB_SPIN_CAP (1u << 18)

__device__ __forceinline__ unsigned xb_ld(unsigned* p)              { return __hip_atomic_load(p, __ATOMIC_RELAXED, __HIP_MEMORY_SCOPE_AGENT); }
__device__ __forceinline__ unsigned xb_add(unsigned* p, unsigned v) { return __hip_atomic_fetch_add(p, v, __ATOMIC_RELAXED, __HIP_MEMORY_SCOPE_AGENT); }
__device__ __forceinline__ unsigned xb_xcc_id() { return (unsigned)__builtin_amdgcn_s_getreg((3 << 11) | 20) & 0xFu; }
#define XB_SPIN(cond, bar) do { unsigned _sp = 0; while (cond) { __builtin_amdgcn_s_sleep(1); \
    if ((++_sp & 255u) == 0u) { if (xb_ld(&(bar)[XB_TMO])) break; if (_sp > XB_SPIN_CAP) { atomicAdd(&(bar)[XB_TMO], 1u); break; } } } } while (0)

struct XcdBarrier {
    unsigned* bar; unsigned x;
    volatile LAS unsigned* st;
};

__device__ __forceinline__ XcdBarrier xcd_barrier_post(unsigned* bar, volatile LAS unsigned* st) {
    XcdBarrier b; b.bar = bar; b.x = xb_xcc_id(); b.st = st;
    if (threadIdx.x == 0) (void)xb_add(&bar[XB_XCNT(b.x)], 1u);
    return b;
}
__device__ __forceinline__ void xcd_barrier_complete(unsigned* bar, unsigned x, unsigned& nloc, unsigned& nx) {
    const unsigned G = gridDim.x * gridDim.y * gridDim.z;
    unsigned sum, cnt, mine, sp = 0u;
    for (;;) {
        sum = 0u; cnt = 0u; mine = 0u;
#pragma unroll
        for (unsigned j = 0; j < 16; ++j) { const unsigned c = xb_ld(&bar[XB_XCNT(j)]); sum += c; cnt += (c > 0u) ? 1u : 0u; mine = (j == x) ? c : mine; }
        if (sum == G) break;
        __builtin_amdgcn_s_sleep(1);
        if ((++sp & 255u) == 0u) { if (xb_ld(&bar[XB_TMO])) break; if (sp > XB_SPIN_CAP) { atomicAdd(&bar[XB_TMO], 1u); break; } }
    }
    nloc = mine > 0u ? mine : 1u; nx = cnt > 0u ? cnt : 1u;
}

__device__ __forceinline__ void xcd_barrier(const XcdBarrier& b) {
    asm volatile("s_waitcnt vmcnt(0)" ::: "memory");
    __syncthreads();
    if (threadIdx.x == 0) {
        unsigned* bar = b.bar;
        __builtin_amdgcn_s_waitcnt(0);
        unsigned nloc = b.st[0], nx = b.st[1];
        if (nloc == 0u) { xcd_barrier_complete(bar, b.x, nloc, nx); b.st[0] = nloc; b.st[1] = nx; }
        const unsigned old = xb_add(&bar[XB_XSUB(b.x)], 1u);
        const unsigned gen = old / nloc;
        if (old + 1u == (gen + 1u) * nloc) {
            __builtin_amdgcn_fence(__ATOMIC_RELEASE, "agent");
            asm volatile("s_waitcnt vmcnt(0)" ::: "memory");
            const unsigned og = xb_add(&bar[XB_TOP], 1u);
            const unsigned tg = og / nx;
            if (og + 1u == (tg + 1u) * nx) xb_add(&bar[XB_TOPGEN], 1u);
            else XB_SPIN(xb_ld(&bar[XB_TOPGEN]) == tg, bar);
            __builtin_amdgcn_fence(__ATOMIC_ACQUIRE, "agent");
            xb_add(&bar[XB_XGEN(b.x)], 1u);
            asm volatile("s_waitcnt vmcnt(0)" ::: "memory");
        } else {
            XB_SPIN(xb_ld(&bar[XB_XGEN(b.x)]) == gen, bar);
            __builtin_amdgcn_fence(__ATOMIC_ACQUIRE, "agent");
            asm volatile("s_waitcnt vmcnt(0)" ::: "memory");
        }
    }
    __syncthreads();
}


using pg8::Unit;
struct EpiUp {
    static constexpr bool PERM = true, AFTER_DRAIN = false;
    static __device__ __forceinline__ int a_row0(int pm) { return pm * 256; }
    bf16_t* O; int ldc;
    __device__ __forceinline__ void operator()(const f32x4 (&acc)[2][2][4][2], const Unit& u, int wr, int wc, int fr, int fq) const {
        const int row0 = u.pm * 256 + wr * 64 + fr, col0 = u.pn * 256 + wc * 32 + 8 * fq;
#pragma unroll
        for (int ai = 0; ai < 2; ++ai)
#pragma unroll
            for (int m = 0; m < 4; ++m) { bf16_t* rowp = O + (size_t)(row0 + ai * 128 + m * 16) * ldc + col0;
#pragma unroll
                for (int bj = 0; bj < 2; ++bj) { const f32x4 v0 = acc[ai][bj][m][0], v1 = acc[ai][bj][m][1];
                    u32x4 w; w.x = cvt_pk_bf16(v0[0], v0[1]); w.y = cvt_pk_bf16(v0[2], v0[3]); w.z = cvt_pk_bf16(v1[0], v1[1]); w.w = cvt_pk_bf16(v1[2], v1[3]);
                    *(u32x4*)(rowp + bj * 128) = w; } }
    }
};
struct EpiResid {
    static constexpr bool PERM = false, AFTER_DRAIN = false;
    static __device__ __forceinline__ int a_row0(int pm) { return pm * 256; }
    const float* xa; const float* xb; float* out; const float* gate;
    __device__ __forceinline__ void operator()(const f32x4 (&acc)[2][2][4][2], const Unit& u, int wr, int wc, int fr, int fq) const {
        const int rbase = u.pm * 256;
        const float* xin = rbase < NCTXROWS ? xa + (size_t)rbase * DM : xb + (size_t)(rbase - NCTXROWS) * DM;
        const int cond = rbase < NCTXROWS ? 0 : 1 + ((rbase - NCTXROWS) >> 12);
        const int col0 = u.pn * 256 + wc * 32 + 4 * fq;
        const float* g = gate + cond * 6144 + col0;
        float* o = out + (size_t)rbase * DM;
        f32x4 gv[2][2];
#pragma unroll
        for (int bj = 0; bj < 2; ++bj)
#pragma unroll
            for (int n = 0; n < 2; ++n) gv[bj][n] = *(const f32x4*)(g + bj * 128 + n * 16);
#pragma unroll
        for (int ai = 0; ai < 2; ++ai)
#pragma unroll
            for (int m = 0; m < 4; ++m) { const size_t off = (size_t)(ai * 128 + wr * 64 + m * 16 + fr) * DM + col0;
#pragma unroll
                for (int bj = 0; bj < 2; ++bj)
#pragma unroll
                    for (int n = 0; n < 2; ++n) { const f32x4 x = *(const f32x4*)(xin + off + bj * 128 + n * 16);
                        *(f32x4*)(o + off + bj * 128 + n * 16) = x + gv[bj][n] * acc[ai][bj][m][n]; }
                if (m & 1) asm volatile("" ::: "memory"); }
    }
};

struct EpiUpConv {
    static constexpr bool PERM = false, AFTER_DRAIN = false;
    static __device__ __forceinline__ int a_row0(int pm) {
        if (pm < 16) return pm * 256;
        const int s = (pm - 16) / 17, j = (pm - 16) % 17; int st = 254 * j - 1; st = st > 3841 ? 3841 : st;
        return NCTXROWS + 4096 * s + st;
    }
    bf16_t* ACT; const float* cw; const float* cb; LAS float* xch;
    __device__ __forceinline__ void operator()(const f32x4 (&acc)[2][2][4][2], const Unit& u, int wr, int wc, int fr, int fq) const {
        const bool latent = u.pm >= 16;
        const int j17 = latent ? (u.pm - 16) % 17 : -1;
        const bool zr0 = (j17 == 0) && (wr == 0) && (fr == 0), zr255 = (j17 == 16) && (wr == 1) && (fr == 15);
        const int grow0 = a_row0(u.pm);
        const int lane = fq * 16 + fr;
        const int src_prev = (lane & 48) | ((fr + 15) & 15), src_next = (lane & 48) | ((fr + 1) & 15);
        const f32x4 z4 = (f32x4){0.f, 0.f, 0.f, 0.f};
#pragma unroll
        for (int ai = 0; ai < 2; ++ai) { const int g = ai * 2 + wr;
#pragma unroll
            for (int bj = 0; bj < 2; ++bj)
#pragma unroll
                for (int n = 0; n < 2; ++n) { const int col = bj * 128 + 32 * wc + 16 * n + 4 * fq;
                    if (fr == 0) *(LAS f32x4*)(xch + (g * 2 + 0) * 256 + col) = (ai == 0 && zr0) ? z4 : acc[ai][bj][0][n];
                    if (fr == 15) *(LAS f32x4*)(xch + (g * 2 + 1) * 256 + col) = (ai == 1 && zr255) ? z4 : acc[ai][bj][3][n]; } }
        asm volatile("s_waitcnt lgkmcnt(0)" ::: "memory"); __builtin_amdgcn_s_barrier(); asm volatile("" ::: "memory");
        const int fbase = u.pn * 128 + 32 * wc + 4 * fq;
#pragma unroll
        for (int n = 0; n < 2; ++n) {
            const int f0 = fbase + 16 * n;
            f32x4 wg[3], wv[3];
#pragma unroll
            for (int o = 0; o < 3; ++o) { wg[o] = *(const f32x4*)(cw + o * DUP + f0); wv[o] = *(const f32x4*)(cw + o * DUP + DFF + f0); }
            const f32x4 bg = *(const f32x4*)(cb + f0), bv = *(const f32x4*)(cb + DFF + f0);
#pragma unroll
            for (int ai = 0; ai < 2; ++ai) {
                const int g = ai * 2 + wr;
                f32x4 bp[2], bn[2];
#pragma unroll
                for (int bj = 0; bj < 2; ++bj) { const int col = bj * 128 + 32 * wc + 16 * n + 4 * fq;
                    bp[bj] = g > 0 ? *(const LAS f32x4*)(xch + ((g - 1) * 2 + 1) * 256 + col) : z4;
                    bn[bj] = g < 3 ? *(const LAS f32x4*)(xch + ((g + 1) * 2 + 0) * 256 + col) : z4; }
#pragma unroll
                for (int m = 0; m < 4; ++m) {
                    f32x4 cv[2];
#pragma unroll
                    for (int bj = 0; bj < 2; ++bj) {
                        f32x4 cur = acc[ai][bj][m][n];
                        if (ai == 0 && m == 0) cur = zr0 ? z4 : cur;
                        if (ai == 1 && m == 3) cur = zr255 ? z4 : cur;
                        f32x4 ps = m > 0 ? acc[ai][bj][m - 1][n] : bp[bj];
                        f32x4 ns = m < 3 ? acc[ai][bj][m + 1][n] : bn[bj];
                        f32x4 tp, tn, pv, nv;
#pragma unroll
                        for (int i = 0; i < 4; ++i) { tp[i] = fr == 15 ? ps[i] : cur[i]; tn[i] = fr == 0 ? ns[i] : cur[i]; }
#pragma unroll
                        for (int i = 0; i < 4; ++i) { pv[i] = __shfl(tp[i], src_prev); nv[i] = __shfl(tn[i], src_next); }
                        const f32x4 w0 = bj ? wv[0] : wg[0], w1 = bj ? wv[1] : wg[1], w2 = bj ? wv[2] : wg[2], bb = bj ? bv : bg;
                        cv[bj] = w0 * pv + w1 * cur + w2 * nv + bb;
                    }
                    f32x4 r;
#pragma unroll
                    for (int i = 0; i < 4; ++i) r[i] = silu_f(cv[0][i]) * cv[1][i];
                    const int R = ai * 128 + wr * 64 + m * 16 + fr;
                    const bool halo = latent && ((ai == 0 && m == 0 && wr == 0 && fr == 0) || (ai == 1 && m == 3 && wr == 1 && fr == 15));
                    if (!halo) { u32x2 w; w.x = cvt_pk_bf16(r[0], r[1]); w.y = cvt_pk_bf16(r[2], r[3]); *(u32x2*)(ACT + (size_t)(grow0 + R) * DFF + f0) = w; }
                }
            }
            asm volatile("" ::: "memory");
        }
    }
};
template <int NKV>
struct EpiQKV {
    static constexpr bool PERM = false, AFTER_DRAIN = false;
    static __device__ __forceinline__ int a_row0(int pm) { return pm * 256; }
    bf16_t* Q; bf16_t* K; bf16_t* VT; float* newk; float* newv; const float* qn; const float* kn; const float* rope;
    __device__ __forceinline__ void operator()(const f32x4 (&acc)[2][2][4][2], const Unit& u, int wr, int wc, int fr, int fq) const {
        constexpr int KLD = NKV * 64;
        const int hs = 4 * u.pn + wc;
        const int rbase = u.pm * 256 + wr * 64 + fr;
        const bool latent = u.pm >= 16;
        if (hs < 16 + NKV) {
            const bool isq = hs < 16;
            const float* nw = isq ? qn : kn;
            f32x4 wn[2][2];
#pragma unroll
            for (int bj = 0; bj < 2; ++bj)
#pragma unroll
                for (int n = 0; n < 2; ++n) wn[bj][n] = *(const f32x4*)(nw + 32 * bj + 16 * n + 4 * fq);
#pragma unroll
            for (int ai = 0; ai < 2; ++ai)
#pragma unroll
                for (int m = 0; m < 4; ++m) {
                    const int row = rbase + ai * 128 + m * 16;
                    f32x4 v[2][2]; float ss = 0.f;
#pragma unroll
                    for (int bj = 0; bj < 2; ++bj)
#pragma unroll
                        for (int n = 0; n < 2; ++n) { v[bj][n] = acc[ai][bj][m][n]; const f32x4 t = v[bj][n] * v[bj][n]; ss += (t[0] + t[1]) + (t[2] + t[3]); }
                    ss += __shfl_xor(ss, 16); ss += __shfl_xor(ss, 32);
                    const float rinv = rsqrtf(ss * (1.0f / 64.0f) + EPSN);
#pragma unroll
                    for (int bj = 0; bj < 2; ++bj)
#pragma unroll
                        for (int n = 0; n < 2; ++n) v[bj][n] = v[bj][n] * rinv * wn[bj][n];
                    if (latent && NKV == 4) {
                        const int pr = ((row - NCTXROWS) & 4095) >> 6, pc = row & 63;
#pragma unroll
                        for (int bj = 0; bj < 2; ++bj) {
                            const int pos = bj ? pc : pr;
                            const f32x4* t = (const f32x4*)(rope + (pos * 16 + 4 * fq) * 2);
                            const f32x4 t0 = t[0], t1 = t[1];
                            const f32x4 cs = (f32x4){t0[0], t0[2], t1[0], t1[2]}, sn = (f32x4){t0[1], t0[3], t1[1], t1[3]};
                            const f32x4 x1 = v[bj][0], x2 = v[bj][1];
                            v[bj][0] = x1 * cs - x2 * sn; v[bj][1] = x2 * cs + x1 * sn;
                        }
                    }
                    if (isq) {
                        bf16_t* p = Q + (size_t)row * DM + hs * 64 + 4 * fq;
#pragma unroll
                        for (int bj = 0; bj < 2; ++bj)
#pragma unroll
                            for (int n = 0; n < 2; ++n) { u32x2 w; w.x = cvt_pk_bf16(v[bj][n][0], v[bj][n][1]); w.y = cvt_pk_bf16(v[bj][n][2], v[bj][n][3]); *(u32x2*)(p + 32 * bj + 16 * n) = w; }
                    } else {
                        const int kvh = hs - 16;
                        bf16_t* p = K + (size_t)row * KLD + kvh * 64 + 4 * fq;
#pragma unroll
                        for (int bj = 0; bj < 2; ++bj)
#pragma unroll
                            for (int n = 0; n < 2; ++n) { u32x2 w; w.x = cvt_pk_bf16(v[bj][n][0], v[bj][n][1]); w.y = cvt_pk_bf16(v[bj][n][2], v[bj][n][3]); *(u32x2*)(p + 32 * bj + 16 * n) = w; }
                        if (!latent) {
                            float* o = newk + (size_t)row * KLD + kvh * 64 + 4 * fq;
#pragma unroll
                            for (int bj = 0; bj < 2; ++bj)
#pragma unroll
                                for (int n = 0; n < 2; ++n) *(f32x4*)(o + 32 * bj + 16 * n) = v[bj][n];
                        }
                    }
                    asm volatile("" ::: "memory");
                }
        } else {
            const int kvh = hs - 16 - NKV;
#pragma unroll
            for (int ai = 0; ai < 2; ++ai)
#pragma unroll
                for (int m = 0; m < 4; ++m) {
                    const int row = rbase + ai * 128 + m * 16;
                    bf16_t* p = VT + ((size_t)(row >> 5) * NKV + kvh) * 2048 + (row & 31) + (4 * fq) * 32;
#pragma unroll
                    for (int bj = 0; bj < 2; ++bj)
#pragma unroll
                        for (int n = 0; n < 2; ++n)
#pragma unroll
                            for (int i = 0; i < 4; ++i) p[(32 * bj + 16 * n + i) * 32] = (bf16_t)f2bf(acc[ai][bj][m][n][i]);
                    if (!latent) {
                        float* o = newv + (size_t)row * KLD + kvh * 64 + 4 * fq;
#pragma unroll
                        for (int bj = 0; bj < 2; ++bj)
#pragma unroll
                            for (int n = 0; n < 2; ++n) *(f32x4*)(o + 32 * bj + 16 * n) = acc[ai][bj][m][n];
                    }
                    asm volatile("" ::: "memory");
                }
        }
    }
};

struct AttnState { f32x4 o[2][4]; float m[2]; float l[2]; };
#define MFMA16(a, b, c) __builtin_amdgcn_mfma_f32_16x16x32_bf16((a), (b), (c), 0, 0, 0)
struct KVFrag { bf16x8 kf[2][2]; bf16x8 vf[4]; };
__device__ __forceinline__ void attn_load(KVFrag& f, const bf16_t* kp, int kld, const bf16_t* vp, int fr, int fq) {
#pragma unroll
    for (int t = 0; t < 2; ++t)
#pragma unroll
        for (int h2 = 0; h2 < 2; ++h2) f.kf[t][h2] = *(const bf16x8*)(kp + (size_t)(16 * t + fr) * kld + 32 * h2 + 8 * fq);
#pragma unroll
    for (int dt = 0; dt < 4; ++dt) { const bf16_t* v = vp + (16 * dt + fr) * 32 + 4 * fq; const u32x2 lo = *(const u32x2*)v, hi = *(const u32x2*)(v + 16);
        f.vf[dt] = __builtin_bit_cast(bf16x8, ((u32x4){lo.x, lo.y, hi.x, hi.y})); }
}
template <int MASK>
__device__ __forceinline__ void attn_compute(AttnState& st, const bf16x8 (&qf)[2][2], const KVFrag& f, int fr, int fq, int mk0, int mk1, const LAS float* bias) {
#pragma unroll
    for (int qb = 0; qb < 2; ++qb) {
        f32x4 s0 = (f32x4){0.f, 0.f, 0.f, 0.f}, s1 = (f32x4){0.f, 0.f, 0.f, 0.f};
        s0 = MFMA16(f.kf[0][0], qf[qb][0], s0); s0 = MFMA16(f.kf[0][1], qf[qb][1], s0);
        s1 = MFMA16(f.kf[1][0], qf[qb][0], s1); s1 = MFMA16(f.kf[1][1], qf[qb][1], s1);
        float sv[8];
#pragma unroll
        for (int j = 0; j < 4; ++j) { sv[j] = s0[j] * SCL2; sv[4 + j] = s1[j] * SCL2; }
        if (MASK == 1) {
            const int d0 = mk0 + 4 * fq - 16 * qb - fr;
#pragma unroll
            for (int t = 0; t < 2; ++t)
#pragma unroll
                for (int j = 0; j < 4; ++j) { const int df = d0 + 16 * t + j; if (df > 128 || df < -128) sv[4 * t + j] = -INFINITY; }
        }
        if (MASK == 2) {
            const int qc = mk1 + 16 * qb + fr; int cs = qc - 8; cs = cs < 0 ? 0 : (cs > 48 ? 48 : cs);
#pragma unroll
            for (int t = 0; t < 2; ++t)
#pragma unroll
                for (int j = 0; j < 4; ++j) { const int kc = mk0 + 16 * t + 4 * fq + j; const bool ok = (kc >= cs) && (kc < cs + 16);
                    int bi = kc - qc + 15; bi = bi < 0 ? 0 : (bi > 30 ? 30 : bi);
                    const float bv = bias[bi];
                    sv[4 * t + j] = ok ? sv[4 * t + j] + bv : -INFINITY; }
        }
        float cmax = fmaxf(fmaxf(fmaxf(sv[0], sv[1]), fmaxf(sv[2], sv[3])), fmaxf(fmaxf(sv[4], sv[5]), fmaxf(sv[6], sv[7])));
        cmax = fmaxf(cmax, __shfl_xor(cmax, 16)); cmax = fmaxf(cmax, __shfl_xor(cmax, 32));
        const float mnew = fmaxf(st.m[qb], cmax);
        const float msafe = (mnew == -INFINITY) ? 0.f : mnew;
        const float alpha = fast_exp2(st.m[qb] - msafe);
        st.m[qb] = mnew;
        float p[8]; float ps = 0.f;
#pragma unroll
        for (int j = 0; j < 8; ++j) { p[j] = fast_exp2(sv[j] - msafe); ps += p[j]; }
        st.l[qb] = st.l[qb] * alpha + ps;
        u32x4 pw; pw.x = cvt_pk_bf16(p[0], p[1]); pw.y = cvt_pk_bf16(p[2], p[3]); pw.z = cvt_pk_bf16(p[4], p[5]); pw.w = cvt_pk_bf16(p[6], p[7]);
        const bf16x8 pf = __builtin_bit_cast(bf16x8, pw);
#pragma unroll
        for (int dt = 0; dt < 4; ++dt) { st.o[qb][dt] = st.o[qb][dt] * alpha; st.o[qb][dt] = MFMA16(f.vf[dt], pf, st.o[qb][dt]); }
    }
}
__device__ __forceinline__ void attn_init(AttnState& st, bf16x8 (&qf)[2][2], const bf16_t* Q, int qrow0, int head, int fr, int fq) {
#pragma unroll
    for (int qb = 0; qb < 2; ++qb) { st.m[qb] = -INFINITY; st.l[qb] = 0.f;
#pragma unroll
        for (int dt = 0; dt < 4; ++dt) st.o[qb][dt] = (f32x4){0.f, 0.f, 0.f, 0.f};
#pragma unroll
        for (int h2 = 0; h2 < 2; ++h2) qf[qb][h2] = *(const bf16x8*)(Q + (size_t)(qrow0 + 16 * qb + fr) * DM + head * 64 + 32 * h2 + 8 * fq); }
}
__device__ __forceinline__ void attn_finish(AttnState& st, bf16_t* O, int qrow0, int head, int fr, int fq, bool has_sink, float sink) {
#pragma unroll
    for (int qb = 0; qb < 2; ++qb) {
        float l = st.l[qb]; l += __shfl_xor(l, 16); l += __shfl_xor(l, 32);
        if (has_sink) l += fast_exp2(sink * LOG2E - st.m[qb]);
        const float inv = 1.0f / l;
        bf16_t* o = O + (size_t)(qrow0 + 16 * qb + fr) * DM + head * 64 + 4 * fq;
#pragma unroll
        for (int dt = 0; dt < 4; ++dt) { const f32x4 v = st.o[qb][dt] * inv; u32x2 w; w.x = cvt_pk_bf16(v[0], v[1]); w.y = cvt_pk_bf16(v[2], v[3]); *(u32x2*)(o + 16 * dt) = w; }
    }
}
__device__ __forceinline__ void attn_phase_a(const bf16_t* Q, const bf16_t* K, const bf16_t* VT, const bf16_t* Kc, const bf16_t* VTc, const float* sinkp, bf16_t* O, int gw, int ngw, int lane) {
    const int fr = lane & 15, fq = lane >> 4;
    for (int t = gw; t < 4096; t += ngw) {
        const int b = t >> 11, rem = t & 2047, kvh = rem >> 9, rem2 = rem & 511, qblk = ((rem2 >> 3) << 1) | (rem2 & 1), g = (rem2 & 7) >> 1;
        const int head = kvh * 4 + g, qpos0 = qblk * 32, seq0 = NCTXROWS + b * 4096, qrow0 = seq0 + qpos0;
        AttnState st; bf16x8 qf[2][2]; KVFrag cur, nxt;
        attn_init(st, qf, Q, qrow0, head, fr, fq);
        const int c0 = qblk - 4 < 0 ? 0 : qblk - 4, c1 = qblk + 4 > 127 ? 127 : qblk + 4;
        const bf16_t* kcp = Kc + (size_t)(b * 512) * 256 + kvh * 64; const bf16_t* vcp = VTc + (size_t)(b * 16 * 4 + kvh) * 2048;
        const bf16_t* klp = K + (size_t)seq0 * 256 + kvh * 64; const bf16_t* vlp = VT + (size_t)((seq0 >> 5) * 4 + kvh) * 2048;
        attn_load(cur, kcp, 256, vcp, fr, fq);
        for (int c = 0; c < 16; ++c) {
            if (c < 15) attn_load(nxt, kcp + (size_t)(32 * (c + 1)) * 256, 256, vcp + (size_t)(c + 1) * 4 * 2048, fr, fq);
            else attn_load(nxt, klp + (size_t)(32 * c0) * 256, 256, vlp + (size_t)c0 * 4 * 2048, fr, fq);
            attn_compute<0>(st, qf, cur, fr, fq, 0, 0, nullptr);
            cur = nxt;
        }
        for (int c = c0; c <= c1; ++c) {
            if (c < c1) attn_load(nxt, klp + (size_t)(32 * (c + 1)) * 256, 256, vlp + (size_t)(c + 1) * 4 * 2048, fr, fq);
            attn_compute<1>(st, qf, cur, fr, fq, 32 * c - qpos0, 0, nullptr);
            cur = nxt;
        }
        attn_finish(st, O, qrow0, head, fr, fq, true, sinkp[head]);
    }
    for (int t = gw; t < 2048; t += ngw) {
        const int b = t >> 7, rem = t & 127, kvh = rem >> 5, rem2 = rem & 31, qblk = ((rem2 >> 3) << 1) | (rem2 & 1), g = (rem2 & 7) >> 1;
        const int head = kvh * 4 + g, qrow0 = b * 256 + qblk * 32;
        AttnState st; bf16x8 qf[2][2]; KVFrag cur, nxt;
        attn_init(st, qf, Q, qrow0, head, fr, fq);
        const bf16_t* kp = K + (size_t)(b * 256) * 256 + kvh * 64; const bf16_t* vp = VT + (size_t)((b * 8) * 4 + kvh) * 2048;
        attn_load(cur, kp, 256, vp, fr, fq);
        for (int c = 0; c < 8; ++c) {
            if (c < 7) attn_load(nxt, kp + (size_t)(32 * (c + 1)) * 256, 256, vp + (size_t)(c + 1) * 4 * 2048, fr, fq);
            attn_compute<0>(st, qf, cur, fr, fq, 0, 0, nullptr);
            cur = nxt;
        }
        attn_finish(st, O, qrow0, head, fr, fq, true, sinkp[head]);
    }
}
__device__ __forceinline__ void attn_phase_b(const bf16_t* Q, const bf16_t* K, const bf16_t* VT, const bf16_t* Kc, const bf16_t* VTc, const float* rpb, bf16_t* O, int gw, int ngw, int lane, LAS float* btab) {
    const int fr = lane & 15, fq = lane >> 4;
    int cur_head = -1;
    for (int t = gw; t < 4096; t += ngw) {
        const int b = t >> 11, rem = t & 2047, head = rem >> 7, qblk = rem & 127, r = qblk >> 1, half = qblk & 1;
        const int seq0 = NCTXROWS + b * 4096, qrow0 = seq0 + qblk * 32;
        if (head != cur_head) { for (int i = lane; i < 465; i += 64) btab[i] = rpb[head * 465 + i] * LOG2E; cur_head = head; asm volatile("s_waitcnt lgkmcnt(0)" ::: "memory"); }
        AttnState st; bf16x8 qf[2][2]; KVFrag cur, nxt;
        attn_init(st, qf, Q, qrow0, head, fr, fq);
        int rs = r - 4; rs = rs < 0 ? 0 : (rs > 56 ? 56 : rs);
        const bf16_t* kcp = Kc + (size_t)(b * 512) * 1024 + head * 64; const bf16_t* vcp = VTc + (size_t)(b * 16 * 16 + head) * 2048;
        const bf16_t* klp = K + (size_t)(seq0 + rs * 64) * 1024 + head * 64; const bf16_t* vlp = VT + (size_t)(((seq0 + rs * 64) >> 5) * 16 + head) * 2048;
        attn_load(cur, kcp, 1024, vcp, fr, fq);
        for (int c = 0; c < 16; ++c) {
            if (c < 15) attn_load(nxt, kcp + (size_t)(32 * (c + 1)) * 1024, 1024, vcp + (size_t)(c + 1) * 16 * 2048, fr, fq);
            else attn_load(nxt, klp, 1024, vlp, fr, fq);
            attn_compute<0>(st, qf, cur, fr, fq, 0, 0, nullptr);
            cur = nxt;
        }
        for (int c = 0; c < 16; ++c) {
            if (c < 15) attn_load(nxt, klp + (size_t)(32 * (c + 1)) * 1024, 1024, vlp + (size_t)(c + 1) * 16 * 2048, fr, fq);
            attn_compute<2>(st, qf, cur, fr, fq, 32 * (c & 1), 32 * half, btab + (rs + (c >> 1) - r + 7) * 31);
            cur = nxt;
        }
        attn_finish(st, O, qrow0, head, fr, fq, false, 0.f);
    }
    for (int t = gw; t < 2048; t += ngw) {
        const int b = t >> 7, rem = t & 127, head = rem >> 3, qblk = rem & 7;
        const int qrow0 = b * 256 + qblk * 32;
        AttnState st; bf16x8 qf[2][2]; KVFrag cur, nxt;
        attn_init(st, qf, Q, qrow0, head, fr, fq);
        const bf16_t* kp = K + (size_t)(b * 256) * 1024 + head * 64; const bf16_t* vp = VT + (size_t)((b * 8) * 16 + head) * 2048;
        attn_load(cur, kp, 1024, vp, fr, fq);
        for (int c = 0; c < 8; ++c) {
            if (c < 7) attn_load(nxt, kp + (size_t)(32 * (c + 1)) * 1024, 1024, vp + (size_t)(c + 1) * 16 * 2048, fr, fq);
            attn_compute<0>(st, qf, cur, fr, fq, 0, 0, nullptr);
            cur = nxt;
        }
        attn_finish(st, O, qrow0, head, fr, fq, false, 0.f);
    }
}


constexpr int KV_LDS_OFF = 16384, KV_BUF_BYTES = 9728, KROW_B = 144, VROW_B = 80, V_OFF = 4608;
__device__ __forceinline__ u32x4 stage_load(const bf16_t* kp, int kld, const bf16_t* vp, int tid) {
    if (tid < 256) return *(const u32x4*)(kp + (size_t)(tid >> 3) * kld + (tid & 7) * 8);
    return *(const u32x4*)(vp + (tid - 256) * 8);
}
__device__ __forceinline__ void stage_store(LAS unsigned char* buf, u32x4 v, int tid) {
    if (tid < 256) *(LAS u32x4*)(buf + (tid >> 3) * KROW_B + (tid & 7) * 16) = v;
    else { const int e = tid - 256; *(LAS u32x4*)(buf + V_OFF + (e >> 2) * VROW_B + (e & 3) * 16) = v; }
}
__device__ __forceinline__ void frag_load(KVFrag& f, const LAS unsigned char* buf, int fr, int fq) {
#pragma unroll
    for (int t = 0; t < 2; ++t)
#pragma unroll
        for (int h2 = 0; h2 < 2; ++h2) f.kf[t][h2] = *(const LAS bf16x8*)(buf + (16 * t + fr) * KROW_B + 64 * h2 + 16 * fq);
#pragma unroll
    for (int dt = 0; dt < 4; ++dt) { const LAS unsigned char* v = buf + V_OFF + (16 * dt + fr) * VROW_B + 8 * fq; const u32x2 lo = *(const LAS u32x2*)v, hi = *(const LAS u32x2*)(v + 32);
        f.vf[dt] = __builtin_bit_cast(bf16x8, ((u32x4){lo.x, lo.y, hi.x, hi.y})); }
}

__device__ __forceinline__ void attn_compute_pair(AttnState& st, const bf16x8 (&qf)[2][2], const LAS unsigned char* ba, const LAS unsigned char* bb, int fr, int fq) {
    bf16x8 pfa[2], pfb[2]; float alpha[2];
    {
        bf16x8 ka[2][2], kb[2][2];
#pragma unroll
        for (int t = 0; t < 2; ++t)
#pragma unroll
            for (int h2 = 0; h2 < 2; ++h2) { ka[t][h2] = *(const LAS bf16x8*)(ba + (16 * t + fr) * KROW_B + 64 * h2 + 16 * fq); kb[t][h2] = *(const LAS bf16x8*)(bb + (16 * t + fr) * KROW_B + 64 * h2 + 16 * fq); }
#pragma unroll
        for (int qb = 0; qb < 2; ++qb) {
            const f32x4 z = (f32x4){0.f, 0.f, 0.f, 0.f};
            f32x4 s0 = MFMA16(ka[0][0], qf[qb][0], z); s0 = MFMA16(ka[0][1], qf[qb][1], s0);
            f32x4 s1 = MFMA16(ka[1][0], qf[qb][0], z); s1 = MFMA16(ka[1][1], qf[qb][1], s1);
            f32x4 s2 = MFMA16(kb[0][0], qf[qb][0], z); s2 = MFMA16(kb[0][1], qf[qb][1], s2);
            f32x4 s3 = MFMA16(kb[1][0], qf[qb][0], z); s3 = MFMA16(kb[1][1], qf[qb][1], s3);
            float sv[16];
#pragma unroll
            for (int j = 0; j < 4; ++j) { sv[j] = s0[j] * SCL2; sv[4 + j] = s1[j] * SCL2; sv[8 + j] = s2[j] * SCL2; sv[12 + j] = s3[j] * SCL2; }
            float cmax = sv[0];
#pragma unroll
            for (int j = 1; j < 16; ++j) cmax = fmaxf(cmax, sv[j]);
            cmax = fmaxf(cmax, __shfl_xor(cmax, 16)); cmax = fmaxf(cmax, __shfl_xor(cmax, 32));
            const float mnew = fmaxf(st.m[qb], cmax);
            alpha[qb] = fast_exp2(st.m[qb] - mnew);
            st.m[qb] = mnew;
            float p[16]; float ps = 0.f;
#pragma unroll
            for (int j = 0; j < 16; ++j) { p[j] = fast_exp2(sv[j] - mnew); ps += p[j]; }
            st.l[qb] = st.l[qb] * alpha[qb] + ps;
            u32x4 pa, pb;
            pa.x = cvt_pk_bf16(p[0], p[1]); pa.y = cvt_pk_bf16(p[2], p[3]); pa.z = cvt_pk_bf16(p[4], p[5]); pa.w = cvt_pk_bf16(p[6], p[7]);
            pb.x = cvt_pk_bf16(p[8], p[9]); pb.y = cvt_pk_bf16(p[10], p[11]); pb.z = cvt_pk_bf16(p[12], p[13]); pb.w = cvt_pk_bf16(p[14], p[15]);
            pfa[qb] = __builtin_bit_cast(bf16x8, pa); pfb[qb] = __builtin_bit_cast(bf16x8, pb);
        }
    }
#pragma unroll
    for (int dt = 0; dt < 4; ++dt) {
        const LAS unsigned char* va = ba + V_OFF + (16 * dt + fr) * VROW_B + 8 * fq; const LAS unsigned char* vb_ = bb + V_OFF + (16 * dt + fr) * VROW_B + 8 * fq;
        const u32x2 alo = *(const LAS u32x2*)va, ahi = *(const LAS u32x2*)(va + 32), blo = *(const LAS u32x2*)vb_, bhi = *(const LAS u32x2*)(vb_ + 32);
        const bf16x8 vfa = __builtin_bit_cast(bf16x8, ((u32x4){alo.x, alo.y, ahi.x, ahi.y})), vfb = __builtin_bit_cast(bf16x8, ((u32x4){blo.x, blo.y, bhi.x, bhi.y}));
#pragma unroll
        for (int qb = 0; qb < 2; ++qb) { st.o[qb][dt] = st.o[qb][dt] * alpha[qb]; st.o[qb][dt] = MFMA16(vfa, pfa[qb], st.o[qb][dt]); st.o[qb][dt] = MFMA16(vfb, pfb[qb], st.o[qb][dt]); }
    }
}
template <int MASK>
__device__ __forceinline__ void attn_compute_pair_m(AttnState& st, const bf16x8 (&qf)[2][2], const LAS unsigned char* ba, const LAS unsigned char* bb, int fr, int fq, int mk0a, int mk0b, int mk1, const LAS float* bias) {
    bf16x8 pfa[2], pfb[2]; float alpha[2];
    {
        bf16x8 ka[2][2], kb[2][2];
#pragma unroll
        for (int t = 0; t < 2; ++t)
#pragma unroll
            for (int h2 = 0; h2 < 2; ++h2) { ka[t][h2] = *(const LAS bf16x8*)(ba + (16 * t + fr) * KROW_B + 64 * h2 + 16 * fq); kb[t][h2] = *(const LAS bf16x8*)(bb + (16 * t + fr) * KROW_B + 64 * h2 + 16 * fq); }
#pragma unroll
        for (int qb = 0; qb < 2; ++qb) {
            const f32x4 z = (f32x4){0.f, 0.f, 0.f, 0.f};
            f32x4 s0 = MFMA16(ka[0][0], qf[qb][0], z); s0 = MFMA16(ka[0][1], qf[qb][1], s0);
            f32x4 s1 = MFMA16(ka[1][0], qf[qb][0], z); s1 = MFMA16(ka[1][1], qf[qb][1], s1);
            f32x4 s2 = MFMA16(kb[0][0], qf[qb][0], z); s2 = MFMA16(kb[0][1], qf[qb][1], s2);
            f32x4 s3 = MFMA16(kb[1][0], qf[qb][0], z); s3 = MFMA16(kb[1][1], qf[qb][1], s3);
            float sv[16];
#pragma unroll
            for (int j = 0; j < 4; ++j) { sv[j] = s0[j] * SCL2; sv[4 + j] = s1[j] * SCL2; sv[8 + j] = s2[j] * SCL2; sv[12 + j] = s3[j] * SCL2; }
            if (MASK == 1) {
#pragma unroll
                for (int h = 0; h < 2; ++h) { const int d0 = (h ? mk0b : mk0a) + 4 * fq - 16 * qb - fr;
#pragma unroll
                    for (int t = 0; t < 2; ++t)
#pragma unroll
                        for (int j = 0; j < 4; ++j) { const int df = d0 + 16 * t + j; if (df > 128 || df < -128) sv[8 * h + 4 * t + j] = -INFINITY; } }
            }
            if (MASK == 2) {
                const int qc = mk1 + 16 * qb + fr; int cs = qc - 8; cs = cs < 0 ? 0 : (cs > 48 ? 48 : cs);
#pragma unroll
                for (int h = 0; h < 2; ++h)
#pragma unroll
                    for (int t = 0; t < 2; ++t)
#pragma unroll
                        for (int j = 0; j < 4; ++j) { const int kc = (h ? mk0b : mk0a) + 16 * t + 4 * fq + j; const bool ok = (kc >= cs) && (kc < cs + 16);
                            int bi = kc - qc + 15; bi = bi < 0 ? 0 : (bi > 30 ? 30 : bi);
                            const float bv = bias[bi];
                            sv[8 * h + 4 * t + j] = ok ? sv[8 * h + 4 * t + j] + bv : -INFINITY; }
            }
            float cmax = sv[0];
#pragma unroll
            for (int j = 1; j < 16; ++j) cmax = fmaxf(cmax, sv[j]);
            cmax = fmaxf(cmax, __shfl_xor(cmax, 16)); cmax = fmaxf(cmax, __shfl_xor(cmax, 32));
            const float mnew = fmaxf(st.m[qb], cmax);
            const float msafe = (mnew == -INFINITY) ? 0.f : mnew;
            alpha[qb] = fast_exp2(st.m[qb] - msafe);
            st.m[qb] = mnew;
            float p[16]; float ps = 0.f;
#pragma unroll
            for (int j = 0; j < 16; ++j) { p[j] = fast_exp2(sv[j] - msafe); ps += p[j]; }
            st.l[qb] = st.l[qb] * alpha[qb] + ps;
            u32x4 pa, pb;
            pa.x = cvt_pk_bf16(p[0], p[1]); pa.y = cvt_pk_bf16(p[2], p[3]); pa.z = cvt_pk_bf16(p[4], p[5]); pa.w = cvt_pk_bf16(p[6], p[7]);
            pb.x = cvt_pk_bf16(p[8], p[9]); pb.y = cvt_pk_bf16(p[10], p[11]); pb.z = cvt_pk_bf16(p[12], p[13]); pb.w = cvt_pk_bf16(p[14], p[15]);
            pfa[qb] = __builtin_bit_cast(bf16x8, pa); pfb[qb] = __builtin_bit_cast(bf16x8, pb);
        }
    }
#pragma unroll
    for (int dt = 0; dt < 4; ++dt) {
        const LAS unsigned char* va = ba + V_OFF + (16 * dt + fr) * VROW_B + 8 * fq; const LAS unsigned char* vb_ = bb + V_OFF + (16 * dt + fr) * VROW_B + 8 * fq;
        const u32x2 alo = *(const LAS u32x2*)va, ahi = *(const LAS u32x2*)(va + 32), blo = *(const LAS u32x2*)vb_, bhi = *(const LAS u32x2*)(vb_ + 32);
        const bf16x8 vfa = __builtin_bit_cast(bf16x8, ((u32x4){alo.x, alo.y, ahi.x, ahi.y})), vfb = __builtin_bit_cast(bf16x8, ((u32x4){blo.x, blo.y, bhi.x, bhi.y}));
#pragma unroll
        for (int qb = 0; qb < 2; ++qb) { st.o[qb][dt] = st.o[qb][dt] * alpha[qb]; st.o[qb][dt] = MFMA16(vfa, pfa[qb], st.o[qb][dt]); st.o[qb][dt] = MFMA16(vfb, pfb[qb], st.o[qb][dt]); }
    }
}
__device__ __forceinline__ void attn_pairs(AttnState& st, const bf16x8 (&qf)[2][2], const bf16_t* kp, int kld, const bf16_t* vp, int vstride, int NP, bool has_next, const bf16_t* kp2, const bf16_t* vp2, const bf16_t* kp3, const bf16_t* vp3,
                                           LAS unsigned char* kvb, int tid, int fr, int fq) {
    u32x4 sr0 = stage_load(kp, kld, vp, tid), sr1 = stage_load(kp + (size_t)32 * kld, kld, vp + vstride, tid);
    stage_store(kvb, sr0, tid); stage_store(kvb + KV_BUF_BYTES, sr1, tid);
    __syncthreads();
    for (int sp = 0; sp < NP; ++sp) {
        const bool more = sp + 1 < NP;
        if (more) { sr0 = stage_load(kp + (size_t)(32 * (2 * sp + 2)) * kld, kld, vp + (size_t)(2 * sp + 2) * vstride, tid); sr1 = stage_load(kp + (size_t)(32 * (2 * sp + 3)) * kld, kld, vp + (size_t)(2 * sp + 3) * vstride, tid); }
        else if (has_next) { sr0 = stage_load(kp2, kld, vp2, tid); sr1 = stage_load(kp3, kld, vp3, tid); }
        const LAS unsigned char* buf = kvb + (sp & 1) * 2 * KV_BUF_BYTES;
        attn_compute_pair(st, qf, buf, buf + KV_BUF_BYTES, fr, fq);
        LAS unsigned char* nb_ = kvb + ((sp + 1) & 1) * 2 * KV_BUF_BYTES;
        if (more) { stage_store(nb_, sr0, tid); stage_store(nb_ + KV_BUF_BYTES, sr1, tid); }
        else if (has_next) { stage_store(nb_, sr0, tid); stage_store(nb_ + KV_BUF_BYTES, sr1, tid); }
        __syncthreads();
    }
}
__device__ __forceinline__ void attn_groups_a(const bf16_t* Q, const bf16_t* K, const bf16_t* VT, const bf16_t* Kc, const bf16_t* VTc, const float* sinkp, bf16_t* O, int vb, int nb, int tid, LAS unsigned char* lds) {
    const int lane = tid & 63, wave = __builtin_amdgcn_readfirstlane(tid >> 6), fr = lane & 15, fq = lane >> 4;
    LAS unsigned char* kvb = lds + KV_LDS_OFF;
    for (int g = vb; g < 512; g += nb) {
        const int t = g * 8 + wave;
        const int b = t >> 11, rem = t & 2047, kvh = rem >> 9, rem2 = rem & 511, qp = rem2 >> 3, qblk = (qp << 1) | (rem2 & 1), gh = (rem2 & 7) >> 1;
        const int head = kvh * 4 + gh, qpos0 = qblk * 32, seq0 = NCTXROWS + b * 4096, qrow0 = seq0 + qpos0;
        const int cmin = 2 * qp - 4 < 0 ? 0 : 2 * qp - 4, cmax = 2 * qp + 5 > 127 ? 127 : 2 * qp + 5, nsteps = 16 + (cmax - cmin + 1);
        AttnState st; bf16x8 qf[2][2]; KVFrag f;
        attn_init(st, qf, Q, qrow0, head, fr, fq);
        const bf16_t* kcp = Kc + (size_t)(b * 512) * 256 + kvh * 64; const bf16_t* vcp = VTc + (size_t)(b * 16 * 4 + kvh) * 2048;
        const bf16_t* klp = K + (size_t)seq0 * 256 + kvh * 64; const bf16_t* vlp = VT + (size_t)((seq0 >> 5) * 4 + kvh) * 2048;
        {
            const int np = (cmax - cmin + 2) >> 1;
#define A_KP(c) (klp + (size_t)(32 * ((c) > 127 ? 127 : (c))) * 256)
#define A_VP(c) (vlp + (size_t)((c) > 127 ? 127 : (c)) * 4 * 2048)
            attn_pairs(st, qf, kcp, 256, vcp, 4 * 2048, 8, true, A_KP(cmin), A_VP(cmin), A_KP(cmin + 1), A_VP(cmin + 1), kvb, tid, fr, fq);
            u32x4 sr0, sr1;
            for (int p = 0; p < np; ++p) { const int ca = cmin + 2 * p, cb = ca + 1;
                if (p + 1 < np) { sr0 = stage_load(A_KP(ca + 2), 256, A_VP(ca + 2), tid); sr1 = stage_load(A_KP(ca + 3), 256, A_VP(ca + 3), tid); }
                const LAS unsigned char* buf = kvb + (p & 1) * 2 * KV_BUF_BYTES;
                if (!(cb < qblk - 4 || ca > qblk + 4)) attn_compute_pair_m<1>(st, qf, buf, buf + KV_BUF_BYTES, fr, fq, 32 * ca - qpos0, 32 * cb - qpos0, 0, nullptr);
                LAS unsigned char* nb_ = kvb + ((p + 1) & 1) * 2 * KV_BUF_BYTES;
                if (p + 1 < np) { stage_store(nb_, sr0, tid); stage_store(nb_ + KV_BUF_BYTES, sr1, tid); }
                __syncthreads(); }
#undef A_KP
#undef A_VP
        }
        attn_finish(st, O, qrow0, head, fr, fq, true, sinkp[head]);
    }
    for (int g = vb; g < 256; g += nb) {
        const int t = g * 8 + wave;
        const int b = t >> 7, rem = t & 127, kvh = rem >> 5, rem2 = rem & 31, qblk = ((rem2 >> 3) << 1) | (rem2 & 1), gh = (rem2 & 7) >> 1;
        const int head = kvh * 4 + gh, qrow0 = b * 256 + qblk * 32;
        AttnState st; bf16x8 qf[2][2]; KVFrag f;
        attn_init(st, qf, Q, qrow0, head, fr, fq);
        const bf16_t* kp = K + (size_t)(b * 256) * 256 + kvh * 64; const bf16_t* vp = VT + (size_t)((b * 8) * 4 + kvh) * 2048;
        attn_pairs(st, qf, kp, 256, vp, 4 * 2048, 4, false, kp, vp, kp, vp, kvb, tid, fr, fq);
        attn_finish(st, O, qrow0, head, fr, fq, true, sinkp[head]);
    }
}
__device__ __forceinline__ void attn_groups_b(const bf16_t* Q, const bf16_t* K, const bf16_t* VT, const bf16_t* Kc, const bf16_t* VTc, const float* rpb, bf16_t* O, int vb, int nb, int tid, LAS unsigned char* lds) {
    const int lane = tid & 63, wave = __builtin_amdgcn_readfirstlane(tid >> 6), fr = lane & 15, fq = lane >> 4;
    LAS unsigned char* kvb = lds + KV_LDS_OFF;
    LAS float* btab = (LAS float*)(lds + wave * 2048);
    for (int g = vb; g < 512; g += nb) {
        const int b = g >> 8, head = (g >> 4) & 15, r0 = 4 * (g & 15), qblk = 2 * r0 + wave, r = r0 + (wave >> 1), half = wave & 1;
        const int seq0 = NCTXROWS + b * 4096, qrow0 = seq0 + qblk * 32;
        for (int i = lane; i < 465; i += 64) btab[i] = rpb[head * 465 + i] * LOG2E;
        int rmin = r0 - 4; rmin = rmin < 0 ? 0 : (rmin > 56 ? 56 : rmin);
        int rmax = r0 - 1; rmax = (rmax < 0 ? 0 : (rmax > 56 ? 56 : rmax)) + 7;
        int rs = r - 4; rs = rs < 0 ? 0 : (rs > 56 ? 56 : rs);
        const int nsteps = 16 + 2 * (rmax - rmin + 1);
        AttnState st; bf16x8 qf[2][2]; KVFrag f;
        attn_init(st, qf, Q, qrow0, head, fr, fq);
        const bf16_t* kcp = Kc + (size_t)(b * 512) * 1024 + head * 64; const bf16_t* vcp = VTc + (size_t)(b * 16 * 16 + head) * 2048;
        const bf16_t* klp = K + (size_t)(seq0 + rmin * 64) * 1024 + head * 64; const bf16_t* vlp = VT + (size_t)(((seq0 + rmin * 64) >> 5) * 16 + head) * 2048;
        {
            const int np = rmax - rmin + 1;
            attn_pairs(st, qf, kcp, 1024, vcp, 16 * 2048, 8, true, klp, vlp, klp + (size_t)32 * 1024, vlp + (size_t)16 * 2048, kvb, tid, fr, fq);
            u32x4 sr0, sr1;
            for (int p = 0; p < np; ++p) { const int kr = rmin + p;
                if (p + 1 < np) { sr0 = stage_load(klp + (size_t)(64 * (p + 1)) * 1024, 1024, vlp + (size_t)(2 * p + 2) * 16 * 2048, tid); sr1 = stage_load(klp + (size_t)(64 * (p + 1) + 32) * 1024, 1024, vlp + (size_t)(2 * p + 3) * 16 * 2048, tid); }
                const LAS unsigned char* buf = kvb + (p & 1) * 2 * KV_BUF_BYTES;
                if (kr >= rs && kr <= rs + 7) attn_compute_pair_m<2>(st, qf, buf, buf + KV_BUF_BYTES, fr, fq, 0, 32, 32 * half, btab + (kr - r + 7) * 31);
                else attn_compute_pair_m<1>(st, qf, buf, buf + KV_BUF_BYTES, fr, fq, 1000000, 1000000, 0, nullptr);
                LAS unsigned char* nb_ = kvb + ((p + 1) & 1) * 2 * KV_BUF_BYTES;
                if (p + 1 < np) { stage_store(nb_, sr0, tid); stage_store(nb_ + KV_BUF_BYTES, sr1, tid); }
                __syncthreads(); }
        }
        attn_finish(st, O, qrow0, head, fr, fq, false, 0.f);
    }
    for (int g = vb; g < 256; g += nb) {
        const int b = g >> 4, head = g & 15, qblk = wave;
        const int qrow0 = b * 256 + qblk * 32;
        AttnState st; bf16x8 qf[2][2]; KVFrag f;
        attn_init(st, qf, Q, qrow0, head, fr, fq);
        const bf16_t* kp = K + (size_t)(b * 256) * 1024 + head * 64; const bf16_t* vp = VT + (size_t)((b * 8) * 16 + head) * 2048;
        attn_pairs(st, qf, kp, 1024, vp, 16 * 2048, 4, false, kp, vp, kp, vp, kvb, tid, fr, fq);
        attn_finish(st, O, qrow0, head, fr, fq, false, 0.f);
    }
}

__device__ __forceinline__ void transpose_item(const float* W, int K, int N, bf16_t* WT, int kb, int nb, int dst_n0, LAS float* scr, int lane) {
    const int k0 = 64 * kb, n0 = 32 * nb;
#pragma unroll 8
    for (int i = 0; i < 32; ++i) { const int kk = 2 * i + (lane >> 5); scr[kk * 33 + (lane & 31)] = W[(size_t)(k0 + kk) * N + n0 + (lane & 31)]; }
    asm volatile("s_waitcnt lgkmcnt(0)" ::: "memory");
    const int c = lane & 7;
#pragma unroll
    for (int j = 0; j < 4; ++j) { const int n = (lane >> 3) + 8 * j; const LAS float* s = scr + (8 * c) * 33 + n;
        u32x4 o; o.x = cvt_pk_bf16(s[0 * 33], s[1 * 33]); o.y = cvt_pk_bf16(s[2 * 33], s[3 * 33]); o.z = cvt_pk_bf16(s[4 * 33], s[5 * 33]); o.w = cvt_pk_bf16(s[6 * 33], s[7 * 33]);
        *(u32x4*)(WT + (size_t)(dst_n0 + n) * K + k0 + 8 * c) = o; }
    asm volatile("s_waitcnt lgkmcnt(0)" ::: "memory");
}
__device__ __forceinline__ int up_perm(int o) { return o < DFF ? 256 * (o / 128) + (o % 128) : 256 * ((o - DFF) / 128) + 128 + ((o - DFF) % 128); }
__device__ __forceinline__ int qkv_perm(int o) { return (o & ~255) + 128 * ((o >> 5) & 1) + 32 * ((o >> 6) & 3); }

__device__ __forceinline__ void prologue(const Args& a, LAS unsigned char* lds, int tid, int lane, int wave) {
    unsigned char* ws = a.ws;
    const int G = gridDim.x, bx = blockIdx.x;
    {
        LAS float* sc = (LAS float*)lds;
        LAS float* red = (LAS float*)(lds + 16384);
        bool have = false;
        for (int it = bx; it < 192; it += G) {
            if (!have) { for (int k = tid; k < 3072; k += NTHR) { const int cnd = k >> 10, kk = k & 1023; const float x = cnd == 0 ? a.in[7][kk] : a.in[6][(cnd - 1) * 1024 + kk]; sc[k] = silu_f(x); } have = true; }
            __syncthreads();
            const int l = it / 96, n0 = (it % 96) * 64;
            const float* W = a.in[10] + (size_t)l * 1024 * 6144 + n0;
            const int c4 = tid & 15, ks = tid >> 4;
            f32x4 a0 = (f32x4){0.f, 0.f, 0.f, 0.f}, a1 = a0, a2 = a0;
#pragma unroll 8
            for (int kk = 0; kk < 32; ++kk) { const int k = ks * 32 + kk; const f32x4 w = *(const f32x4*)(W + (size_t)k * 6144 + 4 * c4);
                a0 += w * sc[k]; a1 += w * sc[1024 + k]; a2 += w * sc[2048 + k]; }
#pragma unroll
            for (int j = 0; j < 4; ++j) { red[(ks * 3 + 0) * 64 + 4 * c4 + j] = a0[j]; red[(ks * 3 + 1) * 64 + 4 * c4 + j] = a1[j]; red[(ks * 3 + 2) * 64 + 4 * c4 + j] = a2[j]; }
            __syncthreads();
            if (tid < 192) { const int cnd = tid >> 6, col = tid & 63; float s = 0.f;
#pragma unroll 8
                for (int q = 0; q < 32; ++q) s += red[(q * 3 + cnd) * 64 + col];
                ((float*)(ws + WS_MOD))[(l * 3 + cnd) * 6144 + n0 + col] = s + a.in[11][l * 6144 + n0 + col]; }
        }
        __syncthreads();
    }
    const int gw = bx * NWAVES + wave, NGW = G * NWAVES;
    const size_t gt = (size_t)bx * NTHR + tid, NT = (size_t)G * NTHR;
    if (gt < 1024) { const int pos = (int)gt >> 4, f = (int)gt & 15; const float freq = exp2f(-(float)f * (13.287712379549449f / 16.0f)); const float ang = (float)pos * freq;
        float* rp = (float*)(ws + WS_ROPE); rp[2 * gt] = cosf(ang); rp[2 * gt + 1] = sinf(ang); }
    {
        LAS float* scr = (LAS float*)(lds + wave * 16384);
        constexpr int I_QA = 16 * 48, I_QB = 16 * 96, I_O = 16 * 32, I_UP = 16 * 176, I_DN = 44 * 32;
        constexpr int NITEMS = I_QA + I_QB + 2 * I_O + 2 * I_UP + 2 * I_DN;
        for (int it = gw; it < NITEMS; it += NGW) {
            int r = it;
            if (r < I_QA) { const int kb = r / 48, nb = r % 48; transpose_item(a.in[12], 1024, 1536, (bf16_t*)(ws + WS_WQKVA), kb, nb, qkv_perm(32 * nb), scr, lane); continue; } r -= I_QA;
            if (r < I_QB) { const int kb = r / 96, nb = r % 96; transpose_item(a.in[17], 1024, 3072, (bf16_t*)(ws + WS_WQKVB), kb, nb, qkv_perm(32 * nb), scr, lane); continue; } r -= I_QB;
            if (r < I_O) { const int kb = r / 32, nb = r % 32; transpose_item(a.in[16], 1024, 1024, (bf16_t*)(ws + WS_WOA), kb, nb, 32 * nb, scr, lane); continue; } r -= I_O;
            if (r < I_O) { const int kb = r / 32, nb = r % 32; transpose_item(a.in[21], 1024, 1024, (bf16_t*)(ws + WS_WOB), kb, nb, 32 * nb, scr, lane); continue; } r -= I_O;
            if (r < 2 * I_UP) { const int l = r / I_UP; r -= l * I_UP; const int kb = r / 176, nb = r % 176;
                transpose_item(a.in[22] + (size_t)l * 1024 * 5632, 1024, 5632, (bf16_t*)(ws + (l ? WS_WUP1 : WS_WUP0)), kb, nb, up_perm(32 * nb), scr, lane); continue; } r -= 2 * I_UP;
            { const int l = r / I_DN; r -= l * I_DN; const int kb = r / 32, nb = r % 32;
                transpose_item(a.in[25] + (size_t)l * 2816 * 1024, 2816, 1024, (bf16_t*)(ws + (l ? WS_WDN1 : WS_WDN0)), kb, nb, 32 * nb, scr, lane); }
        }
    }
    {
        bf16_t* kca = (bf16_t*)(ws + WS_KCA); bf16_t* kcb = (bf16_t*)(ws + WS_KCB); bf16_t* vca = (bf16_t*)(ws + WS_VTCA); bf16_t* vcb = (bf16_t*)(ws + WS_VTCB);
        for (size_t i = gt; i < 262144; i += NT) kca[i] = (bf16_t)f2bf(a.in[2][i]);
        for (size_t i = gt; i < 1048576; i += NT) kcb[i] = (bf16_t)f2bf(a.in[4][i]);
        for (size_t i = gt; i < 262144; i += NT) { const int tt = (int)i & 31, d = ((int)i >> 5) & 63, kvh = ((int)i >> 11) & 3, c = ((int)i >> 13) & 15, b = (int)i >> 17;
            vca[i] = (bf16_t)f2bf(a.in[3][((size_t)(b * 512 + c * 32 + tt) * 4 + kvh) * 64 + d]); }
        for (size_t i = gt; i < 1048576; i += NT) { const int tt = (int)i & 31, d = ((int)i >> 5) & 63, kvh = ((int)i >> 11) & 15, c = ((int)i >> 15) & 15, b = (int)i >> 19;
            vcb[i] = (bf16_t)f2bf(a.in[5][((size_t)(b * 512 + c * 32 + tt) * 16 + kvh) * 64 + d]); }
    }
}
__device__ __forceinline__ void norm_mod_phase(const float* xa, const float* xb, const float* nw, const float* shift, const float* scale, bf16_t* H, int gw, int ngw, int lane) {
    for (int row0 = gw; row0 < MTOK; row0 += 2 * ngw) {
        const int row1 = row0 + ngw; const bool two = row1 < MTOK; const int rowb = two ? row1 : row0;
        const float* xr0 = row0 < NCTXROWS ? xa + (size_t)row0 * DM : xb + (size_t)(row0 - NCTXROWS) * DM;
        const float* xr1 = rowb < NCTXROWS ? xa + (size_t)rowb * DM : xb + (size_t)(rowb - NCTXROWS) * DM;
        const int cond0 = row0 < NCTXROWS ? 0 : 1 + ((row0 - NCTXROWS) >> 12), cond1 = rowb < NCTXROWS ? 0 : 1 + ((rowb - NCTXROWS) >> 12);
        f32x4 v0[4], v1[4]; float s0 = 0.f, s1 = 0.f;
#pragma unroll
        for (int j = 0; j < 4; ++j) { v0[j] = *(const f32x4*)(xr0 + 4 * (lane + 64 * j)); v1[j] = *(const f32x4*)(xr1 + 4 * (lane + 64 * j)); }
#pragma unroll
        for (int j = 0; j < 4; ++j) { const f32x4 t0 = v0[j] * v0[j], t1 = v1[j] * v1[j]; s0 += (t0[0] + t0[1]) + (t0[2] + t0[3]); s1 += (t1[0] + t1[1]) + (t1[2] + t1[3]); }
#pragma unroll
        for (int o = 1; o < 64; o <<= 1) { s0 += __shfl_xor(s0, o); s1 += __shfl_xor(s1, o); }
        const float r0 = rsqrtf(s0 * (1.0f / DM) + EPSN), r1 = rsqrtf(s1 * (1.0f / DM) + EPSN);
#pragma unroll
        for (int j = 0; j < 4; ++j) { const int col = 4 * (lane + 64 * j);
            const f32x4 w = *(const f32x4*)(nw + col);
            const f32x4 sc0 = *(const f32x4*)(scale + cond0 * 6144 + col), sh0 = *(const f32x4*)(shift + cond0 * 6144 + col);
            const f32x4 y0 = (v0[j] * r0 * w) * (sc0 + 1.0f) + sh0;
            u32x2 o0; o0.x = cvt_pk_bf16(y0[0], y0[1]); o0.y = cvt_pk_bf16(y0[2], y0[3]);
            *(u32x2*)(H + (size_t)row0 * DM + col) = o0;
            if (two) { const f32x4 sc1 = *(const f32x4*)(scale + cond1 * 6144 + col), sh1 = *(const f32x4*)(shift + cond1 * 6144 + col);
                const f32x4 y1 = (v1[j] * r1 * w) * (sc1 + 1.0f) + sh1;
                u32x2 o1; o1.x = cvt_pk_bf16(y1[0], y1[1]); o1.y = cvt_pk_bf16(y1[2], y1[3]);
                *(u32x2*)(H + (size_t)row1 * DM + col) = o1; } }
    }
}
__device__ __forceinline__ void conv_act_phase(const bf16_t* U, const float* cw, const float* cb, bf16_t* ACT, size_t gt, size_t nt) {
    for (size_t item = gt; item < (size_t)384 * 352; item += nt) {
        const int rb = (int)(item / 352), fg = (int)(item % 352), r0 = rb * 32, f0 = fg * 8;
        const int pos0 = r0 < NCTXROWS ? (r0 & 255) : (r0 & 4095), L = r0 < NCTXROWS ? 256 : 4096;
        const bool has_prev = pos0 > 0, has_next = pos0 + 32 < L;
        float wg[3][8], wv[3][8], bg[8], bv[8];
#pragma unroll
        for (int o = 0; o < 3; ++o)
#pragma unroll
            for (int j = 0; j < 8; ++j) { wg[o][j] = cw[o * DUP + f0 + j]; wv[o][j] = cw[o * DUP + DFF + f0 + j]; }
#pragma unroll
        for (int j = 0; j < 8; ++j) { bg[j] = cb[f0 + j]; bv[j] = cb[DFF + f0 + j]; }
        const u32x4 z4 = (u32x4){0u, 0u, 0u, 0u};
        const bf16_t* up = U + (size_t)r0 * DUP + f0;
        u32x4 gp = z4, vp = z4, gc, vc, gn, vn;
        if (has_prev) { gp = *(const u32x4*)(up - DUP); vp = *(const u32x4*)(up - DUP + DFF); }
        gc = *(const u32x4*)up; vc = *(const u32x4*)(up + DFF);
        for (int r = 0; r < 32; ++r) {
            gn = z4; vn = z4;
            if (r < 31 || has_next) { gn = *(const u32x4*)(up + (size_t)(r + 1) * DUP); vn = *(const u32x4*)(up + (size_t)(r + 1) * DUP + DFF); }
            float res[8];
#pragma unroll
            for (int q = 0; q < 4; ++q) {
                const float g0 = wg[0][2 * q] * bflo(gp[q]) + wg[1][2 * q] * bflo(gc[q]) + wg[2][2 * q] * bflo(gn[q]) + bg[2 * q];
                const float g1 = wg[0][2 * q + 1] * bfhi(gp[q]) + wg[1][2 * q + 1] * bfhi(gc[q]) + wg[2][2 * q + 1] * bfhi(gn[q]) + bg[2 * q + 1];
                const float v0 = wv[0][2 * q] * bflo(vp[q]) + wv[1][2 * q] * bflo(vc[q]) + wv[2][2 * q] * bflo(vn[q]) + bv[2 * q];
                const float v1 = wv[0][2 * q + 1] * bfhi(vp[q]) + wv[1][2 * q + 1] * bfhi(vc[q]) + wv[2][2 * q + 1] * bfhi(vn[q]) + bv[2 * q + 1];
                res[2 * q] = silu_f(g0) * v0; res[2 * q + 1] = silu_f(g1) * v1;
            }
            u32x4 o; o.x = cvt_pk_bf16(res[0], res[1]); o.y = cvt_pk_bf16(res[2], res[3]); o.z = cvt_pk_bf16(res[4], res[5]); o.w = cvt_pk_bf16(res[6], res[7]);
            *(u32x4*)(ACT + (size_t)(r0 + r) * DFF + f0) = o;
            gp = gc; vp = vc; gc = gn; vc = vn;
        }
    }
}

__global__ void __launch_bounds__(NTHR, 2) mk_fwd(Args a) {
    extern __shared__ __attribute__((aligned(16))) unsigned char lds_raw[];
    cg::grid_group grid = cg::this_grid();
    LAS unsigned char* lds = (LAS unsigned char*)lds_raw;
    const int tid = threadIdx.x, lane = tid & 63, wave = __builtin_amdgcn_readfirstlane(tid >> 6);
    const int G = gridDim.x, bx = blockIdx.x;
    const int gw = bx * NWAVES + wave, NGW = G * NWAVES;
    const size_t gt = (size_t)bx * NTHR + tid, NT = (size_t)G * NTHR;
    unsigned char* ws = a.ws;
    float* out = a.out;
    bf16_t* H = (bf16_t*)(ws + WS_H); bf16_t* ACT = (bf16_t*)(ws + WS_ACT); bf16_t* U = (bf16_t*)(ws + WS_U);
    bf16_t* Qb = (bf16_t*)(ws + WS_Q); bf16_t* Kb = (bf16_t*)(ws + WS_K); bf16_t* VTb = (bf16_t*)(ws + WS_VT); bf16_t* Ob = (bf16_t*)(ws + WS_O);
    const float* rope = (const float*)(ws + WS_ROPE);

    volatile LAS unsigned* bst = (volatile LAS unsigned*)(lds + 131072 + 64);
    if (tid < 2) bst[tid] = 0u;
    __syncthreads();
    const XcdBarrier xbar = xcd_barrier_post((unsigned*)(ws + WS_BAR), bst);
#define GSYNC() xcd_barrier(xbar)
#ifndef NO_PRO
    for (int rep = 0; rep < REP_THIN; ++rep) { prologue(a, lds, tid, lane, wave); __syncthreads(); }
#endif
    GSYNC();
    if (a.ws == nullptr) grid.sync();

#pragma unroll 1
    for (int layer = 0; layer < 2; ++layer) {
        const float* mod = (const float*)(ws + WS_MOD) + layer * 3 * 6144;
        const float* xa = layer == 0 ? a.in[0] : out;
        const float* xb = layer == 0 ? a.in[1] : out + (size_t)NCTXROWS * DM;
#ifndef NO_NORM
        for (int rep = 0; rep < REP_THIN; ++rep)
        { int tl = tid; asm volatile("" : "+v"(tl)); const int wv = __builtin_amdgcn_readfirstlane(tl >> 6);
          norm_mod_phase(xa, xb, a.in[8] + layer * DM, mod + 0 * 1024, mod + 1 * 1024, H, bx * NWAVES + wv, NGW, tl & 63); }
#endif
        GSYNC();
#ifndef NO_QKV
        if (layer == 0) {
            pg8::Gemm g{H, (const bf16_t*)(ws + WS_WQKVA), MTOK, 1536, 1024}; pg8::StaticOrder S; int bxl = bx; asm volatile("" : "+s"(bxl)); int tl = tid; asm volatile("" : "+v"(tl)); S.init(MTOK, 1536, G, bxl);
            EpiQKV<4> E{Qb, Kb, VTb, out + OUT_KA, out + OUT_VA, a.in[13], a.in[14], rope};
            pg8::gemm_phase<EpiQKV<4>, pg8::StaticOrder, true, true>(lds, g, S, E, tl);
        } else {
            pg8::Gemm g{H, (const bf16_t*)(ws + WS_WQKVB), MTOK, 3072, 1024}; pg8::StaticOrder S; int bxl = bx; asm volatile("" : "+s"(bxl)); int tl = tid; asm volatile("" : "+v"(tl)); S.init(MTOK, 3072, G, bxl);
            EpiQKV<16> E{Qb, Kb, VTb, out + OUT_KB, out + OUT_VB, a.in[18], a.in[19], rope};
            pg8::gemm_phase<EpiQKV<16>, pg8::StaticOrder, true, true>(lds, g, S, E, tl);
        }
#endif
        GSYNC();
#ifndef NO_ATTN
        for (int rep = 0; rep < REP_ATTN; ++rep)
        { int tl = tid; asm volatile("" : "+v"(tl));
        if (layer == 0) attn_groups_a(Qb, Kb, VTb, (const bf16_t*)(ws + WS_KCA), (const bf16_t*)(ws + WS_VTCA), a.in[15], Ob, bx, G, tl, lds);
        else attn_groups_b(Qb, Kb, VTb, (const bf16_t*)(ws + WS_KCB), (const bf16_t*)(ws + WS_VTCB), a.in[20], Ob, bx, G, tl, lds); }
#endif
        GSYNC();
#ifndef NO_OPROJ
        {
            pg8::Gemm g{Ob, (const bf16_t*)(ws + (layer ? WS_WOB : WS_WOA)), MTOK, 1024, 1024}; pg8::StaticOrder S; int bxl = bx; asm volatile("" : "+s"(bxl)); int tl = tid; asm volatile("" : "+v"(tl)); S.init(MTOK, 1024, G, bxl);
            EpiResid E{xa, xb, out, mod + 2 * 1024};
            pg8::gemm_phase<EpiResid, pg8::StaticOrder, true, true>(lds, g, S, E, tl);
        }
#endif
        GSYNC();
#ifndef NO_NORM
        for (int rep = 0; rep < REP_THIN; ++rep)
        { int tl = tid; asm volatile("" : "+v"(tl)); const int wv = __builtin_amdgcn_readfirstlane(tl >> 6);
          norm_mod_phase(out, out + (size_t)NCTXROWS * DM, a.in[9] + layer * DM, mod + 3 * 1024, mod + 4 * 1024, H, bx * NWAVES + wv, NGW, tl & 63); }
#endif
        GSYNC();
#ifndef NO_UP
        {
            pg8::Gemm g{H, (const bf16_t*)(ws + (layer ? WS_WUP1 : WS_WUP0)), 50 * 256, DUP, 1024}; pg8::StaticOrder S; int bxl = bx; asm volatile("" : "+s"(bxl)); int tl = tid; asm volatile("" : "+v"(tl)); S.init(50 * 256, DUP, G, bxl);
            EpiUpConv E{ACT, a.in[23] + (size_t)layer * 3 * DUP, a.in[24] + (size_t)layer * DUP, (LAS float*)(lds + 131072 + 1024)};
            pg8::gemm_phase<EpiUpConv, pg8::StaticOrder, true, true>(lds, g, S, E, tl);
        }
#endif
        GSYNC();
#ifndef NO_DOWN
        {
            pg8::Gemm g{ACT, (const bf16_t*)(ws + (layer ? WS_WDN1 : WS_WDN0)), MTOK, 1024, DFF}; pg8::StaticOrder S; int bxl = bx; asm volatile("" : "+s"(bxl)); int tl = tid; asm volatile("" : "+v"(tl)); S.init(MTOK, 1024, G, bxl);
            EpiResid E{out, out + (size_t)NCTXROWS * DM, out, mod + 5 * 1024};
            pg8::gemm_phase<EpiResid, pg8::StaticOrder, true, true>(lds, g, S, E, tl);
        }
#endif
        if (layer == 0) GSYNC();
    }
}

extern "C" void kernel_launch(void* const* d_in, const int* in_sizes, int n_in, void* d_out, int out_size, void* d_ws, size_t ws_size, hipStream_t stream) {
    static int grid = 0;
    if (grid == 0) {
        if (n_in != 26 || out_size != 23068672 || ws_size < WS_END) { fprintf(stderr, "kernel_launch: unexpected shapes n_in %d out %d ws %zu\n", n_in, out_size, ws_size); grid = -1; return; }
        int dev = 0, cus = 0, per_cu = 0;
        hipGetDevice(&dev);
        hipDeviceGetAttribute(&cus, hipDeviceAttributeMultiprocessorCount, dev);
        hipFuncSetAttribute((const void*)mk_fwd, hipFuncAttributeMaxDynamicSharedMemorySize, LDS_BYTES);
        hipOccupancyMaxActiveBlocksPerMultiprocessor(&per_cu, (const void*)mk_fwd, NTHR, LDS_BYTES);
        if (per_cu < 1) per_cu = 1;
        grid = cus * per_cu;
    }
    if (grid < 0) return;
    if (hipMemsetAsync((char*)d_ws + WS_BAR, 0, XCD_BAR_WORDS * 4, stream) != hipSuccess) { fprintf(stderr, "kernel_launch: memset of the barrier words failed\n"); return; }
    Args a{};
    for (int i = 0; i < 26; ++i) a.in[i] = (const float*)d_in[i];
    a.out = (float*)d_out; a.ws = (unsigned char*)d_ws;
    void* args[] = {&a};
    hipError_t e = hipLaunchCooperativeKernel((const void*)mk_fwd, dim3(grid), dim3(NTHR), args, LDS_BYTES, stream);
    if (e != hipSuccess) fprintf(stderr, "cooperative launch failed: %s (grid %d)\n", hipGetErrorString(e), grid);
}
```

```cpp
#include <hip/hip_runtime.h>
#include <hip/hip_cooperative_groups.h>
#include <cstdio>
#include <cstdint>
namespace cg = cooperative_groups;
namespace pg8 {
#define PG8_LAS __attribute__((address_space(3)))
typedef unsigned short bf16_t;
typedef short bf16x8 __attribute__((ext_vector_type(8)));
typedef float f32x4 __attribute__((ext_vector_type(4)));
typedef unsigned u32x4 __attribute__((ext_vector_type(4)));
constexpr int BM = 256, BK = 64, HALF = 128, HTB = HALF * BK * 2  , STAGE_BYTES = 8 * HTB, NXCD = 8, WGM = 8;

__host__ __device__ __forceinline__ int lds_byte(int r, int c) { const int st = (r >> 4) * 2 + (c >> 5), rr = r & 15, cc = c & 31, ob = rr * 64 + cc * 2; return st * 1024 + (ob ^ (((ob >> 9) & 1) << 5)); }
__host__ __device__ __forceinline__ void stage_rc(int b, int& R, int& C) { const int st = b / 1024, sb = b % 1024, swz = sb ^ (((sb >> 9) & 1) << 5); R = (st >> 1) * 16 + swz / 64; C = (st & 1) * 32 + (swz % 64) / 2; }
__host__ __device__ __forceinline__ int perm32(int rho) { const int n = rho >> 4, i = rho & 15; return 8 * (i >> 2) + 4 * n + (i & 3); }

struct Unit { int pm, pn; };
struct Gemm { const bf16_t* A; const bf16_t* Bt; int M, N, K; };

struct StaticOrder {
    int nM, nN, nwg, G, c;
    __host__ __device__ void init(int M, int N, int G_, int c_) { nM = M / BM; nN = N / BM; nwg = nM * nN; G = G_; c = c_; }
    __host__ __device__ bool next(int i, Unit& u) const {
        const long L = (long)i * G + c; if (L >= nwg) return false;
        int wgid = (int)L; { const int q = nwg / NXCD, r = nwg % NXCD, xcd = wgid % NXCD, off = wgid / NXCD; wgid = (xcd < r ? xcd * (q + 1) : r * (q + 1) + (xcd - r) * q) + off; }
        const int nig = WGM * nN, gid = wgid / nig, fm = gid * WGM, gsz = (nM - fm) < WGM ? (nM - fm) : WGM;
        u.pm = fm + ((wgid % nig) % gsz); u.pn = (wgid % nig) / gsz; return true;
    }
    __device__ __forceinline__ void a_ready(const Unit&) const {}
    __device__ __forceinline__ void done(const Unit&) const {}
};

__device__ __forceinline__ unsigned cvt_pk_bf16(float lo, float hi) { unsigned r; asm volatile("v_cvt_pk_bf16_f32 %0, %1, %2" : "=v"(r) : "v"(lo), "v"(hi)); return r; }
template <class Epi, class Sched, bool ALIGN_EPI = false, bool SP2 = false>
__device__ __forceinline__ void gemm_phase(PG8_LAS unsigned char* lds, const Gemm g, const Sched& S, const Epi& E, const int tid_in) {
    const int tid = tid_in, wid = __builtin_amdgcn_readfirstlane(tid >> 6), lane = tid & 63, wr = wid >> 2, wc = wid & 3, fr = lane & 15, fq = lane >> 4;
    const int K = g.K, nt = K / BK;
    unsigned voffA[2], voffB[2];
#pragma unroll
    for (int i = 0; i < 2; ++i) { int R, C; stage_rc(tid * 16 + i * 8192, R, C); const int Rb = Epi::PERM ? ((R & ~31) + perm32(R & 31)) : R;
        voffA[i] = (unsigned)(R * K + C) * 2u; voffB[i] = (unsigned)(Rb * K + C) * 2u; }
    const size_t kstep = (size_t)(BK * 2);
    const size_t hstep = (size_t)HALF * K * 2;
    const size_t tstep = 2 * hstep;
    const unsigned ldsw = (unsigned)wid * 1024u;
    const int aoff = lds_byte(wr * 64 + fr, fq * 8), boff = lds_byte(wc * 32 + fr, fq * 8);
#define PG8_SA(b, h) (((b) * 2 + (h)) * HTB)
#define PG8_SB(b, h) ((4 + (b) * 2 + (h)) * HTB)
#define PG8_STAGE(bufoff, gbase, voff) do { _Pragma("unroll") for (int _i = 0; _i < 2; ++_i) \
        __builtin_amdgcn_global_load_lds((const unsigned*)((const char*)(gbase) + (voff)[_i]), (PG8_LAS unsigned*)(lds + (bufoff) + ldsw + _i * 8192), 16, 0, 0); } while (0)
#define PG8_LDA(dst, b, h) do { _Pragma("unroll") for (int m = 0; m < 4; ++m) _Pragma("unroll") for (int k = 0; k < 2; ++k) dst[m][k] = *(const PG8_LAS bf16x8*)(lds + PG8_SA(b, h) + aoff + m * 2048 + k * 1024); } while (0)
#define PG8_LDB(dst, b, h) do { _Pragma("unroll") for (int n = 0; n < 2; ++n) _Pragma("unroll") for (int k = 0; k < 2; ++k) dst[n][k] = *(const PG8_LAS bf16x8*)(lds + PG8_SB(b, h) + boff + n * 2048 + k * 1024); } while (0)
#define PG8_MMA(ai, bj, At, Bt) do { __builtin_amdgcn_s_setprio(1); _Pragma("unroll") for (int m = 0; m < 4; ++m) _Pragma("unroll") for (int n = 0; n < 2; ++n) _Pragma("unroll") for (int k = 0; k < 2; ++k) \
        acc[ai][bj][m][n] = __builtin_amdgcn_mfma_f32_16x16x32_bf16(Bt[n][k], At[m][k], acc[ai][bj][m][n], 0, 0, 0); __builtin_amdgcn_s_setprio(0); } while (0)
#define PG8_WAIT_V(n) asm volatile("s_waitcnt vmcnt(" #n ")" ::: "memory")
#define PG8_WAIT_L(n) asm volatile("s_waitcnt lgkmcnt(" #n ")" ::: "memory")
#define PG8_BAR __builtin_amdgcn_s_barrier()
#define PG8_SCHED __builtin_amdgcn_sched_barrier(0)
    Unit cur, nxt; int ui = 0;
    if (!S.next(0, cur)) return;
    f32x4 acc[2][2][4][2];
#pragma unroll
    for (int a = 0; a < 2; ++a)
#pragma unroll
        for (int b = 0; b < 2; ++b)
#pragma unroll
            for (int m = 0; m < 4; ++m)
#pragma unroll
                for (int n = 0; n < 2; ++n) acc[a][b][m][n] = (f32x4){0.f, 0.f, 0.f, 0.f};
    bf16x8 At[4][2], B0[2][2], B1[2][2];
    const char* cA = (const char*)g.A + (size_t)Epi::a_row0(cur.pm) * ((size_t)K * 2); const char* cB = (const char*)g.Bt + (size_t)cur.pn * tstep;
    S.a_ready(cur);
    if constexpr (SP2) {
        PG8_STAGE(PG8_SB(0, 0), cB, voffB); PG8_STAGE(PG8_SB(0, 1), cB + hstep, voffB); PG8_STAGE(PG8_SA(0, 0), cA, voffA); PG8_STAGE(PG8_SA(0, 1), cA + hstep, voffA);
        if (wr == 1) PG8_BAR;
        PG8_WAIT_V(2); PG8_BAR;
        PG8_STAGE(PG8_SB(1, 0), cB + kstep, voffB); PG8_STAGE(PG8_SA(1, 0), cA + kstep, voffA); PG8_STAGE(PG8_SB(1, 1), cB + hstep + kstep, voffB);
        PG8_WAIT_V(6); PG8_BAR;
    } else {
        PG8_STAGE(PG8_SB(0, 0), cB, voffB); PG8_STAGE(PG8_SA(0, 0), cA, voffA); PG8_STAGE(PG8_SB(0, 1), cB + hstep, voffB); PG8_STAGE(PG8_SA(0, 1), cA + hstep, voffA);
        if (wr == 1) PG8_BAR;
        PG8_WAIT_V(4); PG8_BAR;
        PG8_STAGE(PG8_SB(1, 0), cB + kstep, voffB); PG8_STAGE(PG8_SA(1, 0), cA + kstep, voffA); PG8_STAGE(PG8_SB(1, 1), cB + hstep + kstep, voffB);
        PG8_WAIT_V(6); PG8_BAR;
    }
    for (;;) {
        const bool has_next = S.next(ui + 1, nxt);
        const char* nA = has_next ? (const char*)g.A + (size_t)Epi::a_row0(nxt.pm) * ((size_t)K * 2) : cA; const char* nB = has_next ? (const char*)g.Bt + (size_t)nxt.pn * tstep : cB;
        for (int t = 0; t < nt; t += 2) {
            const bool last = (t == nt - 2);
            const char* a1 = cA + (size_t)(t + 1) * kstep;
            const char* a2 = last ? nA : cA + (size_t)(t + 2) * kstep; const char* b2 = last ? nB : cB + (size_t)(t + 2) * kstep;
            const char* a3 = a2 + kstep; const char* b3 = b2 + kstep;
            if (last && has_next) S.a_ready(nxt);
            if constexpr (SP2) {
            PG8_LDB(B0, 0, 0); PG8_LDB(B1, 0, 1); PG8_SCHED; PG8_LDA(At, 0, 0); PG8_STAGE(PG8_SA(1, 1), a1 + hstep, voffA);
            PG8_WAIT_V(8); PG8_WAIT_L(0); PG8_BAR; PG8_MMA(0, 0, At, B0); PG8_MMA(0, 1, At, B1); PG8_BAR; PG8_SCHED;
            PG8_LDA(At, 0, 1); PG8_STAGE(PG8_SB(0, 0), b2, voffB); PG8_STAGE(PG8_SB(0, 1), b2 + hstep, voffB); PG8_STAGE(PG8_SA(0, 0), a2, voffA);
            PG8_WAIT_V(8); PG8_WAIT_L(0); PG8_BAR; PG8_MMA(1, 0, At, B0); PG8_MMA(1, 1, At, B1); PG8_BAR; PG8_SCHED;
            PG8_LDB(B0, 1, 0); PG8_LDB(B1, 1, 1); PG8_SCHED; PG8_LDA(At, 1, 0); PG8_STAGE(PG8_SA(0, 1), a2 + hstep, voffA);
            PG8_WAIT_V(8); PG8_WAIT_L(0); PG8_BAR; PG8_MMA(0, 0, At, B0); PG8_MMA(0, 1, At, B1); PG8_BAR; PG8_SCHED;
            PG8_LDA(At, 1, 1); PG8_STAGE(PG8_SB(1, 0), b3, voffB); PG8_STAGE(PG8_SB(1, 1), b3 + hstep, voffB); PG8_STAGE(PG8_SA(1, 0), a3, voffA);
            PG8_WAIT_V(8); PG8_WAIT_L(0); PG8_BAR; PG8_MMA(1, 0, At, B0); PG8_MMA(1, 1, At, B1); PG8_BAR; PG8_SCHED;
            } else {
            PG8_LDB(B0, 0, 0); PG8_SCHED; PG8_LDA(At, 0, 0); PG8_STAGE(PG8_SA(1, 1), a1 + hstep, voffA);
            PG8_WAIT_L(8); PG8_BAR; PG8_WAIT_L(0); PG8_MMA(0, 0, At, B0); PG8_BAR; PG8_SCHED;
            PG8_LDB(B1, 0, 1); PG8_STAGE(PG8_SB(0, 0), b2, voffB);
            PG8_BAR; PG8_WAIT_L(0); PG8_MMA(0, 1, At, B1); PG8_BAR;
            PG8_LDA(At, 0, 1); PG8_STAGE(PG8_SA(0, 0), a2, voffA);
            PG8_BAR; PG8_WAIT_L(0); PG8_MMA(1, 0, At, B0); PG8_BAR; PG8_SCHED;
            PG8_STAGE(PG8_SB(0, 1), b2 + hstep, voffB);
            PG8_WAIT_V(6); PG8_BAR; PG8_MMA(1, 1, At, B1); PG8_BAR;
            PG8_LDB(B0, 1, 0); PG8_SCHED; PG8_LDA(At, 1, 0); PG8_STAGE(PG8_SA(0, 1), a2 + hstep, voffA);
            PG8_WAIT_L(8); PG8_BAR; PG8_WAIT_L(0); PG8_MMA(0, 0, At, B0); PG8_BAR; PG8_SCHED;
            PG8_LDB(B1, 1, 1); PG8_STAGE(PG8_SB(1, 0), b3, voffB);
            PG8_BAR; PG8_WAIT_L(0); PG8_MMA(0, 1, At, B1); PG8_BAR;
            PG8_LDA(At, 1, 1); PG8_STAGE(PG8_SA(1, 0), a3, voffA);
            PG8_BAR; PG8_WAIT_L(0); PG8_MMA(1, 0, At, B0); PG8_BAR; PG8_SCHED;
            PG8_STAGE(PG8_SB(1, 1), b3 + hstep, voffB);
            PG8_WAIT_V(6); PG8_BAR; PG8_MMA(1, 1, At, B1); PG8_BAR;
            }
        }
        if constexpr (ALIGN_EPI) { if (wr == 0) PG8_BAR; }
        if constexpr (!Epi::AFTER_DRAIN) { E(acc, cur, wr, wc, fr, fq); S.done(cur); }
        if (!has_next) break;
#pragma unroll
        for (int a = 0; a < 2; ++a)
#pragma unroll
            for (int b = 0; b < 2; ++b)
#pragma unroll
                for (int m = 0; m < 4; ++m)
#pragma unroll
                    for (int n = 0; n < 2; ++n) acc[a][b][m][n] = (f32x4){0.f, 0.f, 0.f, 0.f};
        cur = nxt; cA = nA; cB = nB; ++ui;
        if constexpr (ALIGN_EPI) { if (wr == 1) PG8_BAR; }
    }
    PG8_WAIT_V(0);
    if constexpr (!ALIGN_EPI) { if (wr == 0) PG8_BAR; }
    PG8_BAR;
    if constexpr (Epi::AFTER_DRAIN) { E.fused(acc, cur, wr, wc, fr, fq, lds, wid, lane); S.done(cur); }
#undef PG8_SA
#undef PG8_SB
#undef PG8_STAGE
#undef PG8_LDA
#undef PG8_LDB
#undef PG8_MMA
#undef PG8_WAIT_V
#undef PG8_WAIT_L
#undef PG8_BAR
#undef PG8_SCHED
}
}

#define LAS __attribute__((address_space(3)))
typedef unsigned short bf16_t;
typedef short bf16x8 __attribute__((ext_vector_type(8)));
typedef float f32x4 __attribute__((ext_vector_type(4)));
typedef float f32x2 __attribute__((ext_vector_type(2)));
typedef unsigned u32x4 __attribute__((ext_vector_type(4)));
typedef unsigned u32x2 __attribute__((ext_vector_type(2)));
using pg8::cvt_pk_bf16;

#ifndef REP_ATTN
#define REP_ATTN 1
#endif
#ifndef REP_THIN
#define REP_THIN 1
#endif
constexpr int NWAVES = 8, NTHR = 512;
constexpr int LDS_BYTES = 147456;
constexpr int MTOK = 12288, NCTXROWS = 4096, DM = 1024, DFF = 2816, DUP = 5632;
constexpr float EPSN = 1e-6f;
constexpr float LOG2E = 1.4426950408889634f;
constexpr float SCL2 = 0.125f * 1.4426950408889634f;

constexpr size_t MiB = 1u << 20;
constexpr size_t WS_MOD = 0;
constexpr size_t WS_ROPE = 256 * 1024;
constexpr size_t WS_BAR = 512 * 1024;
constexpr size_t WS_KCA = 1 * MiB;
constexpr size_t WS_VTCA = 1 * MiB + 512 * 1024;
constexpr size_t WS_KCB = 2 * MiB;
constexpr size_t WS_VTCB = 4 * MiB;
constexpr size_t WS_WQKVA = 6 * MiB, WS_WQKVB = 9 * MiB, WS_WOA = 15 * MiB, WS_WOB = 17 * MiB;
constexpr size_t WS_WUP0 = 19 * MiB, WS_WUP1 = 30 * MiB, WS_WDN0 = 41 * MiB, WS_WDN1 = 46 * MiB + 512 * 1024;
constexpr size_t WS_H = 52 * MiB;
constexpr size_t WS_XR = 76 * MiB;
constexpr size_t WS_ACT = 118 * MiB;
constexpr size_t WS_U = 118 * MiB;
constexpr size_t WS_Q = 118 * MiB, WS_K = 142 * MiB, WS_VT = 166 * MiB, WS_O = 190 * MiB;
constexpr size_t WS_END = 250 * MiB;
constexpr size_t OUT_Y = 0, OUT_KA = 12582912, OUT_VA = 13631488, OUT_KB = 14680064, OUT_VB = 18874368;

__device__ __forceinline__ unsigned f2bf(float f) { unsigned u = __builtin_bit_cast(unsigned, f); return (u + 0x7fffu + ((u >> 16) & 1u)) >> 16; }
__device__ __forceinline__ float bflo(unsigned w) { return __builtin_bit_cast(float, w << 16); }
__device__ __forceinline__ float bfhi(unsigned w) { return __builtin_bit_cast(float, w & 0xffff0000u); }
__device__ __forceinline__ float wave_sum(float v) {
#pragma unroll
    for (int o = 1; o < 64; o <<= 1) v += __shfl_xor(v, o);
    return v;
}
__device__ __forceinline__ float fast_exp2(float x) { return __builtin_amdgcn_exp2f(x); }
__device__ __forceinline__ float silu_f(float x) { return x * __builtin_amdgcn_rcpf(1.0f + __expf(-x)); }

struct Args { const float* in[26]; float* out; unsigned char* ws; };

#define XB_TMO      128
#define XB_XCNT(j)  (256  + 64 * (j))
#define XB_XSUB(j)  (1280 + 64 * (j))
#define XB_XGEN(j)  (2304 + 64 * (j))
#define XB_TOP      3328
#define XB_TOPGEN   3392
#define XCD_BAR_WORDS 3456
#define XB_SPIN_CAP (1u << 18)

__device__ __forceinline__ unsigned xb_ld(unsigned* p)              { return __hip_atomic_load(p, __ATOMIC_RELAXED, __HIP_MEMORY_SCOPE_AGENT); }
__device__ __forceinline__ unsigned xb_add(unsigned* p, unsigned v) { return __hip_atomic_fetch_add(p, v, __ATOMIC_RELAXED, __HIP_MEMORY_SCOPE_AGENT); }
__device__ __forceinline__ unsigned xb_xcc_id() { return (unsigned)__builtin_amdgcn_s_getreg((3 << 11) | 20) & 0xFu; }
#define XB_SPIN(cond, bar) do { unsigned _sp = 0; while (cond) { __builtin_amdgcn_s_sleep(1); \
    if ((++_sp & 255u) == 0u) { if (xb_ld(&(bar)[XB_TMO])) break; if (_sp > XB_SPIN_CAP) { atomicAdd(&(bar)[XB_TMO], 1u); break; } } } } while (0)

struct XcdBarrier {
    unsigned* bar; unsigned x;
    volatile LAS unsigned* st;
};

__device__ __forceinline__ XcdBarrier xcd_barrier_post(unsigned* bar, volatile LAS unsigned* st) {
    XcdBarrier b; b.bar = bar; b.x = xb_xcc_id(); b.st = st;
    if (threadIdx.x == 0) (void)xb_add(&bar[XB_XCNT(b.x)], 1u);
    return b;
}
__device__ __forceinline__ void xcd_barrier_complete(unsigned* bar, unsigned x, unsigned& nloc, unsigned& nx) {
    const unsigned G = gridDim.x * gridDim.y * gridDim.z;
    unsigned sum, cnt, mine, sp = 0u;
    for (;;) {
        sum = 0u; cnt = 0u; mine = 0u;
#pragma unroll
        for (unsigned j = 0; j < 16; ++j) { const unsigned c = xb_ld(&bar[XB_XCNT(j)]); sum += c; cnt += (c > 0u) ? 1u : 0u; mine = (j == x) ? c : mine; }
        if (sum == G) break;
        __builtin_amdgcn_s_sleep(1);
        if ((++sp & 255u) == 0u) { if (xb_ld(&bar[XB_TMO])) break; if (sp > XB_SPIN_CAP) { atomicAdd(&bar[XB_TMO], 1u); break; } }
    }
    nloc = mine > 0u ? mine : 1u; nx = cnt > 0u ? cnt : 1u;
}

__device__ __forceinline__ void xcd_barrier(const XcdBarrier& b) {
    asm volatile("s_waitcnt vmcnt(0)" ::: "memory");
    __syncthreads();
    if (threadIdx.x == 0) {
        unsigned* bar = b.bar;
        __builtin_amdgcn_s_waitcnt(0);
        unsigned nloc = b.st[0], nx = b.st[1];
        if (nloc == 0u) { xcd_barrier_complete(bar, b.x, nloc, nx); b.st[0] = nloc; b.st[1] = nx; }
        const unsigned old = xb_add(&bar[XB_XSUB(b.x)], 1u);
        const unsigned gen = old / nloc;
        if (old + 1u == (gen + 1u) * nloc) {
            __builtin_amdgcn_fence(__ATOMIC_RELEASE, "agent");
            asm volatile("s_waitcnt vmcnt(0)" ::: "memory");
            const unsigned og = xb_add(&bar[XB_TOP], 1u);
            const unsigned tg = og / nx;
            if (og + 1u == (tg + 1u) * nx) xb_add(&bar[XB_TOPGEN], 1u);
            else XB_SPIN(xb_ld(&bar[XB_TOPGEN]) == tg, bar);
            __builtin_amdgcn_fence(__ATOMIC_ACQUIRE, "agent");
            xb_add(&bar[XB_XGEN(b.x)], 1u);
            asm volatile("s_waitcnt vmcnt(0)" ::: "memory");
        } else {
            XB_SPIN(xb_ld(&bar[XB_XGEN(b.x)]) == gen, bar);
            __builtin_amdgcn_fence(__ATOMIC_ACQUIRE, "agent");
            asm volatile("s_waitcnt vmcnt(0)" ::: "memory");
        }
    }
    __syncthreads();
}


using pg8::Unit;
struct EpiUp {
    static constexpr bool PERM = true, AFTER_DRAIN = false;
    static __device__ __forceinline__ int a_row0(int pm) { return pm * 256; }
    bf16_t* O; int ldc;
    __device__ __forceinline__ void operator()(const f32x4 (&acc)[2][2][4][2], const Unit& u, int wr, int wc, int fr, int fq) const {
        const int row0 = u.pm * 256 + wr * 64 + fr, col0 = u.pn * 256 + wc * 32 + 8 * fq;
#pragma unroll
        for (int ai = 0; ai < 2; ++ai)
#pragma unroll
            for (int m = 0; m < 4; ++m) { bf16_t* rowp = O + (size_t)(row0 + ai * 128 + m * 16) * ldc + col0;
#pragma unroll
                for (int bj = 0; bj < 2; ++bj) { const f32x4 v0 = acc[ai][bj][m][0], v1 = acc[ai][bj][m][1];
                    u32x4 w; w.x = cvt_pk_bf16(v0[0], v0[1]); w.y = cvt_pk_bf16(v0[2], v0[3]); w.z = cvt_pk_bf16(v1[0], v1[1]); w.w = cvt_pk_bf16(v1[2], v1[3]);
                    *(u32x4*)(rowp + bj * 128) = w; } }
    }
};
struct EpiResid {
    static constexpr bool PERM = false, AFTER_DRAIN = false;
    static __device__ __forceinline__ int a_row0(int pm) { return pm * 256; }
    const float* xa; const float* xb; const bf16_t* xr; float* outf; bf16_t* outr; const float* gate;
    __device__ __forceinline__ void operator()(const f32x4 (&acc)[2][2][4][2], const Unit& u, int wr, int wc, int fr, int fq) const {
        const int rbase = u.pm * 256;
        const float* xin = rbase < NCTXROWS ? xa + (size_t)rbase * DM : xb + (size_t)(rbase - NCTXROWS) * DM;
        const int cond = rbase < NCTXROWS ? 0 : 1 + ((rbase - NCTXROWS) >> 12);
        const int col0 = u.pn * 256 + wc * 32 + 4 * fq;
        const float* g = gate + cond * 6144 + col0;
        f32x4 gv[2][2];
#pragma unroll
        for (int bj = 0; bj < 2; ++bj)
#pragma unroll
            for (int n = 0; n < 2; ++n) gv[bj][n] = *(const f32x4*)(g + bj * 128 + n * 16);
#pragma unroll
        for (int ai = 0; ai < 2; ++ai)
#pragma unroll
            for (int m = 0; m < 4; ++m) { const size_t off = (size_t)(ai * 128 + wr * 64 + m * 16 + fr) * DM + col0; const size_t goff = (size_t)rbase * DM + off;
#pragma unroll
                for (int bj = 0; bj < 2; ++bj)
#pragma unroll
                    for (int n = 0; n < 2; ++n) { f32x4 x;
                        if (xr) { const u32x2 w = *(const u32x2*)(xr + goff + bj * 128 + n * 16); x = (f32x4){bflo(w.x), bfhi(w.x), bflo(w.y), bfhi(w.y)}; }
                        else x = *(const f32x4*)(xin + off + bj * 128 + n * 16);
                        const f32x4 xo = x + gv[bj][n] * acc[ai][bj][m][n];
                        if (outf) *(f32x4*)(outf + goff + bj * 128 + n * 16) = xo;
                        else { u32x2 w; w.x = cvt_pk_bf16(xo[0], xo[1]); w.y = cvt_pk_bf16(xo[2], xo[3]); *(u32x2*)(outr + goff + bj * 128 + n * 16) = w; } }
                if (m & 1) asm volatile("" ::: "memory"); }
    }
};

struct EpiUpConv {
    static constexpr bool PERM = false, AFTER_DRAIN = false;
    static __device__ __forceinline__ int a_row0(int pm) {
        if (pm < 16) return pm * 256;
        const int s = (pm - 16) / 17, j = (pm - 16) % 17; int st = 254 * j - 1; st = st > 3841 ? 3841 : st;
        return NCTXROWS + 4096 * s + st;
    }
    bf16_t* ACT; const float* cw; const float* cb; LAS float* xch;
    __device__ __forceinline__ void operator()(const f32x4 (&acc)[2][2][4][2], const Unit& u, int wr, int wc, int fr, int fq) const {
        const bool latent = u.pm >= 16;
        const int j17 = latent ? (u.pm - 16) % 17 : -1;
        const bool zr0 = (j17 == 0) && (wr == 0) && (fr == 0), zr255 = (j17 == 16) && (wr == 1) && (fr == 15);
        const int grow0 = a_row0(u.pm);
        const int lane = fq * 16 + fr;
        const int src_prev = (lane & 48) | ((fr + 15) & 15), src_next = (lane & 48) | ((fr + 1) & 15);
        const f32x4 z4 = (f32x4){0.f, 0.f, 0.f, 0.f};
#pragma unroll
        for (int ai = 0; ai < 2; ++ai) { const int g = ai * 2 + wr;
#pragma unroll
            for (int bj = 0; bj < 2; ++bj)
#pragma unroll
                for (int n = 0; n < 2; ++n) { const int col = bj * 128 + 32 * wc + 16 * n + 4 * fq;
                    if (fr == 0) *(LAS f32x4*)(xch + (g * 2 + 0) * 256 + col) = (ai == 0 && zr0) ? z4 : acc[ai][bj][0][n];
                    if (fr == 15) *(LAS f32x4*)(xch + (g * 2 + 1) * 256 + col) = (ai == 1 && zr255) ? z4 : acc[ai][bj][3][n]; } }
        asm volatile("s_waitcnt lgkmcnt(0)" ::: "memory"); __builtin_amdgcn_s_barrier(); asm volatile("" ::: "memory");
        const int fbase = u.pn * 128 + 32 * wc + 4 * fq;
#pragma unroll
        for (int n = 0; n < 2; ++n) {
            const int f0 = fbase + 16 * n;
            f32x4 wg[3], wv[3];
#pragma unroll
            for (int o = 0; o < 3; ++o) { wg[o] = *(const f32x4*)(cw + o * DUP + f0); wv[o] = *(const f32x4*)(cw + o * DUP + DFF + f0); }
            const f32x4 bg = *(const f32x4*)(cb + f0), bv = *(const f32x4*)(cb + DFF + f0);
#pragma unroll
            for (int ai = 0; ai < 2; ++ai) {
                const int g = ai * 2 + wr;
                f32x4 bp[2], bn[2];
#pragma unroll
                for (int bj = 0; bj < 2; ++bj) { const int col = bj * 128 + 32 * wc + 16 * n + 4 * fq;
                    bp[bj] = g > 0 ? *(const LAS f32x4*)(xch + ((g - 1) * 2 + 1) * 256 + col) : z4;
                    bn[bj] = g < 3 ? *(const LAS f32x4*)(xch + ((g + 1) * 2 + 0) * 256 + col) : z4; }
#pragma unroll
                for (int m = 0; m < 4; ++m) {
                    f32x4 cv[2];
#pragma unroll
                    for (int bj = 0; bj < 2; ++bj) {
                        f32x4 cur = acc[ai][bj][m][n];
                        if (ai == 0 && m == 0) cur = zr0 ? z4 : cur;
                        if (ai == 1 && m == 3) cur = zr255 ? z4 : cur;
                        f32x4 ps = m > 0 ? acc[ai][bj][m - 1][n] : bp[bj];
                        f32x4 ns = m < 3 ? acc[ai][bj][m + 1][n] : bn[bj];
                        f32x4 tp, tn, pv, nv;
#pragma unroll
                        for (int i = 0; i < 4; ++i) { tp[i] = fr == 15 ? ps[i] : cur[i]; tn[i] = fr == 0 ? ns[i] : cur[i]; }
#pragma unroll
                        for (int i = 0; i < 4; ++i) { pv[i] = __shfl(tp[i], src_prev); nv[i] = __shfl(tn[i], src_next); }
                        const f32x4 w0 = bj ? wv[0] : wg[0], w1 = bj ? wv[1] : wg[1], w2 = bj ? wv[2] : wg[2], bb = bj ? bv : bg;
                        cv[bj] = w0 * pv + w1 * cur + w2 * nv + bb;
                    }
                    f32x4 r;
#pragma unroll
                    for (int i = 0; i < 4; ++i) r[i] = silu_f(cv[0][i]) * cv[1][i];
                    const int R = ai * 128 + wr * 64 + m * 16 + fr;
                    const bool halo = latent && ((ai == 0 && m == 0 && wr == 0 && fr == 0) || (ai == 1 && m == 3 && wr == 1 && fr == 15));
                    if (!halo) { u32x2 w; w.x = cvt_pk_bf16(r[0], r[1]); w.y = cvt_pk_bf16(r[2], r[3]); *(u32x2*)(ACT + (size_t)(grow0 + R) * DFF + f0) = w; }
                }
            }
            asm volatile("" ::: "memory");
        }
    }
};
template <int NKV>
struct EpiQKV {
    static constexpr bool PERM = false, AFTER_DRAIN = false;
    static __device__ __forceinline__ int a_row0(int pm) { return pm * 256; }
    bf16_t* Q; bf16_t* K; bf16_t* VT; float* newk; float* newv; const float* qn; const float* kn; const float* rope;
    __device__ __forceinline__ void operator()(const f32x4 (&acc)[2][2][4][2], const Unit& u, int wr, int wc, int fr, int fq) const {
        constexpr int KLD = NKV * 64;
        const int hs = 4 * u.pn + wc;
        const int rbase = u.pm * 256 + wr * 64 + fr;
        const bool latent = u.pm >= 16;
        if (hs < 16 + NKV) {
            const bool isq = hs < 16;
            const float* nw = isq ? qn : kn;
            f32x4 wn[2][2];
#pragma unroll
            for (int bj = 0; bj < 2; ++bj)
#pragma unroll
                for (int n = 0; n < 2; ++n) wn[bj][n] = *(const f32x4*)(nw + 32 * bj + 16 * n + 4 * fq);
#pragma unroll
            for (int ai = 0; ai < 2; ++ai)
#pragma unroll
                for (int m = 0; m < 4; ++m) {
                    const int row = rbase + ai * 128 + m * 16;
                    f32x4 v[2][2]; float ss = 0.f;
#pragma unroll
                    for (int bj = 0; bj < 2; ++bj)
#pragma unroll
                        for (int n = 0; n < 2; ++n) { v[bj][n] = acc[ai][bj][m][n]; const f32x4 t = v[bj][n] * v[bj][n]; ss += (t[0] + t[1]) + (t[2] + t[3]); }
                    ss += __shfl_xor(ss, 16); ss += __shfl_xor(ss, 32);
                    const float rinv = rsqrtf(ss * (1.0f / 64.0f) + EPSN);
#pragma unroll
                    for (int bj = 0; bj < 2; ++bj)
#pragma unroll
                        for (int n = 0; n < 2; ++n) v[bj][n] = v[bj][n] * rinv * wn[bj][n];
                    if (latent && NKV == 4) {
                        const int pr = ((row - NCTXROWS) & 4095) >> 6, pc = row & 63;
#pragma unroll
                        for (int bj = 0; bj < 2; ++bj) {
                            const int pos = bj ? pc : pr;
                            const f32x4* t = (const f32x4*)(rope + (pos * 16 + 4 * fq) * 2);
                            const f32x4 t0 = t[0], t1 = t[1];
                            const f32x4 cs = (f32x4){t0[0], t0[2], t1[0], t1[2]}, sn = (f32x4){t0[1], t0[3], t1[1], t1[3]};
                            const f32x4 x1 = v[bj][0], x2 = v[bj][1];
                            v[bj][0] = x1 * cs - x2 * sn; v[bj][1] = x2 * cs + x1 * sn;
                        }
                    }
                    if (isq) {
                        bf16_t* p = Q + (size_t)row * DM + hs * 64 + 4 * fq;
#pragma unroll
                        for (int bj = 0; bj < 2; ++bj)
#pragma unroll
                            for (int n = 0; n < 2; ++n) { u32x2 w; w.x = cvt_pk_bf16(v[bj][n][0], v[bj][n][1]); w.y = cvt_pk_bf16(v[bj][n][2], v[bj][n][3]); *(u32x2*)(p + 32 * bj + 16 * n) = w; }
                    } else {
                        const int kvh = hs - 16;
                        bf16_t* p = K + (size_t)row * KLD + kvh * 64 + 4 * fq;
#pragma unroll
                        for (int bj = 0; bj < 2; ++bj)
#pragma unroll
                            for (int n = 0; n < 2; ++n) { u32x2 w; w.x = cvt_pk_bf16(v[bj][n][0], v[bj][n][1]); w.y = cvt_pk_bf16(v[bj][n][2], v[bj][n][3]); *(u32x2*)(p + 32 * bj + 16 * n) = w; }
                        if (!latent) {
                            float* o = newk + (size_t)row * KLD + kvh * 64 + 4 * fq;
#pragma unroll
                            for (int bj = 0; bj < 2; ++bj)
#pragma unroll
                                for (int n = 0; n < 2; ++n) *(f32x4*)(o + 32 * bj + 16 * n) = v[bj][n];
                        }
                    }
                    asm volatile("" ::: "memory");
                }
        } else {
            const int kvh = hs - 16 - NKV;
#pragma unroll
            for (int ai = 0; ai < 2; ++ai)
#pragma unroll
                for (int m = 0; m < 4; ++m) {
                    const int row = rbase + ai * 128 + m * 16;
                    bf16_t* p = VT + ((size_t)(row >> 5) * NKV + kvh) * 2048 + (row & 31) + (4 * fq) * 32;
#pragma unroll
                    for (int bj = 0; bj < 2; ++bj)
#pragma unroll
                        for (int n = 0; n < 2; ++n)
#pragma unroll
                            for (int i = 0; i < 4; ++i) p[(32 * bj + 16 * n + i) * 32] = (bf16_t)f2bf(acc[ai][bj][m][n][i]);
                    if (!latent) {
                        float* o = newv + (size_t)row * KLD + kvh * 64 + 4 * fq;
#pragma unroll
                        for (int bj = 0; bj < 2; ++bj)
#pragma unroll
                            for (int n = 0; n < 2; ++n) *(f32x4*)(o + 32 * bj + 16 * n) = acc[ai][bj][m][n];
                    }
                    asm volatile("" ::: "memory");
                }
        }
    }
};

struct AttnState { f32x4 o[2][4]; float m[2]; float l[2]; };
#define MFMA16(a, b, c) __builtin_amdgcn_mfma_f32_16x16x32_bf16((a), (b), (c), 0, 0, 0)
struct KVFrag { bf16x8 kf[2][2]; bf16x8 vf[4]; };
__device__ __forceinline__ void attn_load(KVFrag& f, const bf16_t* kp, int kld, const bf16_t* vp, int fr, int fq) {
#pragma unroll
    for (int t = 0; t < 2; ++t)
#pragma unroll
        for (int h2 = 0; h2 < 2; ++h2) f.kf[t][h2] = *(const bf16x8*)(kp + (size_t)(16 * t + fr) * kld + 32 * h2 + 8 * fq);
#pragma unroll
    for (int dt = 0; dt < 4; ++dt) { const bf16_t* v = vp + (16 * dt + fr) * 32 + 4 * fq; const u32x2 lo = *(const u32x2*)v, hi = *(const u32x2*)(v + 16);
        f.vf[dt] = __builtin_bit_cast(bf16x8, ((u32x4){lo.x, lo.y, hi.x, hi.y})); }
}
template <int MASK>
__device__ __forceinline__ void attn_compute(AttnState& st, const bf16x8 (&qf)[2][2], const KVFrag& f, int fr, int fq, int mk0, int mk1, const LAS float* bias) {
#pragma unroll
    for (int qb = 0; qb < 2; ++qb) {
        f32x4 s0 = (f32x4){0.f, 0.f, 0.f, 0.f}, s1 = (f32x4){0.f, 0.f, 0.f, 0.f};
        s0 = MFMA16(f.kf[0][0], qf[qb][0], s0); s0 = MFMA16(f.kf[0][1], qf[qb][1], s0);
        s1 = MFMA16(f.kf[1][0], qf[qb][0], s1); s1 = MFMA16(f.kf[1][1], qf[qb][1], s1);
        float sv[8];
#pragma unroll
        for (int j = 0; j < 4; ++j) { sv[j] = s0[j] * SCL2; sv[4 + j] = s1[j] * SCL2; }
        if (MASK == 1) {
            const int d0 = mk0 + 4 * fq - 16 * qb - fr;
#pragma unroll
            for (int t = 0; t < 2; ++t)
#pragma unroll
                for (int j = 0; j < 4; ++j) { const int df = d0 + 16 * t + j; if (df > 128 || df < -128) sv[4 * t + j] = -INFINITY; }
        }
        if (MASK == 2) {
            const int qc = mk1 + 16 * qb + fr; int cs = qc - 8; cs = cs < 0 ? 0 : (cs > 48 ? 48 : cs);
#pragma unroll
            for (int t = 0; t < 2; ++t)
#pragma unroll
                for (int j = 0; j < 4; ++j) { const int kc = mk0 + 16 * t + 4 * fq + j; const bool ok = (kc >= cs) && (kc < cs + 16);
                    int bi = kc - qc + 15; bi = bi < 0 ? 0 : (bi > 30 ? 30 : bi);
                    const float bv = bias[bi];
                    sv[4 * t + j] = ok ? sv[4 * t + j] + bv : -INFINITY; }
        }
        float cmax = fmaxf(fmaxf(fmaxf(sv[0], sv[1]), fmaxf(sv[2], sv[3])), fmaxf(fmaxf(sv[4], sv[5]), fmaxf(sv[6], sv[7])));
        cmax = fmaxf(cmax, __shfl_xor(cmax, 16)); cmax = fmaxf(cmax, __shfl_xor(cmax, 32));
        const float mnew = fmaxf(st.m[qb], cmax);
        const float msafe = (mnew == -INFINITY) ? 0.f : mnew;
        const float alpha = fast_exp2(st.m[qb] - msafe);
        st.m[qb] = mnew;
        float p[8]; float ps = 0.f;
#pragma unroll
        for (int j = 0; j < 8; ++j) { p[j] = fast_exp2(sv[j] - msafe); ps += p[j]; }
        st.l[qb] = st.l[qb] * alpha + ps;
        u32x4 pw; pw.x = cvt_pk_bf16(p[0], p[1]); pw.y = cvt_pk_bf16(p[2], p[3]); pw.z = cvt_pk_bf16(p[4], p[5]); pw.w = cvt_pk_bf16(p[6], p[7]);
        const bf16x8 pf = __builtin_bit_cast(bf16x8, pw);
#pragma unroll
        for (int dt = 0; dt < 4; ++dt) { st.o[qb][dt] = st.o[qb][dt] * alpha; st.o[qb][dt] = MFMA16(f.vf[dt], pf, st.o[qb][dt]); }
    }
}
__device__ __forceinline__ void attn_init(AttnState& st, bf16x8 (&qf)[2][2], const bf16_t* Q, int qrow0, int head, int fr, int fq) {
#pragma unroll
    for (int qb = 0; qb < 2; ++qb) { st.m[qb] = -INFINITY; st.l[qb] = 0.f;
#pragma unroll
        for (int dt = 0; dt < 4; ++dt) st.o[qb][dt] = (f32x4){0.f, 0.f, 0.f, 0.f};
#pragma unroll
        for (int h2 = 0; h2 < 2; ++h2) qf[qb][h2] = *(const bf16x8*)(Q + (size_t)(qrow0 + 16 * qb + fr) * DM + head * 64 + 32 * h2 + 8 * fq); }
}
__device__ __forceinline__ void attn_finish(AttnState& st, bf16_t* O, int qrow0, int head, int fr, int fq, bool has_sink, float sink) {
#pragma unroll
    for (int qb = 0; qb < 2; ++qb) {
        float l = st.l[qb]; l += __shfl_xor(l, 16); l += __shfl_xor(l, 32);
        if (has_sink) l += fast_exp2(sink * LOG2E - st.m[qb]);
        const float inv = 1.0f / l;
        bf16_t* o = O + (size_t)(qrow0 + 16 * qb + fr) * DM + head * 64 + 4 * fq;
#pragma unroll
        for (int dt = 0; dt < 4; ++dt) { const f32x4 v = st.o[qb][dt] * inv; u32x2 w; w.x = cvt_pk_bf16(v[0], v[1]); w.y = cvt_pk_bf16(v[2], v[3]); *(u32x2*)(o + 16 * dt) = w; }
    }
}
__device__ __forceinline__ void attn_phase_a(const bf16_t* Q, const bf16_t* K, const bf16_t* VT, const bf16_t* Kc, const bf16_t* VTc, const float* sinkp, bf16_t* O, int gw, int ngw, int lane) {
    const int fr = lane & 15, fq = lane >> 4;
    for (int t = gw; t < 4096; t += ngw) {
        const int b = t >> 11, rem = t & 2047, kvh = rem >> 9, rem2 = rem & 511, qblk = ((rem2 >> 3) << 1) | (rem2 & 1), g = (rem2 & 7) >> 1;
        const int head = kvh * 4 + g, qpos0 = qblk * 32, seq0 = NCTXROWS + b * 4096, qrow0 = seq0 + qpos0;
        AttnState st; bf16x8 qf[2][2]; KVFrag cur, nxt;
        attn_init(st, qf, Q, qrow0, head, fr, fq);
        const int c0 = qblk - 4 < 0 ? 0 : qblk - 4, c1 = qblk + 4 > 127 ? 127 : qblk + 4;
        const bf16_t* kcp = Kc + (size_t)(b * 512) * 256 + kvh * 64; const bf16_t* vcp = VTc + (size_t)(b * 16 * 4 + kvh) * 2048;
        const bf16_t* klp = K + (size_t)seq0 * 256 + kvh * 64; const bf16_t* vlp = VT + (size_t)((seq0 >> 5) * 4 + kvh) * 2048;
        attn_load(cur, kcp, 256, vcp, fr, fq);
        for (int c = 0; c < 16; ++c) {
            if (c < 15) attn_load(nxt, kcp + (size_t)(32 * (c + 1)) * 256, 256, vcp + (size_t)(c + 1) * 4 * 2048, fr, fq);
            else attn_load(nxt, klp + (size_t)(32 * c0) * 256, 256, vlp + (size_t)c0 * 4 * 2048, fr, fq);
            attn_compute<0>(st, qf, cur, fr, fq, 0, 0, nullptr);
            cur = nxt;
        }
        for (int c = c0; c <= c1; ++c) {
            if (c < c1) attn_load(nxt, klp + (size_t)(32 * (c + 1)) * 256, 256, vlp + (size_t)(c + 1) * 4 * 2048, fr, fq);
            attn_compute<1>(st, qf, cur, fr, fq, 32 * c - qpos0, 0, nullptr);
            cur = nxt;
        }
        attn_finish(st, O, qrow0, head, fr, fq, true, sinkp[head]);
    }
    for (int t = gw; t < 2048; t += ngw) {
        const int b = t >> 7, rem = t & 127, kvh = rem >> 5, rem2 = rem & 31, qblk = ((rem2 >> 3) << 1) | (rem2 & 1), g = (rem2 & 7) >> 1;
        const int head = kvh * 4 + g, qrow0 = b * 256 + qblk * 32;
        AttnState st; bf16x8 qf[2][2]; KVFrag cur, nxt;
        attn_init(st, qf, Q, qrow0, head, fr, fq);
        const bf16_t* kp = K + (size_t)(b * 256) * 256 + kvh * 64; const bf16_t* vp = VT + (size_t)((b * 8) * 4 + kvh) * 2048;
        attn_load(cur, kp, 256, vp, fr, fq);
        for (int c = 0; c < 8; ++c) {
            if (c < 7) attn_load(nxt, kp + (size_t)(32 * (c + 1)) * 256, 256, vp + (size_t)(c + 1) * 4 * 2048, fr, fq);
            attn_compute<0>(st, qf, cur, fr, fq, 0, 0, nullptr);
            cur = nxt;
        }
        attn_finish(st, O, qrow0, head, fr, fq, true, sinkp[head]);
    }
}
__device__ __forceinline__ void attn_phase_b(const bf16_t* Q, const bf16_t* K, const bf16_t* VT, const bf16_t* Kc, const bf16_t* VTc, const float* rpb, bf16_t* O, int gw, int ngw, int lane, LAS float* btab) {
    const int fr = lane & 15, fq = lane >> 4;
    int cur_head = -1;
    for (int t = gw; t < 4096; t += ngw) {
        const int b = t >> 11, rem = t & 2047, head = rem >> 7, qblk = rem & 127, r = qblk >> 1, half = qblk & 1;
        const int seq0 = NCTXROWS + b * 4096, qrow0 = seq0 + qblk * 32;
        if (head != cur_head) { for (int i = lane; i < 465; i += 64) btab[i] = rpb[head * 465 + i] * LOG2E; cur_head = head; asm volatile("s_waitcnt lgkmcnt(0)" ::: "memory"); }
        AttnState st; bf16x8 qf[2][2]; KVFrag cur, nxt;
        attn_init(st, qf, Q, qrow0, head, fr, fq);
        int rs = r - 4; rs = rs < 0 ? 0 : (rs > 56 ? 56 : rs);
        const bf16_t* kcp = Kc + (size_t)(b * 512) * 1024 + head * 64; const bf16_t* vcp = VTc + (size_t)(b * 16 * 16 + head) * 2048;
        const bf16_t* klp = K + (size_t)(seq0 + rs * 64) * 1024 + head * 64; const bf16_t* vlp = VT + (size_t)(((seq0 + rs * 64) >> 5) * 16 + head) * 2048;
        attn_load(cur, kcp, 1024, vcp, fr, fq);
        for (int c = 0; c < 16; ++c) {
            if (c < 15) attn_load(nxt, kcp + (size_t)(32 * (c + 1)) * 1024, 1024, vcp + (size_t)(c + 1) * 16 * 2048, fr, fq);
            else attn_load(nxt, klp, 1024, vlp, fr, fq);
            attn_compute<0>(st, qf, cur, fr, fq, 0, 0, nullptr);
            cur = nxt;
        }
        for (int c = 0; c < 16; ++c) {
            if (c < 15) attn_load(nxt, klp + (size_t)(32 * (c + 1)) * 1024, 1024, vlp + (size_t)(c + 1) * 16 * 2048, fr, fq);
            attn_compute<2>(st, qf, cur, fr, fq, 32 * (c & 1), 32 * half, btab + (rs + (c >> 1) - r + 7) * 31);
            cur = nxt;
        }
        attn_finish(st, O, qrow0, head, fr, fq, false, 0.f);
    }
    for (int t = gw; t < 2048; t += ngw) {
        const int b = t >> 7, rem = t & 127, head = rem >> 3, qblk = rem & 7;
        const int qrow0 = b * 256 + qblk * 32;
        AttnState st; bf16x8 qf[2][2]; KVFrag cur, nxt;
        attn_init(st, qf, Q, qrow0, head, fr, fq);
        const bf16_t* kp = K + (size_t)(b * 256) * 1024 + head * 64; const bf16_t* vp = VT + (size_t)((b * 8) * 16 + head) * 2048;
        attn_load(cur, kp, 1024, vp, fr, fq);
        for (int c = 0; c < 8; ++c) {
            if (c < 7) attn_load(nxt, kp + (size_t)(32 * (c + 1)) * 1024, 1024, vp + (size_t)(c + 1) * 16 * 2048, fr, fq);
            attn_compute<0>(st, qf, cur, fr, fq, 0, 0, nullptr);
            cur = nxt;
        }
        attn_finish(st, O, qrow0, head, fr, fq, false, 0.f);
    }
}


constexpr int KV_LDS_OFF = 16384, KV_BUF_BYTES = 9728, KROW_B = 144, VROW_B = 80, V_OFF = 4608;
__device__ __forceinline__ u32x4 stage_load(const bf16_t* kp, int kld, const bf16_t* vp, int tid) {
    if (tid < 256) return *(const u32x4*)(kp + (size_t)(tid >> 3) * kld + (tid & 7) * 8);
    return *(const u32x4*)(vp + (tid - 256) * 8);
}
__device__ __forceinline__ void stage_store(LAS unsigned char* buf, u32x4 v, int tid) {
    if (tid < 256) *(LAS u32x4*)(buf + (tid >> 3) * KROW_B + (tid & 7) * 16) = v;
    else { const int e = tid - 256; *(LAS u32x4*)(buf + V_OFF + (e >> 2) * VROW_B + (e & 3) * 16) = v; }
}
__device__ __forceinline__ void frag_load(KVFrag& f, const LAS unsigned char* buf, int fr, int fq) {
#pragma unroll
    for (int t = 0; t < 2; ++t)
#pragma unroll
        for (int h2 = 0; h2 < 2; ++h2) f.kf[t][h2] = *(const LAS bf16x8*)(buf + (16 * t + fr) * KROW_B + 64 * h2 + 16 * fq);
#pragma unroll
    for (int dt = 0; dt < 4; ++dt) { const LAS unsigned char* v = buf + V_OFF + (16 * dt + fr) * VROW_B + 8 * fq; const u32x2 lo = *(const LAS u32x2*)v, hi = *(const LAS u32x2*)(v + 32);
        f.vf[dt] = __builtin_bit_cast(bf16x8, ((u32x4){lo.x, lo.y, hi.x, hi.y})); }
}

__device__ __forceinline__ void attn_compute_pair(AttnState& st, const bf16x8 (&qf)[2][2], const LAS unsigned char* ba, const LAS unsigned char* bb, int fr, int fq) {
    bf16x8 pfa[2], pfb[2]; float alpha[2];
    {
        bf16x8 ka[2][2], kb[2][2];
#pragma unroll
        for (int t = 0; t < 2; ++t)
#pragma unroll
            for (int h2 = 0; h2 < 2; ++h2) { ka[t][h2] = *(const LAS bf16x8*)(ba + (16 * t + fr) * KROW_B + 64 * h2 + 16 * fq); kb[t][h2] = *(const LAS bf16x8*)(bb + (16 * t + fr) * KROW_B + 64 * h2 + 16 * fq); }
#pragma unroll
        for (int qb = 0; qb < 2; ++qb) {
            const f32x4 z = (f32x4){0.f, 0.f, 0.f, 0.f};
            f32x4 s0 = MFMA16(ka[0][0], qf[qb][0], z); s0 = MFMA16(ka[0][1], qf[qb][1], s0);
            f32x4 s1 = MFMA16(ka[1][0], qf[qb][0], z); s1 = MFMA16(ka[1][1], qf[qb][1], s1);
            f32x4 s2 = MFMA16(kb[0][0], qf[qb][0], z); s2 = MFMA16(kb[0][1], qf[qb][1], s2);
            f32x4 s3 = MFMA16(kb[1][0], qf[qb][0], z); s3 = MFMA16(kb[1][1], qf[qb][1], s3);
            float sv[16];
#pragma unroll
            for (int j = 0; j < 4; ++j) { sv[j] = s0[j] * SCL2; sv[4 + j] = s1[j] * SCL2; sv[8 + j] = s2[j] * SCL2; sv[12 + j] = s3[j] * SCL2; }
            float cmax = sv[0];
#pragma unroll
            for (int j = 1; j < 16; ++j) cmax = fmaxf(cmax, sv[j]);
            cmax = fmaxf(cmax, __shfl_xor(cmax, 16)); cmax = fmaxf(cmax, __shfl_xor(cmax, 32));
            const float mnew = fmaxf(st.m[qb], cmax);
            alpha[qb] = fast_exp2(st.m[qb] - mnew);
            st.m[qb] = mnew;
            float p[16]; float ps = 0.f;
#pragma unroll
            for (int j = 0; j < 16; ++j) { p[j] = fast_exp2(sv[j] - mnew); ps += p[j]; }
            st.l[qb] = st.l[qb] * alpha[qb] + ps;
            u32x4 pa, pb;
            pa.x = cvt_pk_bf16(p[0], p[1]); pa.y = cvt_pk_bf16(p[2], p[3]); pa.z = cvt_pk_bf16(p[4], p[5]); pa.w = cvt_pk_bf16(p[6], p[7]);
            pb.x = cvt_pk_bf16(p[8], p[9]); pb.y = cvt_pk_bf16(p[10], p[11]); pb.z = cvt_pk_bf16(p[12], p[13]); pb.w = cvt_pk_bf16(p[14], p[15]);
            pfa[qb] = __builtin_bit_cast(bf16x8, pa); pfb[qb] = __builtin_bit_cast(bf16x8, pb);
        }
    }
#pragma unroll
    for (int dt = 0; dt < 4; ++dt) {
        const LAS unsigned char* va = ba + V_OFF + (16 * dt + fr) * VROW_B + 8 * fq; const LAS unsigned char* vb_ = bb + V_OFF + (16 * dt + fr) * VROW_B + 8 * fq;
        const u32x2 alo = *(const LAS u32x2*)va, ahi = *(const LAS u32x2*)(va + 32), blo = *(const LAS u32x2*)vb_, bhi = *(const LAS u32x2*)(vb_ + 32);
        const bf16x8 vfa = __builtin_bit_cast(bf16x8, ((u32x4){alo.x, alo.y, ahi.x, ahi.y})), vfb = __builtin_bit_cast(bf16x8, ((u32x4){blo.x, blo.y, bhi.x, bhi.y}));
#pragma unroll
        for (int qb = 0; qb < 2; ++qb) { st.o[qb][dt] = st.o[qb][dt] * alpha[qb]; st.o[qb][dt] = MFMA16(vfa, pfa[qb], st.o[qb][dt]); st.o[qb][dt] = MFMA16(vfb, pfb[qb], st.o[qb][dt]); }
    }
}
template <int MASK>
__device__ __forceinline__ void attn_compute_pair_m(AttnState& st, const bf16x8 (&qf)[2][2], const LAS unsigned char* ba, const LAS unsigned char* bb, int fr, int fq, int mk0a, int mk0b, int mk1, const LAS float* bias) {
    bf16x8 pfa[2], pfb[2]; float alpha[2];
    {
        bf16x8 ka[2][2], kb[2][2];
#pragma unroll
        for (int t = 0; t < 2; ++t)
#pragma unroll
            for (int h2 = 0; h2 < 2; ++h2) { ka[t][h2] = *(const LAS bf16x8*)(ba + (16 * t + fr) * KROW_B + 64 * h2 + 16 * fq); kb[t][h2] = *(const LAS bf16x8*)(bb + (16 * t + fr) * KROW_B + 64 * h2 + 16 * fq); }
#pragma unroll
        for (int qb = 0; qb < 2; ++qb) {
            const f32x4 z = (f32x4){0.f, 0.f, 0.f, 0.f};
            f32x4 s0 = MFMA16(ka[0][0], qf[qb][0], z); s0 = MFMA16(ka[0][1], qf[qb][1], s0);
            f32x4 s1 = MFMA16(ka[1][0], qf[qb][0], z); s1 = MFMA16(ka[1][1], qf[qb][1], s1);
            f32x4 s2 = MFMA16(kb[0][0], qf[qb][0], z); s2 = MFMA16(kb[0][1], qf[qb][1], s2);
            f32x4 s3 = MFMA16(kb[1][0], qf[qb][0], z); s3 = MFMA16(kb[1][1], qf[qb][1], s3);
            float sv[16];
#pragma unroll
            for (int j = 0; j < 4; ++j) { sv[j] = s0[j] * SCL2; sv[4 + j] = s1[j] * SCL2; sv[8 + j] = s2[j] * SCL2; sv[12 + j] = s3[j] * SCL2; }
            if (MASK == 1) {
#pragma unroll
                for (int h = 0; h < 2; ++h) { const int d0 = (h ? mk0b : mk0a) + 4 * fq - 16 * qb - fr;
#pragma unroll
                    for (int t = 0; t < 2; ++t)
#pragma unroll
                        for (int j = 0; j < 4; ++j) { const int df = d0 + 16 * t + j; if (df > 128 || df < -128) sv[8 * h + 4 * t + j] = -INFINITY; } }
            }
            if (MASK == 2) {
                const int qc = mk1 + 16 * qb + fr; int cs = qc - 8; cs = cs < 0 ? 0 : (cs > 48 ? 48 : cs);
#pragma unroll
                for (int h = 0; h < 2; ++h)
#pragma unroll
                    for (int t = 0; t < 2; ++t)
#pragma unroll
                        for (int j = 0; j < 4; ++j) { const int kc = (h ? mk0b : mk0a) + 16 * t + 4 * fq + j; const bool ok = (kc >= cs) && (kc < cs + 16);
                            int bi = kc - qc + 15; bi = bi < 0 ? 0 : (bi > 30 ? 30 : bi);
                            const float bv = bias[bi];
                            sv[8 * h + 4 * t + j] = ok ? sv[8 * h + 4 * t + j] + bv : -INFINITY; }
            }
            float cmax = sv[0];
#pragma unroll
            for (int j = 1; j < 16; ++j) cmax = fmaxf(cmax, sv[j]);
            cmax = fmaxf(cmax, __shfl_xor(cmax, 16)); cmax = fmaxf(cmax, __shfl_xor(cmax, 32));
            const float mnew = fmaxf(st.m[qb], cmax);
            const float msafe = (mnew == -INFINITY) ? 0.f : mnew;
            alpha[qb] = fast_exp2(st.m[qb] - msafe);
            st.m[qb] = mnew;
            float p[16]; float ps = 0.f;
#pragma unroll
            for (int j = 0; j < 16; ++j) { p[j] = fast_exp2(sv[j] - msafe); ps += p[j]; }
            st.l[qb] = st.l[qb] * alpha[qb] + ps;
            u32x4 pa, pb;
            pa.x = cvt_pk_bf16(p[0], p[1]); pa.y = cvt_pk_bf16(p[2], p[3]); pa.z = cvt_pk_bf16(p[4], p[5]); pa.w = cvt_pk_bf16(p[6], p[7]);
            pb.x = cvt_pk_bf16(p[8], p[9]); pb.y = cvt_pk_bf16(p[10], p[11]); pb.z = cvt_pk_bf16(p[12], p[13]); pb.w = cvt_pk_bf16(p[14], p[15]);
            pfa[qb] = __builtin_bit_cast(bf16x8, pa); pfb[qb] = __builtin_bit_cast(bf16x8, pb);
        }
    }
#pragma unroll
    for (int dt = 0; dt < 4; ++dt) {
        const LAS unsigned char* va = ba + V_OFF + (16 * dt + fr) * VROW_B + 8 * fq; const LAS unsigned char* vb_ = bb + V_OFF + (16 * dt + fr) * VROW_B + 8 * fq;
        const u32x2 alo = *(const LAS u32x2*)va, ahi = *(const LAS u32x2*)(va + 32), blo = *(const LAS u32x2*)vb_, bhi = *(const LAS u32x2*)(vb_ + 32);
        const bf16x8 vfa = __builtin_bit_cast(bf16x8, ((u32x4){alo.x, alo.y, ahi.x, ahi.y})), vfb = __builtin_bit_cast(bf16x8, ((u32x4){blo.x, blo.y, bhi.x, bhi.y}));
#pragma unroll
        for (int qb = 0; qb < 2; ++qb) { st.o[qb][dt] = st.o[qb][dt] * alpha[qb]; st.o[qb][dt] = MFMA16(vfa, pfa[qb], st.o[qb][dt]); st.o[qb][dt] = MFMA16(vfb, pfb[qb], st.o[qb][dt]); }
    }
}
__device__ __forceinline__ void attn_pairs(AttnState& st, const bf16x8 (&qf)[2][2], const bf16_t* kp, int kld, const bf16_t* vp, int vstride, int NP, bool has_next, const bf16_t* kp2, const bf16_t* vp2, const bf16_t* kp3, const bf16_t* vp3,
                                           LAS unsigned char* kvb, int tid, int fr, int fq) {
    u32x4 sr0 = stage_load(kp, kld, vp, tid), sr1 = stage_load(kp + (size_t)32 * kld, kld, vp + vstride, tid);
    stage_store(kvb, sr0, tid); stage_store(kvb + KV_BUF_BYTES, sr1, tid);
    __syncthreads();
    for (int sp = 0; sp < NP; ++sp) {
        const bool more = sp + 1 < NP;
        if (more) { sr0 = stage_load(kp + (size_t)(32 * (2 * sp + 2)) * kld, kld, vp + (size_t)(2 * sp + 2) * vstride, tid); sr1 = stage_load(kp + (size_t)(32 * (2 * sp + 3)) * kld, kld, vp + (size_t)(2 * sp + 3) * vstride, tid); }
        else if (has_next) { sr0 = stage_load(kp2, kld, vp2, tid); sr1 = stage_load(kp3, kld, vp3, tid); }
        const LAS unsigned char* buf = kvb + (sp & 1) * 2 * KV_BUF_BYTES;
        attn_compute_pair(st, qf, buf, buf + KV_BUF_BYTES, fr, fq);
        LAS unsigned char* nb_ = kvb + ((sp + 1) & 1) * 2 * KV_BUF_BYTES;
        if (more) { stage_store(nb_, sr0, tid); stage_store(nb_ + KV_BUF_BYTES, sr1, tid); }
        else if (has_next) { stage_store(nb_, sr0, tid); stage_store(nb_ + KV_BUF_BYTES, sr1, tid); }
        __syncthreads();
    }
}
__device__ __forceinline__ void attn_groups_a(const bf16_t* Q, const bf16_t* K, const bf16_t* VT, const bf16_t* Kc, const bf16_t* VTc, const float* sinkp, bf16_t* O, int vb, int nb, int tid, LAS unsigned char* lds) {
    const int lane = tid & 63, wave = __builtin_amdgcn_readfirstlane(tid >> 6), fr = lane & 15, fq = lane >> 4;
    LAS unsigned char* kvb = lds + KV_LDS_OFF;
    for (int g = vb; g < 512; g += nb) {
        const int t = g * 8 + wave;
        const int b = t >> 11, rem = t & 2047, kvh = rem >> 9, rem2 = rem & 511, qp = rem2 >> 3, qblk = (qp << 1) | (rem2 & 1), gh = (rem2 & 7) >> 1;
        const int head = kvh * 4 + gh, qpos0 = qblk * 32, seq0 = NCTXROWS + b * 4096, qrow0 = seq0 + qpos0;
        const int cmin = 2 * qp - 4 < 0 ? 0 : 2 * qp - 4, cmax = 2 * qp + 5 > 127 ? 127 : 2 * qp + 5, nsteps = 16 + (cmax - cmin + 1);
        AttnState st; bf16x8 qf[2][2]; KVFrag f;
        attn_init(st, qf, Q, qrow0, head, fr, fq);
        const bf16_t* kcp = Kc + (size_t)(b * 512) * 256 + kvh * 64; const bf16_t* vcp = VTc + (size_t)(b * 16 * 4 + kvh) * 2048;
        const bf16_t* klp = K + (size_t)seq0 * 256 + kvh * 64; const bf16_t* vlp = VT + (size_t)((seq0 >> 5) * 4 + kvh) * 2048;
        {
            const int np = (cmax - cmin + 2) >> 1;
#define A_KP(c) (klp + (size_t)(32 * ((c) > 127 ? 127 : (c))) * 256)
#define A_VP(c) (vlp + (size_t)((c) > 127 ? 127 : (c)) * 4 * 2048)
            attn_pairs(st, qf, kcp, 256, vcp, 4 * 2048, 8, true, A_KP(cmin), A_VP(cmin), A_KP(cmin + 1), A_VP(cmin + 1), kvb, tid, fr, fq);
            u32x4 sr0, sr1;
            for (int p = 0; p < np; ++p) { const int ca = cmin + 2 * p, cb = ca + 1;
                if (p + 1 < np) { sr0 = stage_load(A_KP(ca + 2), 256, A_VP(ca + 2), tid); sr1 = stage_load(A_KP(ca + 3), 256, A_VP(ca + 3), tid); }
                const LAS unsigned char* buf = kvb + (p & 1) * 2 * KV_BUF_BYTES;
                if (!(cb < qblk - 4 || ca > qblk + 4)) attn_compute_pair_m<1>(st, qf, buf, buf + KV_BUF_BYTES, fr, fq, 32 * ca - qpos0, 32 * cb - qpos0, 0, nullptr);
                LAS unsigned char* nb_ = kvb + ((p + 1) & 1) * 2 * KV_BUF_BYTES;
                if (p + 1 < np) { stage_store(nb_, sr0, tid); stage_store(nb_ + KV_BUF_BYTES, sr1, tid); }
                __syncthreads(); }
#undef A_KP
#undef A_VP
        }
        attn_finish(st, O, qrow0, head, fr, fq, true, sinkp[head]);
    }
    for (int g = vb; g < 256; g += nb) {
        const int t = g * 8 + wave;
        const int b = t >> 7, rem = t & 127, kvh = rem >> 5, rem2 = rem & 31, qblk = ((rem2 >> 3) << 1) | (rem2 & 1), gh = (rem2 & 7) >> 1;
        const int head = kvh * 4 + gh, qrow0 = b * 256 + qblk * 32;
        AttnState st; bf16x8 qf[2][2]; KVFrag f;
        attn_init(st, qf, Q, qrow0, head, fr, fq);
        const bf16_t* kp = K + (size_t)(b * 256) * 256 + kvh * 64; const bf16_t* vp = VT + (size_t)((b * 8) * 4 + kvh) * 2048;
        attn_pairs(st, qf, kp, 256, vp, 4 * 2048, 4, false, kp, vp, kp, vp, kvb, tid, fr, fq);
        attn_finish(st, O, qrow0, head, fr, fq, true, sinkp[head]);
    }
}
__device__ __forceinline__ void attn_groups_b(const bf16_t* Q, const bf16_t* K, const bf16_t* VT, const bf16_t* Kc, const bf16_t* VTc, const float* rpb, bf16_t* O, int vb, int nb, int tid, LAS unsigned char* lds) {
    const int lane = tid & 63, wave = __builtin_amdgcn_readfirstlane(tid >> 6), fr = lane & 15, fq = lane >> 4;
    LAS unsigned char* kvb = lds + KV_LDS_OFF;
    LAS float* btab = (LAS float*)(lds + wave * 2048);
    for (int g = vb; g < 512; g += nb) {
        const int b = g >> 8, head = (g >> 4) & 15, r0 = 4 * (g & 15), qblk = 2 * r0 + wave, r = r0 + (wave >> 1), half = wave & 1;
        const int seq0 = NCTXROWS + b * 4096, qrow0 = seq0 + qblk * 32;
        for (int i = lane; i < 465; i += 64) btab[i] = rpb[head * 465 + i] * LOG2E;
        int rmin = r0 - 4; rmin = rmin < 0 ? 0 : (rmin > 56 ? 56 : rmin);
        int rmax = r0 - 1; rmax = (rmax < 0 ? 0 : (rmax > 56 ? 56 : rmax)) + 7;
        int rs = r - 4; rs = rs < 0 ? 0 : (rs > 56 ? 56 : rs);
        const int nsteps = 16 + 2 * (rmax - rmin + 1);
        AttnState st; bf16x8 qf[2][2]; KVFrag f;
        attn_init(st, qf, Q, qrow0, head, fr, fq);
        const bf16_t* kcp = Kc + (size_t)(b * 512) * 1024 + head * 64; const bf16_t* vcp = VTc + (size_t)(b * 16 * 16 + head) * 2048;
        const bf16_t* klp = K + (size_t)(seq0 + rmin * 64) * 1024 + head * 64; const bf16_t* vlp = VT + (size_t)(((seq0 + rmin * 64) >> 5) * 16 + head) * 2048;
        {
            const int np = rmax - rmin + 1;
            attn_pairs(st, qf, kcp, 1024, vcp, 16 * 2048, 8, true, klp, vlp, klp + (size_t)32 * 1024, vlp + (size_t)16 * 2048, kvb, tid, fr, fq);
            u32x4 sr0, sr1;
            for (int p = 0; p < np; ++p) { const int kr = rmin + p;
                if (p + 1 < np) { sr0 = stage_load(klp + (size_t)(64 * (p + 1)) * 1024, 1024, vlp + (size_t)(2 * p + 2) * 16 * 2048, tid); sr1 = stage_load(klp + (size_t)(64 * (p + 1) + 32) * 1024, 1024, vlp + (size_t)(2 * p + 3) * 16 * 2048, tid); }
                const LAS unsigned char* buf = kvb + (p & 1) * 2 * KV_BUF_BYTES;
                if (kr >= rs && kr <= rs + 7) attn_compute_pair_m<2>(st, qf, buf, buf + KV_BUF_BYTES, fr, fq, 0, 32, 32 * half, btab + (kr - r + 7) * 31);
                else attn_compute_pair_m<1>(st, qf, buf, buf + KV_BUF_BYTES, fr, fq, 1000000, 1000000, 0, nullptr);
                LAS unsigned char* nb_ = kvb + ((p + 1) & 1) * 2 * KV_BUF_BYTES;
                if (p + 1 < np) { stage_store(nb_, sr0, tid); stage_store(nb_ + KV_BUF_BYTES, sr1, tid); }
                __syncthreads(); }
        }
        attn_finish(st, O, qrow0, head, fr, fq, false, 0.f);
    }
    for (int g = vb; g < 256; g += nb) {
        const int b = g >> 4, head = g & 15, qblk = wave;
        const int qrow0 = b * 256 + qblk * 32;
        AttnState st; bf16x8 qf[2][2]; KVFrag f;
        attn_init(st, qf, Q, qrow0, head, fr, fq);
        const bf16_t* kp = K + (size_t)(b * 256) * 1024 + head * 64; const bf16_t* vp = VT + (size_t)((b * 8) * 16 + head) * 2048;
        attn_pairs(st, qf, kp, 1024, vp, 16 * 2048, 4, false, kp, vp, kp, vp, kvb, tid, fr, fq);
        attn_finish(st, O, qrow0, head, fr, fq, false, 0.f);
    }
}

__device__ __forceinline__ void transpose_item(const float* W, int K, int N, bf16_t* WT, int kb, int nb, int dst_n0, LAS float* scr, int lane) {
    const int k0 = 64 * kb, n0 = 32 * nb;
#pragma unroll 8
    for (int i = 0; i < 32; ++i) { const int kk = 2 * i + (lane >> 5); scr[kk * 33 + (lane & 31)] = W[(size_t)(k0 + kk) * N + n0 + (lane & 31)]; }
    asm volatile("s_waitcnt lgkmcnt(0)" ::: "memory");
    const int c = lane & 7;
#pragma unroll
    for (int j = 0; j < 4; ++j) { const int n = (lane >> 3) + 8 * j; const LAS float* s = scr + (8 * c) * 33 + n;
        u32x4 o; o.x = cvt_pk_bf16(s[0 * 33], s[1 * 33]); o.y = cvt_pk_bf16(s[2 * 33], s[3 * 33]); o.z = cvt_pk_bf16(s[4 * 33], s[5 * 33]); o.w = cvt_pk_bf16(s[6 * 33], s[7 * 33]);
        *(u32x4*)(WT + (size_t)(dst_n0 + n) * K + k0 + 8 * c) = o; }
    asm volatile("s_waitcnt lgkmcnt(0)" ::: "memory");
}
__device__ __forceinline__ int up_perm(int o) { return o < DFF ? 256 * (o / 128) + (o % 128) : 256 * ((o - DFF) / 128) + 128 + ((o - DFF) % 128); }
__device__ __forceinline__ int qkv_perm(int o) { return (o & ~255) + 128 * ((o >> 5) & 1) + 32 * ((o >> 6) & 3); }

__device__ __forceinline__ void prologue(const Args& a, LAS unsigned char* lds, int tid, int lane, int wave) {
    unsigned char* ws = a.ws;
    const int G = gridDim.x, bx = blockIdx.x;
    {
        LAS float* sc = (LAS float*)lds;
        LAS float* red = (LAS float*)(lds + 16384);
        bool have = false;
        for (int it = bx; it < 192; it += G) {
            if (!have) { for (int k = tid; k < 3072; k += NTHR) { const int cnd = k >> 10, kk = k & 1023; const float x = cnd == 0 ? a.in[7][kk] : a.in[6][(cnd - 1) * 1024 + kk]; sc[k] = silu_f(x); } have = true; }
            __syncthreads();
            const int l = it / 96, n0 = (it % 96) * 64;
            const float* W = a.in[10] + (size_t)l * 1024 * 6144 + n0;
            const int c4 = tid & 15, ks = tid >> 4;
            f32x4 a0 = (f32x4){0.f, 0.f, 0.f, 0.f}, a1 = a0, a2 = a0;
#pragma unroll 8
            for (int kk = 0; kk < 32; ++kk) { const int k = ks * 32 + kk; const f32x4 w = *(const f32x4*)(W + (size_t)k * 6144 + 4 * c4);
                a0 += w * sc[k]; a1 += w * sc[1024 + k]; a2 += w * sc[2048 + k]; }
#pragma unroll
            for (int j = 0; j < 4; ++j) { red[(ks * 3 + 0) * 64 + 4 * c4 + j] = a0[j]; red[(ks * 3 + 1) * 64 + 4 * c4 + j] = a1[j]; red[(ks * 3 + 2) * 64 + 4 * c4 + j] = a2[j]; }
            __syncthreads();
            if (tid < 192) { const int cnd = tid >> 6, col = tid & 63; float s = 0.f;
#pragma unroll 8
                for (int q = 0; q < 32; ++q) s += red[(q * 3 + cnd) * 64 + col];
                ((float*)(ws + WS_MOD))[(l * 3 + cnd) * 6144 + n0 + col] = s + a.in[11][l * 6144 + n0 + col]; }
        }
        __syncthreads();
    }
    const int gw = bx * NWAVES + wave, NGW = G * NWAVES;
    const size_t gt = (size_t)bx * NTHR + tid, NT = (size_t)G * NTHR;
    if (gt < 1024) { const int pos = (int)gt >> 4, f = (int)gt & 15; const float freq = exp2f(-(float)f * (13.287712379549449f / 16.0f)); const float ang = (float)pos * freq;
        float* rp = (float*)(ws + WS_ROPE); rp[2 * gt] = cosf(ang); rp[2 * gt + 1] = sinf(ang); }
    {
        LAS float* scr = (LAS float*)(lds + wave * 16384);
        constexpr int I_QA = 16 * 48, I_QB = 16 * 96, I_O = 16 * 32, I_UP = 16 * 176, I_DN = 44 * 32;
        constexpr int NITEMS = I_QA + I_QB + 2 * I_O + 2 * I_UP + 2 * I_DN;
        for (int it = gw; it < NITEMS; it += NGW) {
            int r = it;
            if (r < I_QA) { const int kb = r / 48, nb = r % 48; transpose_item(a.in[12], 1024, 1536, (bf16_t*)(ws + WS_WQKVA), kb, nb, qkv_perm(32 * nb), scr, lane); continue; } r -= I_QA;
            if (r < I_QB) { const int kb = r / 96, nb = r % 96; transpose_item(a.in[17], 1024, 3072, (bf16_t*)(ws + WS_WQKVB), kb, nb, qkv_perm(32 * nb), scr, lane); continue; } r -= I_QB;
            if (r < I_O) { const int kb = r / 32, nb = r % 32; transpose_item(a.in[16], 1024, 1024, (bf16_t*)(ws + WS_WOA), kb, nb, 32 * nb, scr, lane); continue; } r -= I_O;
            if (r < I_O) { const int kb = r / 32, nb = r % 32; transpose_item(a.in[21], 1024, 1024, (bf16_t*)(ws + WS_WOB), kb, nb, 32 * nb, scr, lane); continue; } r -= I_O;
            if (r < 2 * I_UP) { const int l = r / I_UP; r -= l * I_UP; const int kb = r / 176, nb = r % 176;
                transpose_item(a.in[22] + (size_t)l * 1024 * 5632, 1024, 5632, (bf16_t*)(ws + (l ? WS_WUP1 : WS_WUP0)), kb, nb, up_perm(32 * nb), scr, lane); continue; } r -= 2 * I_UP;
            { const int l = r / I_DN; r -= l * I_DN; const int kb = r / 32, nb = r % 32;
                transpose_item(a.in[25] + (size_t)l * 2816 * 1024, 2816, 1024, (bf16_t*)(ws + (l ? WS_WDN1 : WS_WDN0)), kb, nb, 32 * nb, scr, lane); }
        }
    }
    {
        bf16_t* kca = (bf16_t*)(ws + WS_KCA); bf16_t* kcb = (bf16_t*)(ws + WS_KCB); bf16_t* vca = (bf16_t*)(ws + WS_VTCA); bf16_t* vcb = (bf16_t*)(ws + WS_VTCB);
        for (size_t i = gt; i < 262144; i += NT) kca[i] = (bf16_t)f2bf(a.in[2][i]);
        for (size_t i = gt; i < 1048576; i += NT) kcb[i] = (bf16_t)f2bf(a.in[4][i]);
        for (size_t i = gt; i < 262144; i += NT) { const int tt = (int)i & 31, d = ((int)i >> 5) & 63, kvh = ((int)i >> 11) & 3, c = ((int)i >> 13) & 15, b = (int)i >> 17;
            vca[i] = (bf16_t)f2bf(a.in[3][((size_t)(b * 512 + c * 32 + tt) * 4 + kvh) * 64 + d]); }
        for (size_t i = gt; i < 1048576; i += NT) { const int tt = (int)i & 31, d = ((int)i >> 5) & 63, kvh = ((int)i >> 11) & 15, c = ((int)i >> 15) & 15, b = (int)i >> 19;
            vcb[i] = (bf16_t)f2bf(a.in[5][((size_t)(b * 512 + c * 32 + tt) * 16 + kvh) * 64 + d]); }
    }
}
__device__ __forceinline__ void norm_mod_phase(const float* xa, const float* xb, const bf16_t* xr, const float* nw, const float* shift, const float* scale, bf16_t* H, int gw, int ngw, int lane) {
    for (int row0 = gw; row0 < MTOK; row0 += 2 * ngw) {
        const int row1 = row0 + ngw; const bool two = row1 < MTOK; const int rowb = two ? row1 : row0;
        const int cond0 = row0 < NCTXROWS ? 0 : 1 + ((row0 - NCTXROWS) >> 12), cond1 = rowb < NCTXROWS ? 0 : 1 + ((rowb - NCTXROWS) >> 12);
        f32x4 v0[4], v1[4]; float s0 = 0.f, s1 = 0.f;
        if (xr) {
#pragma unroll
            for (int j = 0; j < 4; ++j) { const u32x2 w0 = *(const u32x2*)(xr + (size_t)row0 * DM + 4 * (lane + 64 * j)), w1 = *(const u32x2*)(xr + (size_t)rowb * DM + 4 * (lane + 64 * j));
                v0[j] = (f32x4){bflo(w0.x), bfhi(w0.x), bflo(w0.y), bfhi(w0.y)}; v1[j] = (f32x4){bflo(w1.x), bfhi(w1.x), bflo(w1.y), bfhi(w1.y)}; }
        } else {
            const float* xr0 = row0 < NCTXROWS ? xa + (size_t)row0 * DM : xb + (size_t)(row0 - NCTXROWS) * DM;
            const float* xr1 = rowb < NCTXROWS ? xa + (size_t)rowb * DM : xb + (size_t)(rowb - NCTXROWS) * DM;
#pragma unroll
            for (int j = 0; j < 4; ++j) { v0[j] = *(const f32x4*)(xr0 + 4 * (lane + 64 * j)); v1[j] = *(const f32x4*)(xr1 + 4 * (lane + 64 * j)); }
        }
#pragma unroll
        for (int j = 0; j < 4; ++j) { const f32x4 t0 = v0[j] * v0[j], t1 = v1[j] * v1[j]; s0 += (t0[0] + t0[1]) + (t0[2] + t0[3]); s1 += (t1[0] + t1[1]) + (t1[2] + t1[3]); }
#pragma unroll
        for (int o = 1; o < 64; o <<= 1) { s0 += __shfl_xor(s0, o); s1 += __shfl_xor(s1, o); }
        const float r0 = rsqrtf(s0 * (1.0f / DM) + EPSN), r1 = rsqrtf(s1 * (1.0f / DM) + EPSN);
#pragma unroll
        for (int j = 0; j < 4; ++j) { const int col = 4 * (lane + 64 * j);
            const f32x4 w = *(const f32x4*)(nw + col);
            const f32x4 sc0 = *(const f32x4*)(scale + cond0 * 6144 + col), sh0 = *(const f32x4*)(shift + cond0 * 6144 + col);
            const f32x4 y0 = (v0[j] * r0 * w) * (sc0 + 1.0f) + sh0;
            u32x2 o0; o0.x = cvt_pk_bf16(y0[0], y0[1]); o0.y = cvt_pk_bf16(y0[2], y0[3]);
            *(u32x2*)(H + (size_t)row0 * DM + col) = o0;
            if (two) { const f32x4 sc1 = *(const f32x4*)(scale + cond1 * 6144 + col), sh1 = *(const f32x4*)(shift + cond1 * 6144 + col);
                const f32x4 y1 = (v1[j] * r1 * w) * (sc1 + 1.0f) + sh1;
                u32x2 o1; o1.x = cvt_pk_bf16(y1[0], y1[1]); o1.y = cvt_pk_bf16(y1[2], y1[3]);
                *(u32x2*)(H + (size_t)row1 * DM + col) = o1; } }
    }
}
__device__ __forceinline__ void conv_act_phase(const bf16_t* U, const float* cw, const float* cb, bf16_t* ACT, size_t gt, size_t nt) {
    for (size_t item = gt; item < (size_t)384 * 352; item += nt) {
        const int rb = (int)(item / 352), fg = (int)(item % 352), r0 = rb * 32, f0 = fg * 8;
        const int pos0 = r0 < NCTXROWS ? (r0 & 255) : (r0 & 4095), L = r0 < NCTXROWS ? 256 : 4096;
        const bool has_prev = pos0 > 0, has_next = pos0 + 32 < L;
        float wg[3][8], wv[3][8], bg[8], bv[8];
#pragma unroll
        for (int o = 0; o < 3; ++o)
#pragma unroll
            for (int j = 0; j < 8; ++j) { wg[o][j] = cw[o * DUP + f0 + j]; wv[o][j] = cw[o * DUP + DFF + f0 + j]; }
#pragma unroll
        for (int j = 0; j < 8; ++j) { bg[j] = cb[f0 + j]; bv[j] = cb[DFF + f0 + j]; }
        const u32x4 z4 = (u32x4){0u, 0u, 0u, 0u};
        const bf16_t* up = U + (size_t)r0 * DUP + f0;
        u32x4 gp = z4, vp = z4, gc, vc, gn, vn;
        if (has_prev) { gp = *(const u32x4*)(up - DUP); vp = *(const u32x4*)(up - DUP + DFF); }
        gc = *(const u32x4*)up; vc = *(const u32x4*)(up + DFF);
        for (int r = 0; r < 32; ++r) {
            gn = z4; vn = z4;
            if (r < 31 || has_next) { gn = *(const u32x4*)(up + (size_t)(r + 1) * DUP); vn = *(const u32x4*)(up + (size_t)(r + 1) * DUP + DFF); }
            float res[8];
#pragma unroll
            for (int q = 0; q < 4; ++q) {
                const float g0 = wg[0][2 * q] * bflo(gp[q]) + wg[1][2 * q] * bflo(gc[q]) + wg[2][2 * q] * bflo(gn[q]) + bg[2 * q];
                const float g1 = wg[0][2 * q + 1] * bfhi(gp[q]) + wg[1][2 * q + 1] * bfhi(gc[q]) + wg[2][2 * q + 1] * bfhi(gn[q]) + bg[2 * q + 1];
                const float v0 = wv[0][2 * q] * bflo(vp[q]) + wv[1][2 * q] * bflo(vc[q]) + wv[2][2 * q] * bflo(vn[q]) + bv[2 * q];
                const float v1 = wv[0][2 * q + 1] * bfhi(vp[q]) + wv[1][2 * q + 1] * bfhi(vc[q]) + wv[2][2 * q + 1] * bfhi(vn[q]) + bv[2 * q + 1];
                res[2 * q] = silu_f(g0) * v0; res[2 * q + 1] = silu_f(g1) * v1;
            }
            u32x4 o; o.x = cvt_pk_bf16(res[0], res[1]); o.y = cvt_pk_bf16(res[2], res[3]); o.z = cvt_pk_bf16(res[4], res[5]); o.w = cvt_pk_bf16(res[6], res[7]);
            *(u32x4*)(ACT + (size_t)(r0 + r) * DFF + f0) = o;
            gp = gc; vp = vc; gc = gn; vc = vn;
        }
    }
}

__global__ void __launch_bounds__(NTHR, 2) mk_fwd(Args a) {
    extern __shared__ __attribute__((aligned(16))) unsigned char lds_raw[];
    cg::grid_group grid = cg::this_grid();
    LAS unsigned char* lds = (LAS unsigned char*)lds_raw;
    const int tid = threadIdx.x, lane = tid & 63, wave = __builtin_amdgcn_readfirstlane(tid >> 6);
    const int G = gridDim.x, bx = blockIdx.x;
    const int gw = bx * NWAVES + wave, NGW = G * NWAVES;
    const size_t gt = (size_t)bx * NTHR + tid, NT = (size_t)G * NTHR;
    unsigned char* ws = a.ws;
    float* out = a.out;
    bf16_t* XR = (bf16_t*)(ws + WS_XR);
    bf16_t* H = (bf16_t*)(ws + WS_H); bf16_t* ACT = (bf16_t*)(ws + WS_ACT); bf16_t* U = (bf16_t*)(ws + WS_U);
    bf16_t* Qb = (bf16_t*)(ws + WS_Q); bf16_t* Kb = (bf16_t*)(ws + WS_K); bf16_t* VTb = (bf16_t*)(ws + WS_VT); bf16_t* Ob = (bf16_t*)(ws + WS_O);
    const float* rope = (const float*)(ws + WS_ROPE);

    volatile LAS unsigned* bst = (volatile LAS unsigned*)(lds + 131072 + 64);
    if (tid < 2) bst[tid] = 0u;
    __syncthreads();
    const XcdBarrier xbar = xcd_barrier_post((unsigned*)(ws + WS_BAR), bst);
#define GSYNC() xcd_barrier(xbar)
#ifndef NO_PRO
    for (int rep = 0; rep < REP_THIN; ++rep) { prologue(a, lds, tid, lane, wave); __syncthreads(); }
#endif
    GSYNC();
    if (a.ws == nullptr) grid.sync();

#pragma unroll 1
    for (int layer = 0; layer < 2; ++layer) {
        const float* mod = (const float*)(ws + WS_MOD) + layer * 3 * 6144;
        const float* xa = layer == 0 ? a.in[0] : out;
        const float* xb = layer == 0 ? a.in[1] : out + (size_t)NCTXROWS * DM;
#ifndef NO_NORM
        for (int rep = 0; rep < REP_THIN; ++rep)
        { int tl = tid; asm volatile("" : "+v"(tl)); const int wv = __builtin_amdgcn_readfirstlane(tl >> 6);
          norm_mod_phase(a.in[0], a.in[1], layer == 0 ? (const bf16_t*)nullptr : XR, a.in[8] + layer * DM, mod + 0 * 1024, mod + 1 * 1024, H, bx * NWAVES + wv, NGW, tl & 63); }
#endif
        GSYNC();
#ifndef NO_QKV
        if (layer == 0) {
            pg8::Gemm g{H, (const bf16_t*)(ws + WS_WQKVA), MTOK, 1536, 1024}; pg8::StaticOrder S; int bxl = bx; asm volatile("" : "+s"(bxl)); int tl = tid; asm volatile("" : "+v"(tl)); S.init(MTOK, 1536, G, bxl);
            EpiQKV<4> E{Qb, Kb, VTb, out + OUT_KA, out + OUT_VA, a.in[13], a.in[14], rope};
            pg8::gemm_phase<EpiQKV<4>, pg8::StaticOrder, true, true>(lds, g, S, E, tl);
        } else {
            pg8::Gemm g{H, (const bf16_t*)(ws + WS_WQKVB), MTOK, 3072, 1024}; pg8::StaticOrder S; int bxl = bx; asm volatile("" : "+s"(bxl)); int tl = tid; asm volatile("" : "+v"(tl)); S.init(MTOK, 3072, G, bxl);
            EpiQKV<16> E{Qb, Kb, VTb, out + OUT_KB, out + OUT_VB, a.in[18], a.in[19], rope};
            pg8::gemm_phase<EpiQKV<16>, pg8::StaticOrder, true, true>(lds, g, S, E, tl);
        }
#endif
        GSYNC();
#ifndef NO_ATTN
        for (int rep = 0; rep < REP_ATTN; ++rep)
        { int tl = tid; asm volatile("" : "+v"(tl));
        if (layer == 0) attn_groups_a(Qb, Kb, VTb, (const bf16_t*)(ws + WS_KCA), (const bf16_t*)(ws + WS_VTCA), a.in[15], Ob, bx, G, tl, lds);
        else attn_groups_b(Qb, Kb, VTb, (const bf16_t*)(ws + WS_KCB), (const bf16_t*)(ws + WS_VTCB), a.in[20], Ob, bx, G, tl, lds); }
#endif
        GSYNC();
#ifndef NO_OPROJ
        {
            pg8::Gemm g{Ob, (const bf16_t*)(ws + (layer ? WS_WOB : WS_WOA)), MTOK, 1024, 1024}; pg8::StaticOrder S; int bxl = bx; asm volatile("" : "+s"(bxl)); int tl = tid; asm volatile("" : "+v"(tl)); S.init(MTOK, 1024, G, bxl);
            EpiResid E{a.in[0], a.in[1], layer == 0 ? (const bf16_t*)nullptr : XR, (float*)nullptr, XR, mod + 2 * 1024};
            pg8::gemm_phase<EpiResid, pg8::StaticOrder, true, true>(lds, g, S, E, tl);
        }
#endif
        GSYNC();
#ifndef NO_NORM
        for (int rep = 0; rep < REP_THIN; ++rep)
        { int tl = tid; asm volatile("" : "+v"(tl)); const int wv = __builtin_amdgcn_readfirstlane(tl >> 6);
          norm_mod_phase(a.in[0], a.in[1], XR, a.in[9] + layer * DM, mod + 3 * 1024, mod + 4 * 1024, H, bx * NWAVES + wv, NGW, tl & 63); }
#endif
        GSYNC();
#ifndef NO_UP
        {
            pg8::Gemm g{H, (const bf16_t*)(ws + (layer ? WS_WUP1 : WS_WUP0)), 50 * 256, DUP, 1024}; pg8::StaticOrder S; int bxl = bx; asm volatile("" : "+s"(bxl)); int tl = tid; asm volatile("" : "+v"(tl)); S.init(50 * 256, DUP, G, bxl);
            EpiUpConv E{ACT, a.in[23] + (size_t)layer * 3 * DUP, a.in[24] + (size_t)layer * DUP, (LAS float*)(lds + 131072 + 1024)};
            pg8::gemm_phase<EpiUpConv, pg8::StaticOrder, true, true>(lds, g, S, E, tl);
        }
#endif
        GSYNC();
#ifndef NO_DOWN
        {
            pg8::Gemm g{ACT, (const bf16_t*)(ws + (layer ? WS_WDN1 : WS_WDN0)), MTOK, 1024, DFF}; pg8::StaticOrder S; int bxl = bx; asm volatile("" : "+s"(bxl)); int tl = tid; asm volatile("" : "+v"(tl)); S.init(MTOK, 1024, G, bxl);
            EpiResid E{a.in[0], a.in[1], XR, layer == 1 ? out : (float*)nullptr, XR, mod + 5 * 1024};
            pg8::gemm_phase<EpiResid, pg8::StaticOrder, true, true>(lds, g, S, E, tl);
        }
#endif
        if (layer == 0) GSYNC();
    }
}

extern "C" void kernel_launch(void* const* d_in, const int* in_sizes, int n_in, void* d_out, int out_size, void* d_ws, size_t ws_size, hipStream_t stream) {
    static int grid = 0;
    if (grid == 0) {
        if (n_in != 26 || out_size != 23068672 || ws_size < WS_END) { fprintf(stderr, "kernel_launch: unexpected shapes n_in %d out %d ws %zu\n", n_in, out_size, ws_size); grid = -1; return; }
        int dev = 0, cus = 0, per_cu = 0;
        hipGetDevice(&dev);
        hipDeviceGetAttribute(&cus, hipDeviceAttributeMultiprocessorCount, dev);
        hipFuncSetAttribute((const void*)mk_fwd, hipFuncAttributeMaxDynamicSharedMemorySize, LDS_BYTES);
        hipOccupancyMaxActiveBlocksPerMultiprocessor(&per_cu, (const void*)mk_fwd, NTHR, LDS_BYTES);
        if (per_cu < 1) per_cu = 1;
        grid = cus * per_cu;
    }
    if (grid < 0) return;
    if (hipMemsetAsync((char*)d_ws + WS_BAR, 0, XCD_BAR_WORDS * 4, stream) != hipSuccess) { fprintf(stderr, "kernel_launch: memset of the barrier words failed\n"); return; }
    Args a{};
    for (int i = 0; i < 26; ++i) a.in[i] = (const float*)d_in[i];
    a.out = (float*)d_out; a.ws = (unsigned char*)d_ws;
    void* args[] = {&a};
    hipError_t e = hipLaunchCooperativeKernel((const void*)mk_fwd, dim3(grid), dim3(NTHR), args, LDS_BYTES, stream);
    if (e != hipSuccess) fprintf(stderr, "cooperative launch failed: %s (grid %d)\n", hipGetErrorString(e), grid);
}
```
